# Optimizing an MI355X kernel written in HIP

```python
import math
import jax, jax.numpy as jnp
from jax import lax
import numpy as np

D_MODEL = 2048
BATCH = 2
SEQ = 4096
DEPTH = 2
DEC_BATCH = 2
DEC_SEQ = 16384
PAST_LEN = 128

CONV_CH = D_MODEL // 4
CONV_WIDTH = 3
ATT_HD = 64
ATT_VD = 2 * ATT_HD
ATT_WIDTH = D_MODEL // 2
ATT_HEADS = ATT_WIDTH // ATT_VD
ATT_QK = ATT_HEADS * 2 * ATT_HD
ROT_DIM = ATT_HD // 4
ROPE_THETA = 500000.0
Q_BLOCK = 128
MLP_WIDTH = D_MODEL // 4
CHUNK = 128
MLP_HD = 128
MLP_HEADS = MLP_WIDTH // MLP_HD
D_FF = 4 * D_MODEL
EPS = 1e-6
SPLIT_SIZES = (CONV_CH, CONV_CH, CONV_CH, ATT_QK, ATT_QK, ATT_WIDTH, MLP_WIDTH, MLP_WIDTH)
IN_WIDTH = 3 * CONV_CH + 2 * ATT_QK + ATT_WIDTH + 2 * MLP_WIDTH
MIX_WIDTH = CONV_CH + ATT_WIDTH + MLP_WIDTH

kernel_name = "hymba_conv_diffattn_gmlp_encoder"


def rms_norm(x, g):
    xf = x.astype(jnp.float32)
    y = xf * lax.rsqrt(jnp.mean(xf * xf, axis=-1, keepdims=True) + EPS)
    return (y * g.astype(jnp.float32)).astype(x.dtype)


def rope_tables(s):
    inv = ROPE_THETA ** (-jnp.arange(0, ROT_DIM, 2, dtype=jnp.float32) / ROT_DIM)
    ang = jnp.arange(s, dtype=jnp.float32)[:, None] * inv[None, :]
    return jnp.cos(ang), jnp.sin(ang)


def apply_partial_rope(x, cos, sin):
    half = ROT_DIM // 2
    xf = x.astype(jnp.float32)
    x1 = xf[..., :half]
    x2 = xf[..., half:ROT_DIM]
    c = cos[None, :, None, None, :]
    s = sin[None, :, None, None, :]
    out = jnp.concatenate([x1 * c - x2 * s, x2 * c + x1 * s, xf[..., ROT_DIM:]], axis=-1)
    return out.astype(x.dtype)


def short_conv_mixer(xa, gb, gc, w_conv):
    z = gc * xa
    zp = jnp.pad(z, ((0, 0), (1, 1), (0, 0)))
    conv = w_conv[0] * zp[:, :-2] + w_conv[1] * zp[:, 1:-1] + w_conv[2] * zp[:, 2:]
    return gb * conv


def diff_attention(q, k, v, lam, g_subln, lambda_init):
    b, s = q.shape[0], q.shape[1]
    nb = s // Q_BLOCK
    qb = q.reshape(b, nb, Q_BLOCK, ATT_HEADS, 2, ATT_HD).swapaxes(0, 1)
    scale = ATT_HD ** -0.5

    def block(qblk):
        sc = jnp.einsum('bqhcd,bkhcd->bhcqk', qblk, k).astype(jnp.float32) * scale
        p = jax.nn.softmax(sc, axis=-1)
        a = p[:, :, 0] - lam * p[:, :, 1]
        return jnp.einsum('bhqk,bkhe->bqhe', a.astype(v.dtype), v)

    o = lax.map(block, qb)
    o = o.swapaxes(0, 1).reshape(b, s, ATT_HEADS, ATT_VD)
    o = rms_norm(o, g_subln) * (1.0 - lambda_init)
    return o.reshape(b, s, ATT_WIDTH)


def chunk_spatial_gating(u, v, w_s, b_s, g_v):
    b, s, _ = u.shape
    n = s // CHUNK
    vn = rms_norm(v.reshape(b, n, CHUNK, MLP_HEADS, MLP_HD), g_v)
    mixed = jnp.einsum('hqp,bnphd->bnqhd', w_s, vn) + b_s.T[None, None, :, :, None]
    return u * mixed.reshape(b, s, MLP_WIDTH)


def encoder_layer(x, l, cos, sin, norm1_g, w_in, conv_w, q_norm_g, k_norm_g,
                  lam_q1, lam_k1, lam_q2, lam_k2, subln_g, sgu_norm_g, sgu_w, sgu_b,
                  w_out, norm2_g, w_up, w_down):
    b, s, _ = x.shape
    h = rms_norm(x, norm1_g[l])
    proj = h @ w_in[l]
    points = []
    acc = 0
    for sz in SPLIT_SIZES[:-1]:
        acc += sz
        points.append(acc)
    a_x, a_b, a_c, q, k, v, c_u, c_v = jnp.split(proj, points, axis=-1)

    out_a = short_conv_mixer(a_x, a_b, a_c, conv_w[l])

    q = q.reshape(b, s, ATT_HEADS, 2, ATT_HD)
    k = k.reshape(b, s, ATT_HEADS, 2, ATT_HD)
    v = v.reshape(b, s, ATT_HEADS, ATT_VD)
    q = apply_partial_rope(rms_norm(q, q_norm_g[l]), cos, sin)
    k = apply_partial_rope(rms_norm(k, k_norm_g[l]), cos, sin)
    lambda_init = 0.8 - 0.6 * math.exp(-0.3 * l)
    lam = (jnp.exp(jnp.sum(lam_q1[l].astype(jnp.float32) * lam_k1[l].astype(jnp.float32)))
           - jnp.exp(jnp.sum(lam_q2[l].astype(jnp.float32) * lam_k2[l].astype(jnp.float32)))
           + lambda_init)
    out_b = diff_attention(q, k, v, lam, subln_g[l], lambda_init)

    out_c = chunk_spatial_gating(jax.nn.gelu(c_u), jax.nn.gelu(c_v), sgu_w[l], sgu_b[l], sgu_norm_g[l])

    mixed = jnp.concatenate([out_a, out_b, out_c], axis=-1)
    x = x + mixed @ w_out[l]

    h2 = rms_norm(x, norm2_g[l])
    x = x + jnp.square(jax.nn.relu(h2 @ w_up[l])) @ w_down[l]
    return x


def run_trunk(x, norm1_g, w_in, conv_w, q_norm_g, k_norm_g, lam_q1, lam_k1, lam_q2, lam_k2,
              subln_g, sgu_norm_g, sgu_w, sgu_b, w_out, norm2_g, w_up, w_down):
    cos, sin = rope_tables(x.shape[1])
    for l in range(DEPTH):
        x = encoder_layer(x, l, cos, sin, norm1_g, w_in, conv_w, q_norm_g, k_norm_g,
                          lam_q1, lam_k1, lam_q2, lam_k2, subln_g, sgu_norm_g, sgu_w, sgu_b,
                          w_out, norm2_g, w_up, w_down)
    return x


def setup_inputs(seed: int = 0) -> dict:
    key = jax.random.key(seed)
    ks = jax.random.split(key, 20)
    f32 = jnp.float32

    def nrm(k, shape, scale):
        return jax.random.normal(k, shape, f32) * scale

    def gain(k, shape):
        return 1.0 + 0.02 * jax.random.normal(k, shape, f32)

    return {
        "x_prompt": nrm(ks[0], (BATCH, SEQ, D_MODEL), 1.0),
        "x_sample": nrm(ks[1], (DEC_BATCH, DEC_SEQ, D_MODEL), 1.0),
        "norm1_g": gain(ks[2], (DEPTH, D_MODEL)),
        "w_in": nrm(ks[3], (DEPTH, D_MODEL, IN_WIDTH), D_MODEL ** -0.5),
        "conv_w": nrm(ks[4], (DEPTH, CONV_WIDTH, CONV_CH), CONV_WIDTH ** -0.5),
        "q_norm_g": gain(ks[5], (DEPTH, ATT_HD)),
        "k_norm_g": gain(ks[6], (DEPTH, ATT_HD)),
        "lam_q1": nrm(ks[7], (DEPTH, ATT_HD), 0.1),
        "lam_k1": nrm(ks[8], (DEPTH, ATT_HD), 0.1),
        "lam_q2": nrm(ks[9], (DEPTH, ATT_HD), 0.1),
        "lam_k2": nrm(ks[10], (DEPTH, ATT_HD), 0.1),
        "subln_g": gain(ks[11], (DEPTH, ATT_VD)),
        "sgu_norm_g": gain(ks[12], (DEPTH, MLP_HD)),
        "sgu_w": nrm(ks[13], (DEPTH, MLP_HEADS, CHUNK, CHUNK), CHUNK ** -0.5),
        "sgu_b": 1.0 + nrm(ks[14], (DEPTH, MLP_HEADS, CHUNK), 0.01),
        "w_out": nrm(ks[15], (DEPTH, MIX_WIDTH, D_MODEL), MIX_WIDTH ** -0.5),
        "norm2_g": gain(ks[16], (DEPTH, D_MODEL)),
        "w_up": nrm(ks[17], (DEPTH, D_MODEL, D_FF), D_MODEL ** -0.5),
        "w_down": nrm(ks[18], (DEPTH, D_FF, D_MODEL), D_FF ** -0.5),
    }


def reference(x_prompt, x_sample, norm1_g, w_in, conv_w, q_norm_g, k_norm_g, lam_q1, lam_k1,
              lam_q2, lam_k2, subln_g, sgu_norm_g, sgu_w, sgu_b, w_out, norm2_g, w_up, w_down):
    y_prompt = run_trunk(x_prompt, norm1_g, w_in, conv_w, q_norm_g, k_norm_g, lam_q1, lam_k1,
                         lam_q2, lam_k2, subln_g, sgu_norm_g, sgu_w, sgu_b, w_out, norm2_g,
                         w_up, w_down)
    y_sample = run_trunk(x_sample, norm1_g, w_in, conv_w, q_norm_g, k_norm_g, lam_q1, lam_k1,
                         lam_q2, lam_k2, subln_g, sgu_norm_g, sgu_w, sgu_b, w_out, norm2_g,
                         w_up, w_down)
    return (y_prompt, y_sample)
```

```cpp
#include <hip/hip_runtime.h>
#include <hip/hip_cooperative_groups.h>
#include <hip/hip_bf16.h>
#include <cstdio>
#include <cstdint>
namespace cg = cooperative_groups;
namespace pg8 {
#define PG8_LAS __attribute__((address_space(3)))
typedef unsigned short bf16_t;
typedef short bf16x8 __attribute__((ext_vector_type(8)));
typedef float f32x4 __attribute__((ext_vector_type(4)));
typedef unsigned u32x4 __attribute__((ext_vector_type(4)));
constexpr int BM = 256, BK = 64, HALF = 128, HTB = HALF * BK * 2  , STAGE_BYTES = 8 * HTB, NXCD = 8, WGM = 8;

__host__ __device__ __forceinline__ int lds_byte(int r, int c) { const int st = (r >> 4) * 2 + (c >> 5), rr = r & 15, cc = c & 31, ob = rr * 64 + cc * 2; return st * 1024 + (ob ^ (((ob >> 9) & 1) << 5)); }
__host__ __device__ __forceinline__ void stage_rc(int b, int& R, int& C) { const int st = b / 1024, sb = b % 1024, swz = sb ^ (((sb >> 9) & 1) << 5); R = (st >> 1) * 16 + swz / 64; C = (st & 1) * 32 + (swz % 64) / 2; }
__host__ __device__ __forceinline__ int perm32(int rho) { const int n = rho >> 4, i = rho & 15; return 8 * (i >> 2) + 4 * n + (i & 3); }

struct Unit { int pm, pn; };
struct Gemm { const bf16_t* A; const bf16_t* Bt; int M, N, K; };

struct StaticOrder {
    int nM, nN, nwg, G, c;
    __host__ __device__ void init(int M, int N, int G_, int c_) { nM = M / BM; nN = N / BM; nwg = nM * nN; G = G_; c = c_; }
    __host__ __device__ bool next(int i, Unit& u) const {
        const long L = (long)i * G + c; if (L >= nwg) return false;
        int wgid = (int)L; { const int q = nwg / NXCD, r = nwg % NXCD, xcd = wgid % NXCD, off = wgid / NXCD; wgid = (xcd < r ? xcd * (q + 1) : r * (q + 1) + (xcd - r) * q) + off; }
        const int nig = WGM * nN, gid = wgid / nig, fm = gid * WGM, gsz = (nM - fm) < WGM ? (nM - fm) : WGM;
        u.pm = fm + ((wgid % nig) % gsz); u.pn = (wgid % nig) / gsz; return true;
    }
    __device__ __forceinline__ void a_ready(const Unit&) const {}
    __device__ __forceinline__ void done(const Unit&) const {}
};

__device__ __forceinline__ unsigned cvt_pk_bf16(float lo, float hi) { unsigned r; asm volatile("v_cvt_pk_bf16_f32 %0, %1, %2" : "=v"(r) : "v"(lo), "v"(hi)); return r; }
typedef float f32x2 __attribute__((ext_vector_type(2)));
typedef unsigned u32x2 __attribute__((ext_vector_type(2)));
template <int ACT> struct EpiBf16 {
    static constexpr bool PERM = true, AFTER_DRAIN = false;
    bf16_t* O; int ldc;
    __device__ __forceinline__ void operator()(const f32x4 (&acc)[2][2][4][2], const Unit& u, int wr, int wc, int fr, int fq) const {
        const int row0 = u.pm * BM + wr * 64 + fr; const int col0 = u.pn * BM + wc * 32 + 8 * fq;
#pragma unroll
        for (int ai = 0; ai < 2; ++ai)
#pragma unroll
            for (int m = 0; m < 4; ++m) { bf16_t* rowp = O + (size_t)(row0 + ai * HALF + m * 16) * ldc + col0;
#pragma unroll
                for (int bj = 0; bj < 2; ++bj) { f32x4 v0 = acc[ai][bj][m][0], v1 = acc[ai][bj][m][1];
                    if (ACT == 2) {
#pragma unroll
                        for (int e = 0; e < 4; ++e) { float a = fmaxf(v0[e], 0.f), b = fmaxf(v1[e], 0.f); v0[e] = a * a; v1[e] = b * b; } }
                    u32x4 w; w.x = cvt_pk_bf16(v0[0], v0[1]); w.y = cvt_pk_bf16(v0[2], v0[3]); w.z = cvt_pk_bf16(v1[0], v1[1]); w.w = cvt_pk_bf16(v1[2], v1[3]);
                    *(u32x4*)(rowp + bj * HALF) = w; } }
    }
};
struct EpiResF32 {
    static constexpr bool PERM = false, AFTER_DRAIN = false;
    const float* res_lo; const float* res_hi; int split_pm; float* out; int ldc;
    __device__ __forceinline__ void operator()(const f32x4 (&acc)[2][2][4][2], const Unit& u, int wr, int wc, int fr, int fq) const {
        const float* rbase = (u.pm < split_pm) ? res_lo : (res_hi - (size_t)split_pm * BM * ldc);
        const int col0 = u.pn * BM + wc * 32 + 4 * fq;
#pragma unroll
        for (int ai = 0; ai < 2; ++ai)
#pragma unroll
            for (int m = 0; m < 4; ++m) { const size_t off = (size_t)(u.pm * BM + ai * HALF + wr * 64 + m * 16 + fr) * ldc + col0;
#pragma unroll
                for (int bj = 0; bj < 2; ++bj)
#pragma unroll
                    for (int n = 0; n < 2; ++n) { const f32x4 bs = *(const f32x4*)(rbase + off + bj * HALF + n * 16); *(f32x4*)(out + off + bj * HALF + n * 16) = bs + acc[ai][bj][m][n]; }
                asm volatile("" ::: "memory"); }
    }
};
template <class Epi, class Sched, bool ALIGN_EPI = false, bool SP2 = false>
__device__ __forceinline__ void gemm_phase(PG8_LAS unsigned char* lds, const Gemm g, const Sched& S, const Epi& E) {
    int tid = threadIdx.x; asm volatile("" : "+v"(tid));
    const int wid = __builtin_amdgcn_readfirstlane(tid >> 6), lane = tid & 63, wr = wid >> 2, wc = wid & 3, fr = lane & 15, fq = lane >> 4;
    const int K = g.K, nt = K / BK;
    unsigned voffA[2], voffB[2];
#pragma unroll
    for (int i = 0; i < 2; ++i) { int R, C; stage_rc(tid * 16 + i * 8192, R, C); const int Rb = Epi::PERM ? ((R & ~31) + perm32(R & 31)) : R;
        voffA[i] = (unsigned)(R * K + C) * 2u; voffB[i] = (unsigned)(Rb * K + C) * 2u; }
    const size_t kstep = (size_t)(BK * 2);
    const size_t hstep = (size_t)HALF * K * 2;
    const size_t tstep = 2 * hstep;
    const unsigned ldsw = (unsigned)wid * 1024u;
    const int aoff = lds_byte(wr * 64 + fr, fq * 8), boff = lds_byte(wc * 32 + fr, fq * 8);
#define PG8_SA(b, h) (((b) * 2 + (h)) * HTB)
#define PG8_SB(b, h) ((4 + (b) * 2 + (h)) * HTB)
#define PG8_STAGE(bufoff, gbase, voff) do { _Pragma("unroll") for (int _i = 0; _i < 2; ++_i) \
        __builtin_amdgcn_global_load_lds((const unsigned*)((const char*)(gbase) + (voff)[_i]), (PG8_LAS unsigned*)(lds + (bufoff) + ldsw + _i * 8192), 16, 0, 0); } while (0)
#define PG8_LDA(dst, b, h) do { _Pragma("unroll") for (int m = 0; m < 4; ++m) _Pragma("unroll") for (int k = 0; k < 2; ++k) dst[m][k] = *(const PG8_LAS bf16x8*)(lds + PG8_SA(b, h) + aoff + m * 2048 + k * 1024); } while (0)
#define PG8_LDB(dst, b, h) do { _Pragma("unroll") for (int n = 0; n < 2; ++n) _Pragma("unroll") for (int k = 0; k < 2; ++k) dst[n][k] = *(const PG8_LAS bf16x8*)(lds + PG8_SB(b, h) + boff + n * 2048 + k * 1024); } while (0)
#define PG8_MMA(ai, bj, At, Bt) do { __builtin_amdgcn_s_setprio(1); _Pragma("unroll") for (int m = 0; m < 4; ++m) _Pragma("unroll") for (int n = 0; n < 2; ++n) _Pragma("unroll") for (int k = 0; k < 2; ++k) \
        acc[ai][bj][m][n] = __builtin_amdgcn_mfma_f32_16x16x32_bf16(Bt[n][k], At[m][k], acc[ai][bj][m][n], 0, 0, 0); __builtin_amdgcn_s_setprio(0); } while (0)
#define PG8_WAIT_V(n) asm volatile("s_waitcnt vmcnt(" #n ")" ::: "memory")
#define PG8_WAIT_L(n) asm volatile("s_waitcnt lgkmcnt(" #n ")" ::: "memory")
#define PG8_BAR __builtin_amdgcn_s_barrier()
#define PG8_SCHED __builtin_amdgcn_sched_barrier(0)
    Unit cur, nxt; int ui = 0;
    if (!S.next(0, cur)) return;
    f32x4 acc[2][2][4][2];
#pragma unroll
    for (int a = 0; a < 2; ++a)
#pragma unroll
        for (int b = 0; b < 2; ++b)
#pragma unroll
            for (int m = 0; m < 4; ++m)
#pragma unroll
                for (int n = 0; n < 2; ++n) acc[a][b][m][n] = (f32x4){0.f, 0.f, 0.f, 0.f};
    bf16x8 At[4][2], B0[2][2], B1[2][2];
    const char* cA = (const char*)g.A + (size_t)cur.pm * tstep; const char* cB = (const char*)g.Bt + (size_t)cur.pn * tstep;
    S.a_ready(cur);
    if constexpr (SP2) {
        PG8_STAGE(PG8_SB(0, 0), cB, voffB); PG8_STAGE(PG8_SB(0, 1), cB + hstep, voffB); PG8_STAGE(PG8_SA(0, 0), cA, voffA); PG8_STAGE(PG8_SA(0, 1), cA + hstep, voffA);
        if (wr == 1) PG8_BAR;
        PG8_WAIT_V(2); PG8_BAR;
        PG8_STAGE(PG8_SB(1, 0), cB + kstep, voffB); PG8_STAGE(PG8_SA(1, 0), cA + kstep, voffA); PG8_STAGE(PG8_SB(1, 1), cB + hstep + kstep, voffB);
        PG8_WAIT_V(6); PG8_BAR;
    } else {
        PG8_STAGE(PG8_SB(0, 0), cB, voffB); PG8_STAGE(PG8_SA(0, 0), cA, voffA); PG8_STAGE(PG8_SB(0, 1), cB + hstep, voffB); PG8_STAGE(PG8_SA(0, 1), cA + hstep, voffA);
        if (wr == 1) PG8_BAR;
        PG8_WAIT_V(4); PG8_BAR;
        PG8_STAGE(PG8_SB(1, 0), cB + kstep, voffB); PG8_STAGE(PG8_SA(1, 0), cA + kstep, voffA); PG8_STAGE(PG8_SB(1, 1), cB + hstep + kstep, voffB);
        PG8_WAIT_V(6); PG8_BAR;
    }
    for (;;) {
        const bool has_next = S.next(ui + 1, nxt);
        const char* nA = has_next ? (const char*)g.A + (size_t)nxt.pm * tstep : cA; const char* nB = has_next ? (const char*)g.Bt + (size_t)nxt.pn * tstep : cB;
        for (int t = 0; t < nt; t += 2) {
            const bool last = (t == nt - 2);
            const char* a1 = cA + (size_t)(t + 1) * kstep;
            const char* a2 = last ? nA : cA + (size_t)(t + 2) * kstep; const char* b2 = last ? nB : cB + (size_t)(t + 2) * kstep;
            const char* a3 = a2 + kstep; const char* b3 = b2 + kstep;
            if (last && has_next) S.a_ready(nxt);
            if constexpr (SP2) {
            PG8_LDB(B0, 0, 0); PG8_LDB(B1, 0, 1); PG8_SCHED; PG8_LDA(At, 0, 0); PG8_STAGE(PG8_SA(1, 1), a1 + hstep, voffA);
            PG8_WAIT_V(8); PG8_WAIT_L(0); PG8_BAR; PG8_MMA(0, 0, At, B0); PG8_MMA(0, 1, At, B1); PG8_BAR; PG8_SCHED;
            PG8_LDA(At, 0, 1); PG8_STAGE(PG8_SB(0, 0), b2, voffB); PG8_STAGE(PG8_SB(0, 1), b2 + hstep, voffB); PG8_STAGE(PG8_SA(0, 0), a2, voffA);
            PG8_WAIT_V(8); PG8_WAIT_L(0); PG8_BAR; PG8_MMA(1, 0, At, B0); PG8_MMA(1, 1, At, B1); PG8_BAR; PG8_SCHED;
            PG8_LDB(B0, 1, 0); PG8_LDB(B1, 1, 1); PG8_SCHED; PG8_LDA(At, 1, 0); PG8_STAGE(PG8_SA(0, 1), a2 + hstep, voffA);
            PG8_WAIT_V(8); PG8_WAIT_L(0); PG8_BAR; PG8_MMA(0, 0, At, B0); PG8_MMA(0, 1, At, B1); PG8_BAR; PG8_SCHED;
            PG8_LDA(At, 1, 1); PG8_STAGE(PG8_SB(1, 0), b3, voffB); PG8_STAGE(PG8_SB(1, 1), b3 + hstep, voffB); PG8_STAGE(PG8_SA(1, 0), a3, voffA);
            PG8_WAIT_V(8); PG8_WAIT_L(0); PG8_BAR; PG8_MMA(1, 0, At, B0); PG8_MMA(1, 1, At, B1); PG8_BAR; PG8_SCHED;
            } else {
            PG8_LDB(B0, 0, 0); PG8_SCHED; PG8_LDA(At, 0, 0); PG8_STAGE(PG8_SA(1, 1), a1 + hstep, voffA);
            PG8_WAIT_L(8); PG8_BAR; PG8_WAIT_L(0); PG8_MMA(0, 0, At, B0); PG8_BAR; PG8_SCHED;
            PG8_LDB(B1, 0, 1); PG8_STAGE(PG8_SB(0, 0), b2, voffB);
            PG8_BAR; PG8_WAIT_L(0); PG8_MMA(0, 1, At, B1); PG8_BAR;
            PG8_LDA(At, 0, 1); PG8_STAGE(PG8_SA(0, 0), a2, voffA);
            PG8_BAR; PG8_WAIT_L(0); PG8_MMA(1, 0, At, B0); PG8_BAR; PG8_SCHED;
            PG8_STAGE(PG8_SB(0, 1), b2 + hstep, voffB);
            PG8_WAIT_V(6); PG8_BAR; PG8_MMA(1, 1, At, B1); PG8_BAR;
            PG8_LDB(B0, 1, 0); PG8_SCHED; PG8_LDA(At, 1, 0); PG8_STAGE(PG8_SA(0, 1), a2 + hstep, voffA);
            PG8_WAIT_L(8); PG8_BAR; PG8_WAIT_L(0); PG8_MMA(0, 0, At, B0); PG8_BAR; PG8_SCHED;
            PG8_LDB(B1, 1, 1); PG8_STAGE(PG8_SB(1, 0), b3, voffB);
            PG8_BAR; PG8_WAIT_L(0); PG8_MMA(0, 1, At, B1); PG8_BAR;
            PG8_LDA(At, 1, 1); PG8_STAGE(PG8_SA(1, 0), a3, voffA);
            PG8_BAR; PG8_WAIT_L(0); PG8_MMA(1, 0, At, B0); PG8_BAR; PG8_SCHED;
            PG8_STAGE(PG8_SB(1, 1), b3 + hstep, voffB);
            PG8_WAIT_V(6); PG8_BAR; PG8_MMA(1, 1, At, B1); PG8_BAR;
            }
        }
        if constexpr (ALIGN_EPI) { if (wr == 0) PG8_BAR; }
        if constexpr (!Epi::AFTER_DRAIN) { E(acc, cur, wr, wc, fr, fq); S.done(cur); }
        if (!has_next) break;
#pragma unroll
        for (int a = 0; a < 2; ++a)
#pragma unroll
            for (int b = 0; b < 2; ++b)
#pragma unroll
                for (int m = 0; m < 4; ++m)
#pragma unroll
                    for (int n = 0; n < 2; ++n) acc[a][b][m][n] = (f32x4){0.f, 0.f, 0.f, 0.f};
        cur = nxt; cA = nA; cB = nB; ++ui;
        if constexpr (ALIGN_EPI) { if (wr == 1) PG8_BAR; }
    }
    PG8_WAIT_V(0);
    if constexpr (!ALIGN_EPI) { if (wr == 0) PG8_BAR; }
    PG8_BAR;
    if constexpr (Epi::AFTER_DRAIN) { E.fused(acc, cur, wr, wc, fr, fq, lds, wid, lane); S.done(cur); }
#undef PG8_SA
#undef PG8_SB
#undef PG8_STAGE
#undef PG8_LDA
#undef PG8_LDB
#undef PG8_MMA
#undef PG8_WAIT_V
#undef PG8_WAIT_L
#undef PG8_BAR
#undef PG8_SCHED
}
}

#ifndef PHM
#define PHM 127
#endif
#ifndef MK_SINGLE
#define MK_SINGLE 1
#endif
constexpr int DM = 2048, MP = 8192, M_ALL = 40960, SEQ_P = 4096, SEQ_S = 16384, INW = 5632, DFF = 8192, NLAYER = 2;
constexpr int OFF_AX = 0, OFF_AB = 512, OFF_AC = 1024, OFF_Q = 1536, OFF_K = 2560, OFF_V = 3584, OFF_CU = 4608, OFF_CV = 5120;
constexpr int MIX_A = 0, MIX_B = 512, MIX_C = 1536;
constexpr float EPS = 1e-6f;
constexpr float C2 = 0.18033688011112042f;
constexpr size_t MiB = 1u << 20;
constexpr size_t WS_WT = 1 * MiB, WT_LAYER = 94 * MiB, WT_IN = 0, WT_OUT = 22 * MiB, WT_UP = 30 * MiB, WT_DN = 62 * MiB;
constexpr size_t WS_XN = 190 * MiB, WS_H = 352 * MiB, WS_PROJ = 352 * MiB, WS_MIX = 792 * MiB, WS_END = 992 * MiB;
static_assert(WS_WT + 2 * WT_LAYER <= WS_XN && WS_XN + (size_t)M_ALL * DM * 2 <= WS_H && WS_PROJ + (size_t)M_ALL * INW * 2 <= WS_MIX && WS_MIX + (size_t)M_ALL * DM * 2 <= WS_END && WS_H + (size_t)M_ALL * DFF * 2 <= WS_END, "ws map");
constexpr int NWAVES = 8, LDS_BYTES = 147456;

typedef unsigned short bf16;
typedef unsigned v4u __attribute__((ext_vector_type(4)));
typedef unsigned v2u __attribute__((ext_vector_type(2)));
typedef float f32x4 __attribute__((ext_vector_type(4)));
#define DI __device__ __forceinline__

DI unsigned pk2(float lo, float hi) { return pg8::cvt_pk_bf16(lo, hi); }
DI float bflo(unsigned u) { return __uint_as_float(u << 16); }
DI float bfhi(unsigned u) { return __uint_as_float(u & 0xffff0000u); }
DI float wave_sum(float v) {
#pragma unroll
    for (int o = 1; o < 64; o <<= 1) v += __shfl_xor(v, o);
    return v;
}
DI float wave_max(float v) {
#pragma unroll
    for (int o = 1; o < 64; o <<= 1) v = fmaxf(v, __shfl_xor(v, o));
    return v;
}
DI float gelu_tanh(float x) {
    const float z = x * (0.7978845608028654f + 0.035677408136300125f * x * x);
    const float e = __builtin_amdgcn_exp2f(-2.8853900817779268f * z);
    return x * __builtin_amdgcn_rcpf(1.0f + e);
}

DI void transpose_item(const float* W, int K, int N, bf16* WT, float* scr, int item, int lane) {
    const int nblk = N / 32, kb = item / nblk, nb = item % nblk, k0 = 64 * kb, n0 = 32 * nb;
#pragma unroll 8
    for (int i = 0; i < 32; ++i) { const int kk = 2 * i + (lane >> 5); scr[kk * 33 + (lane & 31)] = W[(size_t)(k0 + kk) * N + n0 + (lane & 31)]; }
    asm volatile("s_waitcnt lgkmcnt(0)" ::: "memory");
    const int c = lane & 7;
#pragma unroll
    for (int j = 0; j < 4; ++j) { const int n = (lane >> 3) + 8 * j; const float* s = scr + (8 * c) * 33 + n;
        v4u o; o.x = pk2(s[0 * 33], s[1 * 33]); o.y = pk2(s[2 * 33], s[3 * 33]); o.z = pk2(s[4 * 33], s[5 * 33]); o.w = pk2(s[6 * 33], s[7 * 33]);
        *(v4u*)(WT + (size_t)(n0 + n) * K + k0 + 8 * c) = o; }
    asm volatile("s_waitcnt lgkmcnt(0)" ::: "memory");
}
DI void norm_row(const float* xrow, const float* g, bf16* orow, int lane) {
    const f32x4* xr = (const f32x4*)xrow + lane; const f32x4* gr = (const f32x4*)g + lane;
    f32x4 v[8]; float s = 0.f;
#pragma unroll
    for (int j = 0; j < 8; ++j) { v[j] = xr[64 * j]; s += (v[j].x * v[j].x + v[j].y * v[j].y) + (v[j].z * v[j].z + v[j].w * v[j].w); }
    const float rstd = 1.0f / sqrtf(wave_sum(s) * (1.f / DM) + EPS);
    v2u* o8 = (v2u*)orow + lane;
#pragma unroll
    for (int j = 0; j < 8; ++j) { const f32x4 gg = gr[64 * j]; v2u w; w.x = pk2(v[j].x * rstd * gg.x, v[j].y * rstd * gg.y); w.y = pk2(v[j].z * rstd * gg.z, v[j].w * rstd * gg.w); o8[64 * j] = w; }
}

__constant__ double ROPE_INV[8] = {1.0, 0.19392274474868576, 0.03760603093086393, 0.007292664737217109, 0.001414213562373095, 0.0002742481756762073, 5.318295896944988e-05, 1.031338537721246e-05};
DI void qk_row(bf16* P, int row, int pos, const float* qg, const float* kg, int lane) {
    bf16* p = P + (size_t)row * INW + OFF_Q + lane * 32;
    v4u raw[4];
#pragma unroll
    for (int i = 0; i < 4; ++i) raw[i] = *(const v4u*)(p + 8 * i);
    float x[32];
#pragma unroll
    for (int i = 0; i < 4; ++i) { x[8 * i + 0] = bflo(raw[i].x); x[8 * i + 1] = bfhi(raw[i].x); x[8 * i + 2] = bflo(raw[i].y); x[8 * i + 3] = bfhi(raw[i].y);
        x[8 * i + 4] = bflo(raw[i].z); x[8 * i + 5] = bfhi(raw[i].z); x[8 * i + 6] = bflo(raw[i].w); x[8 * i + 7] = bfhi(raw[i].w); }
    float ss = 0.f;
#pragma unroll
    for (int i = 0; i < 32; ++i) ss += x[i] * x[i];
    ss += __shfl_xor(ss, 1);
    const float rstd = 1.0f / sqrtf(ss * (1.f / 64.f) + EPS);
    const bool isq = lane < 32; const int half = lane & 1;
    const float* g = (isq ? qg : kg) + half * 32;
#pragma unroll
    for (int i = 0; i < 8; ++i) { const f32x4 gg = *(const f32x4*)(g + 4 * i); x[4 * i] *= rstd * gg.x; x[4 * i + 1] *= rstd * gg.y; x[4 * i + 2] *= rstd * gg.z; x[4 * i + 3] *= rstd * gg.w; }
    const double t = (double)pos * ROPE_INV[lane & 7] * 0.15915494309189535;
    const float fr = (float)(t - rint(t));
    const float cs = __builtin_amdgcn_cosf(fr), sn = __builtin_amdgcn_sinf(fr);
#pragma unroll
    for (int i = 0; i < 8; ++i) { const float c = __shfl(cs, i), s = __shfl(sn, i);
        if (half == 0) { const float a = x[i], b = x[i + 8]; x[i] = a * c - b * s; x[i + 8] = b * c + a * s; } }
    const float sc = isq ? C2 : 1.0f;
#pragma unroll
    for (int i = 0; i < 4; ++i) { v4u w; w.x = pk2(x[8 * i] * sc, x[8 * i + 1] * sc); w.y = pk2(x[8 * i + 2] * sc, x[8 * i + 3] * sc); w.z = pk2(x[8 * i + 4] * sc, x[8 * i + 5] * sc); w.w = pk2(x[8 * i + 6] * sc, x[8 * i + 7] * sc);
        *(v4u*)(p + 8 * i) = w; }
}
DI void unpack8(const v4u r, float* x) { x[0] = bflo(r.x); x[1] = bfhi(r.x); x[2] = bflo(r.y); x[3] = bfhi(r.y); x[4] = bflo(r.z); x[5] = bfhi(r.z); x[6] = bflo(r.w); x[7] = bfhi(r.w); }
DI void conv_row(const bf16* P, bf16* MIX, int row, int pos, int S, const float* cw, int lane) {
    const bf16* p = P + (size_t)row * INW + lane * 8;
    const v4u z4 = {0u, 0u, 0u, 0u};
    const v4u xa0 = *(const v4u*)(p + OFF_AX), gc0 = *(const v4u*)(p + OFF_AC), gb0 = *(const v4u*)(p + OFF_AB);
    const v4u xam = pos > 0 ? *(const v4u*)(p - INW + OFF_AX) : z4, gcm = pos > 0 ? *(const v4u*)(p - INW + OFF_AC) : z4;
    const v4u xap = pos < S - 1 ? *(const v4u*)(p + INW + OFF_AX) : z4, gcp = pos < S - 1 ? *(const v4u*)(p + INW + OFF_AC) : z4;
    float a0[8], c0[8], b0[8], am[8], cm[8], ap[8], cp[8];
    unpack8(xa0, a0); unpack8(gc0, c0); unpack8(gb0, b0); unpack8(xam, am); unpack8(gcm, cm); unpack8(xap, ap); unpack8(gcp, cp);
    float w0[8], w1[8], w2[8];
#pragma unroll
    for (int i = 0; i < 2; ++i) { const f32x4 a = *(const f32x4*)(cw + lane * 8 + 4 * i), b = *(const f32x4*)(cw + 512 + lane * 8 + 4 * i), c = *(const f32x4*)(cw + 1024 + lane * 8 + 4 * i);
        w0[4 * i] = a.x; w0[4 * i + 1] = a.y; w0[4 * i + 2] = a.z; w0[4 * i + 3] = a.w; w1[4 * i] = b.x; w1[4 * i + 1] = b.y; w1[4 * i + 2] = b.z; w1[4 * i + 3] = b.w;
        w2[4 * i] = c.x; w2[4 * i + 1] = c.y; w2[4 * i + 2] = c.z; w2[4 * i + 3] = c.w; }
    float o[8];
#pragma unroll
    for (int j = 0; j < 8; ++j) o[j] = b0[j] * (w0[j] * (cm[j] * am[j]) + w1[j] * (c0[j] * a0[j]) + w2[j] * (cp[j] * ap[j]));
    v4u w; w.x = pk2(o[0], o[1]); w.y = pk2(o[2], o[3]); w.z = pk2(o[4], o[5]); w.w = pk2(o[6], o[7]);
    *(v4u*)(MIX + (size_t)row * DM + MIX_A + lane * 8) = w;
}

namespace att {
using bf16x8 = __attribute__((ext_vector_type(8))) short;
using s16x4  = __attribute__((ext_vector_type(4))) short;
using f32x16 = __attribute__((ext_vector_type(16))) float;
using u32x4  = __attribute__((ext_vector_type(4))) unsigned;
constexpr int KVBLK = 64;
constexpr int SHM_V = 16384, SHM_K = 16384, SCR_OFF = 65536;
#define KSWZ(row, colB) ((row) * 256 + ((colB) ^ (((row) & 7) << 4)))
#define SBAR() __builtin_amdgcn_sched_barrier(0)
DI int crow(int r, int hi) { return (r & 3) + 8 * (r >> 2) + 4 * hi; }
DI unsigned cvtpk(float lo, float hi) { unsigned r; asm volatile("v_cvt_pk_bf16_f32 %0, %1, %2" : "=v"(r) : "v"(lo), "v"(hi)); return r; }
DI int v_st(int k, int c) { const int kk = (k & ~0xC) | ((k & 4) << 1) | ((k & 8) >> 1); return ((kk >> 3) * 4 + (c >> 5)) * 512 + ((kk & 7) * 32 + (c & 31)) * 2; }
DI int v_rd_base(int lane) { return ((lane & 3) << 3) | (((lane >> 2) & 3) << 6) | (((lane >> 4) & 1) << 5) | (((lane >> 5) & 1) << 8); }
constexpr int v_rd_off(int d0, int ks, int half) { return d0 * 512 + ks * 4096 + half * 2048; }
template <int OFF> DI s16x4 tr_read(int vb) { s16x4 r; asm volatile("ds_read_b64_tr_b16 %0, %1 offset:%2" : "=&v"(r) : "v"(vb), "i"(OFF) : "memory"); return r; }
template <int D0> DI void pv_one(f32x16& od, int vb, bf16x8 pa0, bf16x8 pa1, bf16x8 pa2, bf16x8 pa3) {
  const s16x4 l0 = tr_read<v_rd_off(D0, 0, 0)>(vb), h0 = tr_read<v_rd_off(D0, 0, 1)>(vb), l1 = tr_read<v_rd_off(D0, 1, 0)>(vb), h1 = tr_read<v_rd_off(D0, 1, 1)>(vb);
  const s16x4 l2 = tr_read<v_rd_off(D0, 2, 0)>(vb), h2 = tr_read<v_rd_off(D0, 2, 1)>(vb), l3 = tr_read<v_rd_off(D0, 3, 0)>(vb), h3 = tr_read<v_rd_off(D0, 3, 1)>(vb);
  asm volatile("s_waitcnt lgkmcnt(0)" ::: "memory"); SBAR();
#define PK(L, H) (bf16x8){L[0], L[1], L[2], L[3], H[0], H[1], H[2], H[3]}
  od = __builtin_amdgcn_mfma_f32_32x32x16_bf16(pa0, PK(l0, h0), od, 0, 0, 0);
  od = __builtin_amdgcn_mfma_f32_32x32x16_bf16(pa1, PK(l1, h1), od, 0, 0, 0);
  od = __builtin_amdgcn_mfma_f32_32x32x16_bf16(pa2, PK(l2, h2), od, 0, 0, 0);
  od = __builtin_amdgcn_mfma_f32_32x32x16_bf16(pa3, PK(l3, h3), od, 0, 0, 0);
#undef PK
}
DI void pv_d0(f32x16* o, int vb, bf16x8 pa0, bf16x8 pa1, bf16x8 pa2, bf16x8 pa3) {
  pv_one<0>(o[0], vb, pa0, pa1, pa2, pa3); pv_one<1>(o[1], vb, pa0, pa1, pa2, pa3); pv_one<2>(o[2], vb, pa0, pa1, pa2, pa3); pv_one<3>(o[3], vb, pa0, pa1, pa2, pa3);
}
DI void qkt(f32x16& p0, f32x16& p1, const char* Ks, const bf16x8* qr, int r32, int hi, int c, float negmb) {
#pragma unroll
  for (int r = 0; r < 16; ++r) { p0[r] = negmb; p1[r] = negmb; }
#pragma unroll
  for (int d0 = 0; d0 < 4; ++d0) { const int cb = (c * 64 + d0 * 16 + hi * 8) * 2;
    const bf16x8 b0 = *reinterpret_cast<const bf16x8*>(Ks + KSWZ(r32, cb));
    const bf16x8 b1 = *reinterpret_cast<const bf16x8*>(Ks + KSWZ(32 + r32, cb));
    p0 = __builtin_amdgcn_mfma_f32_32x32x16_bf16(b0, qr[d0], p0, 0, 0, 0);
    p1 = __builtin_amdgcn_mfma_f32_32x32x16_bf16(b1, qr[d0], p1, 0, 0, 0); }
}
DI void expA(f32x16& p0) {
#pragma unroll
  for (int r = 0; r < 16; ++r) p0[r] = __builtin_amdgcn_exp2f(p0[r]);
}
DI void finishSM(f32x16& p0, f32x16& p1, float& l_reg, bf16x8& pa0, bf16x8& pa1, bf16x8& pa2, bf16x8& pa3) {
#pragma unroll
  for (int r = 0; r < 16; ++r) p1[r] = __builtin_amdgcn_exp2f(p1[r]);
  float ps = 0.f;
#pragma unroll
  for (int r = 0; r < 16; ++r) ps += p0[r];
#pragma unroll
  for (int r = 0; r < 16; ++r) ps += p1[r];
  l_reg += ps;
#define PK4(P, BASE, OUT) do { unsigned a0 = cvtpk(P[BASE + 0], P[BASE + 1]), a1 = cvtpk(P[BASE + 2], P[BASE + 3]);   \
    unsigned b0 = cvtpk(P[BASE + 4], P[BASE + 5]), b1 = cvtpk(P[BASE + 6], P[BASE + 7]);                              \
    auto r0 = __builtin_amdgcn_permlane32_swap(a0, b0, false, false); auto r1 = __builtin_amdgcn_permlane32_swap(a1, b1, false, false); \
    u32x4 w = {r0[0], r1[0], r0[1], r1[1]}; OUT = *reinterpret_cast<bf16x8*>(&w); } while (0)
  PK4(p0, 0, pa0); PK4(p0, 8, pa1); PK4(p1, 0, pa2); PK4(p1, 8, pa3);
#undef PK4
}
DI void attn_unit(const bf16* __restrict__ Qb, const bf16* __restrict__ Kh, const bf16* __restrict__ Vh, bf16* __restrict__ Ob, int seq, char* lds,
                  float negmb, float lam, const float* __restrict__ gsub, float post) {
  int tid = threadIdx.x; asm volatile("" : "+v"(tid));
  const int wid = tid >> 6, lane = tid & 63, r32 = lane & 31, hi = lane >> 5, c = wid >> 2, wq = wid & 3;
  char* V_lds = lds; char* K_lds = lds + 2 * SHM_V;
  float* wsf = (float*)(lds + SCR_OFF) + wid * 64;
  float l_reg = 0.f; f32x16 o[4] = {}; bf16x8 qr[4];
  const bf16* Qw = Qb + (size_t)(wq * 32 + r32) * INW + c * 64 + hi * 8;
#pragma unroll
  for (int d0 = 0; d0 < 4; ++d0) qr[d0] = *reinterpret_cast<const bf16x8*>(Qw + d0 * 16);
  const int sr = tid >> 4, sc = (tid & 15) * 8, vst0 = v_st(sr, sc), vst1 = v_st(32 + sr, sc);
  const int vb0 = (int)(uintptr_t)V_lds + v_rd_base(lane);
  constexpr int SDEPTH = 1, SE = 0, SO = SDEPTH - 1;
  struct { bf16x8 vs0, vs1, ks0, ks1; } sr_[SDEPTH];
#define SLOAD(i, k0) do { sr_[i].vs0 = *reinterpret_cast<const bf16x8*>(&Vh[(size_t)((k0) + sr) * INW + sc]); sr_[i].vs1 = *reinterpret_cast<const bf16x8*>(&Vh[(size_t)((k0) + 32 + sr) * INW + sc]); \
    sr_[i].ks0 = *reinterpret_cast<const bf16x8*>(&Kh[(size_t)((k0) + sr) * INW + sc]); sr_[i].ks1 = *reinterpret_cast<const bf16x8*>(&Kh[(size_t)((k0) + 32 + sr) * INW + sc]); } while (0)
#define SWRITE(b, i) do { *(bf16x8*)(V_lds + (b) * SHM_V + vst0) = sr_[i].vs0; *(bf16x8*)(V_lds + (b) * SHM_V + vst1) = sr_[i].vs1; const int kc = sc * 2; \
    *(bf16x8*)(K_lds + (b) * SHM_K + KSWZ(sr, kc)) = sr_[i].ks0; *(bf16x8*)(K_lds + (b) * SHM_K + KSWZ(32 + sr, kc)) = sr_[i].ks1; } while (0)
#define SWAIT() do { if constexpr (SDEPTH == 2) asm volatile("s_waitcnt vmcnt(4)" ::: "memory"); else asm volatile("s_waitcnt vmcnt(0)" ::: "memory"); } while (0)
  f32x16 pA0, pA1, pB0, pB1; bf16x8 pa0, pa1, pa2, pa3; const int NT = seq / KVBLK;
  SLOAD(SE, 0); asm volatile("s_waitcnt vmcnt(0)" ::: "memory"); SWRITE(0, SE); __syncthreads();
  qkt(pA0, pA1, K_lds, qr, r32, hi, c, negmb); expA(pA0);
  SLOAD(SO, KVBLK); if constexpr (SDEPTH == 2) { if (2 < NT) SLOAD(SE, 2 * KVBLK); }
  SWAIT(); SWRITE(1, SO); __syncthreads();
  for (int j = 1; j + 1 < NT; j += 2) {
    SBAR(); qkt(pB0, pB1, K_lds + SHM_K, qr, r32, hi, c, negmb);
    finishSM(pA0, pA1, l_reg, pa0, pa1, pa2, pa3); SBAR();
    SLOAD(SO, (j + SDEPTH) * KVBLK); SBAR();
    pv_d0(o, vb0, pa0, pa1, pa2, pa3); expA(pB0);
    __syncthreads(); SWAIT(); SWRITE(0, SE);
    __syncthreads();
    SBAR(); qkt(pA0, pA1, K_lds, qr, r32, hi, c, negmb);
    finishSM(pB0, pB1, l_reg, pa0, pa1, pa2, pa3); SBAR();
    if (SDEPTH == 1 || j + 3 < NT) SLOAD(SE, (j + 1 + SDEPTH) * KVBLK); SBAR();
    pv_d0(o, vb0 + SHM_V, pa0, pa1, pa2, pa3); expA(pA0);
    __syncthreads(); SWAIT(); SWRITE(1, SO);
    __syncthreads();
  }
  SBAR(); qkt(pB0, pB1, K_lds + SHM_K, qr, r32, hi, c, negmb);
  finishSM(pA0, pA1, l_reg, pa0, pa1, pa2, pa3); SBAR();
  pv_d0(o, vb0, pa0, pa1, pa2, pa3); expA(pB0);
  finishSM(pB0, pB1, l_reg, pa0, pa1, pa2, pa3); SBAR();
  pv_d0(o, vb0 + SHM_V, pa0, pa1, pa2, pa3);
#undef SLOAD
#undef SWRITE
#undef SWAIT
  int lane_e = lane; asm volatile("" : "+v"(lane_e));
  {
  const int lane = lane_e, r32 = lane & 31, hi = lane >> 5;
  { auto rr = __builtin_amdgcn_permlane32_swap(__float_as_uint(l_reg), __float_as_uint(l_reg), false, false); l_reg = __uint_as_float(rr[0]) + __uint_as_float(rr[1]); }
  if (hi == 0) wsf[r32] = l_reg;
  asm volatile("s_waitcnt lgkmcnt(0)" ::: "memory");
  __syncthreads();
  float* X = (float*)lds + wq * 4096;
  if (c == 1) {
#pragma unroll
    for (int r = 0; r < 16; ++r) { const float rl = __builtin_amdgcn_rcpf(wsf[crow(r, hi)]);
#pragma unroll
      for (int d0 = 0; d0 < 4; ++d0) X[(d0 * 16 + r) * 64 + lane] = o[d0][r] * rl; }
  }
  __syncthreads();
  if (c == 0) {
    float g4[4];
#pragma unroll
    for (int d0 = 0; d0 < 4; ++d0) g4[d0] = gsub[32 * d0 + r32] * post;
#pragma unroll
    for (int r = 0; r < 16; ++r) { const float rl = __builtin_amdgcn_rcpf(wsf[crow(r, hi)]); float dv[4]; float s = 0.f;
#pragma unroll
      for (int d0 = 0; d0 < 4; ++d0) { dv[d0] = o[d0][r] * rl - lam * X[(d0 * 16 + r) * 64 + lane]; s += dv[d0] * dv[d0]; }
#pragma unroll
      for (int off = 1; off < 32; off <<= 1) s += __shfl_xor(s, off);
      const float rs = 1.0f / sqrtf(s * (1.f / 128.f) + EPS); bf16* orow = Ob + (size_t)(wq * 32 + crow(r, hi)) * DM + r32;
#pragma unroll
      for (int d0 = 0; d0 < 4; ++d0) orow[32 * d0] = (bf16)(pk2(dv[d0] * rs * g4[d0], 0.f) & 0xffffu); }
  }
  }
  __syncthreads();
}
#undef SBAR
}

DI void sgu_unit(const bf16* P, bf16* MIX, int chunk, int hd, const float* Ws, const float* bs, const float* gv, char* lds) {
    using att::bf16x8; using att::f32x16;
    int tid = threadIdx.x; asm volatile("" : "+v"(tid));
    const int wid = tid >> 6, lane = tid & 63, r32 = lane & 31, hi = lane >> 5;
    bf16* vnT = (bf16*)lds;
    { const int p = tid >> 2, qtr = tid & 3; const bf16* src = P + (size_t)(chunk * 128 + p) * INW + OFF_CV + hd * 128 + qtr * 32;
      v4u raw[4];
#pragma unroll
      for (int i = 0; i < 4; ++i) raw[i] = *(const v4u*)(src + 8 * i);
      float x[32];
#pragma unroll
      for (int i = 0; i < 4; ++i) unpack8(raw[i], x + 8 * i);
      float ss = 0.f;
#pragma unroll
      for (int i = 0; i < 32; ++i) { x[i] = gelu_tanh(x[i]); ss += x[i] * x[i]; }
      ss += __shfl_xor(ss, 1); ss += __shfl_xor(ss, 2);
      const float rstd = 1.0f / sqrtf(ss * (1.f / 128.f) + EPS);
#pragma unroll
      for (int i = 0; i < 32; ++i) { const float v = x[i] * rstd * gv[qtr * 32 + i]; vnT[(qtr * 32 + i) * 136 + p] = (bf16)(pk2(v, 0.f) & 0xffffu); }
    }
    __syncthreads();
    const int qb = wid >> 1;
    bf16x8 a[8];
#pragma unroll
    for (int ks = 0; ks < 8; ++ks) { const float* w = Ws + (size_t)(32 * qb + r32) * 128 + 16 * ks + 8 * hi; const f32x4 w0 = *(const f32x4*)w, w1 = *(const f32x4*)(w + 4);
        att::u32x4 u = {pk2(w0.x, w0.y), pk2(w0.z, w0.w), pk2(w1.x, w1.y), pk2(w1.z, w1.w)}; a[ks] = *reinterpret_cast<bf16x8*>(&u); }
#pragma unroll
    for (int dd = 0; dd < 2; ++dd) { const int db = 2 * (wid & 1) + dd;
        f32x16 acc = {};
#pragma unroll
        for (int ks = 0; ks < 8; ++ks) { const bf16x8 b = *reinterpret_cast<const bf16x8*>(vnT + (32 * db + r32) * 136 + 16 * ks + 8 * hi);
            acc = __builtin_amdgcn_mfma_f32_32x32x16_bf16(a[ks], b, acc, 0, 0, 0); }
        const int d = 32 * db + r32;
#pragma unroll
        for (int i = 0; i < 16; ++i) { const int q = 32 * qb + att::crow(i, hi); const size_t tok = (size_t)chunk * 128 + q;
            const float uval = gelu_tanh(__uint_as_float((unsigned)P[tok * INW + OFF_CU + hd * 128 + d] << 16));
            MIX[tok * DM + MIX_C + hd * 128 + d] = (bf16)(pk2(uval * (acc[i] + bs[q]), 0.f) & 0xffffu); }
    }
    __syncthreads();
}

struct Args { const float* in[19]; float* out; unsigned char* ws; int ph_lo, ph_hi; };
constexpr int N_PHASES = 1 + 8 * NLAYER - 1;

__global__ void __launch_bounds__(NWAVES * 64, 2) mk_fwd(Args args) {
    extern __shared__ __attribute__((aligned(16))) unsigned char lds[];
    cg::grid_group grid = cg::this_grid();
    const int G = gridDim.x; const int bx = blockIdx.x; const int vcu = (G % 8 == 0) ? (bx % 8) * (G / 8) + bx / 8 : bx;
    const int NGW = G * NWAVES;
    unsigned char* ws = args.ws;
    const float* xp = args.in[0]; const float* xs = args.in[1];
    float* out = args.out;
    bf16* XN = (bf16*)(ws + WS_XN); bf16* PROJ = (bf16*)(ws + WS_PROJ); bf16* MIX = (bf16*)(ws + WS_MIX); bf16* HB = (bf16*)(ws + WS_H);

    for (int ph = args.ph_lo; ph < args.ph_hi; ++ph) {
        int tid = threadIdx.x; asm volatile("" : "+v"(tid));
        const int lane = tid & 63, wave = __builtin_amdgcn_readfirstlane(tid >> 6), gw = vcu * NWAVES + wave;
        const int l = (ph - 1) >> 3, k = (ph == 0) ? -1 : ((ph - 1) & 7);
        const unsigned char* wl = ws + WS_WT + (size_t)(l < 0 ? 0 : l) * WT_LAYER;
        if (ph == 0) {
#if PHM & 1
            float* scr = (float*)(lds + wave * 16384);
            constexpr int I_IN = 32 * 176, I_OUT = 32 * 64, I_UP = 32 * 256, I_DN = 128 * 64, I_L = I_IN + I_OUT + I_UP + I_DN;
            for (int it = gw; it < NLAYER * I_L; it += NGW) {
                const int ll = it / I_L; int r = it % I_L; unsigned char* wb = ws + WS_WT + (size_t)ll * WT_LAYER;
                if (r < I_IN) { transpose_item(args.in[3] + (size_t)ll * DM * INW, DM, INW, (bf16*)(wb + WT_IN), scr, r, lane); continue; } r -= I_IN;
                if (r < I_OUT) { transpose_item(args.in[15] + (size_t)ll * DM * DM, DM, DM, (bf16*)(wb + WT_OUT), scr, r, lane); continue; } r -= I_OUT;
                if (r < I_UP) { transpose_item(args.in[17] + (size_t)ll * DM * DFF, DM, DFF, (bf16*)(wb + WT_UP), scr, r, lane); continue; } r -= I_UP;
                transpose_item(args.in[18] + (size_t)ll * DFF * DM, DFF, DM, (bf16*)(wb + WT_DN), scr, r, lane);
            }
            for (int m = gw; m < M_ALL; m += NGW) norm_row(m < MP ? xp + (size_t)m * DM : xs + (size_t)(m - MP) * DM, args.in[2], XN + (size_t)m * DM, lane);
#endif
        } else if (k == 0) {
#if PHM & 2
            pg8::Gemm g{XN, (const bf16*)(wl + WT_IN), M_ALL, INW, DM}; pg8::StaticOrder S; S.init(M_ALL, INW, G, bx);
            pg8::EpiBf16<0> E{PROJ, INW};
            pg8::gemm_phase<pg8::EpiBf16<0>, pg8::StaticOrder, true, true>((PG8_LAS unsigned char*)lds, g, S, E);
#endif
        } else if (k == 1) {
#if PHM & 4
            const float* qg = args.in[5] + l * 64; const float* kg = args.in[6] + l * 64; const float* cw = args.in[4] + l * 1536;
            for (int m = gw; m < M_ALL; m += NGW) {
                const int pos = m < MP ? (m & (SEQ_P - 1)) : ((m - MP) & (SEQ_S - 1)); const int S = m < MP ? SEQ_P : SEQ_S;
                qk_row(PROJ, m, pos, qg, kg, lane);
                conv_row(PROJ, MIX, m, pos, S, cw, lane);
            }
            for (int u = vcu; u < (M_ALL / 128) * 4; u += G) { const int chunk = u >> 2, hd = u & 3;
                sgu_unit(PROJ, MIX, chunk, hd, args.in[13] + ((size_t)l * 4 + hd) * 128 * 128, args.in[14] + (l * 4 + hd) * 128, args.in[12] + l * 128, (char*)lds); }
#endif
        } else if (k == 2) {
#if PHM & 8
            const float linit = (l == 0) ? 0.2f : 0.35550906759096934f;
            const float s1 = wave_sum(args.in[7][l * 64 + lane] * args.in[8][l * 64 + lane]), s2 = wave_sum(args.in[9][l * 64 + lane] * args.in[10][l * 64 + lane]);
            const float lam = __uint_as_float(__builtin_amdgcn_readfirstlane(__float_as_uint(expf(s1) - expf(s2) + linit)));
            const float gq = wave_max(fabsf(args.in[5][l * 64 + lane])), gk = wave_max(fabsf(args.in[6][l * 64 + lane]));
            const float negmb = __uint_as_float(__builtin_amdgcn_readfirstlane(__float_as_uint(-(C2 * 64.0f * gq * gk))));
            for (int t = vcu; t < 2560; t += G) {
                int pair, qb, seq, seqrow0;
                if (t < 2048) { const int i = t >> 8, v = t & 255; const int idx = (v >> 5) * 256 + i * 32 + (v & 31); pair = idx >> 7; qb = idx & 127; seq = SEQ_S; seqrow0 = MP + (pair >> 3) * SEQ_S; }
                else { const int t2 = t - 2048, i = t2 >> 8, v = t2 & 255; pair = 2 * (v >> 5) + i; qb = v & 31; seq = SEQ_P; seqrow0 = (pair >> 3) * SEQ_P; }
                const int h = pair & 7; const size_t row0 = (size_t)seqrow0 + (size_t)qb * 128;
                att::attn_unit(PROJ + row0 * INW + OFF_Q + h * 128, PROJ + (size_t)seqrow0 * INW + OFF_K + h * 128, PROJ + (size_t)seqrow0 * INW + OFF_V + h * 128,
                               MIX + row0 * DM + MIX_B + h * 128, seq, (char*)lds, negmb, lam, args.in[11] + l * 128, 1.0f - linit);
            }
#endif
        } else if (k == 3 || k == 6) {
#if PHM & 16
            pg8::Gemm g; if (k == 3) g = pg8::Gemm{MIX, (const bf16*)(wl + WT_OUT), M_ALL, DM, DM}; else g = pg8::Gemm{HB, (const bf16*)(wl + WT_DN), M_ALL, DM, DFF};
            pg8::StaticOrder S; S.init(M_ALL, DM, G, bx);
            pg8::EpiResF32 E; if (k == 3 && l == 0) E = pg8::EpiResF32{xp, xs, MP / 256, out, DM}; else E = pg8::EpiResF32{out, out, 0, out, DM};
            pg8::gemm_phase<pg8::EpiResF32, pg8::StaticOrder, true, true>((PG8_LAS unsigned char*)lds, g, S, E);
#endif
        } else if (k == 4 || k == 7) {
#if PHM & 32
            const float* gn = (k == 4) ? args.in[16] + l * DM : args.in[2] + (l + 1) * DM;
            for (int m = gw; m < M_ALL; m += NGW) norm_row(out + (size_t)m * DM, gn, XN + (size_t)m * DM, lane);
#endif
        } else {
#if PHM & 64
            pg8::Gemm g{XN, (const bf16*)(wl + WT_UP), M_ALL, DFF, DM}; pg8::StaticOrder S; S.init(M_ALL, DFF, G, bx);
            pg8::EpiBf16<2> E{HB, DFF};
            pg8::gemm_phase<pg8::EpiBf16<2>, pg8::StaticOrder, true, true>((PG8_LAS unsigned char*)lds, g, S, E);
#endif
        }
        if (ph + 1 < args.ph_hi) grid.sync();
    }
}

extern "C" void kernel_launch(void* const* d_in, const int* in_sizes, int n_in, void* d_out, int out_size, void* d_ws, size_t ws_size, hipStream_t stream) {
    static int grid = 0;
    if (grid == 0) {
        if (n_in != 19 || out_size != M_ALL * DM || ws_size < WS_END) { fprintf(stderr, "kernel_launch: unexpected shapes: n_in %d out %d ws %zu (need %zu)\n", n_in, out_size, ws_size, (size_t)WS_END); grid = -1; return; }
        int dev = 0, cus = 0, per_cu = 0;
        if (hipGetDevice(&dev) != hipSuccess || hipDeviceGetAttribute(&cus, hipDeviceAttributeMultiprocessorCount, dev) != hipSuccess) { fprintf(stderr, "kernel_launch: device query failed\n"); grid = -1; return; }
        if (hipFuncSetAttribute((const void*)mk_fwd, hipFuncAttributeMaxDynamicSharedMemorySize, LDS_BYTES) != hipSuccess) { fprintf(stderr, "kernel_launch: hipFuncSetAttribute failed\n"); grid = -1; return; }
        if (hipOccupancyMaxActiveBlocksPerMultiprocessor(&per_cu, (const void*)mk_fwd, NWAVES * 64, LDS_BYTES) != hipSuccess || per_cu < 1) { fprintf(stderr, "kernel_launch: occupancy query gave %d\n", per_cu); per_cu = 1; }
        (void)hipGetLastError();
        grid = cus * 1;
        fprintf(stderr, "kernel_launch: grid %d (cus %d, per_cu %d)\n", grid, cus, per_cu);
    }
    if (grid < 0) return;
    Args a{};
    for (int i = 0; i < 19; ++i) a.in[i] = (const float*)d_in[i];
    a.out = (float*)d_out; a.ws = (unsigned char*)d_ws;
#if MK_SINGLE
    a.ph_lo = 0; a.ph_hi = N_PHASES;
    { void* kargs[] = {&a}; hipError_t e = hipLaunchCooperativeKernel((const void*)mk_fwd, dim3(grid), dim3(NWAVES * 64), kargs, LDS_BYTES, stream);
      if (e != hipSuccess) fprintf(stderr, "kernel_launch: cooperative launch failed: %s\n", hipGetErrorString(e)); }
#else
    for (int ph = 0; ph < N_PHASES; ++ph) { a.ph_lo = ph; a.ph_hi = ph + 1; void* kargs[] = {&a};
        hipError_t e = hipLaunchCooperativeKernel((const void*)mk_fwd, dim3(grid), dim3(NWAVES * 64), kargs, LDS_BYTES, stream);
        if (e != hipSuccess) { fprintf(stderr, "kernel_launch: cooperative launch %d failed: %s\n", ph, hipGetErrorString(e)); break; } }
#endif
}
```

```cpp
#include <hip/hip_runtime.h>
#include <hip/hip_cooperative_groups.h>
#include <hip/hip_bf16.h>
#include <cstdio>
#include <cstdint>
namespace cg = cooperative_groups;
namespace pg8 {
#define PG8_LAS __attribute__((address_space(3)))
typedef unsigned short bf16_t;
typedef short bf16x8 __attribute__((ext_vector_type(8)));
typedef float f32x4 __attribute__((ext_vector_type(4)));
typedef unsigned u32x4 __attribute__((ext_vector_type(4)));
constexpr int BM = 256, BK = 64, HALF = 128, HTB = HALF * BK * 2  , STAGE_BYTES = 8 * HTB, NXCD = 8, WGM = 8;

__host__ __device__ __forceinline__ int lds_byte(int r, int c) { const int st = (r >> 4) * 2 + (c >> 5), rr = r & 15, cc = c & 31, ob = rr * 64 + cc * 2; return st * 1024 + (ob ^ (((ob >> 9) & 1) << 5)); }
__host__ __device__ __forceinline__ void stage_rc(int b, int& R, int& C) { const int st = b / 1024, sb = b % 1024, swz = sb ^ (((sb >> 9) & 1) << 5); R = (st >> 1) * 16 + swz / 64; C = (st & 1) * 32 + (swz % 64) / 2; }
__host__ __device__ __forceinline__ int perm32(int rho) { const int n = rho >> 4, i = rho & 15; return 8 * (i >> 2) + 4 * n + (i & 3); }

struct Unit { int pm, pn; };
struct Gemm { const bf16_t* A; const bf16_t* Bt; int M, N, K; };

struct StaticOrder {
    int nM, nN, nwg, G, c;
    __host__ __device__ void init(int M, int N, int G_, int c_) { nM = M / BM; nN = N / BM; nwg = nM * nN; G = G_; c = c_; }
    __host__ __device__ bool next(int i, Unit& u) const {
        const long L = (long)i * G + c; if (L >= nwg) return false;
        int wgid = (int)L; { const int q = nwg / NXCD, r = nwg % NXCD, xcd = wgid % NXCD, off = wgid / NXCD; wgid = (xcd < r ? xcd * (q + 1) : r * (q + 1) + (xcd - r) * q) + off; }
        const int nig = WGM * nN, gid = wgid / nig, fm = gid * WGM, gsz = (nM - fm) < WGM ? (nM - fm) : WGM;
        u.pm = fm + ((wgid % nig) % gsz); u.pn = (wgid % nig) / gsz; return true;
    }
    __device__ __forceinline__ void a_ready(const Unit&) const {}
    __device__ __forceinline__ void done(const Unit&) const {}
};

__device__ __forceinline__ unsigned cvt_pk_bf16(float lo, float hi) { unsigned r; asm volatile("v_cvt_pk_bf16_f32 %0, %1, %2" : "=v"(r) : "v"(lo), "v"(hi)); return r; }
typedef float f32x2 __attribute__((ext_vector_type(2)));
typedef unsigned u32x2 __attribute__((ext_vector_type(2)));
template <int ACT> struct EpiBf16 {
    static constexpr bool PERM = true, AFTER_DRAIN = false;
    bf16_t* O; int ldc;
    __device__ __forceinline__ void operator()(const f32x4 (&acc)[2][2][4][2], const Unit& u, int wr, int wc, int fr, int fq) const {
        const int row0 = u.pm * BM + wr * 64 + fr; const int col0 = u.pn * BM + wc * 32 + 8 * fq;
#pragma unroll
        for (int ai = 0; ai < 2; ++ai)
#pragma unroll
            for (int m = 0; m < 4; ++m) { bf16_t* rowp = O + (size_t)(row0 + ai * HALF + m * 16) * ldc + col0;
#pragma unroll
                for (int bj = 0; bj < 2; ++bj) { f32x4 v0 = acc[ai][bj][m][0], v1 = acc[ai][bj][m][1];
                    if (ACT == 2) {
#pragma unroll
                        for (int e = 0; e < 4; ++e) { float a = fmaxf(v0[e], 0.f), b = fmaxf(v1[e], 0.f); v0[e] = a * a; v1[e] = b * b; } }
                    u32x4 w; w.x = cvt_pk_bf16(v0[0], v0[1]); w.y = cvt_pk_bf16(v0[2], v0[3]); w.z = cvt_pk_bf16(v1[0], v1[1]); w.w = cvt_pk_bf16(v1[2], v1[3]);
                    *(u32x4*)(rowp + bj * HALF) = w; } }
    }
};
struct EpiResF32 {
    static constexpr bool PERM = false, AFTER_DRAIN = false;
    const float* res_lo; const float* res_hi; int split_pm; float* out; int ldc;
    __device__ __forceinline__ void operator()(const f32x4 (&acc)[2][2][4][2], const Unit& u, int wr, int wc, int fr, int fq) const {
        const float* rbase = (u.pm < split_pm) ? res_lo : (res_hi - (size_t)split_pm * BM * ldc);
        const int col0 = u.pn * BM + wc * 32 + 4 * fq;
#pragma unroll
        for (int ai = 0; ai < 2; ++ai)
#pragma unroll
            for (int m = 0; m < 4; ++m) { const size_t off = (size_t)(u.pm * BM + ai * HALF + wr * 64 + m * 16 + fr) * ldc + col0;
#pragma unroll
                for (int bj = 0; bj < 2; ++bj)
#pragma unroll
                    for (int n = 0; n < 2; ++n) { const f32x4 bs = *(const f32x4*)(rbase + off + bj * HALF + n * 16); *(f32x4*)(out + off + bj * HALF + n * 16) = bs + acc[ai][bj][m][n]; }
                asm volatile("" ::: "memory"); }
    }
};
template <class Epi, class Sched, bool ALIGN_EPI = false, bool SP2 = false>
__device__ __forceinline__ void gemm_phase(PG8_LAS unsigned char* lds, const Gemm g, const Sched& S, const Epi& E) {
    int tid = threadIdx.x; asm volatile("" : "+v"(tid));
    const int wid = __builtin_amdgcn_readfirstlane(tid >> 6), lane = tid & 63, wr = wid >> 2, wc = wid & 3, fr = lane & 15, fq = lane >> 4;
    const int K = g.K, nt = K / BK;
    unsigned voffA[2], voffB[2];
#pragma unroll
    for (int i = 0; i < 2; ++i) { int R, C; stage_rc(tid * 16 + i * 8192, R, C); const int Rb = Epi::PERM ? ((R & ~31) + perm32(R & 31)) : R;
        voffA[i] = (unsigned)(R * K + C) * 2u; voffB[i] = (unsigned)(Rb * K + C) * 2u; }
    const size_t kstep = (size_t)(BK * 2);
    const size_t hstep = (size_t)HALF * K * 2;
    const size_t tstep = 2 * hstep;
    const unsigned ldsw = (unsigned)wid * 1024u;
    const int aoff = lds_byte(wr * 64 + fr, fq * 8), boff = lds_byte(wc * 32 + fr, fq * 8);
#define PG8_SA(b, h) (((b) * 2 + (h)) * HTB)
#define PG8_SB(b, h) ((4 + (b) * 2 + (h)) * HTB)
#define PG8_STAGE(bufoff, gbase, voff) do { _Pragma("unroll") for (int _i = 0; _i < 2; ++_i) \
        __builtin_amdgcn_global_load_lds((const unsigned*)((const char*)(gbase) + (voff)[_i]), (PG8_LAS unsigned*)(lds + (bufoff) + ldsw + _i * 8192), 16, 0, 0); } while (0)
#define PG8_LDA(dst, b, h) do { _Pragma("unroll") for (int m = 0; m < 4; ++m) _Pragma("unroll") for (int k = 0; k < 2; ++k) dst[m][k] = *(const PG8_LAS bf16x8*)(lds + PG8_SA(b, h) + aoff + m * 2048 + k * 1024); } while (0)
#define PG8_LDB(dst, b, h) do { _Pragma("unroll") for (int n = 0; n < 2; ++n) _Pragma("unroll") for (int k = 0; k < 2; ++k) dst[n][k] = *(const PG8_LAS bf16x8*)(lds + PG8_SB(b, h) + boff + n * 2048 + k * 1024); } while (0)
#define PG8_MMA(ai, bj, At, Bt) do { __builtin_amdgcn_s_setprio(1); _Pragma("unroll") for (int m = 0; m < 4; ++m) _Pragma("unroll") for (int n = 0; n < 2; ++n) _Pragma("unroll") for (int k = 0; k < 2; ++k) \
        acc[ai][bj][m][n] = __builtin_amdgcn_mfma_f32_16x16x32_bf16(Bt[n][k], At[m][k], acc[ai][bj][m][n], 0, 0, 0); __builtin_amdgcn_s_setprio(0); } while (0)
#define PG8_WAIT_V(n) asm volatile("s_waitcnt vmcnt(" #n ")" ::: "memory")
#define PG8_WAIT_L(n) asm volatile("s_waitcnt lgkmcnt(" #n ")" ::: "memory")
#define PG8_BAR __builtin_amdgcn_s_barrier()
#define PG8_SCHED __builtin_amdgcn_sched_barrier(0)
    Unit cur, nxt; int ui = 0;
    if (!S.next(0, cur)) return;
    f32x4 acc[2][2][4][2];
#pragma unroll
    for (int a = 0; a < 2; ++a)
#pragma unroll
        for (int b = 0; b < 2; ++b)
#pragma unroll
            for (int m = 0; m < 4; ++m)
#pragma unroll
                for (int n = 0; n < 2; ++n) acc[a][b][m][n] = (f32x4){0.f, 0.f, 0.f, 0.f};
    bf16x8 At[4][2], B0[2][2], B1[2][2];
    const char* cA = (const char*)g.A + (size_t)cur.pm * tstep; const char* cB = (const char*)g.Bt + (size_t)cur.pn * tstep;
    S.a_ready(cur);
    if constexpr (SP2) {
        PG8_STAGE(PG8_SB(0, 0), cB, voffB); PG8_STAGE(PG8_SB(0, 1), cB + hstep, voffB); PG8_STAGE(PG8_SA(0, 0), cA, voffA); PG8_STAGE(PG8_SA(0, 1), cA + hstep, voffA);
        if (wr == 1) PG8_BAR;
        PG8_WAIT_V(2); PG8_BAR;
        PG8_STAGE(PG8_SB(1, 0), cB + kstep, voffB); PG8_STAGE(PG8_SA(1, 0), cA + kstep, voffA); PG8_STAGE(PG8_SB(1, 1), cB + hstep + kstep, voffB);
        PG8_WAIT_V(6); PG8_BAR;
    } else {
        PG8_STAGE(PG8_SB(0, 0), cB, voffB); PG8_STAGE(PG8_SA(0, 0), cA, voffA); PG8_STAGE(PG8_SB(0, 1), cB + hstep, voffB); PG8_STAGE(PG8_SA(0, 1), cA + hstep, voffA);
        if (wr == 1) PG8_BAR;
        PG8_WAIT_V(4); PG8_BAR;
        PG8_STAGE(PG8_SB(1, 0), cB + kstep, voffB); PG8_STAGE(PG8_SA(1, 0), cA + kstep, voffA); PG8_STAGE(PG8_SB(1, 1), cB + hstep + kstep, voffB);
        PG8_WAIT_V(6); PG8_BAR;
    }
    for (;;) {
        const bool has_next = S.next(ui + 1, nxt);
        const char* nA = has_next ? (const char*)g.A + (size_t)nxt.pm * tstep : cA; const char* nB = has_next ? (const char*)g.Bt + (size_t)nxt.pn * tstep : cB;
        for (int t = 0; t < nt; t += 2) {
            const bool last = (t == nt - 2);
            const char* a1 = cA + (size_t)(t + 1) * kstep;
            const char* a2 = last ? nA : cA + (size_t)(t + 2) * kstep; const char* b2 = last ? nB : cB + (size_t)(t + 2) * kstep;
            const char* a3 = a2 + kstep; const char* b3 = b2 + kstep;
            if (last && has_next) S.a_ready(nxt);
            if constexpr (SP2) {
            PG8_LDB(B0, 0, 0); PG8_LDB(B1, 0, 1); PG8_SCHED; PG8_LDA(At, 0, 0); PG8_STAGE(PG8_SA(1, 1), a1 + hstep, voffA);
            PG8_WAIT_V(8); PG8_WAIT_L(0); PG8_BAR; PG8_MMA(0, 0, At, B0); PG8_MMA(0, 1, At, B1); PG8_BAR; PG8_SCHED;
            PG8_LDA(At, 0, 1); PG8_STAGE(PG8_SB(0, 0), b2, voffB); PG8_STAGE(PG8_SB(0, 1), b2 + hstep, voffB); PG8_STAGE(PG8_SA(0, 0), a2, voffA);
            PG8_WAIT_V(8); PG8_WAIT_L(0); PG8_BAR; PG8_MMA(1, 0, At, B0); PG8_MMA(1, 1, At, B1); PG8_BAR; PG8_SCHED;
            PG8_LDB(B0, 1, 0); PG8_LDB(B1, 1, 1); PG8_SCHED; PG8_LDA(At, 1, 0); PG8_STAGE(PG8_SA(0, 1), a2 + hstep, voffA);
            PG8_WAIT_V(8); PG8_WAIT_L(0); PG8_BAR; PG8_MMA(0, 0, At, B0); PG8_MMA(0, 1, At, B1); PG8_BAR; PG8_SCHED;
            PG8_LDA(At, 1, 1); PG8_STAGE(PG8_SB(1, 0), b3, voffB); PG8_STAGE(PG8_SB(1, 1), b3 + hstep, voffB); PG8_STAGE(PG8_SA(1, 0), a3, voffA);
            PG8_WAIT_V(8); PG8_WAIT_L(0); PG8_BAR; PG8_MMA(1, 0, At, B0); PG8_MMA(1, 1, At, B1); PG8_BAR; PG8_SCHED;
            } else {
            PG8_LDB(B0, 0, 0); PG8_SCHED; PG8_LDA(At, 0, 0); PG8_STAGE(PG8_SA(1, 1), a1 + hstep, voffA);
            PG8_WAIT_L(8); PG8_BAR; PG8_WAIT_L(0); PG8_MMA(0, 0, At, B0); PG8_BAR; PG8_SCHED;
            PG8_LDB(B1, 0, 1); PG8_STAGE(PG8_SB(0, 0), b2, voffB);
            PG8_BAR; PG8_WAIT_L(0); PG8_MMA(0, 1, At, B1); PG8_BAR;
            PG8_LDA(At, 0, 1); PG8_STAGE(PG8_SA(0, 0), a2, voffA);
            PG8_BAR; PG8_WAIT_L(0); PG8_MMA(1, 0, At, B0); PG8_BAR; PG8_SCHED;
            PG8_STAGE(PG8_SB(0, 1), b2 + hstep, voffB);
            PG8_WAIT_V(6); PG8_BAR; PG8_MMA(1, 1, At, B1); PG8_BAR;
            PG8_LDB(B0, 1, 0); PG8_SCHED; PG8_LDA(At, 1, 0); PG8_STAGE(PG8_SA(0, 1), a2 + hstep, voffA);
            PG8_WAIT_L(8); PG8_BAR; PG8_WAIT_L(0); PG8_MMA(0, 0, At, B0); PG8_BAR; PG8_SCHED;
            PG8_LDB(B1, 1, 1); PG8_STAGE(PG8_SB(1, 0), b3, voffB);
            PG8_BAR; PG8_WAIT_L(0); PG8_MMA(0, 1, At, B1); PG8_BAR;
            PG8_LDA(At, 1, 1); PG8_STAGE(PG8_SA(1, 0), a3, voffA);
            PG8_BAR; PG8_WAIT_L(0); PG8_MMA(1, 0, At, B0); PG8_BAR; PG8_SCHED;
            PG8_STAGE(PG8_SB(1, 1), b3 + hstep, voffB);
            PG8_WAIT_V(6); PG8_BAR; PG8_MMA(1, 1, At, B1); PG8_BAR;
            }
        }
        if constexpr (ALIGN_EPI) { if (wr == 0) PG8_BAR; }
        if constexpr (!Epi::AFTER_DRAIN) { E(acc, cur, wr, wc, fr, fq); S.done(cur); }
        if (!has_next) break;
#pragma unroll
        for (int a = 0; a < 2; ++a)
#pragma unroll
            for (int b = 0; b < 2; ++b)
#pragma unroll
                for (int m = 0; m < 4; ++m)
#pragma unroll
                    for (int n = 0; n < 2; ++n) acc[a][b][m][n] = (f32x4){0.f, 0.f, 0.f, 0.f};
        cur = nxt; cA = nA; cB = nB; ++ui;
        if constexpr (ALIGN_EPI) { if (wr == 1) PG8_BAR; }
    }
    PG8_WAIT_V(0);
    if constexpr (!ALIGN_EPI) { if (wr == 0) PG8_BAR; }
    PG8_BAR;
    if constexpr (Epi::AFTER_DRAIN) { E.fused(acc, cur, wr, wc, fr, fq, lds, wid, lane); S.done(cur); }
#undef PG8_SA
#undef PG8_SB
#undef PG8_STAGE
#undef PG8_LDA
#undef PG8_LDB
#undef PG8_MMA
#undef PG8_WAIT_V
#undef PG8_WAIT_L
#undef PG8_BAR
#undef PG8_SCHED
}
}

#ifndef PROBE_REP_ATT
#define PROBE_REP_ATT 1
#endif
#ifndef PROBE_REP_UP
#define PROBE_REP_UP 1
#endif
#ifndef PROBE_XSYNC
#define PROBE_XSYNC 0
#endif
#ifndef PHM
#define PHM 127
#endif
#ifndef MK_SINGLE
#define MK_SINGLE 1
#endif
constexpr int DM = 2048, MP = 8192, M_ALL = 40960, SEQ_P = 4096, SEQ_S = 16384, INW = 5632, DFF = 8192, NLAYER = 2;
constexpr int OFF_AX = 0, OFF_AB = 512, OFF_AC = 1024, OFF_Q = 1536, OFF_K = 2560, OFF_V = 3584, OFF_CU = 4608, OFF_CV = 5120;
constexpr int MIX_A = 0, MIX_B = 512, MIX_C = 1536;
constexpr float EPS = 1e-6f;
constexpr float C2 = 0.18033688011112042f;
constexpr size_t MiB = 1u << 20;
constexpr size_t WS_WT = 1 * MiB, WT_LAYER = 94 * MiB, WT_IN = 0, WT_OUT = 22 * MiB, WT_UP = 30 * MiB, WT_DN = 62 * MiB;
constexpr size_t WS_XN = 190 * MiB, WS_H = 352 * MiB, WS_PROJ = 352 * MiB, WS_MIX = 792 * MiB, WS_END = 992 * MiB;
static_assert(WS_WT + 2 * WT_LAYER <= WS_XN && WS_XN + (size_t)M_ALL * DM * 2 <= WS_H && WS_PROJ + (size_t)M_ALL * INW * 2 <= WS_MIX && WS_MIX + (size_t)M_ALL * DM * 2 <= WS_END && WS_H + (size_t)M_ALL * DFF * 2 <= WS_END, "ws map");
constexpr int NWAVES = 8, LDS_BYTES = 147456;

typedef unsigned short bf16;
typedef unsigned v4u __attribute__((ext_vector_type(4)));
typedef unsigned v2u __attribute__((ext_vector_type(2)));
typedef float f32x4 __attribute__((ext_vector_type(4)));
#define DI __device__ __forceinline__

DI unsigned pk2(float lo, float hi) { return pg8::cvt_pk_bf16(lo, hi); }
DI float bflo(unsigned u) { return __uint_as_float(u << 16); }
DI float bfhi(unsigned u) { return __uint_as_float(u & 0xffff0000u); }
DI float wave_sum(float v) {
#pragma unroll
    for (int o = 1; o < 64; o <<= 1) v += __shfl_xor(v, o);
    return v;
}
DI float wave_max(float v) {
#pragma unroll
    for (int o = 1; o < 64; o <<= 1) v = fmaxf(v, __shfl_xor(v, o));
    return v;
}
DI float gelu_tanh(float x) {
    const float z = x * (0.7978845608028654f + 0.035677408136300125f * x * x);
    const float e = __builtin_amdgcn_exp2f(-2.8853900817779268f * z);
    return x * __builtin_amdgcn_rcpf(1.0f + e);
}

DI void transpose_item(const float* W, int K, int N, bf16* WT, float* scr, int item, int lane) {
    const int nblk = N / 32, kb = item / nblk, nb = item % nblk, k0 = 64 * kb, n0 = 32 * nb;
#pragma unroll 32
    for (int i = 0; i < 32; ++i) { const int kk = 2 * i + (lane >> 5); scr[kk * 33 + (lane & 31)] = W[(size_t)(k0 + kk) * N + n0 + (lane & 31)]; }
    asm volatile("s_waitcnt lgkmcnt(0)" ::: "memory");
    const int c = lane & 7;
#pragma unroll
    for (int j = 0; j < 4; ++j) { const int n = (lane >> 3) + 8 * j; const float* s = scr + (8 * c) * 33 + n;
        v4u o; o.x = pk2(s[0 * 33], s[1 * 33]); o.y = pk2(s[2 * 33], s[3 * 33]); o.z = pk2(s[4 * 33], s[5 * 33]); o.w = pk2(s[6 * 33], s[7 * 33]);
        *(v4u*)(WT + (size_t)(n0 + n) * K + k0 + 8 * c) = o; }
    asm volatile("s_waitcnt lgkmcnt(0)" ::: "memory");
}
DI void norm_row(const float* xrow, const float* g, bf16* orow, int lane) {
    const f32x4* xr = (const f32x4*)xrow + lane; const f32x4* gr = (const f32x4*)g + lane;
    f32x4 v[8]; float s = 0.f;
#pragma unroll
    for (int j = 0; j < 8; ++j) { v[j] = xr[64 * j]; s += (v[j].x * v[j].x + v[j].y * v[j].y) + (v[j].z * v[j].z + v[j].w * v[j].w); }
    const float rstd = 1.0f / sqrtf(wave_sum(s) * (1.f / DM) + EPS);
    v2u* o8 = (v2u*)orow + lane;
#pragma unroll
    for (int j = 0; j < 8; ++j) { const f32x4 gg = gr[64 * j]; v2u w; w.x = pk2(v[j].x * rstd * gg.x, v[j].y * rstd * gg.y); w.y = pk2(v[j].z * rstd * gg.z, v[j].w * rstd * gg.w); o8[64 * j] = w; }
}

__constant__ double ROPE_INV[8] = {1.0, 0.19392274474868576, 0.03760603093086393, 0.007292664737217109, 0.001414213562373095, 0.0002742481756762073, 5.318295896944988e-05, 1.031338537721246e-05};
DI void qk_row(bf16* P, int row, int pos, const float* qg, const float* kg, int lane) {
    bf16* p = P + (size_t)row * INW + OFF_Q + lane * 32;
    v4u raw[4];
#pragma unroll
    for (int i = 0; i < 4; ++i) raw[i] = *(const v4u*)(p + 8 * i);
    float x[32];
#pragma unroll
    for (int i = 0; i < 4; ++i) { x[8 * i + 0] = bflo(raw[i].x); x[8 * i + 1] = bfhi(raw[i].x); x[8 * i + 2] = bflo(raw[i].y); x[8 * i + 3] = bfhi(raw[i].y);
        x[8 * i + 4] = bflo(raw[i].z); x[8 * i + 5] = bfhi(raw[i].z); x[8 * i + 6] = bflo(raw[i].w); x[8 * i + 7] = bfhi(raw[i].w); }
    float ss = 0.f;
#pragma unroll
    for (int i = 0; i < 32; ++i) ss += x[i] * x[i];
    ss += __shfl_xor(ss, 1);
    const float rstd = 1.0f / sqrtf(ss * (1.f / 64.f) + EPS);
    const bool isq = lane < 32; const int half = lane & 1;
    const float* g = (isq ? qg : kg) + half * 32;
#pragma unroll
    for (int i = 0; i < 8; ++i) { const f32x4 gg = *(const f32x4*)(g + 4 * i); x[4 * i] *= rstd * gg.x; x[4 * i + 1] *= rstd * gg.y; x[4 * i + 2] *= rstd * gg.z; x[4 * i + 3] *= rstd * gg.w; }
    const double t = (double)pos * ROPE_INV[lane & 7] * 0.15915494309189535;
    const float fr = (float)(t - rint(t));
    const float cs = __builtin_amdgcn_cosf(fr), sn = __builtin_amdgcn_sinf(fr);
#pragma unroll
    for (int i = 0; i < 8; ++i) { const float c = __shfl(cs, i), s = __shfl(sn, i);
        if (half == 0) { const float a = x[i], b = x[i + 8]; x[i] = a * c - b * s; x[i + 8] = b * c + a * s; } }
    const float sc = isq ? C2 : 1.0f;
#pragma unroll
    for (int i = 0; i < 4; ++i) { v4u w; w.x = pk2(x[8 * i] * sc, x[8 * i + 1] * sc); w.y = pk2(x[8 * i + 2] * sc, x[8 * i + 3] * sc); w.z = pk2(x[8 * i + 4] * sc, x[8 * i + 5] * sc); w.w = pk2(x[8 * i + 6] * sc, x[8 * i + 7] * sc);
        *(v4u*)(p + 8 * i) = w; }
}
DI void unpack8(const v4u r, float* x) { x[0] = bflo(r.x); x[1] = bfhi(r.x); x[2] = bflo(r.y); x[3] = bfhi(r.y); x[4] = bflo(r.z); x[5] = bfhi(r.z); x[6] = bflo(r.w); x[7] = bfhi(r.w); }
DI void conv_row(const bf16* P, bf16* MIX, int row, int pos, int S, const float* cw, int lane) {
    const bf16* p = P + (size_t)row * INW + lane * 8;
    const v4u z4 = {0u, 0u, 0u, 0u};
    const v4u xa0 = *(const v4u*)(p + OFF_AX), gc0 = *(const v4u*)(p + OFF_AC), gb0 = *(const v4u*)(p + OFF_AB);
    const v4u xam = pos > 0 ? *(const v4u*)(p - INW + OFF_AX) : z4, gcm = pos > 0 ? *(const v4u*)(p - INW + OFF_AC) : z4;
    const v4u xap = pos < S - 1 ? *(const v4u*)(p + INW + OFF_AX) : z4, gcp = pos < S - 1 ? *(const v4u*)(p + INW + OFF_AC) : z4;
    float a0[8], c0[8], b0[8], am[8], cm[8], ap[8], cp[8];
    unpack8(xa0, a0); unpack8(gc0, c0); unpack8(gb0, b0); unpack8(xam, am); unpack8(gcm, cm); unpack8(xap, ap); unpack8(gcp, cp);
    float w0[8], w1[8], w2[8];
#pragma unroll
    for (int i = 0; i < 2; ++i) { const f32x4 a = *(const f32x4*)(cw + lane * 8 + 4 * i), b = *(const f32x4*)(cw + 512 + lane * 8 + 4 * i), c = *(const f32x4*)(cw + 1024 + lane * 8 + 4 * i);
        w0[4 * i] = a.x; w0[4 * i + 1] = a.y; w0[4 * i + 2] = a.z; w0[4 * i + 3] = a.w; w1[4 * i] = b.x; w1[4 * i + 1] = b.y; w1[4 * i + 2] = b.z; w1[4 * i + 3] = b.w;
        w2[4 * i] = c.x; w2[4 * i + 1] = c.y; w2[4 * i + 2] = c.z; w2[4 * i + 3] = c.w; }
    float o[8];
#pragma unroll
    for (int j = 0; j < 8; ++j) o[j] = b0[j] * (w0[j] * (cm[j] * am[j]) + w1[j] * (c0[j] * a0[j]) + w2[j] * (cp[j] * ap[j]));
    v4u w; w.x = pk2(o[0], o[1]); w.y = pk2(o[2], o[3]); w.z = pk2(o[4], o[5]); w.w = pk2(o[6], o[7]);
    *(v4u*)(MIX + (size_t)row * DM + MIX_A + lane * 8) = w;
}

namespace att {
using bf16x8 = __attribute__((ext_vector_type(8))) short;
using s16x4  = __attribute__((ext_vector_type(4))) short;
using f32x16 = __attribute__((ext_vector_type(16))) float;
using u32x4  = __attribute__((ext_vector_type(4))) unsigned;
constexpr int KVBLK = 64;
constexpr int SHM_V = 16384, SHM_K = 16384, SCR_OFF = 98304;
#define KSWZ(row, colB) ((row) * 256 + ((colB) ^ (((row) & 7) << 4)))
#define SBAR() __builtin_amdgcn_sched_barrier(0)
DI int crow(int r, int hi) { return (r & 3) + 8 * (r >> 2) + 4 * hi; }
DI unsigned cvtpk(float lo, float hi) { unsigned r; asm volatile("v_cvt_pk_bf16_f32 %0, %1, %2" : "=v"(r) : "v"(lo), "v"(hi)); return r; }
DI int v_st(int k, int c) { const int kk = (k & ~0xC) | ((k & 4) << 1) | ((k & 8) >> 1); return ((kk >> 3) * 4 + (c >> 5)) * 512 + ((kk & 7) * 32 + (c & 31)) * 2; }
DI int v_rd_base(int lane) { return ((lane & 3) << 3) | (((lane >> 2) & 3) << 6) | (((lane >> 4) & 1) << 5) | (((lane >> 5) & 1) << 8); }
constexpr int v_rd_off(int d0, int ks, int half) { return d0 * 512 + ks * 4096 + half * 2048; }
template <int OFF> DI s16x4 tr_read(int vb) { s16x4 r; asm volatile("ds_read_b64_tr_b16 %0, %1 offset:%2" : "=&v"(r) : "v"(vb), "i"(OFF) : "memory"); return r; }
template <int D0> DI void pv_one(f32x16& od, int vb, bf16x8 pa0, bf16x8 pa1, bf16x8 pa2, bf16x8 pa3) {
  const s16x4 l0 = tr_read<v_rd_off(D0, 0, 0)>(vb), h0 = tr_read<v_rd_off(D0, 0, 1)>(vb), l1 = tr_read<v_rd_off(D0, 1, 0)>(vb), h1 = tr_read<v_rd_off(D0, 1, 1)>(vb);
  const s16x4 l2 = tr_read<v_rd_off(D0, 2, 0)>(vb), h2 = tr_read<v_rd_off(D0, 2, 1)>(vb), l3 = tr_read<v_rd_off(D0, 3, 0)>(vb), h3 = tr_read<v_rd_off(D0, 3, 1)>(vb);
  asm volatile("s_waitcnt lgkmcnt(0)" ::: "memory"); SBAR();
#define PK(L, H) (bf16x8){L[0], L[1], L[2], L[3], H[0], H[1], H[2], H[3]}
  od = __builtin_amdgcn_mfma_f32_32x32x16_bf16(pa0, PK(l0, h0), od, 0, 0, 0);
  od = __builtin_amdgcn_mfma_f32_32x32x16_bf16(pa1, PK(l1, h1), od, 0, 0, 0);
  od = __builtin_amdgcn_mfma_f32_32x32x16_bf16(pa2, PK(l2, h2), od, 0, 0, 0);
  od = __builtin_amdgcn_mfma_f32_32x32x16_bf16(pa3, PK(l3, h3), od, 0, 0, 0);
#undef PK
}
DI void pv_d0(f32x16* o, int vb, bf16x8 pa0, bf16x8 pa1, bf16x8 pa2, bf16x8 pa3) {
  pv_one<0>(o[0], vb, pa0, pa1, pa2, pa3); pv_one<1>(o[1], vb, pa0, pa1, pa2, pa3); pv_one<2>(o[2], vb, pa0, pa1, pa2, pa3); pv_one<3>(o[3], vb, pa0, pa1, pa2, pa3);
}
template <bool SHIFT> DI void qkt(f32x16& p0, f32x16& p1, const char* Ks, const bf16x8* qr, int r32, int hi, int c, float negmb) {
  if constexpr (SHIFT) {
#pragma unroll
    for (int r = 0; r < 16; ++r) { p0[r] = negmb; p1[r] = negmb; }
  } else { p0 = f32x16{}; p1 = f32x16{}; }
#pragma unroll
  for (int d0 = 0; d0 < 4; ++d0) { const int cb = (c * 64 + d0 * 16 + hi * 8) * 2;
    const bf16x8 b0 = *reinterpret_cast<const bf16x8*>(Ks + KSWZ(r32, cb));
    const bf16x8 b1 = *reinterpret_cast<const bf16x8*>(Ks + KSWZ(32 + r32, cb));
    p0 = __builtin_amdgcn_mfma_f32_32x32x16_bf16(b0, qr[d0], p0, 0, 0, 0);
    p1 = __builtin_amdgcn_mfma_f32_32x32x16_bf16(b1, qr[d0], p1, 0, 0, 0); }
}
DI void expA(f32x16& p0) {
#pragma unroll
  for (int r = 0; r < 16; ++r) p0[r] = __builtin_amdgcn_exp2f(p0[r]);
}
DI void finishSM(f32x16& p0, f32x16& p1, float& l_reg, bf16x8& pa0, bf16x8& pa1, bf16x8& pa2, bf16x8& pa3) {
#pragma unroll
  for (int r = 0; r < 16; ++r) p1[r] = __builtin_amdgcn_exp2f(p1[r]);
  float ps = 0.f;
#pragma unroll
  for (int r = 0; r < 16; ++r) ps += p0[r];
#pragma unroll
  for (int r = 0; r < 16; ++r) ps += p1[r];
  l_reg += ps;
#define PK4(P, BASE, OUT) do { unsigned a0 = cvtpk(P[BASE + 0], P[BASE + 1]), a1 = cvtpk(P[BASE + 2], P[BASE + 3]);   \
    unsigned b0 = cvtpk(P[BASE + 4], P[BASE + 5]), b1 = cvtpk(P[BASE + 6], P[BASE + 7]);                              \
    auto r0 = __builtin_amdgcn_permlane32_swap(a0, b0, false, false); auto r1 = __builtin_amdgcn_permlane32_swap(a1, b1, false, false); \
    u32x4 w = {r0[0], r1[0], r0[1], r1[1]}; OUT = *reinterpret_cast<bf16x8*>(&w); } while (0)
  PK4(p0, 0, pa0); PK4(p0, 8, pa1); PK4(p1, 0, pa2); PK4(p1, 8, pa3);
#undef PK4
}
DI void glds16(const void* gsrc, unsigned lds_dst) { unsigned keep;
  asm volatile("s_mov_b32 %0, m0\n\ts_mov_b32 m0, %2\n\ts_nop 0\n\tglobal_load_lds_dwordx4 %1, off\n\ts_mov_b32 m0, %0" : "=&s"(keep) : "v"(gsrc), "s"(lds_dst) : "memory"); }
#define WAIT_BAR(N) asm volatile("s_waitcnt vmcnt(" #N ") lgkmcnt(0)\n\ts_barrier" ::: "memory")
template <bool SHIFT> DI void attn_unit(const bf16* __restrict__ Qb, const bf16* __restrict__ Kh, const bf16* __restrict__ Vh, bf16* __restrict__ Ob, int seq, char* lds,
                  float negmb, float lam, const float* __restrict__ gsub, float post) {
  int tid = threadIdx.x; asm volatile("" : "+v"(tid));
  const int lane = tid & 63, r32 = lane & 31, hi = lane >> 5; const int wid = __builtin_amdgcn_readfirstlane(tid >> 6), c = wid >> 2, wq = wid & 3;
  char* K_ring = lds; char* V_ring = lds + 3 * SHM_K;
  float* wsf = (float*)(lds + SCR_OFF) + wid * 64;
  const unsigned lds0 = (unsigned)(uintptr_t)lds;
  float l_reg = 0.f; f32x16 o[4] = {}; bf16x8 qr[4];
  const bf16* Qw = Qb + (size_t)(wq * 32 + r32) * INW + c * 64 + hi * 8;
#pragma unroll
  for (int d0 = 0; d0 < 4; ++d0) qr[d0] = *reinterpret_cast<const bf16x8*>(Qw + d0 * 16);
  const bf16* ksrc0; const bf16* ksrc1; const bf16* vsrc0; const bf16* vsrc1;
  { const int row0 = 8 * wid + (lane >> 4), row1 = row0 + 4, cp = lane & 15;
    ksrc0 = Kh + (size_t)row0 * INW + ((cp ^ (row0 & 7)) << 3); ksrc1 = Kh + (size_t)row1 * INW + ((cp ^ (row1 & 7)) << 3);
    const int kk = 8 * wid + ((lane & 31) >> 2), kkey = (kk & ~0xC) | ((kk & 4) << 1) | ((kk & 8) >> 1), cc = (lane >> 5) * 32 + (lane & 3) * 8;
    vsrc0 = Vh + (size_t)kkey * INW + cc; vsrc1 = vsrc0 + 64; }
  const unsigned kdst = lds0 + (unsigned)wid * 2048u, vdst = lds0 + 3u * SHM_K + (unsigned)wid * 2048u;
#define DMA_K(t, slot) do { const size_t to_ = (size_t)(t) * (KVBLK * INW); const unsigned d_ = (unsigned)__builtin_amdgcn_readfirstlane(kdst + (unsigned)(slot)); glds16(ksrc0 + to_, d_); glds16(ksrc1 + to_, d_ + 1024u); } while (0)
#define DMA_V(t, slot) do { const size_t to_ = (size_t)(t) * (KVBLK * INW); const unsigned d_ = (unsigned)__builtin_amdgcn_readfirstlane(vdst + (unsigned)(slot)); glds16(vsrc0 + to_, d_); glds16(vsrc1 + to_, d_ + 1024u); } while (0)
  const int vb0 = (int)(lds0 + 3u * SHM_K) + v_rd_base(lane);
  f32x16 pA0, pA1, pB0, pB1; bf16x8 pa0, pa1, pa2, pa3; const int NT = seq / KVBLK;
  int s0 = 0, s1 = SHM_K, s2 = 2 * SHM_K;
#define ROT() do { const int t_ = s0; s0 = s1; s1 = s2; s2 = t_; } while (0)
  DMA_K(0, 0); DMA_K(1, SHM_K); DMA_V(0, 0);
  WAIT_BAR(4);
  DMA_K(2, 2 * SHM_K); DMA_V(1, SHM_K);
  qkt<SHIFT>(pA0, pA1, K_ring, qr, r32, hi, c, negmb); expA(pA0);
#define ITER(CUR0, CUR1, PRV0, PRV1, j) do { \
    WAIT_BAR(4); \
    { const int tk_ = ((j) + 2 < NT) ? (j) + 2 : NT - 1, tv_ = ((j) + 1 < NT) ? (j) + 1 : NT - 1; DMA_K(tk_, s0); DMA_V(tv_, s2); } \
    SBAR(); qkt<SHIFT>(CUR0, CUR1, K_ring + s1, qr, r32, hi, c, negmb); \
    finishSM(PRV0, PRV1, l_reg, pa0, pa1, pa2, pa3); SBAR(); \
    pv_d0(o, vb0 + s0, pa0, pa1, pa2, pa3); expA(CUR0); \
    ROT(); } while (0)
  for (int j = 1; j + 1 < NT; j += 2) {
    ITER(pB0, pB1, pA0, pA1, j);
    ITER(pA0, pA1, pB0, pB1, j + 1);
  }
  ITER(pB0, pB1, pA0, pA1, NT - 1);
  WAIT_BAR(0);
  finishSM(pB0, pB1, l_reg, pa0, pa1, pa2, pa3); SBAR();
  pv_d0(o, vb0 + s0, pa0, pa1, pa2, pa3);
#undef ITER
#undef ROT
#undef DMA_K
#undef DMA_V
  int lane_e = lane; asm volatile("" : "+v"(lane_e));
  {
  const int lane = lane_e, r32 = lane & 31, hi = lane >> 5;
  { auto rr = __builtin_amdgcn_permlane32_swap(__float_as_uint(l_reg), __float_as_uint(l_reg), false, false); l_reg = __uint_as_float(rr[0]) + __uint_as_float(rr[1]); }
  if (hi == 0) wsf[r32] = l_reg;
  asm volatile("s_waitcnt lgkmcnt(0)" ::: "memory");
  __syncthreads();
  float* X = (float*)lds + wq * 4096;
  if (c == 1) {
#pragma unroll
    for (int r = 0; r < 16; ++r) { const float rl = __builtin_amdgcn_rcpf(wsf[crow(r, hi)]);
#pragma unroll
      for (int d0 = 0; d0 < 4; ++d0) X[(d0 * 16 + r) * 64 + lane] = o[d0][r] * rl; }
  }
  __syncthreads();
  if (c == 0) {
    float g4[4];
#pragma unroll
    for (int d0 = 0; d0 < 4; ++d0) g4[d0] = gsub[32 * d0 + r32] * post;
#pragma unroll
    for (int r = 0; r < 16; ++r) { const float rl = __builtin_amdgcn_rcpf(wsf[crow(r, hi)]); float dv[4]; float s = 0.f;
#pragma unroll
      for (int d0 = 0; d0 < 4; ++d0) { dv[d0] = o[d0][r] * rl - lam * X[(d0 * 16 + r) * 64 + lane]; s += dv[d0] * dv[d0]; }
#pragma unroll
      for (int off = 1; off < 32; off <<= 1) s += __shfl_xor(s, off);
      const float rs = 1.0f / sqrtf(s * (1.f / 128.f) + EPS); bf16* orow = Ob + (size_t)(wq * 32 + crow(r, hi)) * DM + r32;
#pragma unroll
      for (int d0 = 0; d0 < 4; ++d0) orow[32 * d0] = (bf16)(pk2(dv[d0] * rs * g4[d0], 0.f) & 0xffffu); }
  }
  }
  __syncthreads();
}
#undef SBAR
}

DI void sgu_unit(const bf16* P, bf16* MIX, int chunk, int hd, const float* Ws, const float* bs, const float* gv, char* lds) {
    using att::bf16x8; using att::f32x16;
    int tid = threadIdx.x; asm volatile("" : "+v"(tid));
    const int wid = tid >> 6, lane = tid & 63, r32 = lane & 31, hi = lane >> 5;
    bf16* vnT = (bf16*)lds;
    { const int p = tid >> 2, qtr = tid & 3; const bf16* src = P + (size_t)(chunk * 128 + p) * INW + OFF_CV + hd * 128 + qtr * 32;
      v4u raw[4];
#pragma unroll
      for (int i = 0; i < 4; ++i) raw[i] = *(const v4u*)(src + 8 * i);
      float x[32];
#pragma unroll
      for (int i = 0; i < 4; ++i) unpack8(raw[i], x + 8 * i);
      float ss = 0.f;
#pragma unroll
      for (int i = 0; i < 32; ++i) { x[i] = gelu_tanh(x[i]); ss += x[i] * x[i]; }
      ss += __shfl_xor(ss, 1); ss += __shfl_xor(ss, 2);
      const float rstd = 1.0f / sqrtf(ss * (1.f / 128.f) + EPS);
#pragma unroll
      for (int i = 0; i < 32; ++i) { const float v = x[i] * rstd * gv[qtr * 32 + i]; vnT[(qtr * 32 + i) * 136 + p] = (bf16)(pk2(v, 0.f) & 0xffffu); }
    }
    __syncthreads();
    const int qb = wid >> 1;
    bf16x8 a[8];
#pragma unroll
    for (int ks = 0; ks < 8; ++ks) { const float* w = Ws + (size_t)(32 * qb + r32) * 128 + 16 * ks + 8 * hi; const f32x4 w0 = *(const f32x4*)w, w1 = *(const f32x4*)(w + 4);
        att::u32x4 u = {pk2(w0.x, w0.y), pk2(w0.z, w0.w), pk2(w1.x, w1.y), pk2(w1.z, w1.w)}; a[ks] = *reinterpret_cast<bf16x8*>(&u); }
#pragma unroll
    for (int dd = 0; dd < 2; ++dd) { const int db = 2 * (wid & 1) + dd;
        f32x16 acc = {};
#pragma unroll
        for (int ks = 0; ks < 8; ++ks) { const bf16x8 b = *reinterpret_cast<const bf16x8*>(vnT + (32 * db + r32) * 136 + 16 * ks + 8 * hi);
            acc = __builtin_amdgcn_mfma_f32_32x32x16_bf16(a[ks], b, acc, 0, 0, 0); }
        const int d = 32 * db + r32;
#pragma unroll
        for (int i = 0; i < 16; ++i) { const int q = 32 * qb + att::crow(i, hi); const size_t tok = (size_t)chunk * 128 + q;
            const float uval = gelu_tanh(__uint_as_float((unsigned)P[tok * INW + OFF_CU + hd * 128 + d] << 16));
            MIX[tok * DM + MIX_C + hd * 128 + d] = (bf16)(pk2(uval * (acc[i] + bs[q]), 0.f) & 0xffffu); }
    }
    __syncthreads();
}

struct Args { const float* in[19]; float* out; unsigned char* ws; int ph_lo, ph_hi; };
constexpr int N_PHASES = 1 + 8 * NLAYER - 1;

__global__ void __launch_bounds__(NWAVES * 64, 2) mk_fwd(Args args) {
    extern __shared__ __attribute__((aligned(16))) unsigned char lds[];
    cg::grid_group grid = cg::this_grid();
    const int G = gridDim.x; const int bx = blockIdx.x; const int vcu = (G % 8 == 0) ? (bx % 8) * (G / 8) + bx / 8 : bx;
    const int NGW = G * NWAVES;
    unsigned char* ws = args.ws;
    const float* xp = args.in[0]; const float* xs = args.in[1];
    float* out = args.out;
    bf16* XN = (bf16*)(ws + WS_XN); bf16* PROJ = (bf16*)(ws + WS_PROJ); bf16* MIX = (bf16*)(ws + WS_MIX); bf16* HB = (bf16*)(ws + WS_H);

    for (int ph = args.ph_lo; ph < args.ph_hi; ++ph) {
        int tid = threadIdx.x; asm volatile("" : "+v"(tid));
        const int lane = tid & 63, wave = __builtin_amdgcn_readfirstlane(tid >> 6), gw = vcu * NWAVES + wave;
        const int l = (ph - 1) >> 3, k = (ph == 0) ? -1 : ((ph - 1) & 7);
        const unsigned char* wl = ws + WS_WT + (size_t)(l < 0 ? 0 : l) * WT_LAYER;
        if (ph == 0) {
#if PHM & 1
            float* scr = (float*)(lds + wave * 16384);
            constexpr int I_IN = 32 * 176, I_OUT = 32 * 64, I_UP = 32 * 256, I_DN = 128 * 64, I_L = I_IN + I_OUT + I_UP + I_DN;
            for (int it = gw; it < NLAYER * I_L; it += NGW) {
                const int ll = it / I_L; int r = it % I_L; unsigned char* wb = ws + WS_WT + (size_t)ll * WT_LAYER;
                if (r < I_IN) { transpose_item(args.in[3] + (size_t)ll * DM * INW, DM, INW, (bf16*)(wb + WT_IN), scr, r, lane); continue; } r -= I_IN;
                if (r < I_OUT) { transpose_item(args.in[15] + (size_t)ll * DM * DM, DM, DM, (bf16*)(wb + WT_OUT), scr, r, lane); continue; } r -= I_OUT;
                if (r < I_UP) { transpose_item(args.in[17] + (size_t)ll * DM * DFF, DM, DFF, (bf16*)(wb + WT_UP), scr, r, lane); continue; } r -= I_UP;
                transpose_item(args.in[18] + (size_t)ll * DFF * DM, DFF, DM, (bf16*)(wb + WT_DN), scr, r, lane);
            }
            for (int m = gw; m < M_ALL; m += NGW) norm_row(m < MP ? xp + (size_t)m * DM : xs + (size_t)(m - MP) * DM, args.in[2], XN + (size_t)m * DM, lane);
#endif
        } else if (k == 0) {
#if PHM & 2
            pg8::Gemm g{XN, (const bf16*)(wl + WT_IN), M_ALL, INW, DM}; pg8::StaticOrder S; S.init(M_ALL, INW, G, bx);
            pg8::EpiBf16<0> E{PROJ, INW};
            pg8::gemm_phase<pg8::EpiBf16<0>, pg8::StaticOrder, true, true>((PG8_LAS unsigned char*)lds, g, S, E);
#endif
        } else if (k == 1) {
#if PHM & 4
            const float* qg = args.in[5] + l * 64; const float* kg = args.in[6] + l * 64; const float* cw = args.in[4] + l * 1536;
            for (int m = gw; m < M_ALL; m += NGW) {
                const int pos = m < MP ? (m & (SEQ_P - 1)) : ((m - MP) & (SEQ_S - 1)); const int S = m < MP ? SEQ_P : SEQ_S;
                qk_row(PROJ, m, pos, qg, kg, lane);
                conv_row(PROJ, MIX, m, pos, S, cw, lane);
            }
            for (int u = vcu; u < (M_ALL / 128) * 4; u += G) { const int chunk = u >> 2, hd = u & 3;
                sgu_unit(PROJ, MIX, chunk, hd, args.in[13] + ((size_t)l * 4 + hd) * 128 * 128, args.in[14] + (l * 4 + hd) * 128, args.in[12] + l * 128, (char*)lds); }
#endif
        } else if (k == 2) {
#if PHM & 8
            const float linit = (l == 0) ? 0.2f : 0.35550906759096934f;
            const float s1 = wave_sum(args.in[7][l * 64 + lane] * args.in[8][l * 64 + lane]), s2 = wave_sum(args.in[9][l * 64 + lane] * args.in[10][l * 64 + lane]);
            const float lam = __uint_as_float(__builtin_amdgcn_readfirstlane(__float_as_uint(expf(s1) - expf(s2) + linit)));
            const float gq = wave_max(fabsf(args.in[5][l * 64 + lane])), gk = wave_max(fabsf(args.in[6][l * 64 + lane]));
            const float negmb = __uint_as_float(__builtin_amdgcn_readfirstlane(__float_as_uint(-(C2 * 64.0f * gq * gk))));
            for (int rep = 0; rep < PROBE_REP_ATT; ++rep)
            for (int t = vcu; t < 2560; t += G) {
                int pair, qb, seq, seqrow0;
                if (t < 2048) { const int i = t >> 8, v = t & 255; const int idx = (v >> 5) * 256 + i * 32 + (v & 31); pair = idx >> 7; qb = idx & 127; seq = SEQ_S; seqrow0 = MP + (pair >> 3) * SEQ_S; }
                else { const int t2 = t - 2048, i = t2 >> 8, v = t2 & 255; pair = 2 * (v >> 5) + i; qb = v & 31; seq = SEQ_P; seqrow0 = (pair >> 3) * SEQ_P; }
                const int h = pair & 7; const size_t row0 = (size_t)seqrow0 + (size_t)qb * 128;
                if (negmb >= -64.0f)
                att::attn_unit<false>(PROJ + row0 * INW + OFF_Q + h * 128, PROJ + (size_t)seqrow0 * INW + OFF_K + h * 128, PROJ + (size_t)seqrow0 * INW + OFF_V + h * 128,
                               MIX + row0 * DM + MIX_B + h * 128, seq, (char*)lds, 0.f, lam, args.in[11] + l * 128, 1.0f - linit);
                else
                att::attn_unit<true>(PROJ + row0 * INW + OFF_Q + h * 128, PROJ + (size_t)seqrow0 * INW + OFF_K + h * 128, PROJ + (size_t)seqrow0 * INW + OFF_V + h * 128,
                               MIX + row0 * DM + MIX_B + h * 128, seq, (char*)lds, negmb, lam, args.in[11] + l * 128, 1.0f - linit);
            }
#endif
        } else if (k == 3 || k == 6) {
#if PHM & 16
            pg8::Gemm g; if (k == 3) g = pg8::Gemm{MIX, (const bf16*)(wl + WT_OUT), M_ALL, DM, DM}; else g = pg8::Gemm{HB, (const bf16*)(wl + WT_DN), M_ALL, DM, DFF};
            pg8::StaticOrder S; S.init(M_ALL, DM, G, bx);
            pg8::EpiResF32 E; if (k == 3 && l == 0) E = pg8::EpiResF32{xp, xs, MP / 256, out, DM}; else E = pg8::EpiResF32{out, out, 0, out, DM};
            pg8::gemm_phase<pg8::EpiResF32, pg8::StaticOrder, true, true>((PG8_LAS unsigned char*)lds, g, S, E);
#endif
        } else if (k == 4 || k == 7) {
#if PHM & 32
            const float* gn = (k == 4) ? args.in[16] + l * DM : args.in[2] + (l + 1) * DM;
            for (int m = gw; m < M_ALL; m += NGW) norm_row(out + (size_t)m * DM, gn, XN + (size_t)m * DM, lane);
#endif
        } else {
#if PHM & 64
            pg8::Gemm g{XN, (const bf16*)(wl + WT_UP), M_ALL, DFF, DM}; pg8::StaticOrder S; S.init(M_ALL, DFF, G, bx);
            pg8::EpiBf16<2> E{HB, DFF};
            for (int rep = 0; rep < PROBE_REP_UP; ++rep)
            pg8::gemm_phase<pg8::EpiBf16<2>, pg8::StaticOrder, true, true>((PG8_LAS unsigned char*)lds, g, S, E);
#endif
        }
        if (ph + 1 < args.ph_hi) { grid.sync(); for (int e = 0; e < PROBE_XSYNC; ++e) grid.sync(); }
    }
}

extern "C" void kernel_launch(void* const* d_in, const int* in_sizes, int n_in, void* d_out, int out_size, void* d_ws, size_t ws_size, hipStream_t stream) {
    static int grid = 0;
    if (grid == 0) {
        if (n_in != 19 || out_size != M_ALL * DM || ws_size < WS_END) { fprintf(stderr, "kernel_launch: unexpected shapes: n_in %d out %d ws %zu (need %zu)\n", n_in, out_size, ws_size, (size_t)WS_END); grid = -1; return; }
        int dev = 0, cus = 0, per_cu = 0;
        if (hipGetDevice(&dev) != hipSuccess || hipDeviceGetAttribute(&cus, hipDeviceAttributeMultiprocessorCount, dev) != hipSuccess) { fprintf(stderr, "kernel_launch: device query failed\n"); grid = -1; return; }
        if (hipFuncSetAttribute((const void*)mk_fwd, hipFuncAttributeMaxDynamicSharedMemorySize, LDS_BYTES) != hipSuccess) { fprintf(stderr, "kernel_launch: hipFuncSetAttribute failed\n"); grid = -1; return; }
        if (hipOccupancyMaxActiveBlocksPerMultiprocessor(&per_cu, (const void*)mk_fwd, NWAVES * 64, LDS_BYTES) != hipSuccess || per_cu < 1) { fprintf(stderr, "kernel_launch: occupancy query gave %d\n", per_cu); per_cu = 1; }
        (void)hipGetLastError();
        grid = cus * 1;
        fprintf(stderr, "kernel_launch: grid %d (cus %d, per_cu %d)\n", grid, cus, per_cu);
    }
    if (grid < 0) return;
    Args a{};
    for (int i = 0; i < 19; ++i) a.in[i] = (const float*)d_in[i];
    a.out = (float*)d_out; a.ws = (unsigned char*)d_ws;
#if MK_SINGLE
    a.ph_lo = 0; a.ph_hi = N_PHASES;
    { void* kargs[] = {&a}; hipError_t e = hipLaunchCooperativeKernel((const void*)mk_fwd, dim3(grid), dim3(NWAVES * 64), kargs, LDS_BYTES, stream);
      if (e != hipSuccess) fprintf(stderr, "kernel_launch: cooperative launch failed: %s\n", hipGetErrorString(e)); }
#else
    for (int ph = 0; ph < N_PHASES; ++ph) { a.ph_lo = ph; a.ph_hi = ph + 1; void* kargs[] = {&a};
        hipError_t e = hipLaunchCooperativeKernel((const void*)mk_fwd, dim3(grid), dim3(NWAVES * 64), kargs, LDS_BYTES, stream);
        if (e != hipSuccess) { fprintf(stderr, "kernel_launch: cooperative launch %d failed: %s\n", ph, hipGetErrorString(e)); break; } }
#endif
}
```

```cpp
#include <hip/hip_runtime.h>
#include <hip/hip_cooperative_groups.h>
#include <hip/hip_bf16.h>
#include <cstdio>
#include <cstdint>
namespace cg = cooperative_groups;
namespace pg8 {
#define PG8_LAS __attribute__((address_space(3)))
typedef unsigned short bf16_t;
typedef short bf16x8 __attribute__((ext_vector_type(8)));
typedef float f32x4 __attribute__((ext_vector_type(4)));
typedef unsigned u32x4 __attribute__((ext_vector_type(4)));
constexpr int BM = 256, BK = 64, HALF = 128, HTB = HALF * BK * 2  , STAGE_BYTES = 8 * HTB, NXCD = 8, WGM = 8;

__host__ __device__ __forceinline__ int lds_byte(int r, int c) { const int st = (r >> 4) * 2 + (c >> 5), rr = r & 15, cc = c & 31, ob = rr * 64 + cc * 2; return st * 1024 + (ob ^ (((ob >> 9) & 1) << 5)); }
__host__ __device__ __forceinline__ void stage_rc(int b, int& R, int& C) { const int st = b / 1024, sb = b % 1024, swz = sb ^ (((sb >> 9) & 1) << 5); R = (st >> 1) * 16 + swz / 64; C = (st & 1) * 32 + (swz % 64) / 2; }
__host__ __device__ __forceinline__ int perm32(int rho) { const int n = rho >> 4, i = rho & 15; return 8 * (i >> 2) + 4 * n + (i & 3); }

struct Unit { int pm, pn; };
struct Gemm { const bf16_t* A; const bf16_t* Bt; int M, N, K, lda, ldb; };

struct StaticOrder {
    int nM, nN, nwg, G, c;
    __host__ __device__ void init(int M, int N, int G_, int c_) { nM = M / BM; nN = N / BM; nwg = nM * nN; G = G_; c = c_; }
    __host__ __device__ bool next(int i, Unit& u) const {
        const long L = (long)i * G + c; if (L >= nwg) return false;
        int wgid = (int)L; { const int q = nwg / NXCD, r = nwg % NXCD, xcd = wgid % NXCD, off = wgid / NXCD; wgid = (xcd < r ? xcd * (q + 1) : r * (q + 1) + (xcd - r) * q) + off; }
        const int nig = WGM * nN, gid = wgid / nig, fm = gid * WGM, gsz = (nM - fm) < WGM ? (nM - fm) : WGM;
        u.pm = fm + ((wgid % nig) % gsz); u.pn = (wgid % nig) / gsz; return true;
    }
    __device__ __forceinline__ void a_ready(const Unit&) const {}
    __device__ __forceinline__ void done(const Unit&) const {}
};

__device__ __forceinline__ unsigned cvt_pk_bf16(float lo, float hi) { unsigned r; asm volatile("v_cvt_pk_bf16_f32 %0, %1, %2" : "=v"(r) : "v"(lo), "v"(hi)); return r; }
typedef float f32x2 __attribute__((ext_vector_type(2)));
typedef unsigned u32x2 __attribute__((ext_vector_type(2)));
template <int ACT> struct EpiBf16 {
    static constexpr bool PERM = true, AFTER_DRAIN = false;
    bf16_t* O; int ldc;
    __device__ __forceinline__ void operator()(const f32x4 (&acc)[2][2][4][2], const Unit& u, int wr, int wc, int fr, int fq) const {
        const int row0 = u.pm * BM + wr * 64 + fr; const int col0 = u.pn * BM + wc * 32 + 8 * fq;
#pragma unroll
        for (int ai = 0; ai < 2; ++ai)
#pragma unroll
            for (int m = 0; m < 4; ++m) { bf16_t* rowp = O + (size_t)(row0 + ai * HALF + m * 16) * ldc + col0;
#pragma unroll
                for (int bj = 0; bj < 2; ++bj) { f32x4 v0 = acc[ai][bj][m][0], v1 = acc[ai][bj][m][1];
                    if (ACT == 2) {
#pragma unroll
                        for (int e = 0; e < 4; ++e) { float a = fmaxf(v0[e], 0.f), b = fmaxf(v1[e], 0.f); v0[e] = a * a; v1[e] = b * b; } }
                    u32x4 w; w.x = cvt_pk_bf16(v0[0], v0[1]); w.y = cvt_pk_bf16(v0[2], v0[3]); w.z = cvt_pk_bf16(v1[0], v1[1]); w.w = cvt_pk_bf16(v1[2], v1[3]);
                    *(u32x4*)(rowp + bj * HALF) = w; } }
    }
};
struct EpiResF32 {
    static constexpr bool PERM = false, AFTER_DRAIN = false;
    const float* res_lo; const float* res_hi; int split_pm; float* out; int ldc;
    __device__ __forceinline__ void operator()(const f32x4 (&acc)[2][2][4][2], const Unit& u, int wr, int wc, int fr, int fq) const {
        const float* rbase = (u.pm < split_pm) ? res_lo : (res_hi - (size_t)split_pm * BM * ldc);
        const int col0 = u.pn * BM + wc * 32 + 4 * fq;
#pragma unroll
        for (int ai = 0; ai < 2; ++ai)
#pragma unroll
            for (int m = 0; m < 4; ++m) { const size_t off = (size_t)(u.pm * BM + ai * HALF + wr * 64 + m * 16 + fr) * ldc + col0;
#pragma unroll
                for (int bj = 0; bj < 2; ++bj)
#pragma unroll
                    for (int n = 0; n < 2; ++n) { const f32x4 bs = *(const f32x4*)(rbase + off + bj * HALF + n * 16); *(f32x4*)(out + off + bj * HALF + n * 16) = bs + acc[ai][bj][m][n]; }
                if (m == 3) asm volatile("" ::: "memory"); }
    }
};
template <class Epi, class Sched, bool ALIGN_EPI = false, bool SP2 = false>
__device__ __forceinline__ void gemm_phase(PG8_LAS unsigned char* lds, const Gemm g, const Sched& S, const Epi& E) {
    int tid = threadIdx.x; asm volatile("" : "+v"(tid));
    const int wid = __builtin_amdgcn_readfirstlane(tid >> 6), lane = tid & 63, wr = wid >> 2, wc = wid & 3, fr = lane & 15, fq = lane >> 4;
    const int K = g.K, nt = K / BK;
    unsigned voffA[2], voffB[2];
#pragma unroll
    for (int i = 0; i < 2; ++i) { int R, C; stage_rc(tid * 16 + i * 8192, R, C); const int Rb = Epi::PERM ? ((R & ~31) + perm32(R & 31)) : R;
        voffA[i] = (unsigned)(R * g.lda + C) * 2u; voffB[i] = (unsigned)(Rb * g.ldb + C) * 2u; }
    const size_t kstep = (size_t)(BK * 2);
    const size_t hstepA = (size_t)HALF * g.lda * 2, hstepB = (size_t)HALF * g.ldb * 2;
    const size_t tstepA = 2 * hstepA, tstepB = 2 * hstepB;
    const unsigned ldsw = (unsigned)wid * 1024u;
    const int aoff = lds_byte(wr * 64 + fr, fq * 8), boff = lds_byte(wc * 32 + fr, fq * 8);
#define PG8_SA(b, h) (((b) * 2 + (h)) * HTB)
#define PG8_SB(b, h) ((4 + (b) * 2 + (h)) * HTB)
#define PG8_STAGE(bufoff, gbase, voff) do { _Pragma("unroll") for (int _i = 0; _i < 2; ++_i) \
        __builtin_amdgcn_global_load_lds((const unsigned*)((const char*)(gbase) + (voff)[_i]), (PG8_LAS unsigned*)(lds + (bufoff) + ldsw + _i * 8192), 16, 0, 0); } while (0)
#define PG8_LDA(dst, b, h) do { _Pragma("unroll") for (int m = 0; m < 4; ++m) _Pragma("unroll") for (int k = 0; k < 2; ++k) dst[m][k] = *(const PG8_LAS bf16x8*)(lds + PG8_SA(b, h) + aoff + m * 2048 + k * 1024); } while (0)
#define PG8_LDB(dst, b, h) do { _Pragma("unroll") for (int n = 0; n < 2; ++n) _Pragma("unroll") for (int k = 0; k < 2; ++k) dst[n][k] = *(const PG8_LAS bf16x8*)(lds + PG8_SB(b, h) + boff + n * 2048 + k * 1024); } while (0)
#define PG8_MMA(ai, bj, At, Bt) do { __builtin_amdgcn_s_setprio(1); _Pragma("unroll") for (int m = 0; m < 4; ++m) _Pragma("unroll") for (int n = 0; n < 2; ++n) _Pragma("unroll") for (int k = 0; k < 2; ++k) \
        acc[ai][bj][m][n] = __builtin_amdgcn_mfma_f32_16x16x32_bf16(Bt[n][k], At[m][k], acc[ai][bj][m][n], 0, 0, 0); __builtin_amdgcn_s_setprio(0); } while (0)
#define PG8_WAIT_V(n) asm volatile("s_waitcnt vmcnt(" #n ")" ::: "memory")
#define PG8_WAIT_L(n) asm volatile("s_waitcnt lgkmcnt(" #n ")" ::: "memory")
#define PG8_BAR __builtin_amdgcn_s_barrier()
#define PG8_SCHED __builtin_amdgcn_sched_barrier(0)
    Unit cur, nxt; int ui = 0;
    if (!S.next(0, cur)) return;
    f32x4 acc[2][2][4][2];
#pragma unroll
    for (int a = 0; a < 2; ++a)
#pragma unroll
        for (int b = 0; b < 2; ++b)
#pragma unroll
            for (int m = 0; m < 4; ++m)
#pragma unroll
                for (int n = 0; n < 2; ++n) acc[a][b][m][n] = (f32x4){0.f, 0.f, 0.f, 0.f};
    bf16x8 At[4][2], B0[2][2], B1[2][2];
    const char* cA = (const char*)g.A + (size_t)cur.pm * tstepA; const char* cB = (const char*)g.Bt + (size_t)cur.pn * tstepB;
    S.a_ready(cur);
    if constexpr (SP2) {
        PG8_STAGE(PG8_SB(0, 0), cB, voffB); PG8_STAGE(PG8_SB(0, 1), cB + hstepB, voffB); PG8_STAGE(PG8_SA(0, 0), cA, voffA); PG8_STAGE(PG8_SA(0, 1), cA + hstepA, voffA);
        if (wr == 1) PG8_BAR;
        PG8_WAIT_V(2); PG8_BAR;
        PG8_STAGE(PG8_SB(1, 0), cB + kstep, voffB); PG8_STAGE(PG8_SA(1, 0), cA + kstep, voffA); PG8_STAGE(PG8_SB(1, 1), cB + hstepB + kstep, voffB);
        PG8_WAIT_V(6); PG8_BAR;
    } else {
        PG8_STAGE(PG8_SB(0, 0), cB, voffB); PG8_STAGE(PG8_SA(0, 0), cA, voffA); PG8_STAGE(PG8_SB(0, 1), cB + hstepB, voffB); PG8_STAGE(PG8_SA(0, 1), cA + hstepA, voffA);
        if (wr == 1) PG8_BAR;
        PG8_WAIT_V(4); PG8_BAR;
        PG8_STAGE(PG8_SB(1, 0), cB + kstep, voffB); PG8_STAGE(PG8_SA(1, 0), cA + kstep, voffA); PG8_STAGE(PG8_SB(1, 1), cB + hstepB + kstep, voffB);
        PG8_WAIT_V(6); PG8_BAR;
    }
    for (;;) {
        const bool has_next = S.next(ui + 1, nxt);
        const char* nA = has_next ? (const char*)g.A + (size_t)nxt.pm * tstepA : cA; const char* nB = has_next ? (const char*)g.Bt + (size_t)nxt.pn * tstepB : cB;
        for (int t = 0; t < nt; t += 2) {
            const bool last = (t == nt - 2);
            const char* a1 = cA + (size_t)(t + 1) * kstep;
            const char* a2 = last ? nA : cA + (size_t)(t + 2) * kstep; const char* b2 = last ? nB : cB + (size_t)(t + 2) * kstep;
            const char* a3 = a2 + kstep; const char* b3 = b2 + kstep;
            if (last && has_next) S.a_ready(nxt);
            if constexpr (SP2) {
            PG8_LDB(B0, 0, 0); PG8_LDB(B1, 0, 1); PG8_SCHED; PG8_LDA(At, 0, 0); PG8_STAGE(PG8_SA(1, 1), a1 + hstepA, voffA);
            PG8_WAIT_V(8); PG8_WAIT_L(0); PG8_BAR; PG8_MMA(0, 0, At, B0); PG8_MMA(0, 1, At, B1); PG8_BAR; PG8_SCHED;
            PG8_LDA(At, 0, 1); PG8_STAGE(PG8_SB(0, 0), b2, voffB); PG8_STAGE(PG8_SB(0, 1), b2 + hstepB, voffB); PG8_STAGE(PG8_SA(0, 0), a2, voffA);
            PG8_WAIT_V(8); PG8_WAIT_L(0); PG8_BAR; PG8_MMA(1, 0, At, B0); PG8_MMA(1, 1, At, B1); PG8_BAR; PG8_SCHED;
            PG8_LDB(B0, 1, 0); PG8_LDB(B1, 1, 1); PG8_SCHED; PG8_LDA(At, 1, 0); PG8_STAGE(PG8_SA(0, 1), a2 + hstepA, voffA);
            PG8_WAIT_V(8); PG8_WAIT_L(0); PG8_BAR; PG8_MMA(0, 0, At, B0); PG8_MMA(0, 1, At, B1); PG8_BAR; PG8_SCHED;
            PG8_LDA(At, 1, 1); PG8_STAGE(PG8_SB(1, 0), b3, voffB); PG8_STAGE(PG8_SB(1, 1), b3 + hstepB, voffB); PG8_STAGE(PG8_SA(1, 0), a3, voffA);
            PG8_WAIT_V(8); PG8_WAIT_L(0); PG8_BAR; PG8_MMA(1, 0, At, B0); PG8_MMA(1, 1, At, B1); PG8_BAR; PG8_SCHED;
            } else {
            PG8_LDB(B0, 0, 0); PG8_SCHED; PG8_LDA(At, 0, 0); PG8_STAGE(PG8_SA(1, 1), a1 + hstepA, voffA);
            PG8_WAIT_L(8); PG8_BAR; PG8_WAIT_L(0); PG8_MMA(0, 0, At, B0); PG8_BAR; PG8_SCHED;
            PG8_LDB(B1, 0, 1); PG8_STAGE(PG8_SB(0, 0), b2, voffB);
            PG8_BAR; PG8_WAIT_L(0); PG8_MMA(0, 1, At, B1); PG8_BAR;
            PG8_LDA(At, 0, 1); PG8_STAGE(PG8_SA(0, 0), a2, voffA);
            PG8_BAR; PG8_WAIT_L(0); PG8_MMA(1, 0, At, B0); PG8_BAR; PG8_SCHED;
            PG8_STAGE(PG8_SB(0, 1), b2 + hstepB, voffB);
            PG8_WAIT_V(6); PG8_BAR; PG8_MMA(1, 1, At, B1); PG8_BAR;
            PG8_LDB(B0, 1, 0); PG8_SCHED; PG8_LDA(At, 1, 0); PG8_STAGE(PG8_SA(0, 1), a2 + hstepA, voffA);
            PG8_WAIT_L(8); PG8_BAR; PG8_WAIT_L(0); PG8_MMA(0, 0, At, B0); PG8_BAR; PG8_SCHED;
            PG8_LDB(B1, 1, 1); PG8_STAGE(PG8_SB(1, 0), b3, voffB);
            PG8_BAR; PG8_WAIT_L(0); PG8_MMA(0, 1, At, B1); PG8_BAR;
            PG8_LDA(At, 1, 1); PG8_STAGE(PG8_SA(1, 0), a3, voffA);
            PG8_BAR; PG8_WAIT_L(0); PG8_MMA(1, 0, At, B0); PG8_BAR; PG8_SCHED;
            PG8_STAGE(PG8_SB(1, 1), b3 + hstepB, voffB);
            PG8_WAIT_V(6); PG8_BAR; PG8_MMA(1, 1, At, B1); PG8_BAR;
            }
        }
        if constexpr (ALIGN_EPI) { if (wr == 0) PG8_BAR; }
        if constexpr (!Epi::AFTER_DRAIN) { E(acc, cur, wr, wc, fr, fq); S.done(cur); }
        if (!has_next) break;
#pragma unroll
        for (int a = 0; a < 2; ++a)
#pragma unroll
            for (int b = 0; b < 2; ++b)
#pragma unroll
                for (int m = 0; m < 4; ++m)
#pragma unroll
                    for (int n = 0; n < 2; ++n) acc[a][b][m][n] = (f32x4){0.f, 0.f, 0.f, 0.f};
        cur = nxt; cA = nA; cB = nB; ++ui;
        if constexpr (ALIGN_EPI) { if (wr == 1) PG8_BAR; }
    }
    PG8_WAIT_V(0);
    if constexpr (!ALIGN_EPI) { if (wr == 0) PG8_BAR; }
    PG8_BAR;
    if constexpr (Epi::AFTER_DRAIN) { E.fused(acc, cur, wr, wc, fr, fq, lds, wid, lane); S.done(cur); }
#undef PG8_SA
#undef PG8_SB
#undef PG8_STAGE
#undef PG8_LDA
#undef PG8_LDB
#undef PG8_MMA
#undef PG8_WAIT_V
#undef PG8_WAIT_L
#undef PG8_BAR
#undef PG8_SCHED
}
}

#ifndef PROBE_REP_ATT
#define PROBE_REP_ATT 1
#endif
#ifndef PROBE_REP_UP
#define PROBE_REP_UP 1
#endif
#ifndef PROBE_XSYNC
#define PROBE_XSYNC 0
#endif
#ifndef PROBE_REP_MISC
#define PROBE_REP_MISC 1
#endif
#ifndef PROBE_REP_WIN
#define PROBE_REP_WIN 1
#endif
#ifndef PHM
#define PHM 127
#endif
#ifndef MK_SINGLE
#define MK_SINGLE 1
#endif
constexpr int DM = 2048, MP = 8192, M_ALL = 40960, SEQ_P = 4096, SEQ_S = 16384, INW = 5632, DFF = 8192, NLAYER = 2;
constexpr int OFF_AX = 0, OFF_AB = 512, OFF_AC = 1024, OFF_Q = 1536, OFF_K = 2560, OFF_V = 3584, OFF_CU = 4608, OFF_CV = 5120;
constexpr int MIX_A = 0, MIX_B = 512, MIX_C = 1536;
constexpr float EPS = 1e-6f;
constexpr float C2 = 0.18033688011112042f;
constexpr size_t MiB = 1u << 20;
constexpr int LDH = DFF + 128;
constexpr size_t WS_WT = 1 * MiB, WT_LAYER = 96 * MiB, WT_IN = 0, WT_OUT = 22 * MiB, WT_UP = 30 * MiB, WT_DN = 62 * MiB;
constexpr size_t WS_XN = 194 * MiB, WS_H = 356 * MiB, WS_PROJ = 356 * MiB, WS_MIX = 796 * MiB, WS_END = 1008 * MiB;
static_assert(WT_DN + (size_t)DM * LDH * 2 <= WT_LAYER && WS_WT + 2 * WT_LAYER <= WS_XN && WS_XN + (size_t)M_ALL * DM * 2 <= WS_H && WS_PROJ + (size_t)M_ALL * INW * 2 <= WS_MIX && WS_MIX + (size_t)M_ALL * DM * 2 <= WS_END && WS_H + (size_t)M_ALL * LDH * 2 <= WS_END, "ws map");
constexpr int NWAVES = 8, LDS_BYTES = 147456;

typedef unsigned short bf16;
typedef unsigned v4u __attribute__((ext_vector_type(4)));
typedef unsigned v2u __attribute__((ext_vector_type(2)));
typedef float f32x4 __attribute__((ext_vector_type(4)));
#define DI __device__ __forceinline__

DI unsigned pk2(float lo, float hi) { return pg8::cvt_pk_bf16(lo, hi); }
DI float bflo(unsigned u) { return __uint_as_float(u << 16); }
DI float bfhi(unsigned u) { return __uint_as_float(u & 0xffff0000u); }
DI float wave_sum(float v) {
#pragma unroll
    for (int o = 1; o < 64; o <<= 1) v += __shfl_xor(v, o);
    return v;
}
DI float wave_max(float v) {
#pragma unroll
    for (int o = 1; o < 64; o <<= 1) v = fmaxf(v, __shfl_xor(v, o));
    return v;
}
DI float gelu_tanh(float x) {
    const float z = x * (0.7978845608028654f + 0.035677408136300125f * x * x);
    const float e = __builtin_amdgcn_exp2f(-2.8853900817779268f * z);
    return x * __builtin_amdgcn_rcpf(1.0f + e);
}

DI void transpose_item(const float* W, int K, int N, bf16* WT, int ldt, float* scr, int item, int lane) {
    const int nblk = N / 32, kb = item / nblk, nb = item % nblk, k0 = 64 * kb, n0 = 32 * nb;
#pragma unroll 32
    for (int i = 0; i < 32; ++i) { const int kk = 2 * i + (lane >> 5); scr[kk * 33 + (lane & 31)] = W[(size_t)(k0 + kk) * N + n0 + (lane & 31)]; }
    asm volatile("s_waitcnt lgkmcnt(0)" ::: "memory");
    const int c = lane & 7;
#pragma unroll
    for (int j = 0; j < 4; ++j) { const int n = (lane >> 3) + 8 * j; const float* s = scr + (8 * c) * 33 + n;
        v4u o; o.x = pk2(s[0 * 33], s[1 * 33]); o.y = pk2(s[2 * 33], s[3 * 33]); o.z = pk2(s[4 * 33], s[5 * 33]); o.w = pk2(s[6 * 33], s[7 * 33]);
        *(v4u*)(WT + (size_t)(n0 + n) * ldt + k0 + 8 * c) = o; }
    asm volatile("s_waitcnt lgkmcnt(0)" ::: "memory");
}
DI void norm_row(const float* xrow, const float* g, bf16* orow, int lane) {
    const f32x4* xr = (const f32x4*)xrow + lane; const f32x4* gr = (const f32x4*)g + lane;
    f32x4 v[8]; float s = 0.f;
#pragma unroll
    for (int j = 0; j < 8; ++j) { v[j] = xr[64 * j]; s += (v[j].x * v[j].x + v[j].y * v[j].y) + (v[j].z * v[j].z + v[j].w * v[j].w); }
    const float rstd = 1.0f / sqrtf(wave_sum(s) * (1.f / DM) + EPS);
    v2u* o8 = (v2u*)orow + lane;
#pragma unroll
    for (int j = 0; j < 8; ++j) { const f32x4 gg = gr[64 * j]; v2u w; w.x = pk2(v[j].x * rstd * gg.x, v[j].y * rstd * gg.y); w.y = pk2(v[j].z * rstd * gg.z, v[j].w * rstd * gg.w); o8[64 * j] = w; }
}

__constant__ double ROPE_INV[8] = {1.0, 0.19392274474868576, 0.03760603093086393, 0.007292664737217109, 0.001414213562373095, 0.0002742481756762073, 5.318295896944988e-05, 1.031338537721246e-05};
DI void qk_row(bf16* P, int row, int pos, const float* qg, const float* kg, int lane) {
    bf16* p = P + (size_t)row * INW + OFF_Q + lane * 32;
    v4u raw[4];
#pragma unroll
    for (int i = 0; i < 4; ++i) raw[i] = *(const v4u*)(p + 8 * i);
    float x[32];
#pragma unroll
    for (int i = 0; i < 4; ++i) { x[8 * i + 0] = bflo(raw[i].x); x[8 * i + 1] = bfhi(raw[i].x); x[8 * i + 2] = bflo(raw[i].y); x[8 * i + 3] = bfhi(raw[i].y);
        x[8 * i + 4] = bflo(raw[i].z); x[8 * i + 5] = bfhi(raw[i].z); x[8 * i + 6] = bflo(raw[i].w); x[8 * i + 7] = bfhi(raw[i].w); }
    float ss = 0.f;
#pragma unroll
    for (int i = 0; i < 32; ++i) ss += x[i] * x[i];
    ss += __shfl_xor(ss, 1);
    const float rstd = 1.0f / sqrtf(ss * (1.f / 64.f) + EPS);
    const bool isq = lane < 32; const int half = lane & 1;
    const float* g = (isq ? qg : kg) + half * 32;
#pragma unroll
    for (int i = 0; i < 8; ++i) { const f32x4 gg = *(const f32x4*)(g + 4 * i); x[4 * i] *= rstd * gg.x; x[4 * i + 1] *= rstd * gg.y; x[4 * i + 2] *= rstd * gg.z; x[4 * i + 3] *= rstd * gg.w; }
    const double t = (double)pos * ROPE_INV[lane & 7] * 0.15915494309189535;
    const float fr = (float)(t - rint(t));
    const float cs = __builtin_amdgcn_cosf(fr), sn = __builtin_amdgcn_sinf(fr);
#pragma unroll
    for (int i = 0; i < 8; ++i) { const float c = __shfl(cs, i), s = __shfl(sn, i);
        if (half == 0) { const float a = x[i], b = x[i + 8]; x[i] = a * c - b * s; x[i + 8] = b * c + a * s; } }
    const float sc = isq ? C2 : 1.0f;
#pragma unroll
    for (int i = 0; i < 4; ++i) { v4u w; w.x = pk2(x[8 * i] * sc, x[8 * i + 1] * sc); w.y = pk2(x[8 * i + 2] * sc, x[8 * i + 3] * sc); w.z = pk2(x[8 * i + 4] * sc, x[8 * i + 5] * sc); w.w = pk2(x[8 * i + 6] * sc, x[8 * i + 7] * sc);
        *(v4u*)(p + 8 * i) = w; }
}
DI void unpack8(const v4u r, float* x) { x[0] = bflo(r.x); x[1] = bfhi(r.x); x[2] = bflo(r.y); x[3] = bfhi(r.y); x[4] = bflo(r.z); x[5] = bfhi(r.z); x[6] = bflo(r.w); x[7] = bfhi(r.w); }
DI void conv_row(const bf16* P, bf16* MIX, int row, int pos, int S, const float* cw, int lane) {
    const bf16* p = P + (size_t)row * INW + lane * 8;
    const v4u z4 = {0u, 0u, 0u, 0u};
    const v4u xa0 = *(const v4u*)(p + OFF_AX), gc0 = *(const v4u*)(p + OFF_AC), gb0 = *(const v4u*)(p + OFF_AB);
    const v4u xam = pos > 0 ? *(const v4u*)(p - INW + OFF_AX) : z4, gcm = pos > 0 ? *(const v4u*)(p - INW + OFF_AC) : z4;
    const v4u xap = pos < S - 1 ? *(const v4u*)(p + INW + OFF_AX) : z4, gcp = pos < S - 1 ? *(const v4u*)(p + INW + OFF_AC) : z4;
    float a0[8], c0[8], b0[8], am[8], cm[8], ap[8], cp[8];
    unpack8(xa0, a0); unpack8(gc0, c0); unpack8(gb0, b0); unpack8(xam, am); unpack8(gcm, cm); unpack8(xap, ap); unpack8(gcp, cp);
    float w0[8], w1[8], w2[8];
#pragma unroll
    for (int i = 0; i < 2; ++i) { const f32x4 a = *(const f32x4*)(cw + lane * 8 + 4 * i), b = *(const f32x4*)(cw + 512 + lane * 8 + 4 * i), c = *(const f32x4*)(cw + 1024 + lane * 8 + 4 * i);
        w0[4 * i] = a.x; w0[4 * i + 1] = a.y; w0[4 * i + 2] = a.z; w0[4 * i + 3] = a.w; w1[4 * i] = b.x; w1[4 * i + 1] = b.y; w1[4 * i + 2] = b.z; w1[4 * i + 3] = b.w;
        w2[4 * i] = c.x; w2[4 * i + 1] = c.y; w2[4 * i + 2] = c.z; w2[4 * i + 3] = c.w; }
    float o[8];
#pragma unroll
    for (int j = 0; j < 8; ++j) o[j] = b0[j] * (w0[j] * (cm[j] * am[j]) + w1[j] * (c0[j] * a0[j]) + w2[j] * (cp[j] * ap[j]));
    v4u w; w.x = pk2(o[0], o[1]); w.y = pk2(o[2], o[3]); w.z = pk2(o[4], o[5]); w.w = pk2(o[6], o[7]);
    *(v4u*)(MIX + (size_t)row * DM + MIX_A + lane * 8) = w;
}

namespace att {
using bf16x8 = __attribute__((ext_vector_type(8))) short;
using s16x4  = __attribute__((ext_vector_type(4))) short;
using f32x16 = __attribute__((ext_vector_type(16))) float;
using u32x4  = __attribute__((ext_vector_type(4))) unsigned;
constexpr int KVBLK = 64;
constexpr int SHM_V = 16384, SHM_K = 16384, SCR_OFF = 98304;
#define KSWZ(row, colB) ((row) * 256 + ((colB) ^ (((row) & 7) << 4)))
#define SBAR() __builtin_amdgcn_sched_barrier(0)
DI int crow(int r, int hi) { return (r & 3) + 8 * (r >> 2) + 4 * hi; }
DI unsigned cvtpk(float lo, float hi) { unsigned r; asm volatile("v_cvt_pk_bf16_f32 %0, %1, %2" : "=v"(r) : "v"(lo), "v"(hi)); return r; }
DI int v_st(int k, int c) { const int kk = (k & ~0xC) | ((k & 4) << 1) | ((k & 8) >> 1); return ((kk >> 3) * 4 + (c >> 5)) * 512 + ((kk & 7) * 32 + (c & 31)) * 2; }
DI int v_rd_base(int lane) { return ((lane & 3) << 3) | (((lane >> 2) & 3) << 6) | (((lane >> 4) & 1) << 5) | (((lane >> 5) & 1) << 8); }
constexpr int v_rd_off(int d0, int ks, int half) { return d0 * 512 + ks * 4096 + half * 2048; }
template <int OFF> DI s16x4 tr_read(int vb) { s16x4 r; asm volatile("ds_read_b64_tr_b16 %0, %1 offset:%2" : "=&v"(r) : "v"(vb), "i"(OFF) : "memory"); return r; }
template <int D0> DI void pv_one(f32x16& od, int vb, bf16x8 pa0, bf16x8 pa1, bf16x8 pa2, bf16x8 pa3) {
  const s16x4 l0 = tr_read<v_rd_off(D0, 0, 0)>(vb), h0 = tr_read<v_rd_off(D0, 0, 1)>(vb), l1 = tr_read<v_rd_off(D0, 1, 0)>(vb), h1 = tr_read<v_rd_off(D0, 1, 1)>(vb);
  const s16x4 l2 = tr_read<v_rd_off(D0, 2, 0)>(vb), h2 = tr_read<v_rd_off(D0, 2, 1)>(vb), l3 = tr_read<v_rd_off(D0, 3, 0)>(vb), h3 = tr_read<v_rd_off(D0, 3, 1)>(vb);
  asm volatile("s_waitcnt lgkmcnt(0)" ::: "memory"); SBAR();
#define PK(L, H) (bf16x8){L[0], L[1], L[2], L[3], H[0], H[1], H[2], H[3]}
  od = __builtin_amdgcn_mfma_f32_32x32x16_bf16(pa0, PK(l0, h0), od, 0, 0, 0);
  od = __builtin_amdgcn_mfma_f32_32x32x16_bf16(pa1, PK(l1, h1), od, 0, 0, 0);
  od = __builtin_amdgcn_mfma_f32_32x32x16_bf16(pa2, PK(l2, h2), od, 0, 0, 0);
  od = __builtin_amdgcn_mfma_f32_32x32x16_bf16(pa3, PK(l3, h3), od, 0, 0, 0);
#undef PK
}
DI void pv_d0(f32x16* o, int vb, bf16x8 pa0, bf16x8 pa1, bf16x8 pa2, bf16x8 pa3) {
  pv_one<0>(o[0], vb, pa0, pa1, pa2, pa3); pv_one<1>(o[1], vb, pa0, pa1, pa2, pa3); pv_one<2>(o[2], vb, pa0, pa1, pa2, pa3); pv_one<3>(o[3], vb, pa0, pa1, pa2, pa3);
}
template <bool SHIFT> DI void qkt(f32x16& p0, f32x16& p1, const char* Ks, const bf16x8* qr, int r32, int hi, int c, float negmb) {
  if constexpr (SHIFT) {
#pragma unroll
    for (int r = 0; r < 16; ++r) { p0[r] = negmb; p1[r] = negmb; }
  } else { p0 = f32x16{}; p1 = f32x16{}; }
#pragma unroll
  for (int d0 = 0; d0 < 4; ++d0) { const int cb = (c * 64 + d0 * 16 + hi * 8) * 2;
    const bf16x8 b0 = *reinterpret_cast<const bf16x8*>(Ks + KSWZ(r32, cb));
    const bf16x8 b1 = *reinterpret_cast<const bf16x8*>(Ks + KSWZ(32 + r32, cb));
    p0 = __builtin_amdgcn_mfma_f32_32x32x16_bf16(b0, qr[d0], p0, 0, 0, 0);
    p1 = __builtin_amdgcn_mfma_f32_32x32x16_bf16(b1, qr[d0], p1, 0, 0, 0); }
}
DI void expA(f32x16& p0) {
#pragma unroll
  for (int r = 0; r < 16; ++r) p0[r] = __builtin_amdgcn_exp2f(p0[r]);
}
DI void finishSM(f32x16& p0, f32x16& p1, float& l_reg, bf16x8& pa0, bf16x8& pa1, bf16x8& pa2, bf16x8& pa3) {
#pragma unroll
  for (int r = 0; r < 16; ++r) p1[r] = __builtin_amdgcn_exp2f(p1[r]);
  float ps = 0.f;
#pragma unroll
  for (int r = 0; r < 16; ++r) ps += p0[r];
#pragma unroll
  for (int r = 0; r < 16; ++r) ps += p1[r];
  l_reg += ps;
#define PK4(P, BASE, OUT) do { unsigned a0 = cvtpk(P[BASE + 0], P[BASE + 1]), a1 = cvtpk(P[BASE + 2], P[BASE + 3]);   \
    unsigned b0 = cvtpk(P[BASE + 4], P[BASE + 5]), b1 = cvtpk(P[BASE + 6], P[BASE + 7]);                              \
    auto r0 = __builtin_amdgcn_permlane32_swap(a0, b0, false, false); auto r1 = __builtin_amdgcn_permlane32_swap(a1, b1, false, false); \
    u32x4 w = {r0[0], r1[0], r0[1], r1[1]}; OUT = *reinterpret_cast<bf16x8*>(&w); } while (0)
  PK4(p0, 0, pa0); PK4(p0, 8, pa1); PK4(p1, 0, pa2); PK4(p1, 8, pa3);
#undef PK4
}
DI unsigned cvtpk2(float lo, float hi) { typedef float f2_t __attribute__((ext_vector_type(2))); typedef __bf16 b2_t __attribute__((ext_vector_type(2))); f2_t v = {lo, hi}; b2_t b = __builtin_convertvector(v, b2_t); return __builtin_bit_cast(unsigned, b); }
template <int I> DI void vrd(s16x4& l, s16x4& h, int vb) { constexpr int ks = I >> 2, d0 = I & 3; l = tr_read<v_rd_off(d0, ks, 0)>(vb); h = tr_read<v_rd_off(d0, ks, 1)>(vb); }
#define TIEWAIT(N, L, H) asm volatile("s_waitcnt lgkmcnt(" #N ")" : "+v"(L), "+v"(H))
#define PK4B(P, BASE, OUT) do { unsigned a0 = cvtpk2(P[BASE + 0], P[BASE + 1]), a1 = cvtpk2(P[BASE + 2], P[BASE + 3]);   \
    unsigned b0 = cvtpk2(P[BASE + 4], P[BASE + 5]), b1 = cvtpk2(P[BASE + 6], P[BASE + 7]);                              \
    auto r0 = __builtin_amdgcn_permlane32_swap(a0, b0, false, false); auto r1 = __builtin_amdgcn_permlane32_swap(a1, b1, false, false); \
    u32x4 w = {r0[0], r1[0], r0[1], r1[1]}; OUT = *reinterpret_cast<bf16x8*>(&w); } while (0)
#define PKV(L, H) (bf16x8){L[0], L[1], L[2], L[3], H[0], H[1], H[2], H[3]}
#define PVSTEP(i, N, PA, SL, SH, NL, NH) do { TIEWAIT(N, SL, SH); o[(i) & 3] = __builtin_amdgcn_mfma_f32_32x32x16_bf16(PA, PKV(SL, SH), o[(i) & 3], 0, 0, 0); \
    if constexpr ((i) + 3 < 16) vrd<((i) + 3 < 16 ? (i) + 3 : 15)>(NL, NH, vb); } while (0)
DI void finish_pv(f32x16& p0, f32x16& p1, float& l_reg, f32x16* o, int vb) {
  s16x4 l0, h0, l1, h1, l2, h2, l3, h3;
  vrd<0>(l0, h0, vb); vrd<1>(l1, h1, vb); vrd<2>(l2, h2, vb);
  bf16x8 pa0, pa1, pa2, pa3;
  PK4B(p0, 0, pa0); PK4B(p0, 8, pa1);
  PVSTEP(0, 4, pa0, l0, h0, l3, h3); PVSTEP(1, 4, pa0, l1, h1, l0, h0); PVSTEP(2, 4, pa0, l2, h2, l1, h1); PVSTEP(3, 4, pa0, l3, h3, l2, h2);
  PVSTEP(4, 4, pa1, l0, h0, l3, h3); PVSTEP(5, 4, pa1, l1, h1, l0, h0); PVSTEP(6, 4, pa1, l2, h2, l1, h1); PVSTEP(7, 4, pa1, l3, h3, l2, h2);
#pragma unroll
  for (int r = 0; r < 16; ++r) p1[r] = __builtin_amdgcn_exp2f(p1[r]);
  PK4B(p1, 0, pa2); PK4B(p1, 8, pa3);
  PVSTEP(8, 4, pa2, l0, h0, l3, h3); PVSTEP(9, 4, pa2, l1, h1, l0, h0); PVSTEP(10, 4, pa2, l2, h2, l1, h1); PVSTEP(11, 4, pa2, l3, h3, l2, h2);
  PVSTEP(12, 4, pa3, l0, h0, l3, h3); PVSTEP(13, 4, pa3, l1, h1, l0, h0); PVSTEP(14, 2, pa3, l2, h2, l1, h1); PVSTEP(15, 0, pa3, l3, h3, l2, h2);
  float ps = 0.f;
#pragma unroll
  for (int r = 0; r < 16; ++r) ps += p0[r];
#pragma unroll
  for (int r = 0; r < 16; ++r) ps += p1[r];
  l_reg += ps;
}
DI void glds16(const void* gsrc, unsigned lds_dst) { unsigned keep;
  asm volatile("s_mov_b32 %0, m0\n\ts_mov_b32 m0, %2\n\ts_nop 0\n\tglobal_load_lds_dwordx4 %1, off\n\ts_mov_b32 m0, %0" : "=&s"(keep) : "v"(gsrc), "s"(lds_dst) : "memory"); }
#define WAIT_BAR(N) asm volatile("s_waitcnt vmcnt(" #N ") lgkmcnt(0)\n\ts_barrier" ::: "memory")
template <bool SHIFT> DI void attn_unit(const bf16* __restrict__ Qb, const bf16* __restrict__ Kh, const bf16* __restrict__ Vh, bf16* __restrict__ Ob, int seq, char* lds,
                  float negmb, float lam, const float* __restrict__ gsub, float post) {
  int tid = threadIdx.x; asm volatile("" : "+v"(tid));
  const int lane = tid & 63, r32 = lane & 31, hi = lane >> 5; const int wid = __builtin_amdgcn_readfirstlane(tid >> 6), c = wid >> 2, wq = wid & 3;
  char* K_ring = lds; char* V_ring = lds + 3 * SHM_K;
  float* wsf = (float*)(lds + SCR_OFF) + wid * 64;
  const unsigned lds0 = (unsigned)(uintptr_t)lds;
  float l_reg = 0.f; f32x16 o[4] = {}; bf16x8 qr[4];
  const bf16* Qw = Qb + (size_t)(wq * 32 + r32) * INW + c * 64 + hi * 8;
#pragma unroll
  for (int d0 = 0; d0 < 4; ++d0) qr[d0] = *reinterpret_cast<const bf16x8*>(Qw + d0 * 16);
  const bf16* ksrc0; const bf16* ksrc1; const bf16* vsrc0; const bf16* vsrc1;
  { const int row0 = 8 * wid + (lane >> 4), row1 = row0 + 4, cp = lane & 15;
    ksrc0 = Kh + (size_t)row0 * INW + ((cp ^ (row0 & 7)) << 3); ksrc1 = Kh + (size_t)row1 * INW + ((cp ^ (row1 & 7)) << 3);
    const int kk = 8 * wid + ((lane & 31) >> 2), kkey = (kk & ~0xC) | ((kk & 4) << 1) | ((kk & 8) >> 1), cc = (lane >> 5) * 32 + (lane & 3) * 8;
    vsrc0 = Vh + (size_t)kkey * INW + cc; vsrc1 = vsrc0 + 64; }
  const unsigned kdst = lds0 + (unsigned)wid * 2048u, vdst = lds0 + 3u * SHM_K + (unsigned)wid * 2048u;
#define DMA_K(t, slot) do { const size_t to_ = (size_t)(t) * (KVBLK * INW); const unsigned d_ = (unsigned)__builtin_amdgcn_readfirstlane(kdst + (unsigned)(slot)); glds16(ksrc0 + to_, d_); glds16(ksrc1 + to_, d_ + 1024u); } while (0)
#define DMA_V(t, slot) do { const size_t to_ = (size_t)(t) * (KVBLK * INW); const unsigned d_ = (unsigned)__builtin_amdgcn_readfirstlane(vdst + (unsigned)(slot)); glds16(vsrc0 + to_, d_); glds16(vsrc1 + to_, d_ + 1024u); } while (0)
  const int vb0 = (int)(lds0 + 3u * SHM_K) + v_rd_base(lane);
  f32x16 pA0, pA1, pB0, pB1; const int NT = seq / KVBLK;
  int s0 = 0, s1 = SHM_K, s2 = 2 * SHM_K;
#define ROT() do { const int t_ = s0; s0 = s1; s1 = s2; s2 = t_; } while (0)
  DMA_K(0, 0); DMA_K(1, SHM_K); DMA_V(0, 0);
  WAIT_BAR(4);
  DMA_K(2, 2 * SHM_K); DMA_V(1, SHM_K);
  qkt<SHIFT>(pA0, pA1, K_ring, qr, r32, hi, c, negmb); expA(pA0);
#define ITER(CUR0, CUR1, PRV0, PRV1, j) do { \
    WAIT_BAR(4); \
    { const int tk_ = ((j) + 2 < NT) ? (j) + 2 : NT - 1, tv_ = ((j) + 1 < NT) ? (j) + 1 : NT - 1; DMA_K(tk_, s0); DMA_V(tv_, s2); } \
    SBAR(); qkt<SHIFT>(CUR0, CUR1, K_ring + s1, qr, r32, hi, c, negmb); \
    finish_pv(PRV0, PRV1, l_reg, o, vb0 + s0); expA(CUR0); \
    ROT(); } while (0)
  for (int j = 1; j + 1 < NT; j += 2) {
    ITER(pB0, pB1, pA0, pA1, j);
    ITER(pA0, pA1, pB0, pB1, j + 1);
  }
  ITER(pB0, pB1, pA0, pA1, NT - 1);
  WAIT_BAR(0);
  finish_pv(pB0, pB1, l_reg, o, vb0 + s0);
#undef ITER
#undef ROT
#undef DMA_K
#undef DMA_V
  int lane_e = lane; asm volatile("" : "+v"(lane_e));
  {
  const int lane = lane_e, r32 = lane & 31, hi = lane >> 5;
  { auto rr = __builtin_amdgcn_permlane32_swap(__float_as_uint(l_reg), __float_as_uint(l_reg), false, false); l_reg = __uint_as_float(rr[0]) + __uint_as_float(rr[1]); }
  if (hi == 0) wsf[r32] = l_reg;
  asm volatile("s_waitcnt lgkmcnt(0)" ::: "memory");
  __syncthreads();
  float* X = (float*)lds + wq * 4096;
  if (c == 1) {
#pragma unroll
    for (int r = 0; r < 16; ++r) { const float rl = __builtin_amdgcn_rcpf(wsf[crow(r, hi)]);
#pragma unroll
      for (int d0 = 0; d0 < 4; ++d0) X[(d0 * 16 + r) * 64 + lane] = o[d0][r] * rl; }
  }
  __syncthreads();
  if (c == 0) {
    float g4[4];
#pragma unroll
    for (int d0 = 0; d0 < 4; ++d0) g4[d0] = gsub[32 * d0 + r32] * post;
#pragma unroll
    for (int r = 0; r < 16; ++r) { const float rl = __builtin_amdgcn_rcpf(wsf[crow(r, hi)]); float dv[4]; float s = 0.f;
#pragma unroll
      for (int d0 = 0; d0 < 4; ++d0) { dv[d0] = o[d0][r] * rl - lam * X[(d0 * 16 + r) * 64 + lane]; s += dv[d0] * dv[d0]; }
#pragma unroll
      for (int off = 1; off < 32; off <<= 1) s += __shfl_xor(s, off);
      const float rs = 1.0f / sqrtf(s * (1.f / 128.f) + EPS); bf16* orow = Ob + (size_t)(wq * 32 + crow(r, hi)) * DM + r32;
#pragma unroll
      for (int d0 = 0; d0 < 4; ++d0) orow[32 * d0] = (bf16)(pk2(dv[d0] * rs * g4[d0], 0.f) & 0xffffu); }
  }
  }
  __syncthreads();
}
#undef SBAR
}

DI void sgu_unit(const bf16* P, bf16* MIX, int chunk, int hd, const float* Ws, const float* bs, const float* gv, char* lds) {
    using att::bf16x8; using att::f32x16;
    int tid = threadIdx.x; asm volatile("" : "+v"(tid));
    const int wid = tid >> 6, lane = tid & 63, r32 = lane & 31, hi = lane >> 5;
    bf16* vnT = (bf16*)lds;
    { const int p = tid >> 2, qtr = tid & 3; const bf16* src = P + (size_t)(chunk * 128 + p) * INW + OFF_CV + hd * 128 + qtr * 32;
      v4u raw[4];
#pragma unroll
      for (int i = 0; i < 4; ++i) raw[i] = *(const v4u*)(src + 8 * i);
      float x[32];
#pragma unroll
      for (int i = 0; i < 4; ++i) unpack8(raw[i], x + 8 * i);
      float ss = 0.f;
#pragma unroll
      for (int i = 0; i < 32; ++i) { x[i] = gelu_tanh(x[i]); ss += x[i] * x[i]; }
      ss += __shfl_xor(ss, 1); ss += __shfl_xor(ss, 2);
      const float rstd = 1.0f / sqrtf(ss * (1.f / 128.f) + EPS);
#pragma unroll
      for (int i = 0; i < 32; ++i) { const float v = x[i] * rstd * gv[qtr * 32 + i]; vnT[(qtr * 32 + i) * 136 + p] = (bf16)(pk2(v, 0.f) & 0xffffu); }
    }
    __syncthreads();
    const int qb = wid >> 1;
    bf16x8 a[8];
#pragma unroll
    for (int ks = 0; ks < 8; ++ks) { const float* w = Ws + (size_t)(32 * qb + r32) * 128 + 16 * ks + 8 * hi; const f32x4 w0 = *(const f32x4*)w, w1 = *(const f32x4*)(w + 4);
        att::u32x4 u = {pk2(w0.x, w0.y), pk2(w0.z, w0.w), pk2(w1.x, w1.y), pk2(w1.z, w1.w)}; a[ks] = *reinterpret_cast<bf16x8*>(&u); }
#pragma unroll
    for (int dd = 0; dd < 2; ++dd) { const int db = 2 * (wid & 1) + dd;
        f32x16 acc = {};
#pragma unroll
        for (int ks = 0; ks < 8; ++ks) { const bf16x8 b = *reinterpret_cast<const bf16x8*>(vnT + (32 * db + r32) * 136 + 16 * ks + 8 * hi);
            acc = __builtin_amdgcn_mfma_f32_32x32x16_bf16(a[ks], b, acc, 0, 0, 0); }
        const int d = 32 * db + r32;
#pragma unroll
        for (int i = 0; i < 16; ++i) { const int q = 32 * qb + att::crow(i, hi); const size_t tok = (size_t)chunk * 128 + q;
            const float uval = gelu_tanh(__uint_as_float((unsigned)P[tok * INW + OFF_CU + hd * 128 + d] << 16));
            MIX[tok * DM + MIX_C + hd * 128 + d] = (bf16)(pk2(uval * (acc[i] + bs[q]), 0.f) & 0xffffu); }
    }
    __syncthreads();
}

#define LAS __attribute__((address_space(3)))
#define XB_TMO      128
#define XB_XCNT(j)  (256  + 64 * (j))
#define XB_XSUB(j)  (1280 + 64 * (j))
#define XB_XGEN(j)  (2304 + 64 * (j))
#define XB_TOP      3328
#define XB_TOPGEN   3392
#define XCD_BAR_WORDS 3456
#define XB_SPIN_CAP (1u << 18)

__device__ __forceinline__ unsigned xb_ld(unsigned* p)              { return __hip_atomic_load(p, __ATOMIC_RELAXED, __HIP_MEMORY_SCOPE_AGENT); }
__device__ __forceinline__ unsigned xb_add(unsigned* p, unsigned v) { return __hip_atomic_fetch_add(p, v, __ATOMIC_RELAXED, __HIP_MEMORY_SCOPE_AGENT); }
__device__ __forceinline__ unsigned xb_xcc_id() { return (unsigned)__builtin_amdgcn_s_getreg((3 << 11) | 20) & 0xFu; }
#define XB_SPIN(cond, bar) do { unsigned _sp = 0; while (cond) { __builtin_amdgcn_s_sleep(1); \
    if ((++_sp & 255u) == 0u) { if (xb_ld(&(bar)[XB_TMO])) break; if (_sp > XB_SPIN_CAP) { atomicAdd(&(bar)[XB_TMO], 1u); break; } } } } while (0)

struct XcdBarrier {
    unsigned* bar; unsigned x;
    volatile LAS unsigned* st;
};

__device__ __forceinline__ XcdBarrier xcd_barrier_post(unsigned* bar, volatile LAS unsigned* st) {
    XcdBarrier b; b.bar = bar; b.x = xb_xcc_id(); b.st = st;
    if (threadIdx.x == 0) (void)xb_add(&bar[XB_XCNT(b.x)], 1u);
    return b;
}
__device__ __forceinline__ void xcd_barrier_complete(unsigned* bar, unsigned x, unsigned& nloc, unsigned& nx) {
    const unsigned G = gridDim.x * gridDim.y * gridDim.z;
    unsigned sum, cnt, mine, sp = 0u;
    for (;;) {
        sum = 0u; cnt = 0u; mine = 0u;
#pragma unroll
        for (unsigned j = 0; j < 16; ++j) { const unsigned c = xb_ld(&bar[XB_XCNT(j)]); sum += c; cnt += (c > 0u) ? 1u : 0u; mine = (j == x) ? c : mine; }
        if (sum == G) break;
        __builtin_amdgcn_s_sleep(1);
        if ((++sp & 255u) == 0u) { if (xb_ld(&bar[XB_TMO])) break; if (sp > XB_SPIN_CAP) { atomicAdd(&bar[XB_TMO], 1u); break; } }
    }
    nloc = mine > 0u ? mine : 1u; nx = cnt > 0u ? cnt : 1u;
}

__device__ __forceinline__ void xcd_barrier(const XcdBarrier& b) {
    asm volatile("s_waitcnt vmcnt(0)" ::: "memory");
    __syncthreads();
    if (threadIdx.x == 0) {
        unsigned* bar = b.bar;
        __builtin_amdgcn_s_waitcnt(0);
        unsigned nloc = b.st[0], nx = b.st[1];
        if (nloc == 0u) { xcd_barrier_complete(bar, b.x, nloc, nx); b.st[0] = nloc; b.st[1] = nx; }
        const unsigned old = xb_add(&bar[XB_XSUB(b.x)], 1u);
        const unsigned gen = old / nloc;
        if (old + 1u == (gen + 1u) * nloc) {
            __builtin_amdgcn_fence(__ATOMIC_RELEASE, "agent");
            asm volatile("s_waitcnt vmcnt(0)" ::: "memory");
            const unsigned og = xb_add(&bar[XB_TOP], 1u);
            const unsigned tg = og / nx;
            if (og + 1u == (tg + 1u) * nx) xb_add(&bar[XB_TOPGEN], 1u);
            else XB_SPIN(xb_ld(&bar[XB_TOPGEN]) == tg, bar);
            __builtin_amdgcn_fence(__ATOMIC_ACQUIRE, "agent");
            xb_add(&bar[XB_XGEN(b.x)], 1u);
            asm volatile("s_waitcnt vmcnt(0)" ::: "memory");
        } else {
            XB_SPIN(xb_ld(&bar[XB_XGEN(b.x)]) == gen, bar);
            __builtin_amdgcn_fence(__ATOMIC_ACQUIRE, "agent");
            asm volatile("s_waitcnt vmcnt(0)" ::: "memory");
        }
    }
    __syncthreads();
}

struct Args { const float* in[19]; float* out; unsigned char* ws; int ph_lo, ph_hi; };
constexpr int N_PHASES = 1 + 8 * NLAYER - 1;

__global__ void __launch_bounds__(NWAVES * 64, 2) mk_fwd(Args args) {
    extern __shared__ __attribute__((aligned(16))) unsigned char lds[];
    cg::grid_group grid = cg::this_grid();
    const int G = gridDim.x; const int bx = blockIdx.x; const int vcu = (G % 8 == 0) ? (bx % 8) * (G / 8) + bx / 8 : bx;
    const int NGW = G * NWAVES;
    unsigned char* ws = args.ws;
    const float* xp = args.in[0]; const float* xs = args.in[1];
    float* out = args.out;
    bf16* XN = (bf16*)(ws + WS_XN); bf16* PROJ = (bf16*)(ws + WS_PROJ); bf16* MIX = (bf16*)(ws + WS_MIX); bf16* HB = (bf16*)(ws + WS_H);

    volatile LAS unsigned* MISC = (volatile LAS unsigned*)((LAS unsigned char*)lds + 131072 + 320);
    if (threadIdx.x < 32) MISC[threadIdx.x] = 0u;
    __syncthreads();
    const XcdBarrier bar = xcd_barrier_post((unsigned*)ws, MISC + 8);
    for (int ph = args.ph_lo; ph < args.ph_hi; ++ph) {
        int tid = threadIdx.x; asm volatile("" : "+v"(tid));
        const int lane = tid & 63, wave = __builtin_amdgcn_readfirstlane(tid >> 6), gw = vcu * NWAVES + wave;
        const int l = (ph - 1) >> 3, k = (ph == 0) ? -1 : ((ph - 1) & 7);
        const unsigned char* wl = ws + WS_WT + (size_t)(l < 0 ? 0 : l) * WT_LAYER;
        if (ph == 0) {
#if PHM & 1
            for (int rep = 0; rep < PROBE_REP_MISC; ++rep) {
            float* scr = (float*)(lds + wave * 16384);
            constexpr int I_IN = 32 * 176, I_OUT = 32 * 64, I_UP = 32 * 256, I_DN = 128 * 64, I_L = I_IN + I_OUT + I_UP + I_DN;
            for (int it = gw; it < NLAYER * I_L; it += NGW) {
                const int ll = it / I_L; int r = it % I_L; unsigned char* wb = ws + WS_WT + (size_t)ll * WT_LAYER;
                if (r < I_IN) { transpose_item(args.in[3] + (size_t)ll * DM * INW, DM, INW, (bf16*)(wb + WT_IN), DM, scr, r, lane); continue; } r -= I_IN;
                if (r < I_OUT) { transpose_item(args.in[15] + (size_t)ll * DM * DM, DM, DM, (bf16*)(wb + WT_OUT), DM, scr, r, lane); continue; } r -= I_OUT;
                if (r < I_UP) { transpose_item(args.in[17] + (size_t)ll * DM * DFF, DM, DFF, (bf16*)(wb + WT_UP), DM, scr, r, lane); continue; } r -= I_UP;
                transpose_item(args.in[18] + (size_t)ll * DFF * DM, DFF, DM, (bf16*)(wb + WT_DN), LDH, scr, r, lane);
            }
            for (int m = gw; m < M_ALL; m += NGW) norm_row(m < MP ? xp + (size_t)m * DM : xs + (size_t)(m - MP) * DM, args.in[2], XN + (size_t)m * DM, lane);
            }
#endif
        } else if (k == 0) {
#if PHM & 2
            pg8::Gemm g{XN, (const bf16*)(wl + WT_IN), M_ALL, INW, DM, DM, DM}; pg8::StaticOrder S; S.init(M_ALL, INW, G, bx);
            pg8::EpiBf16<0> E{PROJ, INW};
            for (int rep = 0; rep < PROBE_REP_WIN; ++rep)
            pg8::gemm_phase<pg8::EpiBf16<0>, pg8::StaticOrder, true, true>((PG8_LAS unsigned char*)lds, g, S, E);
#endif
        } else if (k == 1) {
#if PHM & 4
            const float* qg = args.in[5] + l * 64; const float* kg = args.in[6] + l * 64; const float* cw = args.in[4] + l * 1536;
            for (int m = gw; m < M_ALL; m += NGW) {
                const int pos = m < MP ? (m & (SEQ_P - 1)) : ((m - MP) & (SEQ_S - 1)); const int S = m < MP ? SEQ_P : SEQ_S;
                qk_row(PROJ, m, pos, qg, kg, lane);
                conv_row(PROJ, MIX, m, pos, S, cw, lane);
            }
            for (int u = vcu; u < (M_ALL / 128) * 4; u += G) { const int chunk = u >> 2, hd = u & 3;
                sgu_unit(PROJ, MIX, chunk, hd, args.in[13] + ((size_t)l * 4 + hd) * 128 * 128, args.in[14] + (l * 4 + hd) * 128, args.in[12] + l * 128, (char*)lds); }
#endif
        } else if (k == 2) {
#if PHM & 8
            const float linit = (l == 0) ? 0.2f : 0.35550906759096934f;
            const float s1 = wave_sum(args.in[7][l * 64 + lane] * args.in[8][l * 64 + lane]), s2 = wave_sum(args.in[9][l * 64 + lane] * args.in[10][l * 64 + lane]);
            const float lam = __uint_as_float(__builtin_amdgcn_readfirstlane(__float_as_uint(expf(s1) - expf(s2) + linit)));
            const float gq = wave_max(fabsf(args.in[5][l * 64 + lane])), gk = wave_max(fabsf(args.in[6][l * 64 + lane]));
            const float negmb = __uint_as_float(__builtin_amdgcn_readfirstlane(__float_as_uint(-(C2 * 64.0f * gq * gk))));
            for (int rep = 0; rep < PROBE_REP_ATT; ++rep)
            for (int t = vcu; t < 2560; t += G) {
                int pair, qb, seq, seqrow0;
                if (t < 2048) { const int i = t >> 8, v = t & 255; const int idx = (v >> 5) * 256 + i * 32 + (v & 31); pair = idx >> 7; qb = idx & 127; seq = SEQ_S; seqrow0 = MP + (pair >> 3) * SEQ_S; }
                else { const int t2 = t - 2048, i = t2 >> 8, v = t2 & 255; pair = 2 * (v >> 5) + i; qb = v & 31; seq = SEQ_P; seqrow0 = (pair >> 3) * SEQ_P; }
                const int h = pair & 7; const size_t row0 = (size_t)seqrow0 + (size_t)qb * 128;
                if (negmb >= -64.0f)
                att::attn_unit<false>(PROJ + row0 * INW + OFF_Q + h * 128, PROJ + (size_t)seqrow0 * INW + OFF_K + h * 128, PROJ + (size_t)seqrow0 * INW + OFF_V + h * 128,
                               MIX + row0 * DM + MIX_B + h * 128, seq, (char*)lds, 0.f, lam, args.in[11] + l * 128, 1.0f - linit);
                else
                att::attn_unit<true>(PROJ + row0 * INW + OFF_Q + h * 128, PROJ + (size_t)seqrow0 * INW + OFF_K + h * 128, PROJ + (size_t)seqrow0 * INW + OFF_V + h * 128,
                               MIX + row0 * DM + MIX_B + h * 128, seq, (char*)lds, negmb, lam, args.in[11] + l * 128, 1.0f - linit);
            }
#endif
        } else if (k == 3 || k == 6) {
#if PHM & 16
            pg8::Gemm g; if (k == 3) g = pg8::Gemm{MIX, (const bf16*)(wl + WT_OUT), M_ALL, DM, DM, DM, DM}; else g = pg8::Gemm{HB, (const bf16*)(wl + WT_DN), M_ALL, DM, DFF, LDH, LDH};
            pg8::StaticOrder S; S.init(M_ALL, DM, G, bx);
            pg8::EpiResF32 E; if (k == 3 && l == 0) E = pg8::EpiResF32{xp, xs, MP / 256, out, DM}; else E = pg8::EpiResF32{out, out, 0, out, DM};
            pg8::gemm_phase<pg8::EpiResF32, pg8::StaticOrder, true, true>((PG8_LAS unsigned char*)lds, g, S, E);
#endif
        } else if (k == 4 || k == 7) {
#if PHM & 32
            const float* gn = (k == 4) ? args.in[16] + l * DM : args.in[2] + (l + 1) * DM;
            for (int rep = 0; rep < PROBE_REP_MISC; ++rep)
            for (int m = gw; m < M_ALL; m += NGW) norm_row(out + (size_t)m * DM, gn, XN + (size_t)m * DM, lane);
#endif
        } else {
#if PHM & 64
            pg8::Gemm g{XN, (const bf16*)(wl + WT_UP), M_ALL, DFF, DM, DM, DM}; pg8::StaticOrder S; S.init(M_ALL, DFF, G, bx);
            pg8::EpiBf16<2> E{HB, LDH};
            for (int rep = 0; rep < PROBE_REP_UP; ++rep)
            pg8::gemm_phase<pg8::EpiBf16<2>, pg8::StaticOrder, true, true>((PG8_LAS unsigned char*)lds, g, S, E);
#endif
        }
        if (ph + 1 < args.ph_hi) { if (ph == args.ph_lo) grid.sync(); else xcd_barrier(bar); }
    }
}

extern "C" void kernel_launch(void* const* d_in, const int* in_sizes, int n_in, void* d_out, int out_size, void* d_ws, size_t ws_size, hipStream_t stream) {
    static int grid = 0;
    if (grid == 0) {
        if (n_in != 19 || out_size != M_ALL * DM || ws_size < WS_END) { fprintf(stderr, "kernel_launch: unexpected shapes: n_in %d out %d ws %zu (need %zu)\n", n_in, out_size, ws_size, (size_t)WS_END); grid = -1; return; }
        int dev = 0, cus = 0, per_cu = 0;
        if (hipGetDevice(&dev) != hipSuccess || hipDeviceGetAttribute(&cus, hipDeviceAttributeMultiprocessorCount, dev) != hipSuccess) { fprintf(stderr, "kernel_launch: device query failed\n"); grid = -1; return; }
        if (hipFuncSetAttribute((const void*)mk_fwd, hipFuncAttributeMaxDynamicSharedMemorySize, LDS_BYTES) != hipSuccess) { fprintf(stderr, "kernel_launch: hipFuncSetAttribute failed\n"); grid = -1; return; }
        if (hipOccupancyMaxActiveBlocksPerMultiprocessor(&per_cu, (const void*)mk_fwd, NWAVES * 64, LDS_BYTES) != hipSuccess || per_cu < 1) { fprintf(stderr, "kernel_launch: occupancy query gave %d\n", per_cu); per_cu = 1; }
        (void)hipGetLastError();
        grid = cus * 1;
        fprintf(stderr, "kernel_launch: grid %d (cus %d, per_cu %d)\n", grid, cus, per_cu);
    }
    if (grid < 0) return;
    if (hipMemsetAsync(d_ws, 0, 65536, stream) != hipSuccess) { fprintf(stderr, "kernel_launch: memset failed\n"); return; }
    Args a{};
    for (int i = 0; i < 19; ++i) a.in[i] = (const float*)d_in[i];
    a.out = (float*)d_out; a.ws = (unsigned char*)d_ws;
#if MK_SINGLE
    a.ph_lo = 0; a.ph_hi = N_PHASES;
    { void* kargs[] = {&a}; hipError_t e = hipLaunchCooperativeKernel((const void*)mk_fwd, dim3(grid), dim3(NWAVES * 64), kargs, LDS_BYTES, stream);
      if (e != hipSuccess) fprintf(stderr, "kernel_launch: cooperative launch failed: %s\n", hipGetErrorString(e)); }
#else
    for (int ph = 0; ph < N_PHASES; ++ph) { a.ph_lo = ph; a.ph_hi = ph + 1; void* kargs[] = {&a};
        hipError_t e = hipLaunchCooperativeKernel((const void*)mk_fwd, dim3(grid), dim3(NWAVES * 64), kargs, LDS_BYTES, stream);
        if (e != hipSuccess) { fprintf(stderr, "kernel_launch: cooperative launch %d failed: %s\n", ph, hipGetErrorString(e)); break; } }
#endif
}
```

```cpp
#include <hip/hip_runtime.h>
#include <hip/hip_cooperative_groups.h>
#include <hip/hip_bf16.h>
#include <cstdio>
#include <cstdint>
namespace cg = cooperative_groups;
namespace pg8 {
#define PG8_LAS __attribute__((address_space(3)))
typedef unsigned short bf16_t;
typedef short bf16x8 __attribute__((ext_vector_type(8)));
typedef float f32x4 __attribute__((ext_vector_type(4)));
typedef unsigned u32x4 __attribute__((ext_vector_type(4)));
constexpr int BM = 256, BK = 64, HALF = 128, HTB = HALF * BK * 2  , STAGE_BYTES = 8 * HTB, NXCD = 8, WGM = 8;

__host__ __device__ __forceinline__ int lds_byte(int r, int c) { const int st = (r >> 4) * 2 + (c >> 5), rr = r & 15, cc = c & 31, ob = rr * 64 + cc * 2; return st * 1024 + (ob ^ (((ob >> 9) & 1) << 5)); }
__host__ __device__ __forceinline__ void stage_rc(int b, int& R, int& C) { const int st = b / 1024, sb = b % 1024, swz = sb ^ (((sb >> 9) & 1) << 5); R = (st >> 1) * 16 + swz / 64; C = (st & 1) * 32 + (swz % 64) / 2; }
__host__ __device__ __forceinline__ int perm32(int rho) { const int n = rho >> 4, i = rho & 15; return 8 * (i >> 2) + 4 * n + (i & 3); }

struct Unit { int pm, pn; };
struct Gemm { const bf16_t* A; const bf16_t* Bt; int M, N, K, lda, ldb; };

struct StaticOrder {
    int nM, nN, nwg, G, c;
    __host__ __device__ void init(int M, int N, int G_, int c_) { nM = M / BM; nN = N / BM; nwg = nM * nN; G = G_; c = c_; }
    __host__ __device__ bool next(int i, Unit& u) const {
        const long L = (long)i * G + c; if (L >= nwg) return false;
        int wgid = (int)L; { const int q = nwg / NXCD, r = nwg % NXCD, xcd = wgid % NXCD, off = wgid / NXCD; wgid = (xcd < r ? xcd * (q + 1) : r * (q + 1) + (xcd - r) * q) + off; }
        const int nig = WGM * nN, gid = wgid / nig, fm = gid * WGM, gsz = (nM - fm) < WGM ? (nM - fm) : WGM;
        u.pm = fm + ((wgid % nig) % gsz); u.pn = (wgid % nig) / gsz; return true;
    }
    __device__ __forceinline__ void a_ready(const Unit&) const {}
    __device__ __forceinline__ void done(const Unit&) const {}
};

__device__ __forceinline__ unsigned cvt_pk_bf16(float lo, float hi) { unsigned r; asm volatile("v_cvt_pk_bf16_f32 %0, %1, %2" : "=v"(r) : "v"(lo), "v"(hi)); return r; }
typedef float f32x2 __attribute__((ext_vector_type(2)));
typedef unsigned u32x2 __attribute__((ext_vector_type(2)));
template <int ACT> struct EpiBf16 {
    static constexpr bool PERM = true, AFTER_DRAIN = false;
    bf16_t* O; int ldc; const float* rowss;
    __device__ __forceinline__ void operator()(const f32x4 (&acc)[2][2][4][2], const Unit& u, int wr, int wc, int fr, int fq) const {
        const int row0 = u.pm * BM + wr * 64 + fr; const int col0 = u.pn * BM + wc * 32 + 8 * fq;
        float rs[2][4];
#pragma unroll
        for (int ai = 0; ai < 2; ++ai)
#pragma unroll
            for (int m = 0; m < 4; ++m) rs[ai][m] = rowss[row0 + ai * HALF + m * 16];
#pragma unroll
        for (int ai = 0; ai < 2; ++ai)
#pragma unroll
            for (int m = 0; m < 4; ++m) { bf16_t* rowp = O + (size_t)(row0 + ai * HALF + m * 16) * ldc + col0;
                const float sc = 1.0f / sqrtf(rs[ai][m] * (1.0f / 2048.0f) + 1e-6f);
#pragma unroll
                for (int bj = 0; bj < 2; ++bj) { f32x4 v0 = acc[ai][bj][m][0] * sc, v1 = acc[ai][bj][m][1] * sc;
                    if (ACT == 2) {
#pragma unroll
                        for (int e = 0; e < 4; ++e) { float a = fmaxf(v0[e], 0.f), b = fmaxf(v1[e], 0.f); v0[e] = a * a; v1[e] = b * b; } }
                    u32x4 w; w.x = cvt_pk_bf16(v0[0], v0[1]); w.y = cvt_pk_bf16(v0[2], v0[3]); w.z = cvt_pk_bf16(v1[0], v1[1]); w.w = cvt_pk_bf16(v1[2], v1[3]);
                    *(u32x4*)(rowp + bj * HALF) = w; } }
    }
};
struct EpiResF32 {
    static constexpr bool PERM = true, AFTER_DRAIN = false;
    const float* res_lo; const float* res_hi; int split_pm; float* out; int ldc; bf16_t* xb; int ldx; float* rowss;
    __device__ __forceinline__ void operator()(const f32x4 (&acc)[2][2][4][2], const Unit& u, int wr, int wc, int fr, int fq) const {
        const float* rbase = (u.pm < split_pm) ? res_lo : (res_hi - (size_t)split_pm * BM * ldc);
        const int col0 = u.pn * BM + wc * 32 + 8 * fq;
#pragma unroll
        for (int ai = 0; ai < 2; ++ai)
#pragma unroll
            for (int m = 0; m < 4; ++m) { const int row = u.pm * BM + ai * HALF + wr * 64 + m * 16 + fr; const size_t off = (size_t)row * ldc + col0; float ss = 0.f;
#pragma unroll
                for (int bj = 0; bj < 2; ++bj) {
                    const f32x4 v0 = *(const f32x4*)(rbase + off + bj * HALF) + acc[ai][bj][m][0], v1 = *(const f32x4*)(rbase + off + bj * HALF + 4) + acc[ai][bj][m][1];
                    *(f32x4*)(out + off + bj * HALF) = v0; *(f32x4*)(out + off + bj * HALF + 4) = v1;
                    if (xb) { u32x4 w; w.x = cvt_pk_bf16(v0[0], v0[1]); w.y = cvt_pk_bf16(v0[2], v0[3]); w.z = cvt_pk_bf16(v1[0], v1[1]); w.w = cvt_pk_bf16(v1[2], v1[3]);
                        *(u32x4*)(xb + (size_t)row * ldx + col0 + bj * HALF) = w;
                        ss += (v0[0] * v0[0] + v0[1] * v0[1]) + (v0[2] * v0[2] + v0[3] * v0[3]) + (v1[0] * v1[0] + v1[1] * v1[1]) + (v1[2] * v1[2] + v1[3] * v1[3]); } }
                if (xb) { ss += __shfl_xor(ss, 16); ss += __shfl_xor(ss, 32);
                    if (fq == 0) __hip_atomic_fetch_add(rowss + row, ss, __ATOMIC_RELAXED, __HIP_MEMORY_SCOPE_AGENT); }
                if (m == 3) asm volatile("" ::: "memory"); }
    }
};
template <class Epi, class Sched, bool ALIGN_EPI = false, bool SP2 = false>
__device__ __forceinline__ void gemm_phase(PG8_LAS unsigned char* lds, const Gemm g, const Sched& S, const Epi& E) {
    int tid = threadIdx.x; asm volatile("" : "+v"(tid));
    const int wid = __builtin_amdgcn_readfirstlane(tid >> 6), lane = tid & 63, wr = wid >> 2, wc = wid & 3, fr = lane & 15, fq = lane >> 4;
    const int K = g.K, nt = K / BK;
    unsigned voffA[2], voffB[2];
#pragma unroll
    for (int i = 0; i < 2; ++i) { int R, C; stage_rc(tid * 16 + i * 8192, R, C); const int Rb = Epi::PERM ? ((R & ~31) + perm32(R & 31)) : R;
        voffA[i] = (unsigned)(R * g.lda + C) * 2u; voffB[i] = (unsigned)(Rb * g.ldb + C) * 2u; }
    const size_t kstep = (size_t)(BK * 2);
    const size_t hstepA = (size_t)HALF * g.lda * 2, hstepB = (size_t)HALF * g.ldb * 2;
    const size_t tstepA = 2 * hstepA, tstepB = 2 * hstepB;
    const unsigned ldsw = (unsigned)wid * 1024u;
    const int aoff = lds_byte(wr * 64 + fr, fq * 8), boff = lds_byte(wc * 32 + fr, fq * 8);
#define PG8_SA(b, h) (((b) * 2 + (h)) * HTB)
#define PG8_SB(b, h) ((4 + (b) * 2 + (h)) * HTB)
#define PG8_STAGE(bufoff, gbase, voff) do { _Pragma("unroll") for (int _i = 0; _i < 2; ++_i) \
        __builtin_amdgcn_global_load_lds((const unsigned*)((const char*)(gbase) + (voff)[_i]), (PG8_LAS unsigned*)(lds + (bufoff) + ldsw + _i * 8192), 16, 0, 0); } while (0)
#define PG8_LDA(dst, b, h) do { _Pragma("unroll") for (int m = 0; m < 4; ++m) _Pragma("unroll") for (int k = 0; k < 2; ++k) dst[m][k] = *(const PG8_LAS bf16x8*)(lds + PG8_SA(b, h) + aoff + m * 2048 + k * 1024); } while (0)
#define PG8_LDB(dst, b, h) do { _Pragma("unroll") for (int n = 0; n < 2; ++n) _Pragma("unroll") for (int k = 0; k < 2; ++k) dst[n][k] = *(const PG8_LAS bf16x8*)(lds + PG8_SB(b, h) + boff + n * 2048 + k * 1024); } while (0)
#define PG8_MMA(ai, bj, At, Bt) do { __builtin_amdgcn_s_setprio(1); _Pragma("unroll") for (int m = 0; m < 4; ++m) _Pragma("unroll") for (int n = 0; n < 2; ++n) _Pragma("unroll") for (int k = 0; k < 2; ++k) \
        acc[ai][bj][m][n] = __builtin_amdgcn_mfma_f32_16x16x32_bf16(Bt[n][k], At[m][k], acc[ai][bj][m][n], 0, 0, 0); __builtin_amdgcn_s_setprio(0); } while (0)
#define PG8_WAIT_V(n) asm volatile("s_waitcnt vmcnt(" #n ")" ::: "memory")
#define PG8_WAIT_L(n) asm volatile("s_waitcnt lgkmcnt(" #n ")" ::: "memory")
#define PG8_BAR __builtin_amdgcn_s_barrier()
#define PG8_SCHED __builtin_amdgcn_sched_barrier(0)
    Unit cur, nxt; int ui = 0;
    if (!S.next(0, cur)) return;
    f32x4 acc[2][2][4][2];
#pragma unroll
    for (int a = 0; a < 2; ++a)
#pragma unroll
        for (int b = 0; b < 2; ++b)
#pragma unroll
            for (int m = 0; m < 4; ++m)
#pragma unroll
                for (int n = 0; n < 2; ++n) acc[a][b][m][n] = (f32x4){0.f, 0.f, 0.f, 0.f};
    bf16x8 At[4][2], B0[2][2], B1[2][2];
    const char* cA = (const char*)g.A + (size_t)cur.pm * tstepA; const char* cB = (const char*)g.Bt + (size_t)cur.pn * tstepB;
    S.a_ready(cur);
    if constexpr (SP2) {
        PG8_STAGE(PG8_SB(0, 0), cB, voffB); PG8_STAGE(PG8_SB(0, 1), cB + hstepB, voffB); PG8_STAGE(PG8_SA(0, 0), cA, voffA); PG8_STAGE(PG8_SA(0, 1), cA + hstepA, voffA);
        if (wr == 1) PG8_BAR;
        PG8_WAIT_V(2); PG8_BAR;
        PG8_STAGE(PG8_SB(1, 0), cB + kstep, voffB); PG8_STAGE(PG8_SA(1, 0), cA + kstep, voffA); PG8_STAGE(PG8_SB(1, 1), cB + hstepB + kstep, voffB);
        PG8_WAIT_V(6); PG8_BAR;
    } else {
        PG8_STAGE(PG8_SB(0, 0), cB, voffB); PG8_STAGE(PG8_SA(0, 0), cA, voffA); PG8_STAGE(PG8_SB(0, 1), cB + hstepB, voffB); PG8_STAGE(PG8_SA(0, 1), cA + hstepA, voffA);
        if (wr == 1) PG8_BAR;
        PG8_WAIT_V(4); PG8_BAR;
        PG8_STAGE(PG8_SB(1, 0), cB + kstep, voffB); PG8_STAGE(PG8_SA(1, 0), cA + kstep, voffA); PG8_STAGE(PG8_SB(1, 1), cB + hstepB + kstep, voffB);
        PG8_WAIT_V(6); PG8_BAR;
    }
    for (;;) {
        const bool has_next = S.next(ui + 1, nxt);
        const char* nA = has_next ? (const char*)g.A + (size_t)nxt.pm * tstepA : cA; const char* nB = has_next ? (const char*)g.Bt + (size_t)nxt.pn * tstepB : cB;
        for (int t = 0; t < nt; t += 2) {
            const bool last = (t == nt - 2);
            const char* a1 = cA + (size_t)(t + 1) * kstep;
            const char* a2 = last ? nA : cA + (size_t)(t + 2) * kstep; const char* b2 = last ? nB : cB + (size_t)(t + 2) * kstep;
            const char* a3 = a2 + kstep; const char* b3 = b2 + kstep;
            if (last && has_next) S.a_ready(nxt);
            if constexpr (SP2) {
            PG8_LDB(B0, 0, 0); PG8_LDB(B1, 0, 1); PG8_SCHED; PG8_LDA(At, 0, 0); PG8_STAGE(PG8_SA(1, 1), a1 + hstepA, voffA);
            PG8_WAIT_V(8); PG8_WAIT_L(0); PG8_BAR; PG8_MMA(0, 0, At, B0); PG8_MMA(0, 1, At, B1); PG8_BAR; PG8_SCHED;
            PG8_LDA(At, 0, 1); PG8_STAGE(PG8_SB(0, 0), b2, voffB); PG8_STAGE(PG8_SB(0, 1), b2 + hstepB, voffB); PG8_STAGE(PG8_SA(0, 0), a2, voffA);
            PG8_WAIT_V(8); PG8_WAIT_L(0); PG8_BAR; PG8_MMA(1, 0, At, B0); PG8_MMA(1, 1, At, B1); PG8_BAR; PG8_SCHED;
            PG8_LDB(B0, 1, 0); PG8_LDB(B1, 1, 1); PG8_SCHED; PG8_LDA(At, 1, 0); PG8_STAGE(PG8_SA(0, 1), a2 + hstepA, voffA);
            PG8_WAIT_V(8); PG8_WAIT_L(0); PG8_BAR; PG8_MMA(0, 0, At, B0); PG8_MMA(0, 1, At, B1); PG8_BAR; PG8_SCHED;
            PG8_LDA(At, 1, 1); PG8_STAGE(PG8_SB(1, 0), b3, voffB); PG8_STAGE(PG8_SB(1, 1), b3 + hstepB, voffB); PG8_STAGE(PG8_SA(1, 0), a3, voffA);
            PG8_WAIT_V(8); PG8_WAIT_L(0); PG8_BAR; PG8_MMA(1, 0, At, B0); PG8_MMA(1, 1, At, B1); PG8_BAR; PG8_SCHED;
            } else {
            PG8_LDB(B0, 0, 0); PG8_SCHED; PG8_LDA(At, 0, 0); PG8_STAGE(PG8_SA(1, 1), a1 + hstepA, voffA);
            PG8_WAIT_L(8); PG8_BAR; PG8_WAIT_L(0); PG8_MMA(0, 0, At, B0); PG8_BAR; PG8_SCHED;
            PG8_LDB(B1, 0, 1); PG8_STAGE(PG8_SB(0, 0), b2, voffB);
            PG8_BAR; PG8_WAIT_L(0); PG8_MMA(0, 1, At, B1); PG8_BAR;
            PG8_LDA(At, 0, 1); PG8_STAGE(PG8_SA(0, 0), a2, voffA);
            PG8_BAR; PG8_WAIT_L(0); PG8_MMA(1, 0, At, B0); PG8_BAR; PG8_SCHED;
            PG8_STAGE(PG8_SB(0, 1), b2 + hstepB, voffB);
            PG8_WAIT_V(6); PG8_BAR; PG8_MMA(1, 1, At, B1); PG8_BAR;
            PG8_LDB(B0, 1, 0); PG8_SCHED; PG8_LDA(At, 1, 0); PG8_STAGE(PG8_SA(0, 1), a2 + hstepA, voffA);
            PG8_WAIT_L(8); PG8_BAR; PG8_WAIT_L(0); PG8_MMA(0, 0, At, B0); PG8_BAR; PG8_SCHED;
            PG8_LDB(B1, 1, 1); PG8_STAGE(PG8_SB(1, 0), b3, voffB);
            PG8_BAR; PG8_WAIT_L(0); PG8_MMA(0, 1, At, B1); PG8_BAR;
            PG8_LDA(At, 1, 1); PG8_STAGE(PG8_SA(1, 0), a3, voffA);
            PG8_BAR; PG8_WAIT_L(0); PG8_MMA(1, 0, At, B0); PG8_BAR; PG8_SCHED;
            PG8_STAGE(PG8_SB(1, 1), b3 + hstepB, voffB);
            PG8_WAIT_V(6); PG8_BAR; PG8_MMA(1, 1, At, B1); PG8_BAR;
            }
        }
        if constexpr (ALIGN_EPI) { if (wr == 0) PG8_BAR; }
        if constexpr (!Epi::AFTER_DRAIN) { E(acc, cur, wr, wc, fr, fq); S.done(cur); }
        if (!has_next) break;
#pragma unroll
        for (int a = 0; a < 2; ++a)
#pragma unroll
            for (int b = 0; b < 2; ++b)
#pragma unroll
                for (int m = 0; m < 4; ++m)
#pragma unroll
                    for (int n = 0; n < 2; ++n) acc[a][b][m][n] = (f32x4){0.f, 0.f, 0.f, 0.f};
        cur = nxt; cA = nA; cB = nB; ++ui;
        if constexpr (ALIGN_EPI) { if (wr == 1) PG8_BAR; }
    }
    PG8_WAIT_V(0);
    if constexpr (!ALIGN_EPI) { if (wr == 0) PG8_BAR; }
    PG8_BAR;
    if constexpr (Epi::AFTER_DRAIN) { E.fused(acc, cur, wr, wc, fr, fq, lds, wid, lane); S.done(cur); }
#undef PG8_SA
#undef PG8_SB
#undef PG8_STAGE
#undef PG8_LDA
#undef PG8_LDB
#undef PG8_MMA
#undef PG8_WAIT_V
#undef PG8_WAIT_L
#undef PG8_BAR
#undef PG8_SCHED
}
}

#ifndef PROBE_REP_ATT
#define PROBE_REP_ATT 1
#endif
#ifndef PROBE_REP_UP
#define PROBE_REP_UP 1
#endif
#ifndef PROBE_XSYNC
#define PROBE_XSYNC 0
#endif
#ifndef PROBE_REP_MISC
#define PROBE_REP_MISC 1
#endif
#ifndef PROBE_REP_WIN
#define PROBE_REP_WIN 1
#endif
#ifndef PHM
#define PHM 127
#endif
#ifndef MK_SINGLE
#define MK_SINGLE 1
#endif
constexpr int DM = 2048, MP = 8192, M_ALL = 40960, SEQ_P = 4096, SEQ_S = 16384, INW = 5632, DFF = 8192, NLAYER = 2;
constexpr int OFF_AX = 0, OFF_AB = 512, OFF_AC = 1024, OFF_Q = 1536, OFF_K = 2560, OFF_V = 3584, OFF_CU = 4608, OFF_CV = 5120;
constexpr int MIX_A = 0, MIX_B = 512, MIX_C = 1536;
constexpr float EPS = 1e-6f;
constexpr float C2 = 0.18033688011112042f;
constexpr size_t MiB = 1u << 20;
constexpr int LDH = DFF + 128;
constexpr size_t WS_WT = 1 * MiB, WT_LAYER = 96 * MiB, WT_IN = 0, WT_OUT = 22 * MiB, WT_UP = 30 * MiB, WT_DN = 62 * MiB;
constexpr size_t WS_XN = 194 * MiB, WS_H = 356 * MiB, WS_PROJ = 356 * MiB, WS_MIX = 796 * MiB, WS_END = 1008 * MiB;
static_assert(WT_DN + (size_t)DM * LDH * 2 <= WT_LAYER && WS_WT + 2 * WT_LAYER <= WS_XN && WS_XN + (size_t)M_ALL * DM * 2 <= WS_H && WS_PROJ + (size_t)M_ALL * INW * 2 <= WS_MIX && WS_MIX + (size_t)M_ALL * DM * 2 <= WS_END && WS_H + (size_t)M_ALL * LDH * 2 <= WS_END, "ws map");
constexpr int NWAVES = 8, LDS_BYTES = 147456;

typedef unsigned short bf16;
typedef unsigned v4u __attribute__((ext_vector_type(4)));
typedef unsigned v2u __attribute__((ext_vector_type(2)));
typedef float f32x4 __attribute__((ext_vector_type(4)));
#define DI __device__ __forceinline__

DI unsigned pk2(float lo, float hi) { return pg8::cvt_pk_bf16(lo, hi); }
DI float bflo(unsigned u) { return __uint_as_float(u << 16); }
DI float bfhi(unsigned u) { return __uint_as_float(u & 0xffff0000u); }
DI float wave_sum(float v) {
#pragma unroll
    for (int o = 1; o < 64; o <<= 1) v += __shfl_xor(v, o);
    return v;
}
DI float wave_max(float v) {
#pragma unroll
    for (int o = 1; o < 64; o <<= 1) v = fmaxf(v, __shfl_xor(v, o));
    return v;
}
DI float gelu_tanh(float x) {
    const float z = x * (0.7978845608028654f + 0.035677408136300125f * x * x);
    const float e = __builtin_amdgcn_exp2f(-2.8853900817779268f * z);
    return x * __builtin_amdgcn_rcpf(1.0f + e);
}

DI void transpose_item(const float* W, int K, int N, bf16* WT, int ldt, const float* gain, float* scr, int item, int lane) {
    const int nblk = N / 32, kb = item / nblk, nb = item % nblk, k0 = 64 * kb, n0 = 32 * nb;
#pragma unroll 32
    for (int i = 0; i < 32; ++i) { const int kk = 2 * i + (lane >> 5); scr[kk * 33 + (lane & 31)] = W[(size_t)(k0 + kk) * N + n0 + (lane & 31)] * (gain ? gain[k0 + kk] : 1.0f); }
    asm volatile("s_waitcnt lgkmcnt(0)" ::: "memory");
    const int c = lane & 7;
#pragma unroll
    for (int j = 0; j < 4; ++j) { const int n = (lane >> 3) + 8 * j; const float* s = scr + (8 * c) * 33 + n;
        v4u o; o.x = pk2(s[0 * 33], s[1 * 33]); o.y = pk2(s[2 * 33], s[3 * 33]); o.z = pk2(s[4 * 33], s[5 * 33]); o.w = pk2(s[6 * 33], s[7 * 33]);
        *(v4u*)(WT + (size_t)(n0 + n) * ldt + k0 + 8 * c) = o; }
    asm volatile("s_waitcnt lgkmcnt(0)" ::: "memory");
}
DI void xb_row(const float* xrow, bf16* orow, float* ssp, int lane) {
    const f32x4* xr = (const f32x4*)xrow + lane;
    f32x4 v[8]; float s = 0.f;
#pragma unroll
    for (int j = 0; j < 8; ++j) { v[j] = xr[64 * j]; s += (v[j].x * v[j].x + v[j].y * v[j].y) + (v[j].z * v[j].z + v[j].w * v[j].w); }
    s = wave_sum(s);
    if (lane == 0) *ssp = s;
    v2u* o8 = (v2u*)orow + lane;
#pragma unroll
    for (int j = 0; j < 8; ++j) { v2u w; w.x = pk2(v[j].x, v[j].y); w.y = pk2(v[j].z, v[j].w); o8[64 * j] = w; }
}

__constant__ double ROPE_INV[8] = {1.0, 0.19392274474868576, 0.03760603093086393, 0.007292664737217109, 0.001414213562373095, 0.0002742481756762073, 5.318295896944988e-05, 1.031338537721246e-05};
DI void qk_row(bf16* P, int row, int pos, const float* qg, const float* kg, int lane) {
    bf16* p = P + (size_t)row * INW + OFF_Q + lane * 32;
    v4u raw[4];
#pragma unroll
    for (int i = 0; i < 4; ++i) raw[i] = *(const v4u*)(p + 8 * i);
    float x[32];
#pragma unroll
    for (int i = 0; i < 4; ++i) { x[8 * i + 0] = bflo(raw[i].x); x[8 * i + 1] = bfhi(raw[i].x); x[8 * i + 2] = bflo(raw[i].y); x[8 * i + 3] = bfhi(raw[i].y);
        x[8 * i + 4] = bflo(raw[i].z); x[8 * i + 5] = bfhi(raw[i].z); x[8 * i + 6] = bflo(raw[i].w); x[8 * i + 7] = bfhi(raw[i].w); }
    float ss = 0.f;
#pragma unroll
    for (int i = 0; i < 32; ++i) ss += x[i] * x[i];
    ss += __shfl_xor(ss, 1);
    const float rstd = 1.0f / sqrtf(ss * (1.f / 64.f) + EPS);
    const bool isq = lane < 32; const int half = lane & 1;
    const float* g = (isq ? qg : kg) + half * 32;
#pragma unroll
    for (int i = 0; i < 8; ++i) { const f32x4 gg = *(const f32x4*)(g + 4 * i); x[4 * i] *= rstd * gg.x; x[4 * i + 1] *= rstd * gg.y; x[4 * i + 2] *= rstd * gg.z; x[4 * i + 3] *= rstd * gg.w; }
    const double t = (double)pos * ROPE_INV[lane & 7] * 0.15915494309189535;
    const float fr = (float)(t - rint(t));
    const float cs = __builtin_amdgcn_cosf(fr), sn = __builtin_amdgcn_sinf(fr);
#pragma unroll
    for (int i = 0; i < 8; ++i) { const float c = __shfl(cs, i), s = __shfl(sn, i);
        if (half == 0) { const float a = x[i], b = x[i + 8]; x[i] = a * c - b * s; x[i + 8] = b * c + a * s; } }
    const float sc = isq ? C2 : 1.0f;
#pragma unroll
    for (int i = 0; i < 4; ++i) { v4u w; w.x = pk2(x[8 * i] * sc, x[8 * i + 1] * sc); w.y = pk2(x[8 * i + 2] * sc, x[8 * i + 3] * sc); w.z = pk2(x[8 * i + 4] * sc, x[8 * i + 5] * sc); w.w = pk2(x[8 * i + 6] * sc, x[8 * i + 7] * sc);
        *(v4u*)(p + 8 * i) = w; }
}
DI void unpack8(const v4u r, float* x) { x[0] = bflo(r.x); x[1] = bfhi(r.x); x[2] = bflo(r.y); x[3] = bfhi(r.y); x[4] = bflo(r.z); x[5] = bfhi(r.z); x[6] = bflo(r.w); x[7] = bfhi(r.w); }
DI void conv_row(const bf16* P, bf16* MIX, int row, int pos, int S, const float* cw, int lane) {
    const bf16* p = P + (size_t)row * INW + lane * 8;
    const v4u z4 = {0u, 0u, 0u, 0u};
    const v4u xa0 = *(const v4u*)(p + OFF_AX), gc0 = *(const v4u*)(p + OFF_AC), gb0 = *(const v4u*)(p + OFF_AB);
    const v4u xam = pos > 0 ? *(const v4u*)(p - INW + OFF_AX) : z4, gcm = pos > 0 ? *(const v4u*)(p - INW + OFF_AC) : z4;
    const v4u xap = pos < S - 1 ? *(const v4u*)(p + INW + OFF_AX) : z4, gcp = pos < S - 1 ? *(const v4u*)(p + INW + OFF_AC) : z4;
    float a0[8], c0[8], b0[8], am[8], cm[8], ap[8], cp[8];
    unpack8(xa0, a0); unpack8(gc0, c0); unpack8(gb0, b0); unpack8(xam, am); unpack8(gcm, cm); unpack8(xap, ap); unpack8(gcp, cp);
    float w0[8], w1[8], w2[8];
#pragma unroll
    for (int i = 0; i < 2; ++i) { const f32x4 a = *(const f32x4*)(cw + lane * 8 + 4 * i), b = *(const f32x4*)(cw + 512 + lane * 8 + 4 * i), c = *(const f32x4*)(cw + 1024 + lane * 8 + 4 * i);
        w0[4 * i] = a.x; w0[4 * i + 1] = a.y; w0[4 * i + 2] = a.z; w0[4 * i + 3] = a.w; w1[4 * i] = b.x; w1[4 * i + 1] = b.y; w1[4 * i + 2] = b.z; w1[4 * i + 3] = b.w;
        w2[4 * i] = c.x; w2[4 * i + 1] = c.y; w2[4 * i + 2] = c.z; w2[4 * i + 3] = c.w; }
    float o[8];
#pragma unroll
    for (int j = 0; j < 8; ++j) o[j] = b0[j] * (w0[j] * (cm[j] * am[j]) + w1[j] * (c0[j] * a0[j]) + w2[j] * (cp[j] * ap[j]));
    v4u w; w.x = pk2(o[0], o[1]); w.y = pk2(o[2], o[3]); w.z = pk2(o[4], o[5]); w.w = pk2(o[6], o[7]);
    *(v4u*)(MIX + (size_t)row * DM + MIX_A + lane * 8) = w;
}

namespace att {
using bf16x8 = __attribute__((ext_vector_type(8))) short;
using s16x4  = __attribute__((ext_vector_type(4))) short;
using f32x16 = __attribute__((ext_vector_type(16))) float;
using u32x4  = __attribute__((ext_vector_type(4))) unsigned;
constexpr int KVBLK = 64;
constexpr int SHM_V = 16384, SHM_K = 16384, SCR_OFF = 98304;
#define KSWZ(row, colB) ((row) * 256 + ((colB) ^ (((row) & 7) << 4)))
#define SBAR() __builtin_amdgcn_sched_barrier(0)
DI int crow(int r, int hi) { return (r & 3) + 8 * (r >> 2) + 4 * hi; }
DI unsigned cvtpk(float lo, float hi) { unsigned r; asm volatile("v_cvt_pk_bf16_f32 %0, %1, %2" : "=v"(r) : "v"(lo), "v"(hi)); return r; }
DI int v_st(int k, int c) { const int kk = (k & ~0xC) | ((k & 4) << 1) | ((k & 8) >> 1); return ((kk >> 3) * 4 + (c >> 5)) * 512 + ((kk & 7) * 32 + (c & 31)) * 2; }
DI int v_rd_base(int lane) { return ((lane & 3) << 3) | (((lane >> 2) & 3) << 6) | (((lane >> 4) & 1) << 5) | (((lane >> 5) & 1) << 8); }
constexpr int v_rd_off(int d0, int ks, int half) { return d0 * 512 + ks * 4096 + half * 2048; }
template <int OFF> DI s16x4 tr_read(int vb) { s16x4 r; asm volatile("ds_read_b64_tr_b16 %0, %1 offset:%2" : "=&v"(r) : "v"(vb), "i"(OFF) : "memory"); return r; }
template <int D0> DI void pv_one(f32x16& od, int vb, bf16x8 pa0, bf16x8 pa1, bf16x8 pa2, bf16x8 pa3) {
  const s16x4 l0 = tr_read<v_rd_off(D0, 0, 0)>(vb), h0 = tr_read<v_rd_off(D0, 0, 1)>(vb), l1 = tr_read<v_rd_off(D0, 1, 0)>(vb), h1 = tr_read<v_rd_off(D0, 1, 1)>(vb);
  const s16x4 l2 = tr_read<v_rd_off(D0, 2, 0)>(vb), h2 = tr_read<v_rd_off(D0, 2, 1)>(vb), l3 = tr_read<v_rd_off(D0, 3, 0)>(vb), h3 = tr_read<v_rd_off(D0, 3, 1)>(vb);
  asm volatile("s_waitcnt lgkmcnt(0)" ::: "memory"); SBAR();
#define PK(L, H) (bf16x8){L[0], L[1], L[2], L[3], H[0], H[1], H[2], H[3]}
  od = __builtin_amdgcn_mfma_f32_32x32x16_bf16(pa0, PK(l0, h0), od, 0, 0, 0);
  od = __builtin_amdgcn_mfma_f32_32x32x16_bf16(pa1, PK(l1, h1), od, 0, 0, 0);
  od = __builtin_amdgcn_mfma_f32_32x32x16_bf16(pa2, PK(l2, h2), od, 0, 0, 0);
  od = __builtin_amdgcn_mfma_f32_32x32x16_bf16(pa3, PK(l3, h3), od, 0, 0, 0);
#undef PK
}
DI void pv_d0(f32x16* o, int vb, bf16x8 pa0, bf16x8 pa1, bf16x8 pa2, bf16x8 pa3) {
  pv_one<0>(o[0], vb, pa0, pa1, pa2, pa3); pv_one<1>(o[1], vb, pa0, pa1, pa2, pa3); pv_one<2>(o[2], vb, pa0, pa1, pa2, pa3); pv_one<3>(o[3], vb, pa0, pa1, pa2, pa3);
}
template <bool SHIFT> DI void qkt(f32x16& p0, f32x16& p1, const char* Ks, const bf16x8* qr, int r32, int hi, int c, float negmb) {
  if constexpr (SHIFT) {
#pragma unroll
    for (int r = 0; r < 16; ++r) { p0[r] = negmb; p1[r] = negmb; }
  } else { p0 = f32x16{}; p1 = f32x16{}; }
#pragma unroll
  for (int d0 = 0; d0 < 4; ++d0) { const int cb = (c * 64 + d0 * 16 + hi * 8) * 2;
    const bf16x8 b0 = *reinterpret_cast<const bf16x8*>(Ks + KSWZ(r32, cb));
    const bf16x8 b1 = *reinterpret_cast<const bf16x8*>(Ks + KSWZ(32 + r32, cb));
    p0 = __builtin_amdgcn_mfma_f32_32x32x16_bf16(b0, qr[d0], p0, 0, 0, 0);
    p1 = __builtin_amdgcn_mfma_f32_32x32x16_bf16(b1, qr[d0], p1, 0, 0, 0); }
}
DI void expA(f32x16& p0) {
#pragma unroll
  for (int r = 0; r < 16; ++r) p0[r] = __builtin_amdgcn_exp2f(p0[r]);
}
DI void finishSM(f32x16& p0, f32x16& p1, float& l_reg, bf16x8& pa0, bf16x8& pa1, bf16x8& pa2, bf16x8& pa3) {
#pragma unroll
  for (int r = 0; r < 16; ++r) p1[r] = __builtin_amdgcn_exp2f(p1[r]);
  float ps = 0.f;
#pragma unroll
  for (int r = 0; r < 16; ++r) ps += p0[r];
#pragma unroll
  for (int r = 0; r < 16; ++r) ps += p1[r];
  l_reg += ps;
#define PK4(P, BASE, OUT) do { unsigned a0 = cvtpk(P[BASE + 0], P[BASE + 1]), a1 = cvtpk(P[BASE + 2], P[BASE + 3]);   \
    unsigned b0 = cvtpk(P[BASE + 4], P[BASE + 5]), b1 = cvtpk(P[BASE + 6], P[BASE + 7]);                              \
    auto r0 = __builtin_amdgcn_permlane32_swap(a0, b0, false, false); auto r1 = __builtin_amdgcn_permlane32_swap(a1, b1, false, false); \
    u32x4 w = {r0[0], r1[0], r0[1], r1[1]}; OUT = *reinterpret_cast<bf16x8*>(&w); } while (0)
  PK4(p0, 0, pa0); PK4(p0, 8, pa1); PK4(p1, 0, pa2); PK4(p1, 8, pa3);
#undef PK4
}
DI unsigned cvtpk2(float lo, float hi) { typedef float f2_t __attribute__((ext_vector_type(2))); typedef __bf16 b2_t __attribute__((ext_vector_type(2))); f2_t v = {lo, hi}; b2_t b = __builtin_convertvector(v, b2_t); return __builtin_bit_cast(unsigned, b); }
template <int I> DI void vrd(s16x4& l, s16x4& h, int vb) { constexpr int ks = I >> 2, d0 = I & 3; l = tr_read<v_rd_off(d0, ks, 0)>(vb); h = tr_read<v_rd_off(d0, ks, 1)>(vb); }
#define TIEWAIT(N, L, H) asm volatile("s_waitcnt lgkmcnt(" #N ")" : "+v"(L), "+v"(H))
#define PK4B(P, BASE, OUT) do { unsigned a0 = cvtpk2(P[BASE + 0], P[BASE + 1]), a1 = cvtpk2(P[BASE + 2], P[BASE + 3]);   \
    unsigned b0 = cvtpk2(P[BASE + 4], P[BASE + 5]), b1 = cvtpk2(P[BASE + 6], P[BASE + 7]);                              \
    auto r0 = __builtin_amdgcn_permlane32_swap(a0, b0, false, false); auto r1 = __builtin_amdgcn_permlane32_swap(a1, b1, false, false); \
    u32x4 w = {r0[0], r1[0], r0[1], r1[1]}; OUT = *reinterpret_cast<bf16x8*>(&w); } while (0)
#define PKV(L, H) (bf16x8){L[0], L[1], L[2], L[3], H[0], H[1], H[2], H[3]}
#define PVSTEP(i, N, PA, SL, SH, NL, NH) do { TIEWAIT(N, SL, SH); o[(i) & 3] = __builtin_amdgcn_mfma_f32_32x32x16_bf16(PA, PKV(SL, SH), o[(i) & 3], 0, 0, 0); \
    if constexpr ((i) + 3 < 16) vrd<((i) + 3 < 16 ? (i) + 3 : 15)>(NL, NH, vb); } while (0)
DI void finish_pv(f32x16& p0, f32x16& p1, float& l_reg, f32x16* o, int vb) {
  s16x4 l0, h0, l1, h1, l2, h2, l3, h3;
  vrd<0>(l0, h0, vb); vrd<1>(l1, h1, vb); vrd<2>(l2, h2, vb);
  bf16x8 pa0, pa1, pa2, pa3;
  PK4B(p0, 0, pa0); PK4B(p0, 8, pa1);
  PVSTEP(0, 4, pa0, l0, h0, l3, h3); PVSTEP(1, 4, pa0, l1, h1, l0, h0); PVSTEP(2, 4, pa0, l2, h2, l1, h1); PVSTEP(3, 4, pa0, l3, h3, l2, h2);
  PVSTEP(4, 4, pa1, l0, h0, l3, h3); PVSTEP(5, 4, pa1, l1, h1, l0, h0); PVSTEP(6, 4, pa1, l2, h2, l1, h1); PVSTEP(7, 4, pa1, l3, h3, l2, h2);
#pragma unroll
  for (int r = 0; r < 16; ++r) p1[r] = __builtin_amdgcn_exp2f(p1[r]);
  PK4B(p1, 0, pa2); PK4B(p1, 8, pa3);
  PVSTEP(8, 4, pa2, l0, h0, l3, h3); PVSTEP(9, 4, pa2, l1, h1, l0, h0); PVSTEP(10, 4, pa2, l2, h2, l1, h1); PVSTEP(11, 4, pa2, l3, h3, l2, h2);
  PVSTEP(12, 4, pa3, l0, h0, l3, h3); PVSTEP(13, 4, pa3, l1, h1, l0, h0); PVSTEP(14, 2, pa3, l2, h2, l1, h1); PVSTEP(15, 0, pa3, l3, h3, l2, h2);
  float ps = 0.f;
#pragma unroll
  for (int r = 0; r < 16; ++r) ps += p0[r];
#pragma unroll
  for (int r = 0; r < 16; ++r) ps += p1[r];
  l_reg += ps;
}
DI void glds16(const void* gsrc, unsigned lds_dst) { unsigned keep;
  asm volatile("s_mov_b32 %0, m0\n\ts_mov_b32 m0, %2\n\ts_nop 0\n\tglobal_load_lds_dwordx4 %1, off\n\ts_mov_b32 m0, %0" : "=&s"(keep) : "v"(gsrc), "s"(lds_dst) : "memory"); }
#define WAIT_BAR(N) asm volatile("s_waitcnt vmcnt(" #N ") lgkmcnt(0)\n\ts_barrier" ::: "memory")
template <bool SHIFT> DI void attn_unit(const bf16* __restrict__ Qb, const bf16* __restrict__ Kh, const bf16* __restrict__ Vh, bf16* __restrict__ Ob, int seq, char* lds,
                  float negmb, float lam, const float* __restrict__ gsub, float post) {
  int tid = threadIdx.x; asm volatile("" : "+v"(tid));
  const int lane = tid & 63, r32 = lane & 31, hi = lane >> 5; const int wid = __builtin_amdgcn_readfirstlane(tid >> 6), c = wid >> 2, wq = wid & 3;
  char* K_ring = lds; char* V_ring = lds + 3 * SHM_K;
  float* wsf = (float*)(lds + SCR_OFF) + wid * 64;
  const unsigned lds0 = (unsigned)(uintptr_t)lds;
  float l_reg = 0.f; f32x16 o[4] = {}; bf16x8 qr[4];
  const bf16* Qw = Qb + (size_t)(wq * 32 + r32) * INW + c * 64 + hi * 8;
#pragma unroll
  for (int d0 = 0; d0 < 4; ++d0) qr[d0] = *reinterpret_cast<const bf16x8*>(Qw + d0 * 16);
  const bf16* ksrc0; const bf16* ksrc1; const bf16* vsrc0; const bf16* vsrc1;
  { const int row0 = 8 * wid + (lane >> 4), row1 = row0 + 4, cp = lane & 15;
    ksrc0 = Kh + (size_t)row0 * INW + ((cp ^ (row0 & 7)) << 3); ksrc1 = Kh + (size_t)row1 * INW + ((cp ^ (row1 & 7)) << 3);
    const int kk = 8 * wid + ((lane & 31) >> 2), kkey = (kk & ~0xC) | ((kk & 4) << 1) | ((kk & 8) >> 1), cc = (lane >> 5) * 32 + (lane & 3) * 8;
    vsrc0 = Vh + (size_t)kkey * INW + cc; vsrc1 = vsrc0 + 64; }
  const unsigned kdst = lds0 + (unsigned)wid * 2048u, vdst = lds0 + 3u * SHM_K + (unsigned)wid * 2048u;
#define DMA_K(t, slot) do { const size_t to_ = (size_t)(t) * (KVBLK * INW); const unsigned d_ = (unsigned)__builtin_amdgcn_readfirstlane(kdst + (unsigned)(slot)); glds16(ksrc0 + to_, d_); glds16(ksrc1 + to_, d_ + 1024u); } while (0)
#define DMA_V(t, slot) do { const size_t to_ = (size_t)(t) * (KVBLK * INW); const unsigned d_ = (unsigned)__builtin_amdgcn_readfirstlane(vdst + (unsigned)(slot)); glds16(vsrc0 + to_, d_); glds16(vsrc1 + to_, d_ + 1024u); } while (0)
  const int vb0 = (int)(lds0 + 3u * SHM_K) + v_rd_base(lane);
  f32x16 pA0, pA1, pB0, pB1; const int NT = seq / KVBLK;
  int s0 = 0, s1 = SHM_K, s2 = 2 * SHM_K;
#define ROT() do { const int t_ = s0; s0 = s1; s1 = s2; s2 = t_; } while (0)
  DMA_K(0, 0); DMA_K(1, SHM_K); DMA_V(0, 0);
  WAIT_BAR(4);
  DMA_K(2, 2 * SHM_K); DMA_V(1, SHM_K);
  qkt<SHIFT>(pA0, pA1, K_ring, qr, r32, hi, c, negmb); expA(pA0);
#define ITER(CUR0, CUR1, PRV0, PRV1, j) do { \
    WAIT_BAR(4); \
    { const int tk_ = ((j) + 2 < NT) ? (j) + 2 : NT - 1, tv_ = ((j) + 1 < NT) ? (j) + 1 : NT - 1; DMA_K(tk_, s0); DMA_V(tv_, s2); } \
    SBAR(); qkt<SHIFT>(CUR0, CUR1, K_ring + s1, qr, r32, hi, c, negmb); \
    finish_pv(PRV0, PRV1, l_reg, o, vb0 + s0); expA(CUR0); \
    ROT(); } while (0)
  for (int j = 1; j + 1 < NT; j += 2) {
    ITER(pB0, pB1, pA0, pA1, j);
    ITER(pA0, pA1, pB0, pB1, j + 1);
  }
  ITER(pB0, pB1, pA0, pA1, NT - 1);
  WAIT_BAR(0);
  finish_pv(pB0, pB1, l_reg, o, vb0 + s0);
#undef ITER
#undef ROT
#undef DMA_K
#undef DMA_V
  int lane_e = lane; asm volatile("" : "+v"(lane_e));
  {
  const int lane = lane_e, r32 = lane & 31, hi = lane >> 5;
  { auto rr = __builtin_amdgcn_permlane32_swap(__float_as_uint(l_reg), __float_as_uint(l_reg), false, false); l_reg = __uint_as_float(rr[0]) + __uint_as_float(rr[1]); }
  if (hi == 0) wsf[r32] = l_reg;
  asm volatile("s_waitcnt lgkmcnt(0)" ::: "memory");
  __syncthreads();
  float* X = (float*)lds + wq * 4096;
  if (c == 1) {
#pragma unroll
    for (int r = 0; r < 16; ++r) { const float rl = __builtin_amdgcn_rcpf(wsf[crow(r, hi)]);
#pragma unroll
      for (int d0 = 0; d0 < 4; ++d0) X[(d0 * 16 + r) * 64 + lane] = o[d0][r] * rl; }
  }
  __syncthreads();
  if (c == 0) {
    float g4[4];
#pragma unroll
    for (int d0 = 0; d0 < 4; ++d0) g4[d0] = gsub[32 * d0 + r32] * post;
#pragma unroll
    for (int r = 0; r < 16; ++r) { const float rl = __builtin_amdgcn_rcpf(wsf[crow(r, hi)]); float dv[4]; float s = 0.f;
#pragma unroll
      for (int d0 = 0; d0 < 4; ++d0) { dv[d0] = o[d0][r] * rl - lam * X[(d0 * 16 + r) * 64 + lane]; s += dv[d0] * dv[d0]; }
#pragma unroll
      for (int off = 1; off < 32; off <<= 1) s += __shfl_xor(s, off);
      const float rs = 1.0f / sqrtf(s * (1.f / 128.f) + EPS); bf16* orow = Ob + (size_t)(wq * 32 + crow(r, hi)) * DM + r32;
#pragma unroll
      for (int d0 = 0; d0 < 4; ++d0) orow[32 * d0] = (bf16)(pk2(dv[d0] * rs * g4[d0], 0.f) & 0xffffu); }
  }
  }
  __syncthreads();
}
#undef SBAR
}

DI void sgu_unit(const bf16* P, bf16* MIX, int chunk, int hd, const float* Ws, const float* bs, const float* gv, char* lds) {
    using att::bf16x8; using att::f32x16;
    int tid = threadIdx.x; asm volatile("" : "+v"(tid));
    const int wid = tid >> 6, lane = tid & 63, r32 = lane & 31, hi = lane >> 5;
    bf16* vnT = (bf16*)lds;
    { const int p = tid >> 2, qtr = tid & 3; const bf16* src = P + (size_t)(chunk * 128 + p) * INW + OFF_CV + hd * 128 + qtr * 32;
      v4u raw[4];
#pragma unroll
      for (int i = 0; i < 4; ++i) raw[i] = *(const v4u*)(src + 8 * i);
      float x[32];
#pragma unroll
      for (int i = 0; i < 4; ++i) unpack8(raw[i], x + 8 * i);
      float ss = 0.f;
#pragma unroll
      for (int i = 0; i < 32; ++i) { x[i] = gelu_tanh(x[i]); ss += x[i] * x[i]; }
      ss += __shfl_xor(ss, 1); ss += __shfl_xor(ss, 2);
      const float rstd = 1.0f / sqrtf(ss * (1.f / 128.f) + EPS);
#pragma unroll
      for (int i = 0; i < 32; ++i) { const float v = x[i] * rstd * gv[qtr * 32 + i]; vnT[(qtr * 32 + i) * 136 + p] = (bf16)(pk2(v, 0.f) & 0xffffu); }
    }
    __syncthreads();
    const int qb = wid >> 1;
    bf16x8 a[8];
#pragma unroll
    for (int ks = 0; ks < 8; ++ks) { const float* w = Ws + (size_t)(32 * qb + r32) * 128 + 16 * ks + 8 * hi; const f32x4 w0 = *(const f32x4*)w, w1 = *(const f32x4*)(w + 4);
        att::u32x4 u = {pk2(w0.x, w0.y), pk2(w0.z, w0.w), pk2(w1.x, w1.y), pk2(w1.z, w1.w)}; a[ks] = *reinterpret_cast<bf16x8*>(&u); }
#pragma unroll
    for (int dd = 0; dd < 2; ++dd) { const int db = 2 * (wid & 1) + dd;
        f32x16 acc = {};
#pragma unroll
        for (int ks = 0; ks < 8; ++ks) { const bf16x8 b = *reinterpret_cast<const bf16x8*>(vnT + (32 * db + r32) * 136 + 16 * ks + 8 * hi);
            acc = __builtin_amdgcn_mfma_f32_32x32x16_bf16(a[ks], b, acc, 0, 0, 0); }
        const int d = 32 * db + r32;
#pragma unroll
        for (int i = 0; i < 16; ++i) { const int q = 32 * qb + att::crow(i, hi); const size_t tok = (size_t)chunk * 128 + q;
            const float uval = gelu_tanh(__uint_as_float((unsigned)P[tok * INW + OFF_CU + hd * 128 + d] << 16));
            MIX[tok * DM + MIX_C + hd * 128 + d] = (bf16)(pk2(uval * (acc[i] + bs[q]), 0.f) & 0xffffu); }
    }
    __syncthreads();
}

#define LAS __attribute__((address_space(3)))
#define XB_TMO      128
#define XB_XCNT(j)  (256  + 64 * (j))
#define XB_XSUB(j)  (1280 + 64 * (j))
#define XB_XGEN(j)  (2304 + 64 * (j))
#define XB_TOP      3328
#define XB_TOPGEN   3392
#define XCD_BAR_WORDS 3456
#define XB_SPIN_CAP (1u << 18)

__device__ __forceinline__ unsigned xb_ld(unsigned* p)              { return __hip_atomic_load(p, __ATOMIC_RELAXED, __HIP_MEMORY_SCOPE_AGENT); }
__device__ __forceinline__ unsigned xb_add(unsigned* p, unsigned v) { return __hip_atomic_fetch_add(p, v, __ATOMIC_RELAXED, __HIP_MEMORY_SCOPE_AGENT); }
__device__ __forceinline__ unsigned xb_xcc_id() { return (unsigned)__builtin_amdgcn_s_getreg((3 << 11) | 20) & 0xFu; }
#define XB_SPIN(cond, bar) do { unsigned _sp = 0; while (cond) { __builtin_amdgcn_s_sleep(1); \
    if ((++_sp & 255u) == 0u) { if (xb_ld(&(bar)[XB_TMO])) break; if (_sp > XB_SPIN_CAP) { atomicAdd(&(bar)[XB_TMO], 1u); break; } } } } while (0)

struct XcdBarrier {
    unsigned* bar; unsigned x;
    volatile LAS unsigned* st;
};

__device__ __forceinline__ XcdBarrier xcd_barrier_post(unsigned* bar, volatile LAS unsigned* st) {
    XcdBarrier b; b.bar = bar; b.x = xb_xcc_id(); b.st = st;
    if (threadIdx.x == 0) (void)xb_add(&bar[XB_XCNT(b.x)], 1u);
    return b;
}
__device__ __forceinline__ void xcd_barrier_complete(unsigned* bar, unsigned x, unsigned& nloc, unsigned& nx) {
    const unsigned G = gridDim.x * gridDim.y * gridDim.z;
    unsigned sum, cnt, mine, sp = 0u;
    for (;;) {
        sum = 0u; cnt = 0u; mine = 0u;
#pragma unroll
        for (unsigned j = 0; j < 16; ++j) { const unsigned c = xb_ld(&bar[XB_XCNT(j)]); sum += c; cnt += (c > 0u) ? 1u : 0u; mine = (j == x) ? c : mine; }
        if (sum == G) break;
        __builtin_amdgcn_s_sleep(1);
        if ((++sp & 255u) == 0u) { if (xb_ld(&bar[XB_TMO])) break; if (sp > XB_SPIN_CAP) { atomicAdd(&bar[XB_TMO], 1u); break; } }
    }
    nloc = mine > 0u ? mine : 1u; nx = cnt > 0u ? cnt : 1u;
}

__device__ __forceinline__ void xcd_barrier(const XcdBarrier& b) {
    asm volatile("s_waitcnt vmcnt(0)" ::: "memory");
    __syncthreads();
    if (threadIdx.x == 0) {
        unsigned* bar = b.bar;
        __builtin_amdgcn_s_waitcnt(0);
        unsigned nloc = b.st[0], nx = b.st[1];
        if (nloc == 0u) { xcd_barrier_complete(bar, b.x, nloc, nx); b.st[0] = nloc; b.st[1] = nx; }
        const unsigned old = xb_add(&bar[XB_XSUB(b.x)], 1u);
        const unsigned gen = old / nloc;
        if (old + 1u == (gen + 1u) * nloc) {
            __builtin_amdgcn_fence(__ATOMIC_RELEASE, "agent");
            asm volatile("s_waitcnt vmcnt(0)" ::: "memory");
            const unsigned og = xb_add(&bar[XB_TOP], 1u);
            const unsigned tg = og / nx;
            if (og + 1u == (tg + 1u) * nx) xb_add(&bar[XB_TOPGEN], 1u);
            else XB_SPIN(xb_ld(&bar[XB_TOPGEN]) == tg, bar);
            __builtin_amdgcn_fence(__ATOMIC_ACQUIRE, "agent");
            xb_add(&bar[XB_XGEN(b.x)], 1u);
            asm volatile("s_waitcnt vmcnt(0)" ::: "memory");
        } else {
            XB_SPIN(xb_ld(&bar[XB_XGEN(b.x)]) == gen, bar);
            __builtin_amdgcn_fence(__ATOMIC_ACQUIRE, "agent");
            asm volatile("s_waitcnt vmcnt(0)" ::: "memory");
        }
    }
    __syncthreads();
}

struct Args { const float* in[19]; float* out; unsigned char* ws; int ph_lo, ph_hi; };
constexpr int N_PHASES = 1 + 6 * NLAYER;

__global__ void __launch_bounds__(NWAVES * 64, 2) mk_fwd(Args args) {
    extern __shared__ __attribute__((aligned(16))) unsigned char lds[];
    cg::grid_group grid = cg::this_grid();
    const int G = gridDim.x; const int bx = blockIdx.x; const int vcu = (G % 8 == 0) ? (bx % 8) * (G / 8) + bx / 8 : bx;
    const int NGW = G * NWAVES;
    unsigned char* ws = args.ws;
    const float* xp = args.in[0]; const float* xs = args.in[1];
    float* out = args.out;
    bf16* XN = (bf16*)(ws + WS_XN); bf16* PROJ = (bf16*)(ws + WS_PROJ); bf16* MIX = (bf16*)(ws + WS_MIX); bf16* HB = (bf16*)(ws + WS_H);

    volatile LAS unsigned* MISC = (volatile LAS unsigned*)((LAS unsigned char*)lds + 131072 + 320);
    if (threadIdx.x < 32) MISC[threadIdx.x] = 0u;
    __syncthreads();
    const XcdBarrier bar = xcd_barrier_post((unsigned*)ws, MISC + 8);
    for (int ph = args.ph_lo; ph < args.ph_hi; ++ph) {
        int tid = threadIdx.x; asm volatile("" : "+v"(tid));
        const int lane = tid & 63, wave = __builtin_amdgcn_readfirstlane(tid >> 6), gw = vcu * NWAVES + wave;
        const int l = (ph - 1) / 6, k = (ph == 0) ? -1 : ((ph - 1) % 6);
        float* const RS = (float*)(ws + 65536);
        const unsigned char* wl = ws + WS_WT + (size_t)(l < 0 ? 0 : l) * WT_LAYER;
        if (ph == 0) {
#if PHM & 1
            for (int rep = 0; rep < PROBE_REP_MISC; ++rep) {
            float* scr = (float*)(lds + wave * 16384);
            constexpr int I_IN = 32 * 176, I_OUT = 32 * 64, I_UP = 32 * 256, I_DN = 128 * 64, I_L = I_IN + I_OUT + I_UP + I_DN;
            for (int it = gw; it < NLAYER * I_L; it += NGW) {
                const int ll = it / I_L; int r = it % I_L; unsigned char* wb = ws + WS_WT + (size_t)ll * WT_LAYER;
                if (r < I_IN) { transpose_item(args.in[3] + (size_t)ll * DM * INW, DM, INW, (bf16*)(wb + WT_IN), DM, args.in[2] + ll * DM, scr, r, lane); continue; } r -= I_IN;
                if (r < I_OUT) { transpose_item(args.in[15] + (size_t)ll * DM * DM, DM, DM, (bf16*)(wb + WT_OUT), DM, nullptr, scr, r, lane); continue; } r -= I_OUT;
                if (r < I_UP) { transpose_item(args.in[17] + (size_t)ll * DM * DFF, DM, DFF, (bf16*)(wb + WT_UP), DM, args.in[16] + ll * DM, scr, r, lane); continue; } r -= I_UP;
                transpose_item(args.in[18] + (size_t)ll * DFF * DM, DFF, DM, (bf16*)(wb + WT_DN), LDH, nullptr, scr, r, lane);
            }
            for (int m = gw; m < M_ALL; m += NGW) xb_row(m < MP ? xp + (size_t)m * DM : xs + (size_t)(m - MP) * DM, XN + (size_t)m * DM, RS + m, lane);
            for (int i = gw * 64 + lane; i < 3 * M_ALL; i += NGW * 64) RS[M_ALL + i] = 0.f;
            }
#endif
        } else if (k == 0) {
#if PHM & 2
            pg8::Gemm g{XN, (const bf16*)(wl + WT_IN), M_ALL, INW, DM, DM, DM}; pg8::StaticOrder S; S.init(M_ALL, INW, G, bx);
            pg8::EpiBf16<0> E{PROJ, INW, RS + (size_t)(2 * l) * M_ALL};
            for (int rep = 0; rep < PROBE_REP_WIN; ++rep)
            pg8::gemm_phase<pg8::EpiBf16<0>, pg8::StaticOrder, true, true>((PG8_LAS unsigned char*)lds, g, S, E);
#endif
        } else if (k == 1) {
#if PHM & 4
            const float* qg = args.in[5] + l * 64; const float* kg = args.in[6] + l * 64; const float* cw = args.in[4] + l * 1536;
            for (int m = gw; m < M_ALL; m += NGW) {
                const int pos = m < MP ? (m & (SEQ_P - 1)) : ((m - MP) & (SEQ_S - 1)); const int S = m < MP ? SEQ_P : SEQ_S;
                qk_row(PROJ, m, pos, qg, kg, lane);
                conv_row(PROJ, MIX, m, pos, S, cw, lane);
            }
            for (int u = vcu; u < (M_ALL / 128) * 4; u += G) { const int chunk = u >> 2, hd = u & 3;
                sgu_unit(PROJ, MIX, chunk, hd, args.in[13] + ((size_t)l * 4 + hd) * 128 * 128, args.in[14] + (l * 4 + hd) * 128, args.in[12] + l * 128, (char*)lds); }
#endif
        } else if (k == 2) {
#if PHM & 8
            const float linit = (l == 0) ? 0.2f : 0.35550906759096934f;
            const float s1 = wave_sum(args.in[7][l * 64 + lane] * args.in[8][l * 64 + lane]), s2 = wave_sum(args.in[9][l * 64 + lane] * args.in[10][l * 64 + lane]);
            const float lam = __uint_as_float(__builtin_amdgcn_readfirstlane(__float_as_uint(expf(s1) - expf(s2) + linit)));
            const float gq = wave_max(fabsf(args.in[5][l * 64 + lane])), gk = wave_max(fabsf(args.in[6][l * 64 + lane]));
            const float negmb = __uint_as_float(__builtin_amdgcn_readfirstlane(__float_as_uint(-(C2 * 64.0f * gq * gk))));
            for (int rep = 0; rep < PROBE_REP_ATT; ++rep)
            for (int t = vcu; t < 2560; t += G) {
                int pair, qb, seq, seqrow0;
                if (t < 2048) { const int i = t >> 8, v = t & 255; const int idx = (v >> 5) * 256 + i * 32 + (v & 31); pair = idx >> 7; qb = idx & 127; seq = SEQ_S; seqrow0 = MP + (pair >> 3) * SEQ_S; }
                else { const int t2 = t - 2048, i = t2 >> 8, v = t2 & 255; pair = 2 * (v >> 5) + i; qb = v & 31; seq = SEQ_P; seqrow0 = (pair >> 3) * SEQ_P; }
                const int h = pair & 7; const size_t row0 = (size_t)seqrow0 + (size_t)qb * 128;
                if (negmb >= -64.0f)
                att::attn_unit<false>(PROJ + row0 * INW + OFF_Q + h * 128, PROJ + (size_t)seqrow0 * INW + OFF_K + h * 128, PROJ + (size_t)seqrow0 * INW + OFF_V + h * 128,
                               MIX + row0 * DM + MIX_B + h * 128, seq, (char*)lds, 0.f, lam, args.in[11] + l * 128, 1.0f - linit);
                else
                att::attn_unit<true>(PROJ + row0 * INW + OFF_Q + h * 128, PROJ + (size_t)seqrow0 * INW + OFF_K + h * 128, PROJ + (size_t)seqrow0 * INW + OFF_V + h * 128,
                               MIX + row0 * DM + MIX_B + h * 128, seq, (char*)lds, negmb, lam, args.in[11] + l * 128, 1.0f - linit);
            }
#endif
        } else if (k == 3 || k == 5) {
#if PHM & 16
            pg8::Gemm g; if (k == 3) g = pg8::Gemm{MIX, (const bf16*)(wl + WT_OUT), M_ALL, DM, DM, DM, DM}; else g = pg8::Gemm{HB, (const bf16*)(wl + WT_DN), M_ALL, DM, DFF, LDH, LDH};
            pg8::StaticOrder S; S.init(M_ALL, DM, G, bx);
            pg8::EpiResF32 E;
            if (k == 3 && l == 0) E = pg8::EpiResF32{xp, xs, MP / 256, out, DM, XN, DM, RS + (size_t)1 * M_ALL};
            else if (k == 3) E = pg8::EpiResF32{out, out, 0, out, DM, XN, DM, RS + (size_t)3 * M_ALL};
            else if (l == 0) E = pg8::EpiResF32{out, out, 0, out, DM, XN, DM, RS + (size_t)2 * M_ALL};
            else E = pg8::EpiResF32{out, out, 0, out, DM, nullptr, 0, nullptr};
            pg8::gemm_phase<pg8::EpiResF32, pg8::StaticOrder, true, true>((PG8_LAS unsigned char*)lds, g, S, E);
#endif
        } else {
#if PHM & 64
            pg8::Gemm g{XN, (const bf16*)(wl + WT_UP), M_ALL, DFF, DM, DM, DM}; pg8::StaticOrder S; S.init(M_ALL, DFF, G, bx);
            pg8::EpiBf16<2> E{HB, LDH, RS + (size_t)(2 * l + 1) * M_ALL};
            for (int rep = 0; rep < PROBE_REP_UP; ++rep)
            pg8::gemm_phase<pg8::EpiBf16<2>, pg8::StaticOrder, true, true>((PG8_LAS unsigned char*)lds, g, S, E);
#endif
        }
        if (ph + 1 < args.ph_hi) { if (ph == args.ph_lo) grid.sync(); else xcd_barrier(bar); }
    }
}

extern "C" void kernel_launch(void* const* d_in, const int* in_sizes, int n_in, void* d_out, int out_size, void* d_ws, size_t ws_size, hipStream_t stream) {
    static int grid = 0;
    if (grid == 0) {
        if (n_in != 19 || out_size != M_ALL * DM || ws_size < WS_END) { fprintf(stderr, "kernel_launch: unexpected shapes: n_in %d out %d ws %zu (need %zu)\n", n_in, out_size, ws_size, (size_t)WS_END); grid = -1; return; }
        int dev = 0, cus = 0, per_cu = 0;
        if (hipGetDevice(&dev) != hipSuccess || hipDeviceGetAttribute(&cus, hipDeviceAttributeMultiprocessorCount, dev) != hipSuccess) { fprintf(stderr, "kernel_launch: device query failed\n"); grid = -1; return; }
        if (hipFuncSetAttribute((const void*)mk_fwd, hipFuncAttributeMaxDynamicSharedMemorySize, LDS_BYTES) != hipSuccess) { fprintf(stderr, "kernel_launch: hipFuncSetAttribute failed\n"); grid = -1; return; }
        if (hipOccupancyMaxActiveBlocksPerMultiprocessor(&per_cu, (const void*)mk_fwd, NWAVES * 64, LDS_BYTES) != hipSuccess || per_cu < 1) { fprintf(stderr, "kernel_launch: occupancy query gave %d\n", per_cu); per_cu = 1; }
        (void)hipGetLastError();
        grid = cus * 1;
        fprintf(stderr, "kernel_launch: grid %d (cus %d, per_cu %d)\n", grid, cus, per_cu);
    }
    if (grid < 0) return;
    if (hipMemsetAsync(d_ws, 0, 65536, stream) != hipSuccess) { fprintf(stderr, "kernel_launch: memset failed\n"); return; }
    Args a{};
    for (int i = 0; i < 19; ++i) a.in[i] = (const float*)d_in[i];
    a.out = (float*)d_out; a.ws = (unsigned char*)d_ws;
#if MK_SINGLE
    a.ph_lo = 0; a.ph_hi = N_PHASES;
    { void* kargs[] = {&a}; hipError_t e = hipLaunchCooperativeKernel((const void*)mk_fwd, dim3(grid), dim3(NWAVES * 64), kargs, LDS_BYTES, stream);
      if (e != hipSuccess) fprintf(stderr, "kernel_launch: cooperative launch failed: %s\n", hipGetErrorString(e)); }
#else
    for (int ph = 0; ph < N_PHASES; ++ph) { a.ph_lo = ph; a.ph_hi = ph + 1; void* kargs[] = {&a};
        hipError_t e = hipLaunchCooperativeKernel((const void*)mk_fwd, dim3(grid), dim3(NWAVES * 64), kargs, LDS_BYTES, stream);
        if (e != hipSuccess) { fprintf(stderr, "kernel_launch: cooperative launch %d failed: %s\n", ph, hipGetErrorString(e)); break; } }
#endif
}
```

```cpp
#include <hip/hip_runtime.h>
#include <hip/hip_cooperative_groups.h>
#include <hip/hip_bf16.h>
#include <cstdio>
#include <cstdint>
namespace cg = cooperative_groups;
namespace pg8 {
#define PG8_LAS __attribute__((address_space(3)))
typedef unsigned short bf16_t;
typedef short bf16x8 __attribute__((ext_vector_type(8)));
typedef float f32x4 __attribute__((ext_vector_type(4)));
typedef unsigned u32x4 __attribute__((ext_vector_type(4)));
constexpr int BM = 256, BK = 64, HALF = 128, HTB = HALF * BK * 2  , STAGE_BYTES = 8 * HTB, NXCD = 8, WGM = 8;

__host__ __device__ __forceinline__ int lds_byte(int r, int c) { const int st = (r >> 4) * 2 + (c >> 5), rr = r & 15, cc = c & 31, ob = rr * 64 + cc * 2; return st * 1024 + (ob ^ (((ob >> 9) & 1) << 5)); }
__host__ __device__ __forceinline__ void stage_rc(int b, int& R, int& C) { const int st = b / 1024, sb = b % 1024, swz = sb ^ (((sb >> 9) & 1) << 5); R = (st >> 1) * 16 + swz / 64; C = (st & 1) * 32 + (swz % 64) / 2; }
__host__ __device__ __forceinline__ int perm32(int rho) { const int n = rho >> 4, i = rho & 15; return 8 * (i >> 2) + 4 * n + (i & 3); }

struct Unit { int pm, pn; };
struct Gemm { const bf16_t* A; const bf16_t* Bt; int M, N, K, lda, ldb; };

struct StaticOrder {
    int nM, nN, nwg, G, c;
    __host__ __device__ void init(int M, int N, int G_, int c_) { nM = M / BM; nN = N / BM; nwg = nM * nN; G = G_; c = c_; }
    __host__ __device__ bool next(int i, Unit& u) const {
        const long L = (long)i * G + c; if (L >= nwg) return false;
        int wgid = (int)L; { const int q = nwg / NXCD, r = nwg % NXCD, xcd = wgid % NXCD, off = wgid / NXCD; wgid = (xcd < r ? xcd * (q + 1) : r * (q + 1) + (xcd - r) * q) + off; }
        const int nig = WGM * nN, gid = wgid / nig, fm = gid * WGM, gsz = (nM - fm) < WGM ? (nM - fm) : WGM;
        u.pm = fm + ((wgid % nig) % gsz); u.pn = (wgid % nig) / gsz; return true;
    }
    __device__ __forceinline__ void a_ready(const Unit&) const {}
    __device__ __forceinline__ void done(const Unit&) const {}
};

__device__ __forceinline__ unsigned cvt_pk_bf16(float lo, float hi) { unsigned r; asm volatile("v_cvt_pk_bf16_f32 %0, %1, %2" : "=v"(r) : "v"(lo), "v"(hi)); return r; }
typedef float f32x2 __attribute__((ext_vector_type(2)));
typedef unsigned u32x2 __attribute__((ext_vector_type(2)));
template <int ACT> struct EpiBf16 {
    static constexpr bool PERM = true, AFTER_DRAIN = false;
    bf16_t* O; int ldc; const float* rowss;
    __device__ __forceinline__ void operator()(const f32x4 (&acc)[2][2][4][2], const Unit& u, int wr, int wc, int fr, int fq) const {
        const int row0 = u.pm * BM + wr * 64 + fr; const int col0 = u.pn * BM + wc * 32 + 8 * fq;
        float rs[2][4];
#pragma unroll
        for (int ai = 0; ai < 2; ++ai)
#pragma unroll
            for (int m = 0; m < 4; ++m) rs[ai][m] = rowss[row0 + ai * HALF + m * 16];
#pragma unroll
        for (int ai = 0; ai < 2; ++ai)
#pragma unroll
            for (int m = 0; m < 4; ++m) { bf16_t* rowp = O + (size_t)(row0 + ai * HALF + m * 16) * ldc + col0;
                const float sc = 1.0f / sqrtf(rs[ai][m] * (1.0f / 2048.0f) + 1e-6f);
#pragma unroll
                for (int bj = 0; bj < 2; ++bj) { f32x4 v0 = acc[ai][bj][m][0] * sc, v1 = acc[ai][bj][m][1] * sc;
                    if (ACT == 2) {
#pragma unroll
                        for (int e = 0; e < 4; ++e) { float a = fmaxf(v0[e], 0.f), b = fmaxf(v1[e], 0.f); v0[e] = a * a; v1[e] = b * b; } }
                    u32x4 w; w.x = cvt_pk_bf16(v0[0], v0[1]); w.y = cvt_pk_bf16(v0[2], v0[3]); w.z = cvt_pk_bf16(v1[0], v1[1]); w.w = cvt_pk_bf16(v1[2], v1[3]);
                    *(u32x4*)(rowp + bj * HALF) = w; } }
    }
};
struct EpiResF32 {
    static constexpr bool PERM = true, AFTER_DRAIN = false;
    const float* res_lo; const float* res_hi; int split_pm; float* out; int ldc; bf16_t* xb; int ldx; float* rowss;
    __device__ __forceinline__ void operator()(const f32x4 (&acc)[2][2][4][2], const Unit& u, int wr, int wc, int fr, int fq) const {
        const float* rbase = (u.pm < split_pm) ? res_lo : (res_hi - (size_t)split_pm * BM * ldc);
        const int col0 = u.pn * BM + wc * 32 + 8 * fq;
#pragma unroll
        for (int ai = 0; ai < 2; ++ai)
#pragma unroll
            for (int m = 0; m < 4; ++m) { const int row = u.pm * BM + ai * HALF + wr * 64 + m * 16 + fr; const size_t off = (size_t)row * ldc + col0; float ss = 0.f;
#pragma unroll
                for (int bj = 0; bj < 2; ++bj) {
                    const f32x4 v0 = *(const f32x4*)(rbase + off + bj * HALF) + acc[ai][bj][m][0], v1 = *(const f32x4*)(rbase + off + bj * HALF + 4) + acc[ai][bj][m][1];
                    *(f32x4*)(out + off + bj * HALF) = v0; *(f32x4*)(out + off + bj * HALF + 4) = v1;
                    if (xb) { u32x4 w; w.x = cvt_pk_bf16(v0[0], v0[1]); w.y = cvt_pk_bf16(v0[2], v0[3]); w.z = cvt_pk_bf16(v1[0], v1[1]); w.w = cvt_pk_bf16(v1[2], v1[3]);
                        *(u32x4*)(xb + (size_t)row * ldx + col0 + bj * HALF) = w;
                        ss += (v0[0] * v0[0] + v0[1] * v0[1]) + (v0[2] * v0[2] + v0[3] * v0[3]) + (v1[0] * v1[0] + v1[1] * v1[1]) + (v1[2] * v1[2] + v1[3] * v1[3]); } }
                if (xb) { ss += __shfl_xor(ss, 16); ss += __shfl_xor(ss, 32);
                    if (fq == 0) __hip_atomic_fetch_add(rowss + row, ss, __ATOMIC_RELAXED, __HIP_MEMORY_SCOPE_AGENT); }
                if (m == 3) asm volatile("" ::: "memory"); }
    }
};
template <class Epi, class Sched, bool ALIGN_EPI = false, bool SP2 = false>
__device__ __forceinline__ void gemm_phase(PG8_LAS unsigned char* lds, const Gemm g, const Sched& S, const Epi& E) {
    int tid = threadIdx.x; asm volatile("" : "+v"(tid));
    const int wid = __builtin_amdgcn_readfirstlane(tid >> 6), lane = tid & 63, wr = wid >> 2, wc = wid & 3, fr = lane & 15, fq = lane >> 4;
    const int K = g.K, nt = K / BK;
    unsigned voffA[2], voffB[2];
#pragma unroll
    for (int i = 0; i < 2; ++i) { int R, C; stage_rc(tid * 16 + i * 8192, R, C); const int Rb = Epi::PERM ? ((R & ~31) + perm32(R & 31)) : R;
        voffA[i] = (unsigned)(R * g.lda + C) * 2u; voffB[i] = (unsigned)(Rb * g.ldb + C) * 2u; }
    const size_t kstep = (size_t)(BK * 2);
    const size_t hstepA = (size_t)HALF * g.lda * 2, hstepB = (size_t)HALF * g.ldb * 2;
    const size_t tstepA = 2 * hstepA, tstepB = 2 * hstepB;
    const unsigned ldsw = (unsigned)wid * 1024u;
    const int aoff = lds_byte(wr * 64 + fr, fq * 8), boff = lds_byte(wc * 32 + fr, fq * 8);
#define PG8_SA(b, h) (((b) * 2 + (h)) * HTB)
#define PG8_SB(b, h) ((4 + (b) * 2 + (h)) * HTB)
#define PG8_STAGE(bufoff, gbase, voff) do { _Pragma("unroll") for (int _i = 0; _i < 2; ++_i) \
        __builtin_amdgcn_global_load_lds((const unsigned*)((const char*)(gbase) + (voff)[_i]), (PG8_LAS unsigned*)(lds + (bufoff) + ldsw + _i * 8192), 16, 0, 0); } while (0)
#define PG8_LDA(dst, b, h) do { _Pragma("unroll") for (int m = 0; m < 4; ++m) _Pragma("unroll") for (int k = 0; k < 2; ++k) dst[m][k] = *(const PG8_LAS bf16x8*)(lds + PG8_SA(b, h) + aoff + m * 2048 + k * 1024); } while (0)
#define PG8_LDB(dst, b, h) do { _Pragma("unroll") for (int n = 0; n < 2; ++n) _Pragma("unroll") for (int k = 0; k < 2; ++k) dst[n][k] = *(const PG8_LAS bf16x8*)(lds + PG8_SB(b, h) + boff + n * 2048 + k * 1024); } while (0)
#define PG8_MMA(ai, bj, At, Bt) do { __builtin_amdgcn_s_setprio(1); _Pragma("unroll") for (int m = 0; m < 4; ++m) _Pragma("unroll") for (int n = 0; n < 2; ++n) _Pragma("unroll") for (int k = 0; k < 2; ++k) \
        acc[ai][bj][m][n] = __builtin_amdgcn_mfma_f32_16x16x32_bf16(Bt[n][k], At[m][k], acc[ai][bj][m][n], 0, 0, 0); __builtin_amdgcn_s_setprio(0); } while (0)
#define PG8_WAIT_V(n) asm volatile("s_waitcnt vmcnt(" #n ")" ::: "memory")
#define PG8_WAIT_L(n) asm volatile("s_waitcnt lgkmcnt(" #n ")" ::: "memory")
#define PG8_BAR __builtin_amdgcn_s_barrier()
#define PG8_SCHED __builtin_amdgcn_sched_barrier(0)
    Unit cur, nxt; int ui = 0;
    if (!S.next(0, cur)) return;
    f32x4 acc[2][2][4][2];
#pragma unroll
    for (int a = 0; a < 2; ++a)
#pragma unroll
        for (int b = 0; b < 2; ++b)
#pragma unroll
            for (int m = 0; m < 4; ++m)
#pragma unroll
                for (int n = 0; n < 2; ++n) acc[a][b][m][n] = (f32x4){0.f, 0.f, 0.f, 0.f};
    bf16x8 At[4][2], B0[2][2], B1[2][2];
    const char* cA = (const char*)g.A + (size_t)cur.pm * tstepA; const char* cB = (const char*)g.Bt + (size_t)cur.pn * tstepB;
    S.a_ready(cur);
    if constexpr (SP2) {
        PG8_STAGE(PG8_SB(0, 0), cB, voffB); PG8_STAGE(PG8_SB(0, 1), cB + hstepB, voffB); PG8_STAGE(PG8_SA(0, 0), cA, voffA); PG8_STAGE(PG8_SA(0, 1), cA + hstepA, voffA);
        if (wr == 1) PG8_BAR;
        PG8_WAIT_V(2); PG8_BAR;
        PG8_STAGE(PG8_SB(1, 0), cB + kstep, voffB); PG8_STAGE(PG8_SA(1, 0), cA + kstep, voffA); PG8_STAGE(PG8_SB(1, 1), cB + hstepB + kstep, voffB);
        PG8_WAIT_V(6); PG8_BAR;
    } else {
        PG8_STAGE(PG8_SB(0, 0), cB, voffB); PG8_STAGE(PG8_SA(0, 0), cA, voffA); PG8_STAGE(PG8_SB(0, 1), cB + hstepB, voffB); PG8_STAGE(PG8_SA(0, 1), cA + hstepA, voffA);
        if (wr == 1) PG8_BAR;
        PG8_WAIT_V(4); PG8_BAR;
        PG8_STAGE(PG8_SB(1, 0), cB + kstep, voffB); PG8_STAGE(PG8_SA(1, 0), cA + kstep, voffA); PG8_STAGE(PG8_SB(1, 1), cB + hstepB + kstep, voffB);
        PG8_WAIT_V(6); PG8_BAR;
    }
    for (;;) {
        const bool has_next = S.next(ui + 1, nxt);
        const char* nA = has_next ? (const char*)g.A + (size_t)nxt.pm * tstepA : cA; const char* nB = has_next ? (const char*)g.Bt + (size_t)nxt.pn * tstepB : cB;
        for (int t = 0; t < nt; t += 2) {
            const bool last = (t == nt - 2);
            const char* a1 = cA + (size_t)(t + 1) * kstep;
            const char* a2 = last ? nA : cA + (size_t)(t + 2) * kstep; const char* b2 = last ? nB : cB + (size_t)(t + 2) * kstep;
            const char* a3 = a2 + kstep; const char* b3 = b2 + kstep;
            if (last && has_next) S.a_ready(nxt);
            if constexpr (SP2) {
            PG8_LDB(B0, 0, 0); PG8_LDB(B1, 0, 1); PG8_SCHED; PG8_LDA(At, 0, 0); PG8_STAGE(PG8_SA(1, 1), a1 + hstepA, voffA);
            PG8_WAIT_V(8); PG8_WAIT_L(0); PG8_BAR; PG8_MMA(0, 0, At, B0); PG8_MMA(0, 1, At, B1); PG8_BAR; PG8_SCHED;
            PG8_LDA(At, 0, 1); PG8_STAGE(PG8_SB(0, 0), b2, voffB); PG8_STAGE(PG8_SB(0, 1), b2 + hstepB, voffB); PG8_STAGE(PG8_SA(0, 0), a2, voffA);
            PG8_WAIT_V(8); PG8_WAIT_L(0); PG8_BAR; PG8_MMA(1, 0, At, B0); PG8_MMA(1, 1, At, B1); PG8_BAR; PG8_SCHED;
            PG8_LDB(B0, 1, 0); PG8_LDB(B1, 1, 1); PG8_SCHED; PG8_LDA(At, 1, 0); PG8_STAGE(PG8_SA(0, 1), a2 + hstepA, voffA);
            PG8_WAIT_V(8); PG8_WAIT_L(0); PG8_BAR; PG8_MMA(0, 0, At, B0); PG8_MMA(0, 1, At, B1); PG8_BAR; PG8_SCHED;
            PG8_LDA(At, 1, 1); PG8_STAGE(PG8_SB(1, 0), b3, voffB); PG8_STAGE(PG8_SB(1, 1), b3 + hstepB, voffB); PG8_STAGE(PG8_SA(1, 0), a3, voffA);
            PG8_WAIT_V(8); PG8_WAIT_L(0); PG8_BAR; PG8_MMA(1, 0, At, B0); PG8_MMA(1, 1, At, B1); PG8_BAR; PG8_SCHED;
            } else {
            PG8_LDB(B0, 0, 0); PG8_SCHED; PG8_LDA(At, 0, 0); PG8_STAGE(PG8_SA(1, 1), a1 + hstepA, voffA);
            PG8_WAIT_L(8); PG8_BAR; PG8_WAIT_L(0); PG8_MMA(0, 0, At, B0); PG8_BAR; PG8_SCHED;
            PG8_LDB(B1, 0, 1); PG8_STAGE(PG8_SB(0, 0), b2, voffB);
            PG8_BAR; PG8_WAIT_L(0); PG8_MMA(0, 1, At, B1); PG8_BAR;
            PG8_LDA(At, 0, 1); PG8_STAGE(PG8_SA(0, 0), a2, voffA);
            PG8_BAR; PG8_WAIT_L(0); PG8_MMA(1, 0, At, B0); PG8_BAR; PG8_SCHED;
            PG8_STAGE(PG8_SB(0, 1), b2 + hstepB, voffB);
            PG8_WAIT_V(6); PG8_BAR; PG8_MMA(1, 1, At, B1); PG8_BAR;
            PG8_LDB(B0, 1, 0); PG8_SCHED; PG8_LDA(At, 1, 0); PG8_STAGE(PG8_SA(0, 1), a2 + hstepA, voffA);
            PG8_WAIT_L(8); PG8_BAR; PG8_WAIT_L(0); PG8_MMA(0, 0, At, B0); PG8_BAR; PG8_SCHED;
            PG8_LDB(B1, 1, 1); PG8_STAGE(PG8_SB(1, 0), b3, voffB);
            PG8_BAR; PG8_WAIT_L(0); PG8_MMA(0, 1, At, B1); PG8_BAR;
            PG8_LDA(At, 1, 1); PG8_STAGE(PG8_SA(1, 0), a3, voffA);
            PG8_BAR; PG8_WAIT_L(0); PG8_MMA(1, 0, At, B0); PG8_BAR; PG8_SCHED;
            PG8_STAGE(PG8_SB(1, 1), b3 + hstepB, voffB);
            PG8_WAIT_V(6); PG8_BAR; PG8_MMA(1, 1, At, B1); PG8_BAR;
            }
        }
        if constexpr (ALIGN_EPI) { if (wr == 0) PG8_BAR; }
        if constexpr (!Epi::AFTER_DRAIN) { E(acc, cur, wr, wc, fr, fq); S.done(cur); }
        if (!has_next) break;
#pragma unroll
        for (int a = 0; a < 2; ++a)
#pragma unroll
            for (int b = 0; b < 2; ++b)
#pragma unroll
                for (int m = 0; m < 4; ++m)
#pragma unroll
                    for (int n = 0; n < 2; ++n) acc[a][b][m][n] = (f32x4){0.f, 0.f, 0.f, 0.f};
        cur = nxt; cA = nA; cB = nB; ++ui;
        if constexpr (ALIGN_EPI) { if (wr == 1) PG8_BAR; }
    }
    PG8_WAIT_V(0);
    if constexpr (!ALIGN_EPI) { if (wr == 0) PG8_BAR; }
    PG8_BAR;
    if constexpr (Epi::AFTER_DRAIN) { E.fused(acc, cur, wr, wc, fr, fq, lds, wid, lane); S.done(cur); }
#undef PG8_SA
#undef PG8_SB
#undef PG8_STAGE
#undef PG8_LDA
#undef PG8_LDB
#undef PG8_MMA
#undef PG8_WAIT_V
#undef PG8_WAIT_L
#undef PG8_BAR
#undef PG8_SCHED
}
}

#ifndef PROBE_REP_ATT
#define PROBE_REP_ATT 1
#endif
#ifndef PROBE_REP_UP
#define PROBE_REP_UP 1
#endif
#ifndef PROBE_XSYNC
#define PROBE_XSYNC 0
#endif
#ifndef PROBE_REP_MISC
#define PROBE_REP_MISC 1
#endif
#ifndef PROBE_REP_WIN
#define PROBE_REP_WIN 1
#endif
#ifndef PHM
#define PHM 127
#endif
#ifndef MK_SINGLE
#define MK_SINGLE 1
#endif
constexpr int DM = 2048, MP = 8192, M_ALL = 40960, SEQ_P = 4096, SEQ_S = 16384, INW = 5632, DFF = 8192, NLAYER = 2;
constexpr int OFF_AX = 0, OFF_AB = 512, OFF_AC = 1024, OFF_Q = 1536, OFF_K = 2560, OFF_V = 3584, OFF_CU = 4608, OFF_CV = 5120;
constexpr int MIX_A = 0, MIX_B = 512, MIX_C = 1536;
constexpr float EPS = 1e-6f;
constexpr float C2 = 0.18033688011112042f;
constexpr size_t MiB = 1u << 20;
constexpr int LDH = DFF + 128;
constexpr size_t WS_WT = 1 * MiB, WT_LAYER = 96 * MiB, WT_IN = 0, WT_OUT = 22 * MiB, WT_UP = 30 * MiB, WT_DN = 62 * MiB;
constexpr size_t WS_XN = 194 * MiB, WS_H = 356 * MiB, WS_PROJ = 356 * MiB, WS_MIX = 796 * MiB, WS_END = 1008 * MiB;
static_assert(WT_DN + (size_t)DM * LDH * 2 <= WT_LAYER && WS_WT + 2 * WT_LAYER <= WS_XN && WS_XN + (size_t)M_ALL * DM * 2 <= WS_H && WS_PROJ + (size_t)M_ALL * INW * 2 <= WS_MIX && WS_MIX + (size_t)M_ALL * DM * 2 <= WS_END && WS_H + (size_t)M_ALL * LDH * 2 <= WS_END, "ws map");
constexpr int NWAVES = 8, LDS_BYTES = 147456;

typedef unsigned short bf16;
typedef unsigned v4u __attribute__((ext_vector_type(4)));
typedef unsigned v2u __attribute__((ext_vector_type(2)));
typedef float f32x4 __attribute__((ext_vector_type(4)));
#define DI __device__ __forceinline__

DI unsigned pk2(float lo, float hi) { return pg8::cvt_pk_bf16(lo, hi); }
DI float bflo(unsigned u) { return __uint_as_float(u << 16); }
DI float bfhi(unsigned u) { return __uint_as_float(u & 0xffff0000u); }
DI float wave_sum(float v) {
#pragma unroll
    for (int o = 1; o < 64; o <<= 1) v += __shfl_xor(v, o);
    return v;
}
DI float wave_max(float v) {
#pragma unroll
    for (int o = 1; o < 64; o <<= 1) v = fmaxf(v, __shfl_xor(v, o));
    return v;
}
DI float gelu_tanh(float x) {
    const float z = x * (0.7978845608028654f + 0.035677408136300125f * x * x);
    const float e = __builtin_amdgcn_exp2f(-2.8853900817779268f * z);
    return x * __builtin_amdgcn_rcpf(1.0f + e);
}

DI void transpose_item(const float* W, int K, int N, bf16* WT, int ldt, const float* gain, float* scr, int item, int lane) {
    const int nblk = N / 32, kb = item / nblk, nb = item % nblk, k0 = 64 * kb, n0 = 32 * nb;
#pragma unroll 32
    for (int i = 0; i < 32; ++i) { const int kk = 2 * i + (lane >> 5); scr[kk * 33 + (lane & 31)] = W[(size_t)(k0 + kk) * N + n0 + (lane & 31)] * (gain ? gain[k0 + kk] : 1.0f); }
    asm volatile("s_waitcnt lgkmcnt(0)" ::: "memory");
    const int c = lane & 7;
#pragma unroll
    for (int j = 0; j < 4; ++j) { const int n = (lane >> 3) + 8 * j; const float* s = scr + (8 * c) * 33 + n;
        v4u o; o.x = pk2(s[0 * 33], s[1 * 33]); o.y = pk2(s[2 * 33], s[3 * 33]); o.z = pk2(s[4 * 33], s[5 * 33]); o.w = pk2(s[6 * 33], s[7 * 33]);
        *(v4u*)(WT + (size_t)(n0 + n) * ldt + k0 + 8 * c) = o; }
    asm volatile("s_waitcnt lgkmcnt(0)" ::: "memory");
}
DI void xb_row(const float* xrow, bf16* orow, float* ssp, int lane) {
    const f32x4* xr = (const f32x4*)xrow + lane;
    f32x4 v[8]; float s = 0.f;
#pragma unroll
    for (int j = 0; j < 8; ++j) { v[j] = xr[64 * j]; s += (v[j].x * v[j].x + v[j].y * v[j].y) + (v[j].z * v[j].z + v[j].w * v[j].w); }
    s = wave_sum(s);
    if (lane == 0) *ssp = s;
    v2u* o8 = (v2u*)orow + lane;
#pragma unroll
    for (int j = 0; j < 8; ++j) { v2u w; w.x = pk2(v[j].x, v[j].y); w.y = pk2(v[j].z, v[j].w); o8[64 * j] = w; }
}

__constant__ double ROPE_INV[8] = {1.0, 0.19392274474868576, 0.03760603093086393, 0.007292664737217109, 0.001414213562373095, 0.0002742481756762073, 5.318295896944988e-05, 1.031338537721246e-05};
DI void qk_row(bf16* P, int row, int pos, const float* qg, const float* kg, int lane) {
    bf16* p = P + (size_t)row * INW + OFF_Q + lane * 32;
    v4u raw[4];
#pragma unroll
    for (int i = 0; i < 4; ++i) raw[i] = *(const v4u*)(p + 8 * i);
    float x[32];
#pragma unroll
    for (int i = 0; i < 4; ++i) { x[8 * i + 0] = bflo(raw[i].x); x[8 * i + 1] = bfhi(raw[i].x); x[8 * i + 2] = bflo(raw[i].y); x[8 * i + 3] = bfhi(raw[i].y);
        x[8 * i + 4] = bflo(raw[i].z); x[8 * i + 5] = bfhi(raw[i].z); x[8 * i + 6] = bflo(raw[i].w); x[8 * i + 7] = bfhi(raw[i].w); }
    float ss = 0.f;
#pragma unroll
    for (int i = 0; i < 32; ++i) ss += x[i] * x[i];
    ss += __shfl_xor(ss, 1);
    const float rstd = 1.0f / sqrtf(ss * (1.f / 64.f) + EPS);
    const bool isq = lane < 32; const int half = lane & 1;
    const float* g = (isq ? qg : kg) + half * 32;
#pragma unroll
    for (int i = 0; i < 8; ++i) { const f32x4 gg = *(const f32x4*)(g + 4 * i); x[4 * i] *= rstd * gg.x; x[4 * i + 1] *= rstd * gg.y; x[4 * i + 2] *= rstd * gg.z; x[4 * i + 3] *= rstd * gg.w; }
    const double t = (double)pos * ROPE_INV[lane & 7] * 0.15915494309189535;
    const float fr = (float)(t - rint(t));
    const float cs = __builtin_amdgcn_cosf(fr), sn = __builtin_amdgcn_sinf(fr);
#pragma unroll
    for (int i = 0; i < 8; ++i) { const float c = __shfl(cs, i), s = __shfl(sn, i);
        if (half == 0) { const float a = x[i], b = x[i + 8]; x[i] = a * c - b * s; x[i + 8] = b * c + a * s; } }
    const float sc = isq ? C2 : 1.0f;
#pragma unroll
    for (int i = 0; i < 4; ++i) { v4u w; w.x = pk2(x[8 * i] * sc, x[8 * i + 1] * sc); w.y = pk2(x[8 * i + 2] * sc, x[8 * i + 3] * sc); w.z = pk2(x[8 * i + 4] * sc, x[8 * i + 5] * sc); w.w = pk2(x[8 * i + 6] * sc, x[8 * i + 7] * sc);
        *(v4u*)(p + 8 * i) = w; }
}
DI void unpack8(const v4u r, float* x) { x[0] = bflo(r.x); x[1] = bfhi(r.x); x[2] = bflo(r.y); x[3] = bfhi(r.y); x[4] = bflo(r.z); x[5] = bfhi(r.z); x[6] = bflo(r.w); x[7] = bfhi(r.w); }
DI void conv_row(const bf16* P, bf16* MIX, int row, int pos, int S, const float* cw, int lane) {
    const bf16* p = P + (size_t)row * INW + lane * 8;
    const v4u z4 = {0u, 0u, 0u, 0u};
    const v4u xa0 = *(const v4u*)(p + OFF_AX), gc0 = *(const v4u*)(p + OFF_AC), gb0 = *(const v4u*)(p + OFF_AB);
    const v4u xam = pos > 0 ? *(const v4u*)(p - INW + OFF_AX) : z4, gcm = pos > 0 ? *(const v4u*)(p - INW + OFF_AC) : z4;
    const v4u xap = pos < S - 1 ? *(const v4u*)(p + INW + OFF_AX) : z4, gcp = pos < S - 1 ? *(const v4u*)(p + INW + OFF_AC) : z4;
    float a0[8], c0[8], b0[8], am[8], cm[8], ap[8], cp[8];
    unpack8(xa0, a0); unpack8(gc0, c0); unpack8(gb0, b0); unpack8(xam, am); unpack8(gcm, cm); unpack8(xap, ap); unpack8(gcp, cp);
    float w0[8], w1[8], w2[8];
#pragma unroll
    for (int i = 0; i < 2; ++i) { const f32x4 a = *(const f32x4*)(cw + lane * 8 + 4 * i), b = *(const f32x4*)(cw + 512 + lane * 8 + 4 * i), c = *(const f32x4*)(cw + 1024 + lane * 8 + 4 * i);
        w0[4 * i] = a.x; w0[4 * i + 1] = a.y; w0[4 * i + 2] = a.z; w0[4 * i + 3] = a.w; w1[4 * i] = b.x; w1[4 * i + 1] = b.y; w1[4 * i + 2] = b.z; w1[4 * i + 3] = b.w;
        w2[4 * i] = c.x; w2[4 * i + 1] = c.y; w2[4 * i + 2] = c.z; w2[4 * i + 3] = c.w; }
    float o[8];
#pragma unroll
    for (int j = 0; j < 8; ++j) o[j] = b0[j] * (w0[j] * (cm[j] * am[j]) + w1[j] * (c0[j] * a0[j]) + w2[j] * (cp[j] * ap[j]));
    v4u w; w.x = pk2(o[0], o[1]); w.y = pk2(o[2], o[3]); w.z = pk2(o[4], o[5]); w.w = pk2(o[6], o[7]);
    *(v4u*)(MIX + (size_t)row * DM + MIX_A + lane * 8) = w;
}

namespace att {
using bf16x8 = __attribute__((ext_vector_type(8))) short;
using s16x4  = __attribute__((ext_vector_type(4))) short;
using f32x16 = __attribute__((ext_vector_type(16))) float;
using u32x4  = __attribute__((ext_vector_type(4))) unsigned;
constexpr int KVBLK = 64;
constexpr int SHM_V = 16384, SHM_K = 16384, SCR_OFF = 98304;
#define KSWZ(row, colB) ((row) * 256 + ((colB) ^ (((row) & 15) << 4)))
#define SBAR() __builtin_amdgcn_sched_barrier(0)
DI int crow(int r, int hi) { return (r & 3) + 8 * (r >> 2) + 4 * hi; }
DI unsigned cvtpk(float lo, float hi) { unsigned r; asm volatile("v_cvt_pk_bf16_f32 %0, %1, %2" : "=v"(r) : "v"(lo), "v"(hi)); return r; }
DI int v_st(int k, int c) { const int kk = (k & ~0xC) | ((k & 4) << 1) | ((k & 8) >> 1); return ((kk >> 3) * 4 + (c >> 5)) * 512 + ((kk & 7) * 32 + (c & 31)) * 2; }
DI int v_rd_base(int lane) { return ((lane & 3) << 3) | (((lane >> 2) & 3) << 6) | (((lane >> 4) & 1) << 5) | (((lane >> 5) & 1) << 8); }
constexpr int v_rd_off(int d0, int ks, int half) { return d0 * 512 + ks * 4096 + half * 2048; }
template <int OFF> DI s16x4 tr_read(int vb) { s16x4 r; asm volatile("ds_read_b64_tr_b16 %0, %1 offset:%2" : "=&v"(r) : "v"(vb), "i"(OFF) : "memory"); return r; }
template <int D0> DI void pv_one(f32x16& od, int vb, bf16x8 pa0, bf16x8 pa1, bf16x8 pa2, bf16x8 pa3) {
  const s16x4 l0 = tr_read<v_rd_off(D0, 0, 0)>(vb), h0 = tr_read<v_rd_off(D0, 0, 1)>(vb), l1 = tr_read<v_rd_off(D0, 1, 0)>(vb), h1 = tr_read<v_rd_off(D0, 1, 1)>(vb);
  const s16x4 l2 = tr_read<v_rd_off(D0, 2, 0)>(vb), h2 = tr_read<v_rd_off(D0, 2, 1)>(vb), l3 = tr_read<v_rd_off(D0, 3, 0)>(vb), h3 = tr_read<v_rd_off(D0, 3, 1)>(vb);
  asm volatile("s_waitcnt lgkmcnt(0)" ::: "memory"); SBAR();
#define PK(L, H) (bf16x8){L[0], L[1], L[2], L[3], H[0], H[1], H[2], H[3]}
  od = __builtin_amdgcn_mfma_f32_32x32x16_bf16(pa0, PK(l0, h0), od, 0, 0, 0);
  od = __builtin_amdgcn_mfma_f32_32x32x16_bf16(pa1, PK(l1, h1), od, 0, 0, 0);
  od = __builtin_amdgcn_mfma_f32_32x32x16_bf16(pa2, PK(l2, h2), od, 0, 0, 0);
  od = __builtin_amdgcn_mfma_f32_32x32x16_bf16(pa3, PK(l3, h3), od, 0, 0, 0);
#undef PK
}
DI void pv_d0(f32x16* o, int vb, bf16x8 pa0, bf16x8 pa1, bf16x8 pa2, bf16x8 pa3) {
  pv_one<0>(o[0], vb, pa0, pa1, pa2, pa3); pv_one<1>(o[1], vb, pa0, pa1, pa2, pa3); pv_one<2>(o[2], vb, pa0, pa1, pa2, pa3); pv_one<3>(o[3], vb, pa0, pa1, pa2, pa3);
}
template <bool SHIFT> DI void qkt(f32x16& p0, f32x16& p1, const char* Ks, const bf16x8* qr, int r32, int hi, int c, float negmb) {
  if constexpr (SHIFT) {
#pragma unroll
    for (int r = 0; r < 16; ++r) { p0[r] = negmb; p1[r] = negmb; }
  } else { p0 = f32x16{}; p1 = f32x16{}; }
#pragma unroll
  for (int d0 = 0; d0 < 4; ++d0) { const int cb = (c * 64 + d0 * 16 + hi * 8) * 2;
    const bf16x8 b0 = *reinterpret_cast<const bf16x8*>(Ks + KSWZ(r32, cb));
    const bf16x8 b1 = *reinterpret_cast<const bf16x8*>(Ks + KSWZ(32 + r32, cb));
    p0 = __builtin_amdgcn_mfma_f32_32x32x16_bf16(b0, qr[d0], p0, 0, 0, 0);
    p1 = __builtin_amdgcn_mfma_f32_32x32x16_bf16(b1, qr[d0], p1, 0, 0, 0); }
}
DI void expA(f32x16& p0) {
#pragma unroll
  for (int r = 0; r < 16; ++r) p0[r] = __builtin_amdgcn_exp2f(p0[r]);
}
DI void finishSM(f32x16& p0, f32x16& p1, float& l_reg, bf16x8& pa0, bf16x8& pa1, bf16x8& pa2, bf16x8& pa3) {
#pragma unroll
  for (int r = 0; r < 16; ++r) p1[r] = __builtin_amdgcn_exp2f(p1[r]);
  float ps = 0.f;
#pragma unroll
  for (int r = 0; r < 16; ++r) ps += p0[r];
#pragma unroll
  for (int r = 0; r < 16; ++r) ps += p1[r];
  l_reg += ps;
#define PK4(P, BASE, OUT) do { unsigned a0 = cvtpk(P[BASE + 0], P[BASE + 1]), a1 = cvtpk(P[BASE + 2], P[BASE + 3]);   \
    unsigned b0 = cvtpk(P[BASE + 4], P[BASE + 5]), b1 = cvtpk(P[BASE + 6], P[BASE + 7]);                              \
    auto r0 = __builtin_amdgcn_permlane32_swap(a0, b0, false, false); auto r1 = __builtin_amdgcn_permlane32_swap(a1, b1, false, false); \
    u32x4 w = {r0[0], r1[0], r0[1], r1[1]}; OUT = *reinterpret_cast<bf16x8*>(&w); } while (0)
  PK4(p0, 0, pa0); PK4(p0, 8, pa1); PK4(p1, 0, pa2); PK4(p1, 8, pa3);
#undef PK4
}
DI unsigned cvtpk2(float lo, float hi) { typedef float f2_t __attribute__((ext_vector_type(2))); typedef __bf16 b2_t __attribute__((ext_vector_type(2))); f2_t v = {lo, hi}; b2_t b = __builtin_convertvector(v, b2_t); return __builtin_bit_cast(unsigned, b); }
template <int I> DI void vrd(s16x4& l, s16x4& h, int vb) { constexpr int ks = I >> 2, d0 = I & 3; l = tr_read<v_rd_off(d0, ks, 0)>(vb); h = tr_read<v_rd_off(d0, ks, 1)>(vb); }
#define TIEWAIT(N, L, H) asm volatile("s_waitcnt lgkmcnt(" #N ")" : "+v"(L), "+v"(H))
#define PK4B(P, BASE, OUT) do { unsigned a0 = cvtpk2(P[BASE + 0], P[BASE + 1]), a1 = cvtpk2(P[BASE + 2], P[BASE + 3]);   \
    unsigned b0 = cvtpk2(P[BASE + 4], P[BASE + 5]), b1 = cvtpk2(P[BASE + 6], P[BASE + 7]);                              \
    auto r0 = __builtin_amdgcn_permlane32_swap(a0, b0, false, false); auto r1 = __builtin_amdgcn_permlane32_swap(a1, b1, false, false); \
    u32x4 w = {r0[0], r1[0], r0[1], r1[1]}; OUT = *reinterpret_cast<bf16x8*>(&w); } while (0)
#define PKV(L, H) (bf16x8){L[0], L[1], L[2], L[3], H[0], H[1], H[2], H[3]}
#define PVSTEP(i, N, PA, SL, SH, NL, NH) do { TIEWAIT(N, SL, SH); o[(i) & 3] = __builtin_amdgcn_mfma_f32_32x32x16_bf16(PA, PKV(SL, SH), o[(i) & 3], 0, 0, 0); \
    if constexpr ((i) + 3 < 16) vrd<((i) + 3 < 16 ? (i) + 3 : 15)>(NL, NH, vb); } while (0)
DI void finish_pv(f32x16& p0, f32x16& p1, float& l_reg, f32x16* o, int vb) {
  s16x4 l0, h0, l1, h1, l2, h2, l3, h3;
  vrd<0>(l0, h0, vb); vrd<1>(l1, h1, vb); vrd<2>(l2, h2, vb);
  bf16x8 pa0, pa1, pa2, pa3;
  PK4B(p0, 0, pa0); PK4B(p0, 8, pa1);
  PVSTEP(0, 4, pa0, l0, h0, l3, h3); PVSTEP(1, 4, pa0, l1, h1, l0, h0); PVSTEP(2, 4, pa0, l2, h2, l1, h1); PVSTEP(3, 4, pa0, l3, h3, l2, h2);
  PVSTEP(4, 4, pa1, l0, h0, l3, h3); PVSTEP(5, 4, pa1, l1, h1, l0, h0); PVSTEP(6, 4, pa1, l2, h2, l1, h1); PVSTEP(7, 4, pa1, l3, h3, l2, h2);
#pragma unroll
  for (int r = 0; r < 16; ++r) p1[r] = __builtin_amdgcn_exp2f(p1[r]);
  PK4B(p1, 0, pa2); PK4B(p1, 8, pa3);
  PVSTEP(8, 4, pa2, l0, h0, l3, h3); PVSTEP(9, 4, pa2, l1, h1, l0, h0); PVSTEP(10, 4, pa2, l2, h2, l1, h1); PVSTEP(11, 4, pa2, l3, h3, l2, h2);
  PVSTEP(12, 4, pa3, l0, h0, l3, h3); PVSTEP(13, 4, pa3, l1, h1, l0, h0); PVSTEP(14, 2, pa3, l2, h2, l1, h1); PVSTEP(15, 0, pa3, l3, h3, l2, h2);
  float ps = 0.f;
#pragma unroll
  for (int r = 0; r < 16; ++r) ps += p0[r];
#pragma unroll
  for (int r = 0; r < 16; ++r) ps += p1[r];
  l_reg += ps;
}
DI void glds16(const void* gsrc, unsigned lds_dst) { unsigned keep;
  asm volatile("s_mov_b32 %0, m0\n\ts_mov_b32 m0, %2\n\ts_nop 0\n\tglobal_load_lds_dwordx4 %1, off\n\ts_mov_b32 m0, %0" : "=&s"(keep) : "v"(gsrc), "s"(lds_dst) : "memory"); }
#define WAIT_BAR(N) asm volatile("s_waitcnt vmcnt(" #N ") lgkmcnt(0)\n\ts_barrier" ::: "memory")
template <bool SHIFT> DI void attn_unit(const bf16* __restrict__ Qb, const bf16* __restrict__ Kh, const bf16* __restrict__ Vh, bf16* __restrict__ Ob, int seq, char* lds,
                  float negmb, float lam, const float* __restrict__ gsub, float post) {
  int tid = threadIdx.x; asm volatile("" : "+v"(tid));
  const int lane = tid & 63, r32 = lane & 31, hi = lane >> 5; const int wid = __builtin_amdgcn_readfirstlane(tid >> 6), c = wid >> 2, wq = wid & 3;
  char* K_ring = lds; char* V_ring = lds + 3 * SHM_K;
  float* wsf = (float*)(lds + SCR_OFF) + wid * 64;
  const unsigned lds0 = (unsigned)(uintptr_t)lds;
  float l_reg = 0.f; f32x16 o[4] = {}; bf16x8 qr[4];
  const bf16* Qw = Qb + (size_t)(wq * 32 + r32) * INW + c * 64 + hi * 8;
#pragma unroll
  for (int d0 = 0; d0 < 4; ++d0) qr[d0] = *reinterpret_cast<const bf16x8*>(Qw + d0 * 16);
  const bf16* ksrc0; const bf16* ksrc1; const bf16* vsrc0; const bf16* vsrc1;
  { const int row0 = 8 * wid + (lane >> 4), row1 = row0 + 4, cp = lane & 15;
    ksrc0 = Kh + (size_t)row0 * INW + ((cp ^ (row0 & 15)) << 3); ksrc1 = Kh + (size_t)row1 * INW + ((cp ^ (row1 & 15)) << 3);
    const int kk = 8 * wid + ((lane & 31) >> 2), kkey = (kk & ~0xC) | ((kk & 4) << 1) | ((kk & 8) >> 1), cc = (lane >> 5) * 32 + (lane & 3) * 8;
    vsrc0 = Vh + (size_t)kkey * INW + cc; vsrc1 = vsrc0 + 64; }
  const unsigned kdst = lds0 + (unsigned)wid * 2048u, vdst = lds0 + 3u * SHM_K + (unsigned)wid * 2048u;
#define DMA_K(t, slot) do { const size_t to_ = (size_t)(t) * (KVBLK * INW); const unsigned d_ = (unsigned)__builtin_amdgcn_readfirstlane(kdst + (unsigned)(slot)); glds16(ksrc0 + to_, d_); glds16(ksrc1 + to_, d_ + 1024u); } while (0)
#define DMA_V(t, slot) do { const size_t to_ = (size_t)(t) * (KVBLK * INW); const unsigned d_ = (unsigned)__builtin_amdgcn_readfirstlane(vdst + (unsigned)(slot)); glds16(vsrc0 + to_, d_); glds16(vsrc1 + to_, d_ + 1024u); } while (0)
  const int vb0 = (int)(lds0 + 3u * SHM_K) + v_rd_base(lane);
  f32x16 pA0, pA1, pB0, pB1; const int NT = seq / KVBLK;
  int s0 = 0, s1 = SHM_K, s2 = 2 * SHM_K;
#define ROT() do { const int t_ = s0; s0 = s1; s1 = s2; s2 = t_; } while (0)
  DMA_K(0, 0); DMA_K(1, SHM_K); DMA_V(0, 0);
  WAIT_BAR(4);
  DMA_K(2, 2 * SHM_K); DMA_V(1, SHM_K);
  qkt<SHIFT>(pA0, pA1, K_ring, qr, r32, hi, c, negmb); expA(pA0);
#define ITER(CUR0, CUR1, PRV0, PRV1, j) do { \
    WAIT_BAR(4); \
    { const int tk_ = ((j) + 2 < NT) ? (j) + 2 : NT - 1, tv_ = ((j) + 1 < NT) ? (j) + 1 : NT - 1; DMA_K(tk_, s0); DMA_V(tv_, s2); } \
    SBAR(); qkt<SHIFT>(CUR0, CUR1, K_ring + s1, qr, r32, hi, c, negmb); \
    finish_pv(PRV0, PRV1, l_reg, o, vb0 + s0); expA(CUR0); \
    ROT(); } while (0)
  for (int j = 1; j + 1 < NT; j += 2) {
    ITER(pB0, pB1, pA0, pA1, j);
    ITER(pA0, pA1, pB0, pB1, j + 1);
  }
  ITER(pB0, pB1, pA0, pA1, NT - 1);
  WAIT_BAR(0);
  finish_pv(pB0, pB1, l_reg, o, vb0 + s0);
#undef ITER
#undef ROT
#undef DMA_K
#undef DMA_V
  int lane_e = lane; asm volatile("" : "+v"(lane_e));
  {
  const int lane = lane_e, r32 = lane & 31, hi = lane >> 5;
  { auto rr = __builtin_amdgcn_permlane32_swap(__float_as_uint(l_reg), __float_as_uint(l_reg), false, false); l_reg = __uint_as_float(rr[0]) + __uint_as_float(rr[1]); }
  if (hi == 0) wsf[r32] = l_reg;
  asm volatile("s_waitcnt lgkmcnt(0)" ::: "memory");
  __syncthreads();
  float* X = (float*)lds + wq * 4096;
  if (c == 1) {
#pragma unroll
    for (int r = 0; r < 16; ++r) { const float rl = __builtin_amdgcn_rcpf(wsf[crow(r, hi)]);
#pragma unroll
      for (int d0 = 0; d0 < 4; ++d0) X[(d0 * 16 + r) * 64 + lane] = o[d0][r] * rl; }
  }
  __syncthreads();
  if (c == 0) {
    float g4[4];
#pragma unroll
    for (int d0 = 0; d0 < 4; ++d0) g4[d0] = gsub[32 * d0 + r32] * post;
#pragma unroll
    for (int r = 0; r < 16; ++r) { const float rl = __builtin_amdgcn_rcpf(wsf[crow(r, hi)]); float dv[4]; float s = 0.f;
#pragma unroll
      for (int d0 = 0; d0 < 4; ++d0) { dv[d0] = o[d0][r] * rl - lam * X[(d0 * 16 + r) * 64 + lane]; s += dv[d0] * dv[d0]; }
#pragma unroll
      for (int off = 1; off < 32; off <<= 1) s += __shfl_xor(s, off);
      const float rs = 1.0f / sqrtf(s * (1.f / 128.f) + EPS); bf16* orow = Ob + (size_t)(wq * 32 + crow(r, hi)) * DM + r32;
#pragma unroll
      for (int d0 = 0; d0 < 4; ++d0) orow[32 * d0] = (bf16)(pk2(dv[d0] * rs * g4[d0], 0.f) & 0xffffu); }
  }
  }
  __syncthreads();
}
#undef SBAR
}

DI void sgu_unit(const bf16* P, bf16* MIX, int chunk, int hd, const float* Ws, const float* bs, const float* gv, char* lds) {
    using att::bf16x8; using att::f32x16;
    int tid = threadIdx.x; asm volatile("" : "+v"(tid));
    const int wid = tid >> 6, lane = tid & 63, r32 = lane & 31, hi = lane >> 5;
    bf16* vnT = (bf16*)lds;
    { const int p = tid >> 2, qtr = tid & 3; const bf16* src = P + (size_t)(chunk * 128 + p) * INW + OFF_CV + hd * 128 + qtr * 32;
      v4u raw[4];
#pragma unroll
      for (int i = 0; i < 4; ++i) raw[i] = *(const v4u*)(src + 8 * i);
      float x[32];
#pragma unroll
      for (int i = 0; i < 4; ++i) unpack8(raw[i], x + 8 * i);
      float ss = 0.f;
#pragma unroll
      for (int i = 0; i < 32; ++i) { x[i] = gelu_tanh(x[i]); ss += x[i] * x[i]; }
      ss += __shfl_xor(ss, 1); ss += __shfl_xor(ss, 2);
      const float rstd = 1.0f / sqrtf(ss * (1.f / 128.f) + EPS);
#pragma unroll
      for (int i = 0; i < 32; ++i) { const float v = x[i] * rstd * gv[qtr * 32 + i]; vnT[(qtr * 32 + i) * 136 + p] = (bf16)(pk2(v, 0.f) & 0xffffu); }
    }
    __syncthreads();
    const int qb = wid >> 1;
    bf16x8 a[8];
#pragma unroll
    for (int ks = 0; ks < 8; ++ks) { const float* w = Ws + (size_t)(32 * qb + r32) * 128 + 16 * ks + 8 * hi; const f32x4 w0 = *(const f32x4*)w, w1 = *(const f32x4*)(w + 4);
        att::u32x4 u = {pk2(w0.x, w0.y), pk2(w0.z, w0.w), pk2(w1.x, w1.y), pk2(w1.z, w1.w)}; a[ks] = *reinterpret_cast<bf16x8*>(&u); }
#pragma unroll
    for (int dd = 0; dd < 2; ++dd) { const int db = 2 * (wid & 1) + dd;
        f32x16 acc = {};
#pragma unroll
        for (int ks = 0; ks < 8; ++ks) { const bf16x8 b = *reinterpret_cast<const bf16x8*>(vnT + (32 * db + r32) * 136 + 16 * ks + 8 * hi);
            acc = __builtin_amdgcn_mfma_f32_32x32x16_bf16(a[ks], b, acc, 0, 0, 0); }
        const int d = 32 * db + r32;
#pragma unroll
        for (int i = 0; i < 16; ++i) { const int q = 32 * qb + att::crow(i, hi); const size_t tok = (size_t)chunk * 128 + q;
            const float uval = gelu_tanh(__uint_as_float((unsigned)P[tok * INW + OFF_CU + hd * 128 + d] << 16));
            MIX[tok * DM + MIX_C + hd * 128 + d] = (bf16)(pk2(uval * (acc[i] + bs[q]), 0.f) & 0xffffu); }
    }
    __syncthreads();
}

#define LAS __attribute__((address_space(3)))
#define XB_TMO      128
#define XB_XCNT(j)  (256  + 64 * (j))
#define XB_XSUB(j)  (1280 + 64 * (j))
#define XB_XGEN(j)  (2304 + 64 * (j))
#define XB_TOP      3328
#define XB_TOPGEN   3392
#define XCD_BAR_WORDS 3456
#define XB_SPIN_CAP (1u << 18)

__device__ __forceinline__ unsigned xb_ld(unsigned* p)              { return __hip_atomic_load(p, __ATOMIC_RELAXED, __HIP_MEMORY_SCOPE_AGENT); }
__device__ __forceinline__ unsigned xb_add(unsigned* p, unsigned v) { return __hip_atomic_fetch_add(p, v, __ATOMIC_RELAXED, __HIP_MEMORY_SCOPE_AGENT); }
__device__ __forceinline__ unsigned xb_xcc_id() { return (unsigned)__builtin_amdgcn_s_getreg((3 << 11) | 20) & 0xFu; }
#define XB_SPIN(cond, bar) do { unsigned _sp = 0; while (cond) { __builtin_amdgcn_s_sleep(1); \
    if ((++_sp & 255u) == 0u) { if (xb_ld(&(bar)[XB_TMO])) break; if (_sp > XB_SPIN_CAP) { atomicAdd(&(bar)[XB_TMO], 1u); break; } } } } while (0)

struct XcdBarrier {
    unsigned* bar; unsigned x;
    volatile LAS unsigned* st;
};

__device__ __forceinline__ XcdBarrier xcd_barrier_post(unsigned* bar, volatile LAS unsigned* st) {
    XcdBarrier b; b.bar = bar; b.x = xb_xcc_id(); b.st = st;
    if (threadIdx.x == 0) (void)xb_add(&bar[XB_XCNT(b.x)], 1u);
    return b;
}
__device__ __forceinline__ void xcd_barrier_complete(unsigned* bar, unsigned x, unsigned& nloc, unsigned& nx) {
    const unsigned G = gridDim.x * gridDim.y * gridDim.z;
    unsigned sum, cnt, mine, sp = 0u;
    for (;;) {
        sum = 0u; cnt = 0u; mine = 0u;
#pragma unroll
        for (unsigned j = 0; j < 16; ++j) { const unsigned c = xb_ld(&bar[XB_XCNT(j)]); sum += c; cnt += (c > 0u) ? 1u : 0u; mine = (j == x) ? c : mine; }
        if (sum == G) break;
        __builtin_amdgcn_s_sleep(1);
        if ((++sp & 255u) == 0u) { if (xb_ld(&bar[XB_TMO])) break; if (sp > XB_SPIN_CAP) { atomicAdd(&bar[XB_TMO], 1u); break; } }
    }
    nloc = mine > 0u ? mine : 1u; nx = cnt > 0u ? cnt : 1u;
}

__device__ __forceinline__ void xcd_barrier(const XcdBarrier& b) {
    asm volatile("s_waitcnt vmcnt(0)" ::: "memory");
    __syncthreads();
    if (threadIdx.x == 0) {
        unsigned* bar = b.bar;
        __builtin_amdgcn_s_waitcnt(0);
        unsigned nloc = b.st[0], nx = b.st[1];
        if (nloc == 0u) { xcd_barrier_complete(bar, b.x, nloc, nx); b.st[0] = nloc; b.st[1] = nx; }
        const unsigned old = xb_add(&bar[XB_XSUB(b.x)], 1u);
        const unsigned gen = old / nloc;
        if (old + 1u == (gen + 1u) * nloc) {
            __builtin_amdgcn_fence(__ATOMIC_RELEASE, "agent");
            asm volatile("s_waitcnt vmcnt(0)" ::: "memory");
            const unsigned og = xb_add(&bar[XB_TOP], 1u);
            const unsigned tg = og / nx;
            if (og + 1u == (tg + 1u) * nx) xb_add(&bar[XB_TOPGEN], 1u);
            else XB_SPIN(xb_ld(&bar[XB_TOPGEN]) == tg, bar);
            __builtin_amdgcn_fence(__ATOMIC_ACQUIRE, "agent");
            xb_add(&bar[XB_XGEN(b.x)], 1u);
            asm volatile("s_waitcnt vmcnt(0)" ::: "memory");
        } else {
            XB_SPIN(xb_ld(&bar[XB_XGEN(b.x)]) == gen, bar);
            __builtin_amdgcn_fence(__ATOMIC_ACQUIRE, "agent");
            asm volatile("s_waitcnt vmcnt(0)" ::: "memory");
        }
    }
    __syncthreads();
}

struct Args { const float* in[19]; float* out; unsigned char* ws; int ph_lo, ph_hi; };
constexpr int N_PHASES = 1 + 6 * NLAYER;

__global__ void __launch_bounds__(NWAVES * 64, 2) mk_fwd(Args args) {
    extern __shared__ __attribute__((aligned(16))) unsigned char lds[];
    cg::grid_group grid = cg::this_grid();
    const int G = gridDim.x; const int bx = blockIdx.x; const int vcu = (G % 8 == 0) ? (bx % 8) * (G / 8) + bx / 8 : bx;
    const int NGW = G * NWAVES;
    unsigned char* ws = args.ws;
    const float* xp = args.in[0]; const float* xs = args.in[1];
    float* out = args.out;
    bf16* XN = (bf16*)(ws + WS_XN); bf16* PROJ = (bf16*)(ws + WS_PROJ); bf16* MIX = (bf16*)(ws + WS_MIX); bf16* HB = (bf16*)(ws + WS_H);

    volatile LAS unsigned* MISC = (volatile LAS unsigned*)((LAS unsigned char*)lds + 131072 + 320);
    if (threadIdx.x < 32) MISC[threadIdx.x] = 0u;
    __syncthreads();
    const XcdBarrier bar = xcd_barrier_post((unsigned*)ws, MISC + 8);
    for (int ph = args.ph_lo; ph < args.ph_hi; ++ph) {
        int tid = threadIdx.x; asm volatile("" : "+v"(tid));
        const int lane = tid & 63, wave = __builtin_amdgcn_readfirstlane(tid >> 6), gw = vcu * NWAVES + wave;
        const int l = (ph - 1) / 6, k = (ph == 0) ? -1 : ((ph - 1) % 6);
        float* const RS = (float*)(ws + 65536);
        const unsigned char* wl = ws + WS_WT + (size_t)(l < 0 ? 0 : l) * WT_LAYER;
        if (ph == 0) {
#if PHM & 1
            for (int rep = 0; rep < PROBE_REP_MISC; ++rep) {
            float* scr = (float*)(lds + wave * 16384);
            constexpr int I_IN = 32 * 176, I_OUT = 32 * 64, I_UP = 32 * 256, I_DN = 128 * 64, I_L = I_IN + I_OUT + I_UP + I_DN;
            for (int it = gw; it < NLAYER * I_L; it += NGW) {
                const int ll = it / I_L; int r = it % I_L; unsigned char* wb = ws + WS_WT + (size_t)ll * WT_LAYER;
                if (r < I_IN) { transpose_item(args.in[3] + (size_t)ll * DM * INW, DM, INW, (bf16*)(wb + WT_IN), DM, args.in[2] + ll * DM, scr, r, lane); continue; } r -= I_IN;
                if (r < I_OUT) { transpose_item(args.in[15] + (size_t)ll * DM * DM, DM, DM, (bf16*)(wb + WT_OUT), DM, nullptr, scr, r, lane); continue; } r -= I_OUT;
                if (r < I_UP) { transpose_item(args.in[17] + (size_t)ll * DM * DFF, DM, DFF, (bf16*)(wb + WT_UP), DM, args.in[16] + ll * DM, scr, r, lane); continue; } r -= I_UP;
                transpose_item(args.in[18] + (size_t)ll * DFF * DM, DFF, DM, (bf16*)(wb + WT_DN), LDH, nullptr, scr, r, lane);
            }
            for (int m = gw; m < M_ALL; m += NGW) xb_row(m < MP ? xp + (size_t)m * DM : xs + (size_t)(m - MP) * DM, XN + (size_t)m * DM, RS + m, lane);
            for (int i = gw * 64 + lane; i < 3 * M_ALL; i += NGW * 64) RS[M_ALL + i] = 0.f;
            }
#endif
        } else if (k == 0) {
#if PHM & 2
            pg8::Gemm g{XN, (const bf16*)(wl + WT_IN), M_ALL, INW, DM, DM, DM}; pg8::StaticOrder S; S.init(M_ALL, INW, G, bx);
            pg8::EpiBf16<0> E{PROJ, INW, RS + (size_t)(2 * l) * M_ALL};
            for (int rep = 0; rep < PROBE_REP_WIN; ++rep)
            pg8::gemm_phase<pg8::EpiBf16<0>, pg8::StaticOrder, true, true>((PG8_LAS unsigned char*)lds, g, S, E);
#endif
        } else if (k == 1) {
#if PHM & 4
            const float* qg = args.in[5] + l * 64; const float* kg = args.in[6] + l * 64; const float* cw = args.in[4] + l * 1536;
            for (int m = gw; m < M_ALL; m += NGW) {
                const int pos = m < MP ? (m & (SEQ_P - 1)) : ((m - MP) & (SEQ_S - 1)); const int S = m < MP ? SEQ_P : SEQ_S;
                qk_row(PROJ, m, pos, qg, kg, lane);
                conv_row(PROJ, MIX, m, pos, S, cw, lane);
            }
            for (int u = vcu; u < (M_ALL / 128) * 4; u += G) { const int chunk = u >> 2, hd = u & 3;
                sgu_unit(PROJ, MIX, chunk, hd, args.in[13] + ((size_t)l * 4 + hd) * 128 * 128, args.in[14] + (l * 4 + hd) * 128, args.in[12] + l * 128, (char*)lds); }
#endif
        } else if (k == 2) {
#if PHM & 8
            const float linit = (l == 0) ? 0.2f : 0.35550906759096934f;
            const float s1 = wave_sum(args.in[7][l * 64 + lane] * args.in[8][l * 64 + lane]), s2 = wave_sum(args.in[9][l * 64 + lane] * args.in[10][l * 64 + lane]);
            const float lam = __uint_as_float(__builtin_amdgcn_readfirstlane(__float_as_uint(expf(s1) - expf(s2) + linit)));
            const float gq = wave_max(fabsf(args.in[5][l * 64 + lane])), gk = wave_max(fabsf(args.in[6][l * 64 + lane]));
            const float negmb = __uint_as_float(__builtin_amdgcn_readfirstlane(__float_as_uint(-(C2 * 64.0f * gq * gk))));
            for (int rep = 0; rep < PROBE_REP_ATT; ++rep)
            for (int t = vcu; t < 2560; t += G) {
                int pair, qb, seq, seqrow0;
                if (t < 2048) { const int i = t >> 8, v = t & 255; const int idx = (v >> 5) * 256 + i * 32 + (v & 31); pair = idx >> 7; qb = idx & 127; seq = SEQ_S; seqrow0 = MP + (pair >> 3) * SEQ_S; }
                else { const int t2 = t - 2048, i = t2 >> 8, v = t2 & 255; pair = 2 * (v >> 5) + i; qb = v & 31; seq = SEQ_P; seqrow0 = (pair >> 3) * SEQ_P; }
                const int h = pair & 7; const size_t row0 = (size_t)seqrow0 + (size_t)qb * 128;
                if (negmb >= -64.0f)
                att::attn_unit<false>(PROJ + row0 * INW + OFF_Q + h * 128, PROJ + (size_t)seqrow0 * INW + OFF_K + h * 128, PROJ + (size_t)seqrow0 * INW + OFF_V + h * 128,
                               MIX + row0 * DM + MIX_B + h * 128, seq, (char*)lds, 0.f, lam, args.in[11] + l * 128, 1.0f - linit);
                else
                att::attn_unit<true>(PROJ + row0 * INW + OFF_Q + h * 128, PROJ + (size_t)seqrow0 * INW + OFF_K + h * 128, PROJ + (size_t)seqrow0 * INW + OFF_V + h * 128,
                               MIX + row0 * DM + MIX_B + h * 128, seq, (char*)lds, negmb, lam, args.in[11] + l * 128, 1.0f - linit);
            }
#endif
        } else if (k == 3 || k == 5) {
#if PHM & 16
            pg8::Gemm g; if (k == 3) g = pg8::Gemm{MIX, (const bf16*)(wl + WT_OUT), M_ALL, DM, DM, DM, DM}; else g = pg8::Gemm{HB, (const bf16*)(wl + WT_DN), M_ALL, DM, DFF, LDH, LDH};
            pg8::StaticOrder S; S.init(M_ALL, DM, G, bx);
            pg8::EpiResF32 E;
            if (k == 3 && l == 0) E = pg8::EpiResF32{xp, xs, MP / 256, out, DM, XN, DM, RS + (size_t)1 * M_ALL};
            else if (k == 3) E = pg8::EpiResF32{out, out, 0, out, DM, XN, DM, RS + (size_t)3 * M_ALL};
            else if (l == 0) E = pg8::EpiResF32{out, out, 0, out, DM, XN, DM, RS + (size_t)2 * M_ALL};
            else E = pg8::EpiResF32{out, out, 0, out, DM, nullptr, 0, nullptr};
            pg8::gemm_phase<pg8::EpiResF32, pg8::StaticOrder, true, true>((PG8_LAS unsigned char*)lds, g, S, E);
#endif
        } else {
#if PHM & 64
            pg8::Gemm g{XN, (const bf16*)(wl + WT_UP), M_ALL, DFF, DM, DM, DM}; pg8::StaticOrder S; S.init(M_ALL, DFF, G, bx);
            pg8::EpiBf16<2> E{HB, LDH, RS + (size_t)(2 * l + 1) * M_ALL};
            for (int rep = 0; rep < PROBE_REP_UP; ++rep)
            pg8::gemm_phase<pg8::EpiBf16<2>, pg8::StaticOrder, true, true>((PG8_LAS unsigned char*)lds, g, S, E);
#endif
        }
        if (ph + 1 < args.ph_hi) { if (ph == args.ph_lo) grid.sync(); else xcd_barrier(bar); }
    }
}

extern "C" void kernel_launch(void* const* d_in, const int* in_sizes, int n_in, void* d_out, int out_size, void* d_ws, size_t ws_size, hipStream_t stream) {
    static int grid = 0;
    if (grid == 0) {
        if (n_in != 19 || out_size != M_ALL * DM || ws_size < WS_END) { fprintf(stderr, "kernel_launch: unexpected shapes: n_in %d out %d ws %zu (need %zu)\n", n_in, out_size, ws_size, (size_t)WS_END); grid = -1; return; }
        int dev = 0, cus = 0, per_cu = 0;
        if (hipGetDevice(&dev) != hipSuccess || hipDeviceGetAttribute(&cus, hipDeviceAttributeMultiprocessorCount, dev) != hipSuccess) { fprintf(stderr, "kernel_launch: device query failed\n"); grid = -1; return; }
        if (hipFuncSetAttribute((const void*)mk_fwd, hipFuncAttributeMaxDynamicSharedMemorySize, LDS_BYTES) != hipSuccess) { fprintf(stderr, "kernel_launch: hipFuncSetAttribute failed\n"); grid = -1; return; }
        if (hipOccupancyMaxActiveBlocksPerMultiprocessor(&per_cu, (const void*)mk_fwd, NWAVES * 64, LDS_BYTES) != hipSuccess || per_cu < 1) { fprintf(stderr, "kernel_launch: occupancy query gave %d\n", per_cu); per_cu = 1; }
        (void)hipGetLastError();
        grid = cus * 1;
        fprintf(stderr, "kernel_launch: grid %d (cus %d, per_cu %d)\n", grid, cus, per_cu);
    }
    if (grid < 0) return;
    if (hipMemsetAsync(d_ws, 0, 65536, stream) != hipSuccess) { fprintf(stderr, "kernel_launch: memset failed\n"); return; }
    Args a{};
    for (int i = 0; i < 19; ++i) a.in[i] = (const float*)d_in[i];
    a.out = (float*)d_out; a.ws = (unsigned char*)d_ws;
#if MK_SINGLE
    a.ph_lo = 0; a.ph_hi = N_PHASES;
    { void* kargs[] = {&a}; hipError_t e = hipLaunchCooperativeKernel((const void*)mk_fwd, dim3(grid), dim3(NWAVES * 64), kargs, LDS_BYTES, stream);
      if (e != hipSuccess) fprintf(stderr, "kernel_launch: cooperative launch failed: %s\n", hipGetErrorString(e)); }
#else
    for (int ph = 0; ph < N_PHASES; ++ph) { a.ph_lo = ph; a.ph_hi = ph + 1; void* kargs[] = {&a};
        hipError_t e = hipLaunchCooperativeKernel((const void*)mk_fwd, dim3(grid), dim3(NWAVES * 64), kargs, LDS_BYTES, stream);
        if (e != hipSuccess) { fprintf(stderr, "kernel_launch: cooperative launch %d failed: %s\n", ph, hipGetErrorString(e)); break; } }
#endif
}
```

```cpp
#include <hip/hip_runtime.h>
#include <hip/hip_cooperative_groups.h>
#include <hip/hip_bf16.h>
#include <cstdio>
#include <cstdint>
namespace cg = cooperative_groups;
namespace pg8 {
#define PG8_LAS __attribute__((address_space(3)))
typedef unsigned short bf16_t;
typedef short bf16x8 __attribute__((ext_vector_type(8)));
typedef float f32x4 __attribute__((ext_vector_type(4)));
typedef unsigned u32x4 __attribute__((ext_vector_type(4)));
constexpr int BM = 256, BK = 64, HALF = 128, HTB = HALF * BK * 2  , STAGE_BYTES = 8 * HTB, NXCD = 8, WGM = 8;

__host__ __device__ __forceinline__ int lds_byte(int r, int c) { const int st = (r >> 4) * 2 + (c >> 5), rr = r & 15, cc = c & 31, ob = rr * 64 + cc * 2; return st * 1024 + (ob ^ (((ob >> 9) & 1) << 5)); }
__host__ __device__ __forceinline__ void stage_rc(int b, int& R, int& C) { const int st = b / 1024, sb = b % 1024, swz = sb ^ (((sb >> 9) & 1) << 5); R = (st >> 1) * 16 + swz / 64; C = (st & 1) * 32 + (swz % 64) / 2; }
__host__ __device__ __forceinline__ int perm32(int rho) { const int n = rho >> 4, i = rho & 15; return 8 * (i >> 2) + 4 * n + (i & 3); }

struct Unit { int pm, pn; };
struct Gemm { const bf16_t* A; const bf16_t* Bt; int M, N, K, lda, ldb; };

struct StaticOrder {
    int nM, nN, nwg, G, c;
    __host__ __device__ void init(int M, int N, int G_, int c_) { nM = M / BM; nN = N / BM; nwg = nM * nN; G = G_; c = c_; }
    __host__ __device__ bool next(int i, Unit& u) const {
        const long L = (long)i * G + c; if (L >= nwg) return false;
        int wgid = (int)L; { const int q = nwg / NXCD, r = nwg % NXCD, xcd = wgid % NXCD, off = wgid / NXCD; wgid = (xcd < r ? xcd * (q + 1) : r * (q + 1) + (xcd - r) * q) + off; }
        const int nig = WGM * nN, gid = wgid / nig, fm = gid * WGM, gsz = (nM - fm) < WGM ? (nM - fm) : WGM;
        u.pm = fm + ((wgid % nig) % gsz); u.pn = (wgid % nig) / gsz; return true;
    }
    __device__ __forceinline__ void a_ready(const Unit&) const {}
    __device__ __forceinline__ void done(const Unit&) const {}
};

__device__ __forceinline__ unsigned cvt_pk_bf16(float lo, float hi) { unsigned r; asm volatile("v_cvt_pk_bf16_f32 %0, %1, %2" : "=v"(r) : "v"(lo), "v"(hi)); return r; }
typedef float f32x2 __attribute__((ext_vector_type(2)));
typedef unsigned u32x2 __attribute__((ext_vector_type(2)));
template <int ACT> struct EpiBf16 {
    static constexpr bool PERM = true, AFTER_DRAIN = false;
    bf16_t* O; int ldc; const float* rowss;
    __device__ __forceinline__ void operator()(const f32x4 (&acc)[2][2][4][2], const Unit& u, int wr, int wc, int fr, int fq) const {
        const int row0 = u.pm * BM + wr * 64 + fr; const int col0 = u.pn * BM + wc * 32 + 8 * fq;
        float rs[2][4];
#pragma unroll
        for (int ai = 0; ai < 2; ++ai)
#pragma unroll
            for (int m = 0; m < 4; ++m) rs[ai][m] = rowss[row0 + ai * HALF + m * 16];
#pragma unroll
        for (int ai = 0; ai < 2; ++ai)
#pragma unroll
            for (int m = 0; m < 4; ++m) { bf16_t* rowp = O + (size_t)(row0 + ai * HALF + m * 16) * ldc + col0;
                const float sc = 1.0f / sqrtf(rs[ai][m] * (1.0f / 2048.0f) + 1e-6f);
#pragma unroll
                for (int bj = 0; bj < 2; ++bj) { f32x4 v0 = acc[ai][bj][m][0] * sc, v1 = acc[ai][bj][m][1] * sc;
                    if (ACT == 2) {
#pragma unroll
                        for (int e = 0; e < 4; ++e) { float a = fmaxf(v0[e], 0.f), b = fmaxf(v1[e], 0.f); v0[e] = a * a; v1[e] = b * b; } }
                    u32x4 w; w.x = cvt_pk_bf16(v0[0], v0[1]); w.y = cvt_pk_bf16(v0[2], v0[3]); w.z = cvt_pk_bf16(v1[0], v1[1]); w.w = cvt_pk_bf16(v1[2], v1[3]);
                    *(u32x4*)(rowp + bj * HALF) = w; } }
    }
};
struct EpiResF32 {
    static constexpr bool PERM = true, AFTER_DRAIN = false;
    const float* res_lo; const float* res_hi; int split_pm; float* out; int ldc; bf16_t* xb; int ldx; float* rowss;
    __device__ __forceinline__ void operator()(const f32x4 (&acc)[2][2][4][2], const Unit& u, int wr, int wc, int fr, int fq) const {
        const float* rbase = (u.pm < split_pm) ? res_lo : (res_hi - (size_t)split_pm * BM * ldc);
        const int col0 = u.pn * BM + wc * 32 + 8 * fq;
#pragma unroll
        for (int ai = 0; ai < 2; ++ai)
#pragma unroll
            for (int m = 0; m < 4; ++m) { const int row = u.pm * BM + ai * HALF + wr * 64 + m * 16 + fr; const size_t off = (size_t)row * ldc + col0; float ss = 0.f;
#pragma unroll
                for (int bj = 0; bj < 2; ++bj) {
                    const f32x4 v0 = *(const f32x4*)(rbase + off + bj * HALF) + acc[ai][bj][m][0], v1 = *(const f32x4*)(rbase + off + bj * HALF + 4) + acc[ai][bj][m][1];
                    *(f32x4*)(out + off + bj * HALF) = v0; *(f32x4*)(out + off + bj * HALF + 4) = v1;
                    if (xb) { u32x4 w; w.x = cvt_pk_bf16(v0[0], v0[1]); w.y = cvt_pk_bf16(v0[2], v0[3]); w.z = cvt_pk_bf16(v1[0], v1[1]); w.w = cvt_pk_bf16(v1[2], v1[3]);
                        *(u32x4*)(xb + (size_t)row * ldx + col0 + bj * HALF) = w;
                        ss += (v0[0] * v0[0] + v0[1] * v0[1]) + (v0[2] * v0[2] + v0[3] * v0[3]) + (v1[0] * v1[0] + v1[1] * v1[1]) + (v1[2] * v1[2] + v1[3] * v1[3]); } }
                if (xb) { ss += __shfl_xor(ss, 16); ss += __shfl_xor(ss, 32);
                    if (fq == 0) __hip_atomic_fetch_add(rowss + row, ss, __ATOMIC_RELAXED, __HIP_MEMORY_SCOPE_AGENT); }
                if (m == 3) asm volatile("" ::: "memory"); }
    }
};
template <class Epi, class Sched, bool ALIGN_EPI = false, bool SP2 = false>
__device__ __forceinline__ void gemm_phase(PG8_LAS unsigned char* lds, const Gemm g, const Sched& S, const Epi& E) {
    int tid = threadIdx.x; asm volatile("" : "+v"(tid));
    const int wid = __builtin_amdgcn_readfirstlane(tid >> 6), lane = tid & 63, wr = wid >> 2, wc = wid & 3, fr = lane & 15, fq = lane >> 4;
    const int K = g.K, nt = K / BK;
    unsigned voffA[2], voffB[2];
#pragma unroll
    for (int i = 0; i < 2; ++i) { int R, C; stage_rc(tid * 16 + i * 8192, R, C); const int Rb = Epi::PERM ? ((R & ~31) + perm32(R & 31)) : R;
        voffA[i] = (unsigned)(R * g.lda + C) * 2u; voffB[i] = (unsigned)(Rb * g.ldb + C) * 2u; }
    const size_t kstep = (size_t)(BK * 2);
    const size_t hstepA = (size_t)HALF * g.lda * 2, hstepB = (size_t)HALF * g.ldb * 2;
    const size_t tstepA = 2 * hstepA, tstepB = 2 * hstepB;
    const unsigned ldsw = (unsigned)wid * 1024u;
    const int aoff = lds_byte(wr * 64 + fr, fq * 8), boff = lds_byte(wc * 32 + fr, fq * 8);
#define PG8_SA(b, h) (((b) * 2 + (h)) * HTB)
#define PG8_SB(b, h) ((4 + (b) * 2 + (h)) * HTB)
#define PG8_STAGE(bufoff, gbase, voff) do { _Pragma("unroll") for (int _i = 0; _i < 2; ++_i) \
        __builtin_amdgcn_global_load_lds((const unsigned*)((const char*)(gbase) + (voff)[_i]), (PG8_LAS unsigned*)(lds + (bufoff) + ldsw + _i * 8192), 16, 0, 0); } while (0)
#define PG8_LDA(dst, b, h) do { _Pragma("unroll") for (int m = 0; m < 4; ++m) _Pragma("unroll") for (int k = 0; k < 2; ++k) dst[m][k] = *(const PG8_LAS bf16x8*)(lds + PG8_SA(b, h) + aoff + m * 2048 + k * 1024); } while (0)
#define PG8_LDB(dst, b, h) do { _Pragma("unroll") for (int n = 0; n < 2; ++n) _Pragma("unroll") for (int k = 0; k < 2; ++k) dst[n][k] = *(const PG8_LAS bf16x8*)(lds + PG8_SB(b, h) + boff + n * 2048 + k * 1024); } while (0)
#define PG8_MMA(ai, bj, At, Bt) do { __builtin_amdgcn_s_setprio(1); _Pragma("unroll") for (int m = 0; m < 4; ++m) _Pragma("unroll") for (int n = 0; n < 2; ++n) _Pragma("unroll") for (int k = 0; k < 2; ++k) \
        acc[ai][bj][m][n] = __builtin_amdgcn_mfma_f32_16x16x32_bf16(Bt[n][k], At[m][k], acc[ai][bj][m][n], 0, 0, 0); __builtin_amdgcn_s_setprio(0); } while (0)
#define PG8_WAIT_V(n) asm volatile("s_waitcnt vmcnt(" #n ")" ::: "memory")
#define PG8_WAIT_L(n) asm volatile("s_waitcnt lgkmcnt(" #n ")" ::: "memory")
#define PG8_BAR __builtin_amdgcn_s_barrier()
#define PG8_SCHED __builtin_amdgcn_sched_barrier(0)
    Unit cur, nxt; int ui = 0;
    if (!S.next(0, cur)) return;
    f32x4 acc[2][2][4][2];
#pragma unroll
    for (int a = 0; a < 2; ++a)
#pragma unroll
        for (int b = 0; b < 2; ++b)
#pragma unroll
            for (int m = 0; m < 4; ++m)
#pragma unroll
                for (int n = 0; n < 2; ++n) acc[a][b][m][n] = (f32x4){0.f, 0.f, 0.f, 0.f};
    bf16x8 At[4][2], B0[2][2], B1[2][2];
    const char* cA = (const char*)g.A + (size_t)cur.pm * tstepA; const char* cB = (const char*)g.Bt + (size_t)cur.pn * tstepB;
    S.a_ready(cur);
    if constexpr (SP2) {
        PG8_STAGE(PG8_SB(0, 0), cB, voffB); PG8_STAGE(PG8_SB(0, 1), cB + hstepB, voffB); PG8_STAGE(PG8_SA(0, 0), cA, voffA); PG8_STAGE(PG8_SA(0, 1), cA + hstepA, voffA);
        if (wr == 1) PG8_BAR;
        PG8_WAIT_V(2); PG8_BAR;
        PG8_STAGE(PG8_SB(1, 0), cB + kstep, voffB); PG8_STAGE(PG8_SA(1, 0), cA + kstep, voffA); PG8_STAGE(PG8_SB(1, 1), cB + hstepB + kstep, voffB);
        PG8_WAIT_V(6); PG8_BAR;
    } else {
        PG8_STAGE(PG8_SB(0, 0), cB, voffB); PG8_STAGE(PG8_SA(0, 0), cA, voffA); PG8_STAGE(PG8_SB(0, 1), cB + hstepB, voffB); PG8_STAGE(PG8_SA(0, 1), cA + hstepA, voffA);
        if (wr == 1) PG8_BAR;
        PG8_WAIT_V(4); PG8_BAR;
        PG8_STAGE(PG8_SB(1, 0), cB + kstep, voffB); PG8_STAGE(PG8_SA(1, 0), cA + kstep, voffA); PG8_STAGE(PG8_SB(1, 1), cB + hstepB + kstep, voffB);
        PG8_WAIT_V(6); PG8_BAR;
    }
    for (;;) {
        const bool has_next = S.next(ui + 1, nxt);
        const char* nA = has_next ? (const char*)g.A + (size_t)nxt.pm * tstepA : cA; const char* nB = has_next ? (const char*)g.Bt + (size_t)nxt.pn * tstepB : cB;
        for (int t = 0; t < nt; t += 2) {
            const bool last = (t == nt - 2);
            const char* a1 = cA + (size_t)(t + 1) * kstep;
            const char* a2 = last ? nA : cA + (size_t)(t + 2) * kstep; const char* b2 = last ? nB : cB + (size_t)(t + 2) * kstep;
            const char* a3 = a2 + kstep; const char* b3 = b2 + kstep;
            if (last && has_next) S.a_ready(nxt);
            if constexpr (SP2) {
            PG8_LDB(B0, 0, 0); PG8_LDB(B1, 0, 1); PG8_SCHED; PG8_LDA(At, 0, 0); PG8_STAGE(PG8_SA(1, 1), a1 + hstepA, voffA);
            PG8_WAIT_V(8); PG8_WAIT_L(0); PG8_BAR; PG8_MMA(0, 0, At, B0); PG8_MMA(0, 1, At, B1); PG8_BAR; PG8_SCHED;
            PG8_LDA(At, 0, 1); PG8_STAGE(PG8_SB(0, 0), b2, voffB); PG8_STAGE(PG8_SB(0, 1), b2 + hstepB, voffB); PG8_STAGE(PG8_SA(0, 0), a2, voffA);
            PG8_WAIT_V(8); PG8_WAIT_L(0); PG8_BAR; PG8_MMA(1, 0, At, B0); PG8_MMA(1, 1, At, B1); PG8_BAR; PG8_SCHED;
            PG8_LDB(B0, 1, 0); PG8_LDB(B1, 1, 1); PG8_SCHED; PG8_LDA(At, 1, 0); PG8_STAGE(PG8_SA(0, 1), a2 + hstepA, voffA);
            PG8_WAIT_V(8); PG8_WAIT_L(0); PG8_BAR; PG8_MMA(0, 0, At, B0); PG8_MMA(0, 1, At, B1); PG8_BAR; PG8_SCHED;
            PG8_LDA(At, 1, 1); PG8_STAGE(PG8_SB(1, 0), b3, voffB); PG8_STAGE(PG8_SB(1, 1), b3 + hstepB, voffB); PG8_STAGE(PG8_SA(1, 0), a3, voffA);
            PG8_WAIT_V(8); PG8_WAIT_L(0); PG8_BAR; PG8_MMA(1, 0, At, B0); PG8_MMA(1, 1, At, B1); PG8_BAR; PG8_SCHED;
            } else {
            PG8_LDB(B0, 0, 0); PG8_SCHED; PG8_LDA(At, 0, 0); PG8_STAGE(PG8_SA(1, 1), a1 + hstepA, voffA);
            PG8_WAIT_L(8); PG8_BAR; PG8_WAIT_L(0); PG8_MMA(0, 0, At, B0); PG8_BAR; PG8_SCHED;
            PG8_LDB(B1, 0, 1); PG8_STAGE(PG8_SB(0, 0), b2, voffB);
            PG8_BAR; PG8_WAIT_L(0); PG8_MMA(0, 1, At, B1); PG8_BAR;
            PG8_LDA(At, 0, 1); PG8_STAGE(PG8_SA(0, 0), a2, voffA);
            PG8_BAR; PG8_WAIT_L(0); PG8_MMA(1, 0, At, B0); PG8_BAR; PG8_SCHED;
            PG8_STAGE(PG8_SB(0, 1), b2 + hstepB, voffB);
            PG8_WAIT_V(6); PG8_BAR; PG8_MMA(1, 1, At, B1); PG8_BAR;
            PG8_LDB(B0, 1, 0); PG8_SCHED; PG8_LDA(At, 1, 0); PG8_STAGE(PG8_SA(0, 1), a2 + hstepA, voffA);
            PG8_WAIT_L(8); PG8_BAR; PG8_WAIT_L(0); PG8_MMA(0, 0, At, B0); PG8_BAR; PG8_SCHED;
            PG8_LDB(B1, 1, 1); PG8_STAGE(PG8_SB(1, 0), b3, voffB);
            PG8_BAR; PG8_WAIT_L(0); PG8_MMA(0, 1, At, B1); PG8_BAR;
            PG8_LDA(At, 1, 1); PG8_STAGE(PG8_SA(1, 0), a3, voffA);
            PG8_BAR; PG8_WAIT_L(0); PG8_MMA(1, 0, At, B0); PG8_BAR; PG8_SCHED;
            PG8_STAGE(PG8_SB(1, 1), b3 + hstepB, voffB);
            PG8_WAIT_V(6); PG8_BAR; PG8_MMA(1, 1, At, B1); PG8_BAR;
            }
        }
        if constexpr (ALIGN_EPI) { if (wr == 0) PG8_BAR; }
        if constexpr (!Epi::AFTER_DRAIN) { E(acc, cur, wr, wc, fr, fq); S.done(cur); }
        if (!has_next) break;
#pragma unroll
        for (int a = 0; a < 2; ++a)
#pragma unroll
            for (int b = 0; b < 2; ++b)
#pragma unroll
                for (int m = 0; m < 4; ++m)
#pragma unroll
                    for (int n = 0; n < 2; ++n) acc[a][b][m][n] = (f32x4){0.f, 0.f, 0.f, 0.f};
        cur = nxt; cA = nA; cB = nB; ++ui;
        if constexpr (ALIGN_EPI) { if (wr == 1) PG8_BAR; }
    }
    PG8_WAIT_V(0);
    if constexpr (!ALIGN_EPI) { if (wr == 0) PG8_BAR; }
    PG8_BAR;
    if constexpr (Epi::AFTER_DRAIN) { E.fused(acc, cur, wr, wc, fr, fq, lds, wid, lane); S.done(cur); }
#undef PG8_SA
#undef PG8_SB
#undef PG8_STAGE
#undef PG8_LDA
#undef PG8_LDB
#undef PG8_MMA
#undef PG8_WAIT_V
#undef PG8_WAIT_L
#undef PG8_BAR
#undef PG8_SCHED
}
}

#ifndef PROBE_REP_ATT
#define PROBE_REP_ATT 1
#endif
#ifndef PROBE_REP_UP
#define PROBE_REP_UP 1
#endif
#ifndef PROBE_XSYNC
#define PROBE_XSYNC 0
#endif
#ifndef PROBE_REP_MISC
#define PROBE_REP_MISC 1
#endif
#ifndef PROBE_REP_WIN
#define PROBE_REP_WIN 1
#endif
#ifndef PHM
#define PHM 127
#endif
#ifndef MK_SINGLE
#define MK_SINGLE 1
#endif
constexpr int DM = 2048, MP = 8192, M_ALL = 40960, SEQ_P = 4096, SEQ_S = 16384, INW = 5632, DFF = 8192, NLAYER = 2;
constexpr int OFF_AX = 0, OFF_AB = 512, OFF_AC = 1024, OFF_Q = 1536, OFF_K = 2560, OFF_V = 3584, OFF_CU = 4608, OFF_CV = 5120;
constexpr int MIX_A = 0, MIX_B = 512, MIX_C = 1536;
constexpr float EPS = 1e-6f;
constexpr float C2 = 0.18033688011112042f;
constexpr size_t MiB = 1u << 20;
constexpr int LDH = DFF + 128;
constexpr size_t WS_WT = 1 * MiB, WT_LAYER = 96 * MiB, WT_IN = 0, WT_OUT = 22 * MiB, WT_UP = 30 * MiB, WT_DN = 62 * MiB;
constexpr size_t WS_XN = 194 * MiB, WS_H = 356 * MiB, WS_PROJ = 356 * MiB, WS_MIX = 796 * MiB, WS_END = 1008 * MiB;
static_assert(WT_DN + (size_t)DM * LDH * 2 <= WT_LAYER && WS_WT + 2 * WT_LAYER <= WS_XN && WS_XN + (size_t)M_ALL * DM * 2 <= WS_H && WS_PROJ + (size_t)M_ALL * INW * 2 <= WS_MIX && WS_MIX + (size_t)M_ALL * DM * 2 <= WS_END && WS_H + (size_t)M_ALL * LDH * 2 <= WS_END, "ws map");
constexpr int NWAVES = 8, LDS_BYTES = 147456;

typedef unsigned short bf16;
typedef unsigned v4u __attribute__((ext_vector_type(4)));
typedef unsigned v2u __attribute__((ext_vector_type(2)));
typedef float f32x4 __attribute__((ext_vector_type(4)));
#define DI __device__ __forceinline__

DI unsigned pk2(float lo, float hi) { return pg8::cvt_pk_bf16(lo, hi); }
DI float bflo(unsigned u) { return __uint_as_float(u << 16); }
DI float bfhi(unsigned u) { return __uint_as_float(u & 0xffff0000u); }
DI float wave_sum(float v) {
#pragma unroll
    for (int o = 1; o < 64; o <<= 1) v += __shfl_xor(v, o);
    return v;
}
DI float wave_max(float v) {
#pragma unroll
    for (int o = 1; o < 64; o <<= 1) v = fmaxf(v, __shfl_xor(v, o));
    return v;
}
DI float gelu_tanh(float x) {
    const float z = x * (0.7978845608028654f + 0.035677408136300125f * x * x);
    const float e = __builtin_amdgcn_exp2f(-2.8853900817779268f * z);
    return x * __builtin_amdgcn_rcpf(1.0f + e);
}

DI void transpose_item(const float* W, int K, int N, bf16* WT, int ldt, const float* gain, float* scr, int item, int lane) {
    const int nblk = N / 32, kb = item / nblk, nb = item % nblk, k0 = 64 * kb, n0 = 32 * nb;
#pragma unroll 32
    for (int i = 0; i < 32; ++i) { const int kk = 2 * i + (lane >> 5); scr[kk * 33 + (lane & 31)] = W[(size_t)(k0 + kk) * N + n0 + (lane & 31)] * (gain ? gain[k0 + kk] : 1.0f); }
    asm volatile("s_waitcnt lgkmcnt(0)" ::: "memory");
    const int c = lane & 7;
#pragma unroll
    for (int j = 0; j < 4; ++j) { const int n = (lane >> 3) + 8 * j; const float* s = scr + (8 * c) * 33 + n;
        v4u o; o.x = pk2(s[0 * 33], s[1 * 33]); o.y = pk2(s[2 * 33], s[3 * 33]); o.z = pk2(s[4 * 33], s[5 * 33]); o.w = pk2(s[6 * 33], s[7 * 33]);
        *(v4u*)(WT + (size_t)(n0 + n) * ldt + k0 + 8 * c) = o; }
    asm volatile("s_waitcnt lgkmcnt(0)" ::: "memory");
}
DI void xb_row(const float* xrow, bf16* orow, float* ssp, int lane) {
    const f32x4* xr = (const f32x4*)xrow + lane;
    f32x4 v[8]; float s = 0.f;
#pragma unroll
    for (int j = 0; j < 8; ++j) { v[j] = xr[64 * j]; s += (v[j].x * v[j].x + v[j].y * v[j].y) + (v[j].z * v[j].z + v[j].w * v[j].w); }
    s = wave_sum(s);
    if (lane == 0) *ssp = s;
    v2u* o8 = (v2u*)orow + lane;
#pragma unroll
    for (int j = 0; j < 8; ++j) { v2u w; w.x = pk2(v[j].x, v[j].y); w.y = pk2(v[j].z, v[j].w); o8[64 * j] = w; }
}

__constant__ double ROPE_INV[8] = {1.0, 0.19392274474868576, 0.03760603093086393, 0.007292664737217109, 0.001414213562373095, 0.0002742481756762073, 5.318295896944988e-05, 1.031338537721246e-05};
DI void qk_row(bf16* P, int row, int pos, const float* qg, const float* kg, int lane) {
    bf16* p = P + (size_t)row * INW + OFF_Q + lane * 32;
    v4u raw[4];
#pragma unroll
    for (int i = 0; i < 4; ++i) raw[i] = *(const v4u*)(p + 8 * i);
    float x[32];
#pragma unroll
    for (int i = 0; i < 4; ++i) { x[8 * i + 0] = bflo(raw[i].x); x[8 * i + 1] = bfhi(raw[i].x); x[8 * i + 2] = bflo(raw[i].y); x[8 * i + 3] = bfhi(raw[i].y);
        x[8 * i + 4] = bflo(raw[i].z); x[8 * i + 5] = bfhi(raw[i].z); x[8 * i + 6] = bflo(raw[i].w); x[8 * i + 7] = bfhi(raw[i].w); }
    float ss = 0.f;
#pragma unroll
    for (int i = 0; i < 32; ++i) ss += x[i] * x[i];
    ss += __shfl_xor(ss, 1);
    const float rstd = 1.0f / sqrtf(ss * (1.f / 64.f) + EPS);
    const bool isq = lane < 32; const int half = lane & 1;
    const float* g = (isq ? qg : kg) + half * 32;
#pragma unroll
    for (int i = 0; i < 8; ++i) { const f32x4 gg = *(const f32x4*)(g + 4 * i); x[4 * i] *= rstd * gg.x; x[4 * i + 1] *= rstd * gg.y; x[4 * i + 2] *= rstd * gg.z; x[4 * i + 3] *= rstd * gg.w; }
    const double t = (double)pos * ROPE_INV[lane & 7] * 0.15915494309189535;
    const float fr = (float)(t - rint(t));
    const float cs = __builtin_amdgcn_cosf(fr), sn = __builtin_amdgcn_sinf(fr);
#pragma unroll
    for (int i = 0; i < 8; ++i) { const float c = __shfl(cs, i), s = __shfl(sn, i);
        if (half == 0) { const float a = x[i], b = x[i + 8]; x[i] = a * c - b * s; x[i + 8] = b * c + a * s; } }
    const float sc = isq ? C2 : 1.0f;
#pragma unroll
    for (int i = 0; i < 4; ++i) { v4u w; w.x = pk2(x[8 * i] * sc, x[8 * i + 1] * sc); w.y = pk2(x[8 * i + 2] * sc, x[8 * i + 3] * sc); w.z = pk2(x[8 * i + 4] * sc, x[8 * i + 5] * sc); w.w = pk2(x[8 * i + 6] * sc, x[8 * i + 7] * sc);
        *(v4u*)(p + 8 * i) = w; }
}
DI void unpack8(const v4u r, float* x) { x[0] = bflo(r.x); x[1] = bfhi(r.x); x[2] = bflo(r.y); x[3] = bfhi(r.y); x[4] = bflo(r.z); x[5] = bfhi(r.z); x[6] = bflo(r.w); x[7] = bfhi(r.w); }
DI void conv_row(const bf16* P, bf16* MIX, int row, int pos, int S, const float* cw, int lane) {
    const bf16* p = P + (size_t)row * INW + lane * 8;
    const v4u z4 = {0u, 0u, 0u, 0u};
    const v4u xa0 = *(const v4u*)(p + OFF_AX), gc0 = *(const v4u*)(p + OFF_AC), gb0 = *(const v4u*)(p + OFF_AB);
    const v4u xam = pos > 0 ? *(const v4u*)(p - INW + OFF_AX) : z4, gcm = pos > 0 ? *(const v4u*)(p - INW + OFF_AC) : z4;
    const v4u xap = pos < S - 1 ? *(const v4u*)(p + INW + OFF_AX) : z4, gcp = pos < S - 1 ? *(const v4u*)(p + INW + OFF_AC) : z4;
    float a0[8], c0[8], b0[8], am[8], cm[8], ap[8], cp[8];
    unpack8(xa0, a0); unpack8(gc0, c0); unpack8(gb0, b0); unpack8(xam, am); unpack8(gcm, cm); unpack8(xap, ap); unpack8(gcp, cp);
    float w0[8], w1[8], w2[8];
#pragma unroll
    for (int i = 0; i < 2; ++i) { const f32x4 a = *(const f32x4*)(cw + lane * 8 + 4 * i), b = *(const f32x4*)(cw + 512 + lane * 8 + 4 * i), c = *(const f32x4*)(cw + 1024 + lane * 8 + 4 * i);
        w0[4 * i] = a.x; w0[4 * i + 1] = a.y; w0[4 * i + 2] = a.z; w0[4 * i + 3] = a.w; w1[4 * i] = b.x; w1[4 * i + 1] = b.y; w1[4 * i + 2] = b.z; w1[4 * i + 3] = b.w;
        w2[4 * i] = c.x; w2[4 * i + 1] = c.y; w2[4 * i + 2] = c.z; w2[4 * i + 3] = c.w; }
    float o[8];
#pragma unroll
    for (int j = 0; j < 8; ++j) o[j] = b0[j] * (w0[j] * (cm[j] * am[j]) + w1[j] * (c0[j] * a0[j]) + w2[j] * (cp[j] * ap[j]));
    v4u w; w.x = pk2(o[0], o[1]); w.y = pk2(o[2], o[3]); w.z = pk2(o[4], o[5]); w.w = pk2(o[6], o[7]);
    *(v4u*)(MIX + (size_t)row * DM + MIX_A + lane * 8) = w;
}

namespace att {
using bf16x8 = __attribute__((ext_vector_type(8))) short;
using s16x4  = __attribute__((ext_vector_type(4))) short;
using f32x16 = __attribute__((ext_vector_type(16))) float;
using u32x4  = __attribute__((ext_vector_type(4))) unsigned;
constexpr int KVBLK = 64;
constexpr int SHM_V = 16384, SHM_K = 16384, SCR_OFF = 98304;
#define KSWZ(row, colB) ((row) * 256 + ((colB) ^ (((row) & 15) << 4)))
#define SBAR() __builtin_amdgcn_sched_barrier(0)
DI int crow(int r, int hi) { return (r & 3) + 8 * (r >> 2) + 4 * hi; }
DI unsigned cvtpk(float lo, float hi) { unsigned r; asm volatile("v_cvt_pk_bf16_f32 %0, %1, %2" : "=v"(r) : "v"(lo), "v"(hi)); return r; }
DI int v_st(int k, int c) { const int kk = (k & ~0xC) | ((k & 4) << 1) | ((k & 8) >> 1); return ((kk >> 3) * 4 + (c >> 5)) * 512 + ((kk & 7) * 32 + (c & 31)) * 2; }
DI int v_rd_base(int lane) { return ((lane & 3) << 3) | (((lane >> 2) & 3) << 6) | (((lane >> 4) & 1) << 5) | (((lane >> 5) & 1) << 8); }
constexpr int v_rd_off(int d0, int ks, int half) { return d0 * 512 + ks * 4096 + half * 2048; }
template <int OFF> DI s16x4 tr_read(int vb) { s16x4 r; asm volatile("ds_read_b64_tr_b16 %0, %1 offset:%2" : "=&v"(r) : "v"(vb), "i"(OFF) : "memory"); return r; }
template <int D0> DI void pv_one(f32x16& od, int vb, bf16x8 pa0, bf16x8 pa1, bf16x8 pa2, bf16x8 pa3) {
  const s16x4 l0 = tr_read<v_rd_off(D0, 0, 0)>(vb), h0 = tr_read<v_rd_off(D0, 0, 1)>(vb), l1 = tr_read<v_rd_off(D0, 1, 0)>(vb), h1 = tr_read<v_rd_off(D0, 1, 1)>(vb);
  const s16x4 l2 = tr_read<v_rd_off(D0, 2, 0)>(vb), h2 = tr_read<v_rd_off(D0, 2, 1)>(vb), l3 = tr_read<v_rd_off(D0, 3, 0)>(vb), h3 = tr_read<v_rd_off(D0, 3, 1)>(vb);
  asm volatile("s_waitcnt lgkmcnt(0)" ::: "memory"); SBAR();
#define PK(L, H) (bf16x8){L[0], L[1], L[2], L[3], H[0], H[1], H[2], H[3]}
  od = __builtin_amdgcn_mfma_f32_32x32x16_bf16(pa0, PK(l0, h0), od, 0, 0, 0);
  od = __builtin_amdgcn_mfma_f32_32x32x16_bf16(pa1, PK(l1, h1), od, 0, 0, 0);
  od = __builtin_amdgcn_mfma_f32_32x32x16_bf16(pa2, PK(l2, h2), od, 0, 0, 0);
  od = __builtin_amdgcn_mfma_f32_32x32x16_bf16(pa3, PK(l3, h3), od, 0, 0, 0);
#undef PK
}
DI void pv_d0(f32x16* o, int vb, bf16x8 pa0, bf16x8 pa1, bf16x8 pa2, bf16x8 pa3) {
  pv_one<0>(o[0], vb, pa0, pa1, pa2, pa3); pv_one<1>(o[1], vb, pa0, pa1, pa2, pa3); pv_one<2>(o[2], vb, pa0, pa1, pa2, pa3); pv_one<3>(o[3], vb, pa0, pa1, pa2, pa3);
}
template <bool SHIFT> DI void qkt(f32x16& p0, f32x16& p1, const char* Ks, const bf16x8* qr, int r32, int hi, int c, float negmb) {
  if constexpr (SHIFT) {
#pragma unroll
    for (int r = 0; r < 16; ++r) { p0[r] = negmb; p1[r] = negmb; }
  } else { p0 = f32x16{}; p1 = f32x16{}; }
#pragma unroll
  for (int d0 = 0; d0 < 4; ++d0) { const int cb = (c * 64 + d0 * 16 + hi * 8) * 2;
    const bf16x8 b0 = *reinterpret_cast<const bf16x8*>(Ks + KSWZ(r32, cb));
    const bf16x8 b1 = *reinterpret_cast<const bf16x8*>(Ks + KSWZ(32 + r32, cb));
    p0 = __builtin_amdgcn_mfma_f32_32x32x16_bf16(b0, qr[d0], p0, 0, 0, 0);
    p1 = __builtin_amdgcn_mfma_f32_32x32x16_bf16(b1, qr[d0], p1, 0, 0, 0); }
}
DI void expA(f32x16& p0) {
#pragma unroll
  for (int r = 0; r < 16; ++r) p0[r] = __builtin_amdgcn_exp2f(p0[r]);
}
DI void finishSM(f32x16& p0, f32x16& p1, float& l_reg, bf16x8& pa0, bf16x8& pa1, bf16x8& pa2, bf16x8& pa3) {
#pragma unroll
  for (int r = 0; r < 16; ++r) p1[r] = __builtin_amdgcn_exp2f(p1[r]);
  float ps = 0.f;
#pragma unroll
  for (int r = 0; r < 16; ++r) ps += p0[r];
#pragma unroll
  for (int r = 0; r < 16; ++r) ps += p1[r];
  l_reg += ps;
#define PK4(P, BASE, OUT) do { unsigned a0 = cvtpk(P[BASE + 0], P[BASE + 1]), a1 = cvtpk(P[BASE + 2], P[BASE + 3]);   \
    unsigned b0 = cvtpk(P[BASE + 4], P[BASE + 5]), b1 = cvtpk(P[BASE + 6], P[BASE + 7]);                              \
    auto r0 = __builtin_amdgcn_permlane32_swap(a0, b0, false, false); auto r1 = __builtin_amdgcn_permlane32_swap(a1, b1, false, false); \
    u32x4 w = {r0[0], r1[0], r0[1], r1[1]}; OUT = *reinterpret_cast<bf16x8*>(&w); } while (0)
  PK4(p0, 0, pa0); PK4(p0, 8, pa1); PK4(p1, 0, pa2); PK4(p1, 8, pa3);
#undef PK4
}
DI unsigned cvtpk2(float lo, float hi) { typedef float f2_t __attribute__((ext_vector_type(2))); typedef __bf16 b2_t __attribute__((ext_vector_type(2))); f2_t v = {lo, hi}; b2_t b = __builtin_convertvector(v, b2_t); return __builtin_bit_cast(unsigned, b); }
template <int I> DI void vrd(s16x4& l, s16x4& h, int vb) { constexpr int ks = I >> 2, d0 = I & 3; l = tr_read<v_rd_off(d0, ks, 0)>(vb); h = tr_read<v_rd_off(d0, ks, 1)>(vb); }
#define TIEWAIT(N, L, H) asm volatile("s_waitcnt lgkmcnt(" #N ")" : "+v"(L), "+v"(H))
#define PK4B(P, BASE, OUT) do { unsigned a0 = cvtpk2(P[BASE + 0], P[BASE + 1]), a1 = cvtpk2(P[BASE + 2], P[BASE + 3]);   \
    unsigned b0 = cvtpk2(P[BASE + 4], P[BASE + 5]), b1 = cvtpk2(P[BASE + 6], P[BASE + 7]);                              \
    auto r0 = __builtin_amdgcn_permlane32_swap(a0, b0, false, false); auto r1 = __builtin_amdgcn_permlane32_swap(a1, b1, false, false); \
    u32x4 w = {r0[0], r1[0], r0[1], r1[1]}; OUT = *reinterpret_cast<bf16x8*>(&w); } while (0)
#define PKV(L, H) (bf16x8){L[0], L[1], L[2], L[3], H[0], H[1], H[2], H[3]}
#define PVSTEP(i, N, PA, SL, SH, NL, NH) do { TIEWAIT(N, SL, SH); o[(i) & 3] = __builtin_amdgcn_mfma_f32_32x32x16_bf16(PA, PKV(SL, SH), o[(i) & 3], 0, 0, 0); \
    if constexpr ((i) + 3 < 16) vrd<((i) + 3 < 16 ? (i) + 3 : 15)>(NL, NH, vb); } while (0)
DI void finish_pv(f32x16& p0, f32x16& p1, float& l_reg, f32x16* o, int vb) {
  s16x4 l0, h0, l1, h1, l2, h2, l3, h3;
  vrd<0>(l0, h0, vb); vrd<1>(l1, h1, vb); vrd<2>(l2, h2, vb);
  bf16x8 pa0, pa1, pa2, pa3;
  PK4B(p0, 0, pa0); PK4B(p0, 8, pa1);
  PVSTEP(0, 4, pa0, l0, h0, l3, h3); PVSTEP(1, 4, pa0, l1, h1, l0, h0); PVSTEP(2, 4, pa0, l2, h2, l1, h1); PVSTEP(3, 4, pa0, l3, h3, l2, h2);
  PVSTEP(4, 4, pa1, l0, h0, l3, h3); PVSTEP(5, 4, pa1, l1, h1, l0, h0); PVSTEP(6, 4, pa1, l2, h2, l1, h1); PVSTEP(7, 4, pa1, l3, h3, l2, h2);
  PK4B(p1, 0, pa2); PK4B(p1, 8, pa3);
  PVSTEP(8, 4, pa2, l0, h0, l3, h3); PVSTEP(9, 4, pa2, l1, h1, l0, h0); PVSTEP(10, 4, pa2, l2, h2, l1, h1); PVSTEP(11, 4, pa2, l3, h3, l2, h2);
  PVSTEP(12, 4, pa3, l0, h0, l3, h3); PVSTEP(13, 4, pa3, l1, h1, l0, h0); PVSTEP(14, 2, pa3, l2, h2, l1, h1); PVSTEP(15, 0, pa3, l3, h3, l2, h2);
  float ps = 0.f;
#pragma unroll
  for (int r = 0; r < 16; ++r) ps += p0[r];
#pragma unroll
  for (int r = 0; r < 16; ++r) ps += p1[r];
  l_reg += ps;
}
DI void glds16(const void* gsrc, unsigned lds_dst) { unsigned keep;
  asm volatile("s_mov_b32 %0, m0\n\ts_mov_b32 m0, %2\n\ts_nop 0\n\tglobal_load_lds_dwordx4 %1, off\n\ts_mov_b32 m0, %0" : "=&s"(keep) : "v"(gsrc), "s"(lds_dst) : "memory"); }
#define WAIT_BAR(N) asm volatile("s_waitcnt vmcnt(" #N ") lgkmcnt(0)\n\ts_barrier" ::: "memory")
template <bool SHIFT> DI void attn_unit(const bf16* __restrict__ Qb, const bf16* __restrict__ Kh, const bf16* __restrict__ Vh, bf16* __restrict__ Ob, int seq, char* lds,
                  float negmb, float lam, const float* __restrict__ gsub, float post) {
  int tid = threadIdx.x; asm volatile("" : "+v"(tid));
  const int lane = tid & 63, r32 = lane & 31, hi = lane >> 5; const int wid = __builtin_amdgcn_readfirstlane(tid >> 6), c = wid >> 2, wq = wid & 3;
  char* K_ring = lds; char* V_ring = lds + 3 * SHM_K;
  float* wsf = (float*)(lds + SCR_OFF) + wid * 64;
  const unsigned lds0 = (unsigned)(uintptr_t)lds;
  float l_reg = 0.f; f32x16 o[4] = {}; bf16x8 qr[4];
  const bf16* Qw = Qb + (size_t)(wq * 32 + r32) * INW + c * 64 + hi * 8;
#pragma unroll
  for (int d0 = 0; d0 < 4; ++d0) qr[d0] = *reinterpret_cast<const bf16x8*>(Qw + d0 * 16);
  const bf16* ksrc0; const bf16* ksrc1; const bf16* vsrc0; const bf16* vsrc1;
  { const int row0 = 8 * wid + (lane >> 4), row1 = row0 + 4, cp = lane & 15;
    ksrc0 = Kh + (size_t)row0 * INW + ((cp ^ (row0 & 15)) << 3); ksrc1 = Kh + (size_t)row1 * INW + ((cp ^ (row1 & 15)) << 3);
    const int kk = 8 * wid + ((lane & 31) >> 2), kkey = (kk & ~0xC) | ((kk & 4) << 1) | ((kk & 8) >> 1), cc = (lane >> 5) * 32 + (lane & 3) * 8;
    vsrc0 = Vh + (size_t)kkey * INW + cc; vsrc1 = vsrc0 + 64; }
  const unsigned kdst = lds0 + (unsigned)wid * 2048u, vdst = lds0 + 3u * SHM_K + (unsigned)wid * 2048u;
#define DMA_K(t, slot) do { const size_t to_ = (size_t)(t) * (KVBLK * INW); const unsigned d_ = (unsigned)__builtin_amdgcn_readfirstlane(kdst + (unsigned)(slot)); glds16(ksrc0 + to_, d_); glds16(ksrc1 + to_, d_ + 1024u); } while (0)
#define DMA_V(t, slot) do { const size_t to_ = (size_t)(t) * (KVBLK * INW); const unsigned d_ = (unsigned)__builtin_amdgcn_readfirstlane(vdst + (unsigned)(slot)); glds16(vsrc0 + to_, d_); glds16(vsrc1 + to_, d_ + 1024u); } while (0)
  const int vb0 = (int)(lds0 + 3u * SHM_K) + v_rd_base(lane);
  f32x16 pA0, pA1, pB0, pB1; const int NT = seq / KVBLK;
  int s0 = 0, s1 = SHM_K, s2 = 2 * SHM_K;
#define ROT() do { const int t_ = s0; s0 = s1; s1 = s2; s2 = t_; } while (0)
  DMA_K(0, 0); DMA_K(1, SHM_K); DMA_V(0, 0);
  WAIT_BAR(4);
  DMA_K(2, 2 * SHM_K); DMA_V(1, SHM_K);
  qkt<SHIFT>(pA0, pA1, K_ring, qr, r32, hi, c, negmb); expA(pA0); expA(pA1);
#define ITER(CUR0, CUR1, PRV0, PRV1, j) do { \
    WAIT_BAR(4); \
    { const int tk_ = ((j) + 2 < NT) ? (j) + 2 : NT - 1, tv_ = ((j) + 1 < NT) ? (j) + 1 : NT - 1; DMA_K(tk_, s0); DMA_V(tv_, s2); } \
    SBAR(); qkt<SHIFT>(CUR0, CUR1, K_ring + s1, qr, r32, hi, c, negmb); \
    finish_pv(PRV0, PRV1, l_reg, o, vb0 + s0); expA(CUR0); expA(CUR1); \
    ROT(); } while (0)
  for (int j = 1; j + 1 < NT; j += 2) {
    ITER(pB0, pB1, pA0, pA1, j);
    ITER(pA0, pA1, pB0, pB1, j + 1);
  }
  ITER(pB0, pB1, pA0, pA1, NT - 1);
  WAIT_BAR(0);
  finish_pv(pB0, pB1, l_reg, o, vb0 + s0);
#undef ITER
#undef ROT
#undef DMA_K
#undef DMA_V
  int lane_e = lane; asm volatile("" : "+v"(lane_e));
  {
  const int lane = lane_e, r32 = lane & 31, hi = lane >> 5;
  { auto rr = __builtin_amdgcn_permlane32_swap(__float_as_uint(l_reg), __float_as_uint(l_reg), false, false); l_reg = __uint_as_float(rr[0]) + __uint_as_float(rr[1]); }
  if (hi == 0) wsf[r32] = l_reg;
  asm volatile("s_waitcnt lgkmcnt(0)" ::: "memory");
  __syncthreads();
  float* X = (float*)lds + wq * 4096;
  if (c == 1) {
#pragma unroll
    for (int r = 0; r < 16; ++r) { const float rl = __builtin_amdgcn_rcpf(wsf[crow(r, hi)]);
#pragma unroll
      for (int d0 = 0; d0 < 4; ++d0) X[(d0 * 16 + r) * 64 + lane] = o[d0][r] * rl; }
  }
  __syncthreads();
  if (c == 0) {
    float g4[4];
#pragma unroll
    for (int d0 = 0; d0 < 4; ++d0) g4[d0] = gsub[32 * d0 + r32] * post;
#pragma unroll
    for (int r = 0; r < 16; ++r) { const float rl = __builtin_amdgcn_rcpf(wsf[crow(r, hi)]); float dv[4]; float s = 0.f;
#pragma unroll
      for (int d0 = 0; d0 < 4; ++d0) { dv[d0] = o[d0][r] * rl - lam * X[(d0 * 16 + r) * 64 + lane]; s += dv[d0] * dv[d0]; }
#pragma unroll
      for (int off = 1; off < 32; off <<= 1) s += __shfl_xor(s, off);
      const float rs = 1.0f / sqrtf(s * (1.f / 128.f) + EPS); bf16* orow = Ob + (size_t)(wq * 32 + crow(r, hi)) * DM + r32;
#pragma unroll
      for (int d0 = 0; d0 < 4; ++d0) orow[32 * d0] = (bf16)(pk2(dv[d0] * rs * g4[d0], 0.f) & 0xffffu); }
  }
  }
  __syncthreads();
}
#undef SBAR
}

DI void sgu_unit(const bf16* P, bf16* MIX, int chunk, int hd, const float* Ws, const float* bs, const float* gv, char* lds) {
    using att::bf16x8; using att::f32x16;
    int tid = threadIdx.x; asm volatile("" : "+v"(tid));
    const int wid = tid >> 6, lane = tid & 63, r32 = lane & 31, hi = lane >> 5;
    bf16* vnT = (bf16*)lds;
    { const int p = tid >> 2, qtr = tid & 3; const bf16* src = P + (size_t)(chunk * 128 + p) * INW + OFF_CV + hd * 128 + qtr * 32;
      v4u raw[4];
#pragma unroll
      for (int i = 0; i < 4; ++i) raw[i] = *(const v4u*)(src + 8 * i);
      float x[32];
#pragma unroll
      for (int i = 0; i < 4; ++i) unpack8(raw[i], x + 8 * i);
      float ss = 0.f;
#pragma unroll
      for (int i = 0; i < 32; ++i) { x[i] = gelu_tanh(x[i]); ss += x[i] * x[i]; }
      ss += __shfl_xor(ss, 1); ss += __shfl_xor(ss, 2);
      const float rstd = 1.0f / sqrtf(ss * (1.f / 128.f) + EPS);
#pragma unroll
      for (int i = 0; i < 32; ++i) { const float v = x[i] * rstd * gv[qtr * 32 + i]; vnT[(qtr * 32 + i) * 136 + p] = (bf16)(pk2(v, 0.f) & 0xffffu); }
    }
    __syncthreads();
    const int qb = wid >> 1;
    bf16x8 a[8];
#pragma unroll
    for (int ks = 0; ks < 8; ++ks) { const float* w = Ws + (size_t)(32 * qb + r32) * 128 + 16 * ks + 8 * hi; const f32x4 w0 = *(const f32x4*)w, w1 = *(const f32x4*)(w + 4);
        att::u32x4 u = {pk2(w0.x, w0.y), pk2(w0.z, w0.w), pk2(w1.x, w1.y), pk2(w1.z, w1.w)}; a[ks] = *reinterpret_cast<bf16x8*>(&u); }
#pragma unroll
    for (int dd = 0; dd < 2; ++dd) { const int db = 2 * (wid & 1) + dd;
        f32x16 acc = {};
#pragma unroll
        for (int ks = 0; ks < 8; ++ks) { const bf16x8 b = *reinterpret_cast<const bf16x8*>(vnT + (32 * db + r32) * 136 + 16 * ks + 8 * hi);
            acc = __builtin_amdgcn_mfma_f32_32x32x16_bf16(a[ks], b, acc, 0, 0, 0); }
        const int d = 32 * db + r32;
#pragma unroll
        for (int i = 0; i < 16; ++i) { const int q = 32 * qb + att::crow(i, hi); const size_t tok = (size_t)chunk * 128 + q;
            const float uval = gelu_tanh(__uint_as_float((unsigned)P[tok * INW + OFF_CU + hd * 128 + d] << 16));
            MIX[tok * DM + MIX_C + hd * 128 + d] = (bf16)(pk2(uval * (acc[i] + bs[q]), 0.f) & 0xffffu); }
    }
    __syncthreads();
}

#define LAS __attribute__((address_space(3)))
#define XB_TMO      128
#define XB_XCNT(j)  (256  + 64 * (j))
#define XB_XSUB(j)  (1280 + 64 * (j))
#define XB_XGEN(j)  (2304 + 64 * (j))
#define XB_TOP      3328
#define XB_TOPGEN   3392
#define XCD_BAR_WORDS 3456
#define XB_SPIN_CAP (1u << 18)

__device__ __forceinline__ unsigned xb_ld(unsigned* p)              { return __hip_atomic_load(p, __ATOMIC_RELAXED, __HIP_MEMORY_SCOPE_AGENT); }
__device__ __forceinline__ unsigned xb_add(unsigned* p, unsigned v) { return __hip_atomic_fetch_add(p, v, __ATOMIC_RELAXED, __HIP_MEMORY_SCOPE_AGENT); }
__device__ __forceinline__ unsigned xb_xcc_id() { return (unsigned)__builtin_amdgcn_s_getreg((3 << 11) | 20) & 0xFu; }
#define XB_SPIN(cond, bar) do { unsigned _sp = 0; while (cond) { __builtin_amdgcn_s_sleep(1); \
    if ((++_sp & 255u) == 0u) { if (xb_ld(&(bar)[XB_TMO])) break; if (_sp > XB_SPIN_CAP) { atomicAdd(&(bar)[XB_TMO], 1u); break; } } } } while (0)

struct XcdBarrier {
    unsigned* bar; unsigned x;
    volatile LAS unsigned* st;
};

__device__ __forceinline__ XcdBarrier xcd_barrier_post(unsigned* bar, volatile LAS unsigned* st) {
    XcdBarrier b; b.bar = bar; b.x = xb_xcc_id(); b.st = st;
    if (threadIdx.x == 0) (void)xb_add(&bar[XB_XCNT(b.x)], 1u);
    return b;
}
__device__ __forceinline__ void xcd_barrier_complete(unsigned* bar, unsigned x, unsigned& nloc, unsigned& nx) {
    const unsigned G = gridDim.x * gridDim.y * gridDim.z;
    unsigned sum, cnt, mine, sp = 0u;
    for (;;) {
        sum = 0u; cnt = 0u; mine = 0u;
#pragma unroll
        for (unsigned j = 0; j < 16; ++j) { const unsigned c = xb_ld(&bar[XB_XCNT(j)]); sum += c; cnt += (c > 0u) ? 1u : 0u; mine = (j == x) ? c : mine; }
        if (sum == G) break;
        __builtin_amdgcn_s_sleep(1);
        if ((++sp & 255u) == 0u) { if (xb_ld(&bar[XB_TMO])) break; if (sp > XB_SPIN_CAP) { atomicAdd(&bar[XB_TMO], 1u); break; } }
    }
    nloc = mine > 0u ? mine : 1u; nx = cnt > 0u ? cnt : 1u;
}

__device__ __forceinline__ void xcd_barrier(const XcdBarrier& b) {
    asm volatile("s_waitcnt vmcnt(0)" ::: "memory");
    __syncthreads();
    if (threadIdx.x == 0) {
        unsigned* bar = b.bar;
        __builtin_amdgcn_s_waitcnt(0);
        unsigned nloc = b.st[0], nx = b.st[1];
        if (nloc == 0u) { xcd_barrier_complete(bar, b.x, nloc, nx); b.st[0] = nloc; b.st[1] = nx; }
        const unsigned old = xb_add(&bar[XB_XSUB(b.x)], 1u);
        const unsigned gen = old / nloc;
        if (old + 1u == (gen + 1u) * nloc) {
            __builtin_amdgcn_fence(__ATOMIC_RELEASE, "agent");
            asm volatile("s_waitcnt vmcnt(0)" ::: "memory");
            const unsigned og = xb_add(&bar[XB_TOP], 1u);
            const unsigned tg = og / nx;
            if (og + 1u == (tg + 1u) * nx) xb_add(&bar[XB_TOPGEN], 1u);
            else XB_SPIN(xb_ld(&bar[XB_TOPGEN]) == tg, bar);
            __builtin_amdgcn_fence(__ATOMIC_ACQUIRE, "agent");
            xb_add(&bar[XB_XGEN(b.x)], 1u);
            asm volatile("s_waitcnt vmcnt(0)" ::: "memory");
        } else {
            XB_SPIN(xb_ld(&bar[XB_XGEN(b.x)]) == gen, bar);
            __builtin_amdgcn_fence(__ATOMIC_ACQUIRE, "agent");
            asm volatile("s_waitcnt vmcnt(0)" ::: "memory");
        }
    }
    __syncthreads();
}

struct Args { const float* in[19]; float* out; unsigned char* ws; int ph_lo, ph_hi; };
constexpr int N_PHASES = 1 + 6 * NLAYER;

__global__ void __launch_bounds__(NWAVES * 64, 2) mk_fwd(Args args) {
    extern __shared__ __attribute__((aligned(16))) unsigned char lds[];
    cg::grid_group grid = cg::this_grid();
    const int G = gridDim.x; const int bx = blockIdx.x; const int vcu = (G % 8 == 0) ? (bx % 8) * (G / 8) + bx / 8 : bx;
    const int NGW = G * NWAVES;
    unsigned char* ws = args.ws;
    const float* xp = args.in[0]; const float* xs = args.in[1];
    float* out = args.out;
    bf16* XN = (bf16*)(ws + WS_XN); bf16* PROJ = (bf16*)(ws + WS_PROJ); bf16* MIX = (bf16*)(ws + WS_MIX); bf16* HB = (bf16*)(ws + WS_H);

    volatile LAS unsigned* MISC = (volatile LAS unsigned*)((LAS unsigned char*)lds + 131072 + 320);
    if (threadIdx.x < 32) MISC[threadIdx.x] = 0u;
    __syncthreads();
    const XcdBarrier bar = xcd_barrier_post((unsigned*)ws, MISC + 8);
    for (int ph = args.ph_lo; ph < args.ph_hi; ++ph) {
        int tid = threadIdx.x; asm volatile("" : "+v"(tid));
        const int lane = tid & 63, wave = __builtin_amdgcn_readfirstlane(tid >> 6), gw = vcu * NWAVES + wave;
        const int l = (ph - 1) / 6, k = (ph == 0) ? -1 : ((ph - 1) % 6);
        float* const RS = (float*)(ws + 65536);
        const unsigned char* wl = ws + WS_WT + (size_t)(l < 0 ? 0 : l) * WT_LAYER;
        if (ph == 0) {
#if PHM & 1
            for (int rep = 0; rep < PROBE_REP_MISC; ++rep) {
            float* scr = (float*)(lds + wave * 16384);
            constexpr int I_IN = 32 * 176, I_OUT = 32 * 64, I_UP = 32 * 256, I_DN = 128 * 64, I_L = I_IN + I_OUT + I_UP + I_DN;
            for (int it = gw; it < NLAYER * I_L; it += NGW) {
                const int ll = it / I_L; int r = it % I_L; unsigned char* wb = ws + WS_WT + (size_t)ll * WT_LAYER;
                if (r < I_IN) { transpose_item(args.in[3] + (size_t)ll * DM * INW, DM, INW, (bf16*)(wb + WT_IN), DM, args.in[2] + ll * DM, scr, r, lane); continue; } r -= I_IN;
                if (r < I_OUT) { transpose_item(args.in[15] + (size_t)ll * DM * DM, DM, DM, (bf16*)(wb + WT_OUT), DM, nullptr, scr, r, lane); continue; } r -= I_OUT;
                if (r < I_UP) { transpose_item(args.in[17] + (size_t)ll * DM * DFF, DM, DFF, (bf16*)(wb + WT_UP), DM, args.in[16] + ll * DM, scr, r, lane); continue; } r -= I_UP;
                transpose_item(args.in[18] + (size_t)ll * DFF * DM, DFF, DM, (bf16*)(wb + WT_DN), LDH, nullptr, scr, r, lane);
            }
            for (int m = gw; m < M_ALL; m += NGW) xb_row(m < MP ? xp + (size_t)m * DM : xs + (size_t)(m - MP) * DM, XN + (size_t)m * DM, RS + m, lane);
            for (int i = gw * 64 + lane; i < 3 * M_ALL; i += NGW * 64) RS[M_ALL + i] = 0.f;
            }
#endif
        } else if (k == 0) {
#if PHM & 2
            pg8::Gemm g{XN, (const bf16*)(wl + WT_IN), M_ALL, INW, DM, DM, DM}; pg8::StaticOrder S; S.init(M_ALL, INW, G, bx);
            pg8::EpiBf16<0> E{PROJ, INW, RS + (size_t)(2 * l) * M_ALL};
            for (int rep = 0; rep < PROBE_REP_WIN; ++rep)
            pg8::gemm_phase<pg8::EpiBf16<0>, pg8::StaticOrder, true, true>((PG8_LAS unsigned char*)lds, g, S, E);
#endif
        } else if (k == 1) {
#if PHM & 4
            const float* qg = args.in[5] + l * 64; const float* kg = args.in[6] + l * 64; const float* cw = args.in[4] + l * 1536;
            for (int m = gw; m < M_ALL; m += NGW) {
                const int pos = m < MP ? (m & (SEQ_P - 1)) : ((m - MP) & (SEQ_S - 1)); const int S = m < MP ? SEQ_P : SEQ_S;
                qk_row(PROJ, m, pos, qg, kg, lane);
                conv_row(PROJ, MIX, m, pos, S, cw, lane);
            }
            for (int u = vcu; u < (M_ALL / 128) * 4; u += G) { const int chunk = u >> 2, hd = u & 3;
                sgu_unit(PROJ, MIX, chunk, hd, args.in[13] + ((size_t)l * 4 + hd) * 128 * 128, args.in[14] + (l * 4 + hd) * 128, args.in[12] + l * 128, (char*)lds); }
#endif
        } else if (k == 2) {
#if PHM & 8
            const float linit = (l == 0) ? 0.2f : 0.35550906759096934f;
            const float s1 = wave_sum(args.in[7][l * 64 + lane] * args.in[8][l * 64 + lane]), s2 = wave_sum(args.in[9][l * 64 + lane] * args.in[10][l * 64 + lane]);
            const float lam = __uint_as_float(__builtin_amdgcn_readfirstlane(__float_as_uint(expf(s1) - expf(s2) + linit)));
            const float gq = wave_max(fabsf(args.in[5][l * 64 + lane])), gk = wave_max(fabsf(args.in[6][l * 64 + lane]));
            const float negmb = __uint_as_float(__builtin_amdgcn_readfirstlane(__float_as_uint(-(C2 * 64.0f * gq * gk))));
            for (int rep = 0; rep < PROBE_REP_ATT; ++rep)
            for (int t = vcu; t < 2560; t += G) {
                int pair, qb, seq, seqrow0;
                if (t < 2048) { const int i = t >> 8, v = t & 255; const int idx = (v >> 5) * 256 + i * 32 + (v & 31); pair = idx >> 7; qb = idx & 127; seq = SEQ_S; seqrow0 = MP + (pair >> 3) * SEQ_S; }
                else { const int t2 = t - 2048, i = t2 >> 8, v = t2 & 255; pair = 2 * (v >> 5) + i; qb = v & 31; seq = SEQ_P; seqrow0 = (pair >> 3) * SEQ_P; }
                const int h = pair & 7; const size_t row0 = (size_t)seqrow0 + (size_t)qb * 128;
                if (negmb >= -64.0f)
                att::attn_unit<false>(PROJ + row0 * INW + OFF_Q + h * 128, PROJ + (size_t)seqrow0 * INW + OFF_K + h * 128, PROJ + (size_t)seqrow0 * INW + OFF_V + h * 128,
                               MIX + row0 * DM + MIX_B + h * 128, seq, (char*)lds, 0.f, lam, args.in[11] + l * 128, 1.0f - linit);
                else
                att::attn_unit<true>(PROJ + row0 * INW + OFF_Q + h * 128, PROJ + (size_t)seqrow0 * INW + OFF_K + h * 128, PROJ + (size_t)seqrow0 * INW + OFF_V + h * 128,
                               MIX + row0 * DM + MIX_B + h * 128, seq, (char*)lds, negmb, lam, args.in[11] + l * 128, 1.0f - linit);
            }
#endif
        } else if (k == 3 || k == 5) {
#if PHM & 16
            pg8::Gemm g; if (k == 3) g = pg8::Gemm{MIX, (const bf16*)(wl + WT_OUT), M_ALL, DM, DM, DM, DM}; else g = pg8::Gemm{HB, (const bf16*)(wl + WT_DN), M_ALL, DM, DFF, LDH, LDH};
            pg8::StaticOrder S; S.init(M_ALL, DM, G, bx);
            pg8::EpiResF32 E;
            if (k == 3 && l == 0) E = pg8::EpiResF32{xp, xs, MP / 256, out, DM, XN, DM, RS + (size_t)1 * M_ALL};
            else if (k == 3) E = pg8::EpiResF32{out, out, 0, out, DM, XN, DM, RS + (size_t)3 * M_ALL};
            else if (l == 0) E = pg8::EpiResF32{out, out, 0, out, DM, XN, DM, RS + (size_t)2 * M_ALL};
            else E = pg8::EpiResF32{out, out, 0, out, DM, nullptr, 0, nullptr};
            pg8::gemm_phase<pg8::EpiResF32, pg8::StaticOrder, true, true>((PG8_LAS unsigned char*)lds, g, S, E);
#endif
        } else {
#if PHM & 64
            pg8::Gemm g{XN, (const bf16*)(wl + WT_UP), M_ALL, DFF, DM, DM, DM}; pg8::StaticOrder S; S.init(M_ALL, DFF, G, bx);
            pg8::EpiBf16<2> E{HB, LDH, RS + (size_t)(2 * l + 1) * M_ALL};
            for (int rep = 0; rep < PROBE_REP_UP; ++rep)
            pg8::gemm_phase<pg8::EpiBf16<2>, pg8::StaticOrder, true, true>((PG8_LAS unsigned char*)lds, g, S, E);
#endif
        }
        if (ph + 1 < args.ph_hi) { if (ph == args.ph_lo) grid.sync(); else xcd_barrier(bar); }
    }
}

extern "C" void kernel_launch(void* const* d_in, const int* in_sizes, int n_in, void* d_out, int out_size, void* d_ws, size_t ws_size, hipStream_t stream) {
    static int grid = 0;
    if (grid == 0) {
        if (n_in != 19 || out_size != M_ALL * DM || ws_size < WS_END) { fprintf(stderr, "kernel_launch: unexpected shapes: n_in %d out %d ws %zu (need %zu)\n", n_in, out_size, ws_size, (size_t)WS_END); grid = -1; return; }
        int dev = 0, cus = 0, per_cu = 0;
        if (hipGetDevice(&dev) != hipSuccess || hipDeviceGetAttribute(&cus, hipDeviceAttributeMultiprocessorCount, dev) != hipSuccess) { fprintf(stderr, "kernel_launch: device query failed\n"); grid = -1; return; }
        if (hipFuncSetAttribute((const void*)mk_fwd, hipFuncAttributeMaxDynamicSharedMemorySize, LDS_BYTES) != hipSuccess) { fprintf(stderr, "kernel_launch: hipFuncSetAttribute failed\n"); grid = -1; return; }
        if (hipOccupancyMaxActiveBlocksPerMultiprocessor(&per_cu, (const void*)mk_fwd, NWAVES * 64, LDS_BYTES) != hipSuccess || per_cu < 1) { fprintf(stderr, "kernel_launch: occupancy query gave %d\n", per_cu); per_cu = 1; }
        (void)hipGetLastError();
        grid = cus * 1;
        fprintf(stderr, "kernel_launch: grid %d (cus %d, per_cu %d)\n", grid, cus, per_cu);
    }
    if (grid < 0) return;
    if (hipMemsetAsync(d_ws, 0, 65536, stream) != hipSuccess) { fprintf(stderr, "kernel_launch: memset failed\n"); return; }
    Args a{};
    for (int i = 0; i < 19; ++i) a.in[i] = (const float*)d_in[i];
    a.out = (float*)d_out; a.ws = (unsigned char*)d_ws;
#if MK_SINGLE
    a.ph_lo = 0; a.ph_hi = N_PHASES;
    { void* kargs[] = {&a}; hipError_t e = hipLaunchCooperativeKernel((const void*)mk_fwd, dim3(grid), dim3(NWAVES * 64), kargs, LDS_BYTES, stream);
      if (e != hipSuccess) fprintf(stderr, "kernel_launch: cooperative launch failed: %s\n", hipGetErrorString(e)); }
#else
    for (int ph = 0; ph < N_PHASES; ++ph) { a.ph_lo = ph; a.ph_hi = ph + 1; void* kargs[] = {&a};
        hipError_t e = hipLaunchCooperativeKernel((const void*)mk_fwd, dim3(grid), dim3(NWAVES * 64), kargs, LDS_BYTES, stream);
        if (e != hipSuccess) { fprintf(stderr, "kernel_launch: cooperative launch %d failed: %s\n", ph, hipGetErrorString(e)); break; } }
#endif
}
```

```cpp
#include <hip/hip_runtime.h>
#include <hip/hip_cooperative_groups.h>
#include <hip/hip_bf16.h>
#include <cstdio>
#include <cstdint>
namespace cg = cooperative_groups;
namespace pg8 {
#define PG8_LAS __attribute__((address_space(3)))
typedef unsigned short bf16_t;
typedef short bf16x8 __attribute__((ext_vector_type(8)));
typedef float f32x4 __attribute__((ext_vector_type(4)));
typedef unsigned u32x4 __attribute__((ext_vector_type(4)));
constexpr int BM = 256, BK = 64, HALF = 128, HTB = HALF * BK * 2  , STAGE_BYTES = 8 * HTB, NXCD = 8, WGM = 8;

__host__ __device__ __forceinline__ int lds_byte(int r, int c) { const int st = (r >> 4) * 2 + (c >> 5), rr = r & 15, cc = c & 31, ob = rr * 64 + cc * 2; return st * 1024 + (ob ^ (((ob >> 9) & 1) << 5)); }
__host__ __device__ __forceinline__ void stage_rc(int b, int& R, int& C) { const int st = b / 1024, sb = b % 1024, swz = sb ^ (((sb >> 9) & 1) << 5); R = (st >> 1) * 16 + swz / 64; C = (st & 1) * 32 + (swz % 64) / 2; }
__host__ __device__ __forceinline__ int perm32(int rho) { const int n = rho >> 4, i = rho & 15; return 8 * (i >> 2) + 4 * n + (i & 3); }

struct Unit { int pm, pn; };
struct Gemm { const bf16_t* A; const bf16_t* Bt; int M, N, K, lda, ldb; };

struct StaticOrder {
    int nM, nN, nwg, G, c;
    __host__ __device__ void init(int M, int N, int G_, int c_) { nM = M / BM; nN = N / BM; nwg = nM * nN; G = G_; c = c_; }
    __host__ __device__ bool next(int i, Unit& u) const {
        const long L = (long)i * G + c; if (L >= nwg) return false;
        int wgid = (int)L; { const int q = nwg / NXCD, r = nwg % NXCD, xcd = wgid % NXCD, off = wgid / NXCD; wgid = (xcd < r ? xcd * (q + 1) : r * (q + 1) + (xcd - r) * q) + off; }
        const int nig = WGM * nN, gid = wgid / nig, fm = gid * WGM, gsz = (nM - fm) < WGM ? (nM - fm) : WGM;
        u.pm = fm + ((wgid % nig) % gsz); u.pn = (wgid % nig) / gsz; return true;
    }
    __device__ __forceinline__ void a_ready(const Unit&) const {}
    __device__ __forceinline__ void done(const Unit&) const {}
};

__device__ __forceinline__ unsigned cvt_pk_bf16(float lo, float hi) { unsigned r; asm volatile("v_cvt_pk_bf16_f32 %0, %1, %2" : "=v"(r) : "v"(lo), "v"(hi)); return r; }
typedef float f32x2 __attribute__((ext_vector_type(2)));
typedef unsigned u32x2 __attribute__((ext_vector_type(2)));
template <int ACT> struct EpiBf16 {
    static constexpr bool PERM = true, AFTER_DRAIN = false;
    bf16_t* O; int ldc; const float* rowss;
    __device__ __forceinline__ void operator()(const f32x4 (&acc)[2][2][4][2], const Unit& u, int wr, int wc, int fr, int fq) const {
        const int row0 = u.pm * BM + wr * 64 + fr; const int col0 = u.pn * BM + wc * 32 + 8 * fq;
        float rs[2][4];
#pragma unroll
        for (int ai = 0; ai < 2; ++ai)
#pragma unroll
            for (int m = 0; m < 4; ++m) rs[ai][m] = rowss[row0 + ai * HALF + m * 16];
#pragma unroll
        for (int ai = 0; ai < 2; ++ai)
#pragma unroll
            for (int m = 0; m < 4; ++m) { bf16_t* rowp = O + (size_t)(row0 + ai * HALF + m * 16) * ldc + col0;
                const float sc = 1.0f / sqrtf(rs[ai][m] * (1.0f / 2048.0f) + 1e-6f);
#pragma unroll
                for (int bj = 0; bj < 2; ++bj) { f32x4 v0 = acc[ai][bj][m][0] * sc, v1 = acc[ai][bj][m][1] * sc;
                    if (ACT == 2) {
#pragma unroll
                        for (int e = 0; e < 4; ++e) { float a = fmaxf(v0[e], 0.f), b = fmaxf(v1[e], 0.f); v0[e] = a * a; v1[e] = b * b; } }
                    u32x4 w; w.x = cvt_pk_bf16(v0[0], v0[1]); w.y = cvt_pk_bf16(v0[2], v0[3]); w.z = cvt_pk_bf16(v1[0], v1[1]); w.w = cvt_pk_bf16(v1[2], v1[3]);
                    *(u32x4*)(rowp + bj * HALF) = w; } }
    }
};
struct EpiResF32 {
    static constexpr bool PERM = true, AFTER_DRAIN = false;
    const float* res_lo; const float* res_hi; int split_pm; const bf16_t* resb; float* out; int ldc; bf16_t* xb; int ldx; float* rowss;
    __device__ __forceinline__ void operator()(const f32x4 (&acc)[2][2][4][2], const Unit& u, int wr, int wc, int fr, int fq) const {
        const float* rbase = (u.pm < split_pm) ? res_lo : (res_hi - (size_t)split_pm * BM * ldc);
        const int col0 = u.pn * BM + wc * 32 + 8 * fq;
#pragma unroll
        for (int ai = 0; ai < 2; ++ai)
#pragma unroll
            for (int m = 0; m < 4; ++m) { const int row = u.pm * BM + ai * HALF + wr * 64 + m * 16 + fr; const size_t off = (size_t)row * ldc + col0, offb = (size_t)row * ldx + col0; float ss = 0.f;
#pragma unroll
                for (int bj = 0; bj < 2; ++bj) {
                    f32x4 v0, v1;
                    if (resb) { const u32x4 r = *(const u32x4*)(resb + offb + bj * HALF);
                        v0 = (f32x4){__uint_as_float(r.x << 16), __uint_as_float(r.x & 0xffff0000u), __uint_as_float(r.y << 16), __uint_as_float(r.y & 0xffff0000u)};
                        v1 = (f32x4){__uint_as_float(r.z << 16), __uint_as_float(r.z & 0xffff0000u), __uint_as_float(r.w << 16), __uint_as_float(r.w & 0xffff0000u)}; }
                    else { v0 = *(const f32x4*)(rbase + off + bj * HALF); v1 = *(const f32x4*)(rbase + off + bj * HALF + 4); }
                    v0 += acc[ai][bj][m][0]; v1 += acc[ai][bj][m][1];
                    if (out) { *(f32x4*)(out + off + bj * HALF) = v0; *(f32x4*)(out + off + bj * HALF + 4) = v1; }
                    if (xb) { u32x4 w; w.x = cvt_pk_bf16(v0[0], v0[1]); w.y = cvt_pk_bf16(v0[2], v0[3]); w.z = cvt_pk_bf16(v1[0], v1[1]); w.w = cvt_pk_bf16(v1[2], v1[3]);
                        *(u32x4*)(xb + offb + bj * HALF) = w;
                        ss += (v0[0] * v0[0] + v0[1] * v0[1]) + (v0[2] * v0[2] + v0[3] * v0[3]) + (v1[0] * v1[0] + v1[1] * v1[1]) + (v1[2] * v1[2] + v1[3] * v1[3]); } }
                if (xb) { ss += __shfl_xor(ss, 16); ss += __shfl_xor(ss, 32);
                    if (fq == 0) __hip_atomic_fetch_add(rowss + row, ss, __ATOMIC_RELAXED, __HIP_MEMORY_SCOPE_AGENT); }
                if (m == 3) asm volatile("" ::: "memory"); }
    }
};
template <class Epi, class Sched, bool ALIGN_EPI = false, bool SP2 = false>
__device__ __forceinline__ void gemm_phase(PG8_LAS unsigned char* lds, const Gemm g, const Sched& S, const Epi& E) {
    int tid = threadIdx.x; asm volatile("" : "+v"(tid));
    const int wid = __builtin_amdgcn_readfirstlane(tid >> 6), lane = tid & 63, wr = wid >> 2, wc = wid & 3, fr = lane & 15, fq = lane >> 4;
    const int K = g.K, nt = K / BK;
    unsigned voffA[2], voffB[2];
#pragma unroll
    for (int i = 0; i < 2; ++i) { int R, C; stage_rc(tid * 16 + i * 8192, R, C); const int Rb = Epi::PERM ? ((R & ~31) + perm32(R & 31)) : R;
        voffA[i] = (unsigned)(R * g.lda + C) * 2u; voffB[i] = (unsigned)(Rb * g.ldb + C) * 2u; }
    const size_t kstep = (size_t)(BK * 2);
    const size_t hstepA = (size_t)HALF * g.lda * 2, hstepB = (size_t)HALF * g.ldb * 2;
    const size_t tstepA = 2 * hstepA, tstepB = 2 * hstepB;
    const unsigned ldsw = (unsigned)wid * 1024u;
    const int aoff = lds_byte(wr * 64 + fr, fq * 8), boff = lds_byte(wc * 32 + fr, fq * 8);
#define PG8_SA(b, h) (((b) * 2 + (h)) * HTB)
#define PG8_SB(b, h) ((4 + (b) * 2 + (h)) * HTB)
#define PG8_STAGE(bufoff, gbase, voff) do { _Pragma("unroll") for (int _i = 0; _i < 2; ++_i) \
        __builtin_amdgcn_global_load_lds((const unsigned*)((const char*)(gbase) + (voff)[_i]), (PG8_LAS unsigned*)(lds + (bufoff) + ldsw + _i * 8192), 16, 0, 0); } while (0)
#define PG8_LDA(dst, b, h) do { _Pragma("unroll") for (int m = 0; m < 4; ++m) _Pragma("unroll") for (int k = 0; k < 2; ++k) dst[m][k] = *(const PG8_LAS bf16x8*)(lds + PG8_SA(b, h) + aoff + m * 2048 + k * 1024); } while (0)
#define PG8_LDB(dst, b, h) do { _Pragma("unroll") for (int n = 0; n < 2; ++n) _Pragma("unroll") for (int k = 0; k < 2; ++k) dst[n][k] = *(const PG8_LAS bf16x8*)(lds + PG8_SB(b, h) + boff + n * 2048 + k * 1024); } while (0)
#define PG8_MMA(ai, bj, At, Bt) do { __builtin_amdgcn_s_setprio(1); _Pragma("unroll") for (int m = 0; m < 4; ++m) _Pragma("unroll") for (int n = 0; n < 2; ++n) _Pragma("unroll") for (int k = 0; k < 2; ++k) \
        acc[ai][bj][m][n] = __builtin_amdgcn_mfma_f32_16x16x32_bf16(Bt[n][k], At[m][k], acc[ai][bj][m][n], 0, 0, 0); __builtin_amdgcn_s_setprio(0); } while (0)
#define PG8_WAIT_V(n) asm volatile("s_waitcnt vmcnt(" #n ")" ::: "memory")
#define PG8_WAIT_L(n) asm volatile("s_waitcnt lgkmcnt(" #n ")" ::: "memory")
#define PG8_BAR __builtin_amdgcn_s_barrier()
#define PG8_SCHED __builtin_amdgcn_sched_barrier(0)
    Unit cur, nxt; int ui = 0;
    if (!S.next(0, cur)) return;
    f32x4 acc[2][2][4][2];
#pragma unroll
    for (int a = 0; a < 2; ++a)
#pragma unroll
        for (int b = 0; b < 2; ++b)
#pragma unroll
            for (int m = 0; m < 4; ++m)
#pragma unroll
                for (int n = 0; n < 2; ++n) acc[a][b][m][n] = (f32x4){0.f, 0.f, 0.f, 0.f};
    bf16x8 At[4][2], B0[2][2], B1[2][2];
    const char* cA = (const char*)g.A + (size_t)cur.pm * tstepA; const char* cB = (const char*)g.Bt + (size_t)cur.pn * tstepB;
    S.a_ready(cur);
    if constexpr (SP2) {
        PG8_STAGE(PG8_SB(0, 0), cB, voffB); PG8_STAGE(PG8_SB(0, 1), cB + hstepB, voffB); PG8_STAGE(PG8_SA(0, 0), cA, voffA); PG8_STAGE(PG8_SA(0, 1), cA + hstepA, voffA);
        if (wr == 1) PG8_BAR;
        PG8_WAIT_V(2); PG8_BAR;
        PG8_STAGE(PG8_SB(1, 0), cB + kstep, voffB); PG8_STAGE(PG8_SA(1, 0), cA + kstep, voffA); PG8_STAGE(PG8_SB(1, 1), cB + hstepB + kstep, voffB);
        PG8_WAIT_V(6); PG8_BAR;
    } else {
        PG8_STAGE(PG8_SB(0, 0), cB, voffB); PG8_STAGE(PG8_SA(0, 0), cA, voffA); PG8_STAGE(PG8_SB(0, 1), cB + hstepB, voffB); PG8_STAGE(PG8_SA(0, 1), cA + hstepA, voffA);
        if (wr == 1) PG8_BAR;
        PG8_WAIT_V(4); PG8_BAR;
        PG8_STAGE(PG8_SB(1, 0), cB + kstep, voffB); PG8_STAGE(PG8_SA(1, 0), cA + kstep, voffA); PG8_STAGE(PG8_SB(1, 1), cB + hstepB + kstep, voffB);
        PG8_WAIT_V(6); PG8_BAR;
    }
    for (;;) {
        const bool has_next = S.next(ui + 1, nxt);
        const char* nA = has_next ? (const char*)g.A + (size_t)nxt.pm * tstepA : cA; const char* nB = has_next ? (const char*)g.Bt + (size_t)nxt.pn * tstepB : cB;
        for (int t = 0; t < nt; t += 2) {
            const bool last = (t == nt - 2);
            const char* a1 = cA + (size_t)(t + 1) * kstep;
            const char* a2 = last ? nA : cA + (size_t)(t + 2) * kstep; const char* b2 = last ? nB : cB + (size_t)(t + 2) * kstep;
            const char* a3 = a2 + kstep; const char* b3 = b2 + kstep;
            if (last && has_next) S.a_ready(nxt);
            if constexpr (SP2) {
            PG8_LDB(B0, 0, 0); PG8_LDB(B1, 0, 1); PG8_SCHED; PG8_LDA(At, 0, 0); PG8_STAGE(PG8_SA(1, 1), a1 + hstepA, voffA);
            PG8_WAIT_V(8); PG8_WAIT_L(0); PG8_BAR; PG8_MMA(0, 0, At, B0); PG8_MMA(0, 1, At, B1); PG8_BAR; PG8_SCHED;
            PG8_LDA(At, 0, 1); PG8_STAGE(PG8_SB(0, 0), b2, voffB); PG8_STAGE(PG8_SB(0, 1), b2 + hstepB, voffB); PG8_STAGE(PG8_SA(0, 0), a2, voffA);
            PG8_WAIT_V(8); PG8_WAIT_L(0); PG8_BAR; PG8_MMA(1, 0, At, B0); PG8_MMA(1, 1, At, B1); PG8_BAR; PG8_SCHED;
            PG8_LDB(B0, 1, 0); PG8_LDB(B1, 1, 1); PG8_SCHED; PG8_LDA(At, 1, 0); PG8_STAGE(PG8_SA(0, 1), a2 + hstepA, voffA);
            PG8_WAIT_V(8); PG8_WAIT_L(0); PG8_BAR; PG8_MMA(0, 0, At, B0); PG8_MMA(0, 1, At, B1); PG8_BAR; PG8_SCHED;
            PG8_LDA(At, 1, 1); PG8_STAGE(PG8_SB(1, 0), b3, voffB); PG8_STAGE(PG8_SB(1, 1), b3 + hstepB, voffB); PG8_STAGE(PG8_SA(1, 0), a3, voffA);
            PG8_WAIT_V(8); PG8_WAIT_L(0); PG8_BAR; PG8_MMA(1, 0, At, B0); PG8_MMA(1, 1, At, B1); PG8_BAR; PG8_SCHED;
            } else {
            PG8_LDB(B0, 0, 0); PG8_SCHED; PG8_LDA(At, 0, 0); PG8_STAGE(PG8_SA(1, 1), a1 + hstepA, voffA);
            PG8_WAIT_L(8); PG8_BAR; PG8_WAIT_L(0); PG8_MMA(0, 0, At, B0); PG8_BAR; PG8_SCHED;
            PG8_LDB(B1, 0, 1); PG8_STAGE(PG8_SB(0, 0), b2, voffB);
            PG8_BAR; PG8_WAIT_L(0); PG8_MMA(0, 1, At, B1); PG8_BAR;
            PG8_LDA(At, 0, 1); PG8_STAGE(PG8_SA(0, 0), a2, voffA);
            PG8_BAR; PG8_WAIT_L(0); PG8_MMA(1, 0, At, B0); PG8_BAR; PG8_SCHED;
            PG8_STAGE(PG8_SB(0, 1), b2 + hstepB, voffB);
            PG8_WAIT_V(6); PG8_BAR; PG8_MMA(1, 1, At, B1); PG8_BAR;
            PG8_LDB(B0, 1, 0); PG8_SCHED; PG8_LDA(At, 1, 0); PG8_STAGE(PG8_SA(0, 1), a2 + hstepA, voffA);
            PG8_WAIT_L(8); PG8_BAR; PG8_WAIT_L(0); PG8_MMA(0, 0, At, B0); PG8_BAR; PG8_SCHED;
            PG8_LDB(B1, 1, 1); PG8_STAGE(PG8_SB(1, 0), b3, voffB);
            PG8_BAR; PG8_WAIT_L(0); PG8_MMA(0, 1, At, B1); PG8_BAR;
            PG8_LDA(At, 1, 1); PG8_STAGE(PG8_SA(1, 0), a3, voffA);
            PG8_BAR; PG8_WAIT_L(0); PG8_MMA(1, 0, At, B0); PG8_BAR; PG8_SCHED;
            PG8_STAGE(PG8_SB(1, 1), b3 + hstepB, voffB);
            PG8_WAIT_V(6); PG8_BAR; PG8_MMA(1, 1, At, B1); PG8_BAR;
            }
        }
        if constexpr (ALIGN_EPI) { if (wr == 0) PG8_BAR; }
        if constexpr (!Epi::AFTER_DRAIN) { E(acc, cur, wr, wc, fr, fq); S.done(cur); }
        if (!has_next) break;
#pragma unroll
        for (int a = 0; a < 2; ++a)
#pragma unroll
            for (int b = 0; b < 2; ++b)
#pragma unroll
                for (int m = 0; m < 4; ++m)
#pragma unroll
                    for (int n = 0; n < 2; ++n) acc[a][b][m][n] = (f32x4){0.f, 0.f, 0.f, 0.f};
        cur = nxt; cA = nA; cB = nB; ++ui;
        if constexpr (ALIGN_EPI) { if (wr == 1) PG8_BAR; }
    }
    PG8_WAIT_V(0);
    if constexpr (!ALIGN_EPI) { if (wr == 0) PG8_BAR; }
    PG8_BAR;
    if constexpr (Epi::AFTER_DRAIN) { E.fused(acc, cur, wr, wc, fr, fq, lds, wid, lane); S.done(cur); }
#undef PG8_SA
#undef PG8_SB
#undef PG8_STAGE
#undef PG8_LDA
#undef PG8_LDB
#undef PG8_MMA
#undef PG8_WAIT_V
#undef PG8_WAIT_L
#undef PG8_BAR
#undef PG8_SCHED
}
}

#ifndef PROBE_REP_ATT
#define PROBE_REP_ATT 1
#endif
#ifndef PROBE_REP_UP
#define PROBE_REP_UP 1
#endif
#ifndef PROBE_XSYNC
#define PROBE_XSYNC 0
#endif
#ifndef PROBE_REP_MISC
#define PROBE_REP_MISC 1
#endif
#ifndef PROBE_REP_WIN
#define PROBE_REP_WIN 1
#endif
#ifndef PHM
#define PHM 127
#endif
#ifndef MK_SINGLE
#define MK_SINGLE 1
#endif
constexpr int DM = 2048, MP = 8192, M_ALL = 40960, SEQ_P = 4096, SEQ_S = 16384, INW = 5632, DFF = 8192, NLAYER = 2;
constexpr int OFF_AX = 0, OFF_AB = 512, OFF_AC = 1024, OFF_Q = 1536, OFF_K = 2560, OFF_V = 3584, OFF_CU = 4608, OFF_CV = 5120;
constexpr int MIX_A = 0, MIX_B = 512, MIX_C = 1536;
constexpr float EPS = 1e-6f;
constexpr float C2 = 0.18033688011112042f;
constexpr size_t MiB = 1u << 20;
constexpr int LDH = DFF + 128;
constexpr size_t WS_WT = 1 * MiB, WT_LAYER = 96 * MiB, WT_IN = 0, WT_OUT = 22 * MiB, WT_UP = 30 * MiB, WT_DN = 62 * MiB;
constexpr size_t WS_XN = 194 * MiB, WS_H = 356 * MiB, WS_PROJ = 356 * MiB, WS_MIX = 796 * MiB, WS_END = 1008 * MiB;
static_assert(WT_DN + (size_t)DM * LDH * 2 <= WT_LAYER && WS_WT + 2 * WT_LAYER <= WS_XN && WS_XN + (size_t)M_ALL * DM * 2 <= WS_H && WS_PROJ + (size_t)M_ALL * INW * 2 <= WS_MIX && WS_MIX + (size_t)M_ALL * DM * 2 <= WS_END && WS_H + (size_t)M_ALL * LDH * 2 <= WS_END, "ws map");
constexpr int NWAVES = 8, LDS_BYTES = 147456;

typedef unsigned short bf16;
typedef unsigned v4u __attribute__((ext_vector_type(4)));
typedef unsigned v2u __attribute__((ext_vector_type(2)));
typedef float f32x4 __attribute__((ext_vector_type(4)));
#define DI __device__ __forceinline__

DI unsigned pk2(float lo, float hi) { return pg8::cvt_pk_bf16(lo, hi); }
DI float bflo(unsigned u) { return __uint_as_float(u << 16); }
DI float bfhi(unsigned u) { return __uint_as_float(u & 0xffff0000u); }
DI float wave_sum(float v) {
#pragma unroll
    for (int o = 1; o < 64; o <<= 1) v += __shfl_xor(v, o);
    return v;
}
DI float wave_max(float v) {
#pragma unroll
    for (int o = 1; o < 64; o <<= 1) v = fmaxf(v, __shfl_xor(v, o));
    return v;
}
DI float gelu_tanh(float x) {
    const float z = x * (0.7978845608028654f + 0.035677408136300125f * x * x);
    const float e = __builtin_amdgcn_exp2f(-2.8853900817779268f * z);
    return x * __builtin_amdgcn_rcpf(1.0f + e);
}

DI void transpose_item(const float* W, int K, int N, bf16* WT, int ldt, const float* gain, float* scr, int item, int lane) {
    const int nblk = N / 32, kb = item / nblk, nb = item % nblk, k0 = 64 * kb, n0 = 32 * nb;
#pragma unroll 32
    for (int i = 0; i < 32; ++i) { const int kk = 2 * i + (lane >> 5); scr[kk * 33 + (lane & 31)] = W[(size_t)(k0 + kk) * N + n0 + (lane & 31)] * (gain ? gain[k0 + kk] : 1.0f); }
    asm volatile("s_waitcnt lgkmcnt(0)" ::: "memory");
    const int c = lane & 7;
#pragma unroll
    for (int j = 0; j < 4; ++j) { const int n = (lane >> 3) + 8 * j; const float* s = scr + (8 * c) * 33 + n;
        v4u o; o.x = pk2(s[0 * 33], s[1 * 33]); o.y = pk2(s[2 * 33], s[3 * 33]); o.z = pk2(s[4 * 33], s[5 * 33]); o.w = pk2(s[6 * 33], s[7 * 33]);
        *(v4u*)(WT + (size_t)(n0 + n) * ldt + k0 + 8 * c) = o; }
    asm volatile("s_waitcnt lgkmcnt(0)" ::: "memory");
}
DI void xb_row(const float* xrow, bf16* orow, float* ssp, int lane) {
    const f32x4* xr = (const f32x4*)xrow + lane;
    f32x4 v[8]; float s = 0.f;
#pragma unroll
    for (int j = 0; j < 8; ++j) { v[j] = xr[64 * j]; s += (v[j].x * v[j].x + v[j].y * v[j].y) + (v[j].z * v[j].z + v[j].w * v[j].w); }
    s = wave_sum(s);
    if (lane == 0) *ssp = s;
    v2u* o8 = (v2u*)orow + lane;
#pragma unroll
    for (int j = 0; j < 8; ++j) { v2u w; w.x = pk2(v[j].x, v[j].y); w.y = pk2(v[j].z, v[j].w); o8[64 * j] = w; }
}

__constant__ double ROPE_INV[8] = {1.0, 0.19392274474868576, 0.03760603093086393, 0.007292664737217109, 0.001414213562373095, 0.0002742481756762073, 5.318295896944988e-05, 1.031338537721246e-05};
DI void qk_row(bf16* P, int row, int pos, const float* qg, const float* kg, int lane) {
    bf16* p = P + (size_t)row * INW + OFF_Q + lane * 32;
    v4u raw[4];
#pragma unroll
    for (int i = 0; i < 4; ++i) raw[i] = *(const v4u*)(p + 8 * i);
    float x[32];
#pragma unroll
    for (int i = 0; i < 4; ++i) { x[8 * i + 0] = bflo(raw[i].x); x[8 * i + 1] = bfhi(raw[i].x); x[8 * i + 2] = bflo(raw[i].y); x[8 * i + 3] = bfhi(raw[i].y);
        x[8 * i + 4] = bflo(raw[i].z); x[8 * i + 5] = bfhi(raw[i].z); x[8 * i + 6] = bflo(raw[i].w); x[8 * i + 7] = bfhi(raw[i].w); }
    float ss = 0.f;
#pragma unroll
    for (int i = 0; i < 32; ++i) ss += x[i] * x[i];
    ss += __shfl_xor(ss, 1);
    const float rstd = 1.0f / sqrtf(ss * (1.f / 64.f) + EPS);
    const bool isq = lane < 32; const int half = lane & 1;
    const float* g = (isq ? qg : kg) + half * 32;
#pragma unroll
    for (int i = 0; i < 8; ++i) { const f32x4 gg = *(const f32x4*)(g + 4 * i); x[4 * i] *= rstd * gg.x; x[4 * i + 1] *= rstd * gg.y; x[4 * i + 2] *= rstd * gg.z; x[4 * i + 3] *= rstd * gg.w; }
    const double t = (double)pos * ROPE_INV[lane & 7] * 0.15915494309189535;
    const float fr = (float)(t - rint(t));
    const float cs = __builtin_amdgcn_cosf(fr), sn = __builtin_amdgcn_sinf(fr);
#pragma unroll
    for (int i = 0; i < 8; ++i) { const float c = __shfl(cs, i), s = __shfl(sn, i);
        if (half == 0) { const float a = x[i], b = x[i + 8]; x[i] = a * c - b * s; x[i + 8] = b * c + a * s; } }
    const float sc = isq ? C2 : 1.0f;
#pragma unroll
    for (int i = 0; i < 4; ++i) { v4u w; w.x = pk2(x[8 * i] * sc, x[8 * i + 1] * sc); w.y = pk2(x[8 * i + 2] * sc, x[8 * i + 3] * sc); w.z = pk2(x[8 * i + 4] * sc, x[8 * i + 5] * sc); w.w = pk2(x[8 * i + 6] * sc, x[8 * i + 7] * sc);
        *(v4u*)(p + 8 * i) = w; }
}
DI void unpack8(const v4u r, float* x) { x[0] = bflo(r.x); x[1] = bfhi(r.x); x[2] = bflo(r.y); x[3] = bfhi(r.y); x[4] = bflo(r.z); x[5] = bfhi(r.z); x[6] = bflo(r.w); x[7] = bfhi(r.w); }
DI void conv_row(const bf16* P, bf16* MIX, int row, int pos, int S, const float* cw, int lane) {
    const bf16* p = P + (size_t)row * INW + lane * 8;
    const v4u z4 = {0u, 0u, 0u, 0u};
    const v4u xa0 = *(const v4u*)(p + OFF_AX), gc0 = *(const v4u*)(p + OFF_AC), gb0 = *(const v4u*)(p + OFF_AB);
    const v4u xam = pos > 0 ? *(const v4u*)(p - INW + OFF_AX) : z4, gcm = pos > 0 ? *(const v4u*)(p - INW + OFF_AC) : z4;
    const v4u xap = pos < S - 1 ? *(const v4u*)(p + INW + OFF_AX) : z4, gcp = pos < S - 1 ? *(const v4u*)(p + INW + OFF_AC) : z4;
    float a0[8], c0[8], b0[8], am[8], cm[8], ap[8], cp[8];
    unpack8(xa0, a0); unpack8(gc0, c0); unpack8(gb0, b0); unpack8(xam, am); unpack8(gcm, cm); unpack8(xap, ap); unpack8(gcp, cp);
    float w0[8], w1[8], w2[8];
#pragma unroll
    for (int i = 0; i < 2; ++i) { const f32x4 a = *(const f32x4*)(cw + lane * 8 + 4 * i), b = *(const f32x4*)(cw + 512 + lane * 8 + 4 * i), c = *(const f32x4*)(cw + 1024 + lane * 8 + 4 * i);
        w0[4 * i] = a.x; w0[4 * i + 1] = a.y; w0[4 * i + 2] = a.z; w0[4 * i + 3] = a.w; w1[4 * i] = b.x; w1[4 * i + 1] = b.y; w1[4 * i + 2] = b.z; w1[4 * i + 3] = b.w;
        w2[4 * i] = c.x; w2[4 * i + 1] = c.y; w2[4 * i + 2] = c.z; w2[4 * i + 3] = c.w; }
    float o[8];
#pragma unroll
    for (int j = 0; j < 8; ++j) o[j] = b0[j] * (w0[j] * (cm[j] * am[j]) + w1[j] * (c0[j] * a0[j]) + w2[j] * (cp[j] * ap[j]));
    v4u w; w.x = pk2(o[0], o[1]); w.y = pk2(o[2], o[3]); w.z = pk2(o[4], o[5]); w.w = pk2(o[6], o[7]);
    *(v4u*)(MIX + (size_t)row * DM + MIX_A + lane * 8) = w;
}

namespace att {
using bf16x8 = __attribute__((ext_vector_type(8))) short;
using s16x4  = __attribute__((ext_vector_type(4))) short;
using f32x16 = __attribute__((ext_vector_type(16))) float;
using u32x4  = __attribute__((ext_vector_type(4))) unsigned;
constexpr int KVBLK = 64;
constexpr int SHM_V = 16384, SHM_K = 16384, SCR_OFF = 98304;
#define KSWZ(row, colB) ((row) * 256 + ((colB) ^ (((row) & 15) << 4)))
#define SBAR() __builtin_amdgcn_sched_barrier(0)
DI int crow(int r, int hi) { return (r & 3) + 8 * (r >> 2) + 4 * hi; }
DI unsigned cvtpk(float lo, float hi) { unsigned r; asm volatile("v_cvt_pk_bf16_f32 %0, %1, %2" : "=v"(r) : "v"(lo), "v"(hi)); return r; }
DI int v_st(int k, int c) { const int kk = (k & ~0xC) | ((k & 4) << 1) | ((k & 8) >> 1); return ((kk >> 3) * 4 + (c >> 5)) * 512 + ((kk & 7) * 32 + (c & 31)) * 2; }
DI int v_rd_base(int lane) { return ((lane & 3) << 3) | (((lane >> 2) & 3) << 6) | (((lane >> 4) & 1) << 5) | (((lane >> 5) & 1) << 8); }
constexpr int v_rd_off(int d0, int ks, int half) { return d0 * 512 + ks * 4096 + half * 2048; }
template <int OFF> DI s16x4 tr_read(int vb) { s16x4 r; asm volatile("ds_read_b64_tr_b16 %0, %1 offset:%2" : "=&v"(r) : "v"(vb), "i"(OFF) : "memory"); return r; }
template <int D0> DI void pv_one(f32x16& od, int vb, bf16x8 pa0, bf16x8 pa1, bf16x8 pa2, bf16x8 pa3) {
  const s16x4 l0 = tr_read<v_rd_off(D0, 0, 0)>(vb), h0 = tr_read<v_rd_off(D0, 0, 1)>(vb), l1 = tr_read<v_rd_off(D0, 1, 0)>(vb), h1 = tr_read<v_rd_off(D0, 1, 1)>(vb);
  const s16x4 l2 = tr_read<v_rd_off(D0, 2, 0)>(vb), h2 = tr_read<v_rd_off(D0, 2, 1)>(vb), l3 = tr_read<v_rd_off(D0, 3, 0)>(vb), h3 = tr_read<v_rd_off(D0, 3, 1)>(vb);
  asm volatile("s_waitcnt lgkmcnt(0)" ::: "memory"); SBAR();
#define PK(L, H) (bf16x8){L[0], L[1], L[2], L[3], H[0], H[1], H[2], H[3]}
  od = __builtin_amdgcn_mfma_f32_32x32x16_bf16(pa0, PK(l0, h0), od, 0, 0, 0);
  od = __builtin_amdgcn_mfma_f32_32x32x16_bf16(pa1, PK(l1, h1), od, 0, 0, 0);
  od = __builtin_amdgcn_mfma_f32_32x32x16_bf16(pa2, PK(l2, h2), od, 0, 0, 0);
  od = __builtin_amdgcn_mfma_f32_32x32x16_bf16(pa3, PK(l3, h3), od, 0, 0, 0);
#undef PK
}
DI void pv_d0(f32x16* o, int vb, bf16x8 pa0, bf16x8 pa1, bf16x8 pa2, bf16x8 pa3) {
  pv_one<0>(o[0], vb, pa0, pa1, pa2, pa3); pv_one<1>(o[1], vb, pa0, pa1, pa2, pa3); pv_one<2>(o[2], vb, pa0, pa1, pa2, pa3); pv_one<3>(o[3], vb, pa0, pa1, pa2, pa3);
}
template <bool SHIFT> DI void qkt(f32x16& p0, f32x16& p1, const char* Ks, const bf16x8* qr, int r32, int hi, int c, float negmb) {
  if constexpr (SHIFT) {
#pragma unroll
    for (int r = 0; r < 16; ++r) { p0[r] = negmb; p1[r] = negmb; }
  } else { p0 = f32x16{}; p1 = f32x16{}; }
#pragma unroll
  for (int d0 = 0; d0 < 4; ++d0) { const int cb = (c * 64 + d0 * 16 + hi * 8) * 2;
    const bf16x8 b0 = *reinterpret_cast<const bf16x8*>(Ks + KSWZ(r32, cb));
    const bf16x8 b1 = *reinterpret_cast<const bf16x8*>(Ks + KSWZ(32 + r32, cb));
    p0 = __builtin_amdgcn_mfma_f32_32x32x16_bf16(b0, qr[d0], p0, 0, 0, 0);
    p1 = __builtin_amdgcn_mfma_f32_32x32x16_bf16(b1, qr[d0], p1, 0, 0, 0); }
}
DI void expA(f32x16& p0) {
#pragma unroll
  for (int r = 0; r < 16; ++r) p0[r] = __builtin_amdgcn_exp2f(p0[r]);
}
DI void finishSM(f32x16& p0, f32x16& p1, float& l_reg, bf16x8& pa0, bf16x8& pa1, bf16x8& pa2, bf16x8& pa3) {
#pragma unroll
  for (int r = 0; r < 16; ++r) p1[r] = __builtin_amdgcn_exp2f(p1[r]);
  float ps = 0.f;
#pragma unroll
  for (int r = 0; r < 16; ++r) ps += p0[r];
#pragma unroll
  for (int r = 0; r < 16; ++r) ps += p1[r];
  l_reg += ps;
#define PK4(P, BASE, OUT) do { unsigned a0 = cvtpk(P[BASE + 0], P[BASE + 1]), a1 = cvtpk(P[BASE + 2], P[BASE + 3]);   \
    unsigned b0 = cvtpk(P[BASE + 4], P[BASE + 5]), b1 = cvtpk(P[BASE + 6], P[BASE + 7]);                              \
    auto r0 = __builtin_amdgcn_permlane32_swap(a0, b0, false, false); auto r1 = __builtin_amdgcn_permlane32_swap(a1, b1, false, false); \
    u32x4 w = {r0[0], r1[0], r0[1], r1[1]}; OUT = *reinterpret_cast<bf16x8*>(&w); } while (0)
  PK4(p0, 0, pa0); PK4(p0, 8, pa1); PK4(p1, 0, pa2); PK4(p1, 8, pa3);
#undef PK4
}
DI unsigned cvtpk2(float lo, float hi) { typedef float f2_t __attribute__((ext_vector_type(2))); typedef __bf16 b2_t __attribute__((ext_vector_type(2))); f2_t v = {lo, hi}; b2_t b = __builtin_convertvector(v, b2_t); return __builtin_bit_cast(unsigned, b); }
template <int I> DI void vrd(s16x4& l, s16x4& h, int vb) { constexpr int ks = I >> 2, d0 = I & 3; l = tr_read<v_rd_off(d0, ks, 0)>(vb); h = tr_read<v_rd_off(d0, ks, 1)>(vb); }
#define TIEWAIT(N, L, H) asm volatile("s_waitcnt lgkmcnt(" #N ")" : "+v"(L), "+v"(H))
#define PK4B(P, BASE, OUT) do { unsigned a0 = cvtpk2(P[BASE + 0], P[BASE + 1]), a1 = cvtpk2(P[BASE + 2], P[BASE + 3]);   \
    unsigned b0 = cvtpk2(P[BASE + 4], P[BASE + 5]), b1 = cvtpk2(P[BASE + 6], P[BASE + 7]);                              \
    auto r0 = __builtin_amdgcn_permlane32_swap(a0, b0, false, false); auto r1 = __builtin_amdgcn_permlane32_swap(a1, b1, false, false); \
    u32x4 w = {r0[0], r1[0], r0[1], r1[1]}; OUT = *reinterpret_cast<bf16x8*>(&w); } while (0)
#define PKV(L, H) (bf16x8){L[0], L[1], L[2], L[3], H[0], H[1], H[2], H[3]}
#define PVSTEP(i, N, PA, SL, SH, NL, NH) do { TIEWAIT(N, SL, SH); o[(i) & 3] = __builtin_amdgcn_mfma_f32_32x32x16_bf16(PA, PKV(SL, SH), o[(i) & 3], 0, 0, 0); \
    if constexpr ((i) + 3 < 16) vrd<((i) + 3 < 16 ? (i) + 3 : 15)>(NL, NH, vb); } while (0)
DI void finish_pv(f32x16& p0, f32x16& p1, float& l_reg, f32x16* o, int vb) {
  s16x4 l0, h0, l1, h1, l2, h2, l3, h3;
  vrd<0>(l0, h0, vb); vrd<1>(l1, h1, vb); vrd<2>(l2, h2, vb);
  bf16x8 pa0, pa1, pa2, pa3;
  PK4B(p0, 0, pa0); PK4B(p0, 8, pa1);
  PVSTEP(0, 4, pa0, l0, h0, l3, h3); PVSTEP(1, 4, pa0, l1, h1, l0, h0); PVSTEP(2, 4, pa0, l2, h2, l1, h1); PVSTEP(3, 4, pa0, l3, h3, l2, h2);
  PVSTEP(4, 4, pa1, l0, h0, l3, h3); PVSTEP(5, 4, pa1, l1, h1, l0, h0); PVSTEP(6, 4, pa1, l2, h2, l1, h1); PVSTEP(7, 4, pa1, l3, h3, l2, h2);
  PK4B(p1, 0, pa2); PK4B(p1, 8, pa3);
  PVSTEP(8, 4, pa2, l0, h0, l3, h3); PVSTEP(9, 4, pa2, l1, h1, l0, h0); PVSTEP(10, 4, pa2, l2, h2, l1, h1); PVSTEP(11, 4, pa2, l3, h3, l2, h2);
  PVSTEP(12, 4, pa3, l0, h0, l3, h3); PVSTEP(13, 4, pa3, l1, h1, l0, h0); PVSTEP(14, 2, pa3, l2, h2, l1, h1); PVSTEP(15, 0, pa3, l3, h3, l2, h2);
  float ps = 0.f;
#pragma unroll
  for (int r = 0; r < 16; ++r) ps += p0[r];
#pragma unroll
  for (int r = 0; r < 16; ++r) ps += p1[r];
  l_reg += ps;
}
DI void glds16(const void* gsrc, unsigned lds_dst) { unsigned keep;
  asm volatile("s_mov_b32 %0, m0\n\ts_mov_b32 m0, %2\n\ts_nop 0\n\tglobal_load_lds_dwordx4 %1, off\n\ts_mov_b32 m0, %0" : "=&s"(keep) : "v"(gsrc), "s"(lds_dst) : "memory"); }
#define WAIT_BAR(N) asm volatile("s_waitcnt vmcnt(" #N ") lgkmcnt(0)\n\ts_barrier" ::: "memory")
template <bool SHIFT> DI void attn_unit(const bf16* __restrict__ Qb, const bf16* __restrict__ Kh, const bf16* __restrict__ Vh, bf16* __restrict__ Ob, int seq, char* lds,
                  float negmb, float lam, const float* __restrict__ gsub, float post) {
  int tid = threadIdx.x; asm volatile("" : "+v"(tid));
  const int lane = tid & 63, r32 = lane & 31, hi = lane >> 5; const int wid = __builtin_amdgcn_readfirstlane(tid >> 6), c = wid >> 2, wq = wid & 3;
  char* K_ring = lds; char* V_ring = lds + 3 * SHM_K;
  float* wsf = (float*)(lds + SCR_OFF) + wid * 64;
  const unsigned lds0 = (unsigned)(uintptr_t)lds;
  float l_reg = 0.f; f32x16 o[4] = {}; bf16x8 qr[4];
  const bf16* Qw = Qb + (size_t)(wq * 32 + r32) * INW + c * 64 + hi * 8;
#pragma unroll
  for (int d0 = 0; d0 < 4; ++d0) qr[d0] = *reinterpret_cast<const bf16x8*>(Qw + d0 * 16);
  const bf16* ksrc0; const bf16* ksrc1; const bf16* vsrc0; const bf16* vsrc1;
  { const int row0 = 8 * wid + (lane >> 4), row1 = row0 + 4, cp = lane & 15;
    ksrc0 = Kh + (size_t)row0 * INW + ((cp ^ (row0 & 15)) << 3); ksrc1 = Kh + (size_t)row1 * INW + ((cp ^ (row1 & 15)) << 3);
    const int kk = 8 * wid + ((lane & 31) >> 2), kkey = (kk & ~0xC) | ((kk & 4) << 1) | ((kk & 8) >> 1), cc = (lane >> 5) * 32 + (lane & 3) * 8;
    vsrc0 = Vh + (size_t)kkey * INW + cc; vsrc1 = vsrc0 + 64; }
  const unsigned kdst = lds0 + (unsigned)wid * 2048u, vdst = lds0 + 3u * SHM_K + (unsigned)wid * 2048u;
#define DMA_K(t, slot) do { const size_t to_ = (size_t)(t) * (KVBLK * INW); const unsigned d_ = (unsigned)__builtin_amdgcn_readfirstlane(kdst + (unsigned)(slot)); glds16(ksrc0 + to_, d_); glds16(ksrc1 + to_, d_ + 1024u); } while (0)
#define DMA_V(t, slot) do { const size_t to_ = (size_t)(t) * (KVBLK * INW); const unsigned d_ = (unsigned)__builtin_amdgcn_readfirstlane(vdst + (unsigned)(slot)); glds16(vsrc0 + to_, d_); glds16(vsrc1 + to_, d_ + 1024u); } while (0)
  const int vb0 = (int)(lds0 + 3u * SHM_K) + v_rd_base(lane);
  f32x16 pA0, pA1, pB0, pB1; const int NT = seq / KVBLK;
  int s0 = 0, s1 = SHM_K, s2 = 2 * SHM_K;
#define ROT() do { const int t_ = s0; s0 = s1; s1 = s2; s2 = t_; } while (0)
  DMA_K(0, 0); DMA_K(1, SHM_K); DMA_V(0, 0);
  WAIT_BAR(4);
  DMA_K(2, 2 * SHM_K); DMA_V(1, SHM_K);
  qkt<SHIFT>(pA0, pA1, K_ring, qr, r32, hi, c, negmb); expA(pA0); expA(pA1);
#define ITER(CUR0, CUR1, PRV0, PRV1, j) do { \
    WAIT_BAR(4); \
    { const int tk_ = ((j) + 2 < NT) ? (j) + 2 : NT - 1, tv_ = ((j) + 1 < NT) ? (j) + 1 : NT - 1; DMA_K(tk_, s0); DMA_V(tv_, s2); } \
    SBAR(); qkt<SHIFT>(CUR0, CUR1, K_ring + s1, qr, r32, hi, c, negmb); \
    finish_pv(PRV0, PRV1, l_reg, o, vb0 + s0); expA(CUR0); expA(CUR1); \
    ROT(); } while (0)
  for (int j = 1; j + 1 < NT; j += 2) {
    ITER(pB0, pB1, pA0, pA1, j);
    ITER(pA0, pA1, pB0, pB1, j + 1);
  }
  ITER(pB0, pB1, pA0, pA1, NT - 1);
  WAIT_BAR(0);
  finish_pv(pB0, pB1, l_reg, o, vb0 + s0);
#undef ITER
#undef ROT
#undef DMA_K
#undef DMA_V
  int lane_e = lane; asm volatile("" : "+v"(lane_e));
  {
  const int lane = lane_e, r32 = lane & 31, hi = lane >> 5;
  { auto rr = __builtin_amdgcn_permlane32_swap(__float_as_uint(l_reg), __float_as_uint(l_reg), false, false); l_reg = __uint_as_float(rr[0]) + __uint_as_float(rr[1]); }
  if (hi == 0) wsf[r32] = l_reg;
  asm volatile("s_waitcnt lgkmcnt(0)" ::: "memory");
  __syncthreads();
  float* X = (float*)lds + wq * 4096;
  if (c == 1) {
#pragma unroll
    for (int r = 0; r < 16; ++r) { const float rl = __builtin_amdgcn_rcpf(wsf[crow(r, hi)]);
#pragma unroll
      for (int d0 = 0; d0 < 4; ++d0) X[(d0 * 16 + r) * 64 + lane] = o[d0][r] * rl; }
  }
  __syncthreads();
  if (c == 0) {
    float g4[4];
#pragma unroll
    for (int d0 = 0; d0 < 4; ++d0) g4[d0] = gsub[32 * d0 + r32] * post;
#pragma unroll
    for (int r = 0; r < 16; ++r) { const float rl = __builtin_amdgcn_rcpf(wsf[crow(r, hi)]); float dv[4]; float s = 0.f;
#pragma unroll
      for (int d0 = 0; d0 < 4; ++d0) { dv[d0] = o[d0][r] * rl - lam * X[(d0 * 16 + r) * 64 + lane]; s += dv[d0] * dv[d0]; }
#pragma unroll
      for (int off = 1; off < 32; off <<= 1) s += __shfl_xor(s, off);
      const float rs = 1.0f / sqrtf(s * (1.f / 128.f) + EPS); bf16* orow = Ob + (size_t)(wq * 32 + crow(r, hi)) * DM + r32;
#pragma unroll
      for (int d0 = 0; d0 < 4; ++d0) orow[32 * d0] = (bf16)(pk2(dv[d0] * rs * g4[d0], 0.f) & 0xffffu); }
  }
  }
  __syncthreads();
}
#undef SBAR
}

DI void sgu_unit(const bf16* P, bf16* MIX, int chunk, int hd, const float* Ws, const float* bs, const float* gv, char* lds) {
    using att::bf16x8; using att::f32x16;
    int tid = threadIdx.x; asm volatile("" : "+v"(tid));
    const int wid = tid >> 6, lane = tid & 63, r32 = lane & 31, hi = lane >> 5;
    bf16* vnT = (bf16*)lds;
    { const int p = tid >> 2, qtr = tid & 3; const bf16* src = P + (size_t)(chunk * 128 + p) * INW + OFF_CV + hd * 128 + qtr * 32;
      v4u raw[4];
#pragma unroll
      for (int i = 0; i < 4; ++i) raw[i] = *(const v4u*)(src + 8 * i);
      float x[32];
#pragma unroll
      for (int i = 0; i < 4; ++i) unpack8(raw[i], x + 8 * i);
      float ss = 0.f;
#pragma unroll
      for (int i = 0; i < 32; ++i) { x[i] = gelu_tanh(x[i]); ss += x[i] * x[i]; }
      ss += __shfl_xor(ss, 1); ss += __shfl_xor(ss, 2);
      const float rstd = 1.0f / sqrtf(ss * (1.f / 128.f) + EPS);
#pragma unroll
      for (int i = 0; i < 32; ++i) { const float v = x[i] * rstd * gv[qtr * 32 + i]; vnT[(qtr * 32 + i) * 136 + p] = (bf16)(pk2(v, 0.f) & 0xffffu); }
    }
    __syncthreads();
    const int qb = wid >> 1;
    bf16x8 a[8];
#pragma unroll
    for (int ks = 0; ks < 8; ++ks) { const float* w = Ws + (size_t)(32 * qb + r32) * 128 + 16 * ks + 8 * hi; const f32x4 w0 = *(const f32x4*)w, w1 = *(const f32x4*)(w + 4);
        att::u32x4 u = {pk2(w0.x, w0.y), pk2(w0.z, w0.w), pk2(w1.x, w1.y), pk2(w1.z, w1.w)}; a[ks] = *reinterpret_cast<bf16x8*>(&u); }
#pragma unroll
    for (int dd = 0; dd < 2; ++dd) { const int db = 2 * (wid & 1) + dd;
        f32x16 acc = {};
#pragma unroll
        for (int ks = 0; ks < 8; ++ks) { const bf16x8 b = *reinterpret_cast<const bf16x8*>(vnT + (32 * db + r32) * 136 + 16 * ks + 8 * hi);
            acc = __builtin_amdgcn_mfma_f32_32x32x16_bf16(a[ks], b, acc, 0, 0, 0); }
        const int d = 32 * db + r32;
#pragma unroll
        for (int i = 0; i < 16; ++i) { const int q = 32 * qb + att::crow(i, hi); const size_t tok = (size_t)chunk * 128 + q;
            const float uval = gelu_tanh(__uint_as_float((unsigned)P[tok * INW + OFF_CU + hd * 128 + d] << 16));
            MIX[tok * DM + MIX_C + hd * 128 + d] = (bf16)(pk2(uval * (acc[i] + bs[q]), 0.f) & 0xffffu); }
    }
    __syncthreads();
}

#define LAS __attribute__((address_space(3)))
#define XB_TMO      128
#define XB_XCNT(j)  (256  + 64 * (j))
#define XB_XSUB(j)  (1280 + 64 * (j))
#define XB_XGEN(j)  (2304 + 64 * (j))
#define XB_TOP      3328
#define XB_TOPGEN   3392
#define XCD_BAR_WORDS 3456
#define XB_SPIN_CAP (1u << 18)

__device__ __forceinline__ unsigned xb_ld(unsigned* p)              { return __hip_atomic_load(p, __ATOMIC_RELAXED, __HIP_MEMORY_SCOPE_AGENT); }
__device__ __forceinline__ unsigned xb_add(unsigned* p, unsigned v) { return __hip_atomic_fetch_add(p, v, __ATOMIC_RELAXED, __HIP_MEMORY_SCOPE_AGENT); }
__device__ __forceinline__ unsigned xb_xcc_id() { return (unsigned)__builtin_amdgcn_s_getreg((3 << 11) | 20) & 0xFu; }
#define XB_SPIN(cond, bar) do { unsigned _sp = 0; while (cond) { __builtin_amdgcn_s_sleep(1); \
    if ((++_sp & 255u) == 0u) { if (xb_ld(&(bar)[XB_TMO])) break; if (_sp > XB_SPIN_CAP) { atomicAdd(&(bar)[XB_TMO], 1u); break; } } } } while (0)

struct XcdBarrier {
    unsigned* bar; unsigned x;
    volatile LAS unsigned* st;
};

__device__ __forceinline__ XcdBarrier xcd_barrier_post(unsigned* bar, volatile LAS unsigned* st) {
    XcdBarrier b; b.bar = bar; b.x = xb_xcc_id(); b.st = st;
    if (threadIdx.x == 0) (void)xb_add(&bar[XB_XCNT(b.x)], 1u);
    return b;
}
__device__ __forceinline__ void xcd_barrier_complete(unsigned* bar, unsigned x, unsigned& nloc, unsigned& nx) {
    const unsigned G = gridDim.x * gridDim.y * gridDim.z;
    unsigned sum, cnt, mine, sp = 0u;
    for (;;) {
        sum = 0u; cnt = 0u; mine = 0u;
#pragma unroll
        for (unsigned j = 0; j < 16; ++j) { const unsigned c = xb_ld(&bar[XB_XCNT(j)]); sum += c; cnt += (c > 0u) ? 1u : 0u; mine = (j == x) ? c : mine; }
        if (sum == G) break;
        __builtin_amdgcn_s_sleep(1);
        if ((++sp & 255u) == 0u) { if (xb_ld(&bar[XB_TMO])) break; if (sp > XB_SPIN_CAP) { atomicAdd(&bar[XB_TMO], 1u); break; } }
    }
    nloc = mine > 0u ? mine : 1u; nx = cnt > 0u ? cnt : 1u;
}

__device__ __forceinline__ void xcd_barrier(const XcdBarrier& b) {
    asm volatile("s_waitcnt vmcnt(0)" ::: "memory");
    __syncthreads();
    if (threadIdx.x == 0) {
        unsigned* bar = b.bar;
        __builtin_amdgcn_s_waitcnt(0);
        unsigned nloc = b.st[0], nx = b.st[1];
        if (nloc == 0u) { xcd_barrier_complete(bar, b.x, nloc, nx); b.st[0] = nloc; b.st[1] = nx; }
        const unsigned old = xb_add(&bar[XB_XSUB(b.x)], 1u);
        const unsigned gen = old / nloc;
        if (old + 1u == (gen + 1u) * nloc) {
            __builtin_amdgcn_fence(__ATOMIC_RELEASE, "agent");
            asm volatile("s_waitcnt vmcnt(0)" ::: "memory");
            const unsigned og = xb_add(&bar[XB_TOP], 1u);
            const unsigned tg = og / nx;
            if (og + 1u == (tg + 1u) * nx) xb_add(&bar[XB_TOPGEN], 1u);
            else XB_SPIN(xb_ld(&bar[XB_TOPGEN]) == tg, bar);
            __builtin_amdgcn_fence(__ATOMIC_ACQUIRE, "agent");
            xb_add(&bar[XB_XGEN(b.x)], 1u);
            asm volatile("s_waitcnt vmcnt(0)" ::: "memory");
        } else {
            XB_SPIN(xb_ld(&bar[XB_XGEN(b.x)]) == gen, bar);
            __builtin_amdgcn_fence(__ATOMIC_ACQUIRE, "agent");
            asm volatile("s_waitcnt vmcnt(0)" ::: "memory");
        }
    }
    __syncthreads();
}

struct Args { const float* in[19]; float* out; unsigned char* ws; int ph_lo, ph_hi; };
constexpr int N_PHASES = 1 + 6 * NLAYER;

__global__ void __launch_bounds__(NWAVES * 64, 2) mk_fwd(Args args) {
    extern __shared__ __attribute__((aligned(16))) unsigned char lds[];
    cg::grid_group grid = cg::this_grid();
    const int G = gridDim.x; const int bx = blockIdx.x; const int vcu = (G % 8 == 0) ? (bx % 8) * (G / 8) + bx / 8 : bx;
    const int NGW = G * NWAVES;
    unsigned char* ws = args.ws;
    const float* xp = args.in[0]; const float* xs = args.in[1];
    float* out = args.out;
    bf16* XN = (bf16*)(ws + WS_XN); bf16* PROJ = (bf16*)(ws + WS_PROJ); bf16* MIX = (bf16*)(ws + WS_MIX); bf16* HB = (bf16*)(ws + WS_H);

    volatile LAS unsigned* MISC = (volatile LAS unsigned*)((LAS unsigned char*)lds + 131072 + 320);
    if (threadIdx.x < 32) MISC[threadIdx.x] = 0u;
    __syncthreads();
    const XcdBarrier bar = xcd_barrier_post((unsigned*)ws, MISC + 8);
    for (int ph = args.ph_lo; ph < args.ph_hi; ++ph) {
        int tid = threadIdx.x; asm volatile("" : "+v"(tid));
        const int lane = tid & 63, wave = __builtin_amdgcn_readfirstlane(tid >> 6), gw = vcu * NWAVES + wave;
        const int l = (ph - 1) / 6, k = (ph == 0) ? -1 : ((ph - 1) % 6);
        float* const RS = (float*)(ws + 65536);
        const unsigned char* wl = ws + WS_WT + (size_t)(l < 0 ? 0 : l) * WT_LAYER;
        if (ph == 0) {
#if PHM & 1
            for (int rep = 0; rep < PROBE_REP_MISC; ++rep) {
            float* scr = (float*)(lds + wave * 16384);
            constexpr int I_IN = 32 * 176, I_OUT = 32 * 64, I_UP = 32 * 256, I_DN = 128 * 64, I_L = I_IN + I_OUT + I_UP + I_DN;
            for (int it = gw; it < NLAYER * I_L; it += NGW) {
                const int ll = it / I_L; int r = it % I_L; unsigned char* wb = ws + WS_WT + (size_t)ll * WT_LAYER;
                if (r < I_IN) { transpose_item(args.in[3] + (size_t)ll * DM * INW, DM, INW, (bf16*)(wb + WT_IN), DM, args.in[2] + ll * DM, scr, r, lane); continue; } r -= I_IN;
                if (r < I_OUT) { transpose_item(args.in[15] + (size_t)ll * DM * DM, DM, DM, (bf16*)(wb + WT_OUT), DM, nullptr, scr, r, lane); continue; } r -= I_OUT;
                if (r < I_UP) { transpose_item(args.in[17] + (size_t)ll * DM * DFF, DM, DFF, (bf16*)(wb + WT_UP), DM, args.in[16] + ll * DM, scr, r, lane); continue; } r -= I_UP;
                transpose_item(args.in[18] + (size_t)ll * DFF * DM, DFF, DM, (bf16*)(wb + WT_DN), LDH, nullptr, scr, r, lane);
            }
            for (int m = gw; m < M_ALL; m += NGW) xb_row(m < MP ? xp + (size_t)m * DM : xs + (size_t)(m - MP) * DM, XN + (size_t)m * DM, RS + m, lane);
            for (int i = gw * 64 + lane; i < 3 * M_ALL; i += NGW * 64) RS[M_ALL + i] = 0.f;
            }
#endif
        } else if (k == 0) {
#if PHM & 2
            pg8::Gemm g{XN, (const bf16*)(wl + WT_IN), M_ALL, INW, DM, DM, DM}; pg8::StaticOrder S; S.init(M_ALL, INW, G, bx);
            pg8::EpiBf16<0> E{PROJ, INW, RS + (size_t)(2 * l) * M_ALL};
            for (int rep = 0; rep < PROBE_REP_WIN; ++rep)
            pg8::gemm_phase<pg8::EpiBf16<0>, pg8::StaticOrder, true, true>((PG8_LAS unsigned char*)lds, g, S, E);
#endif
        } else if (k == 1) {
#if PHM & 4
            const float* qg = args.in[5] + l * 64; const float* kg = args.in[6] + l * 64; const float* cw = args.in[4] + l * 1536;
            for (int m = gw; m < M_ALL; m += NGW) {
                const int pos = m < MP ? (m & (SEQ_P - 1)) : ((m - MP) & (SEQ_S - 1)); const int S = m < MP ? SEQ_P : SEQ_S;
                qk_row(PROJ, m, pos, qg, kg, lane);
                conv_row(PROJ, MIX, m, pos, S, cw, lane);
            }
            for (int u = vcu; u < (M_ALL / 128) * 4; u += G) { const int chunk = u >> 2, hd = u & 3;
                sgu_unit(PROJ, MIX, chunk, hd, args.in[13] + ((size_t)l * 4 + hd) * 128 * 128, args.in[14] + (l * 4 + hd) * 128, args.in[12] + l * 128, (char*)lds); }
#endif
        } else if (k == 2) {
#if PHM & 8
            const float linit = (l == 0) ? 0.2f : 0.35550906759096934f;
            const float s1 = wave_sum(args.in[7][l * 64 + lane] * args.in[8][l * 64 + lane]), s2 = wave_sum(args.in[9][l * 64 + lane] * args.in[10][l * 64 + lane]);
            const float lam = __uint_as_float(__builtin_amdgcn_readfirstlane(__float_as_uint(expf(s1) - expf(s2) + linit)));
            const float gq = wave_max(fabsf(args.in[5][l * 64 + lane])), gk = wave_max(fabsf(args.in[6][l * 64 + lane]));
            const float negmb = __uint_as_float(__builtin_amdgcn_readfirstlane(__float_as_uint(-(C2 * 64.0f * gq * gk))));
            for (int rep = 0; rep < PROBE_REP_ATT; ++rep)
            for (int t = vcu; t < 2560; t += G) {
                int pair, qb, seq, seqrow0;
                if (t < 2048) { const int i = t >> 8, v = t & 255; const int idx = (v >> 5) * 256 + i * 32 + (v & 31); pair = idx >> 7; qb = idx & 127; seq = SEQ_S; seqrow0 = MP + (pair >> 3) * SEQ_S; }
                else { const int t2 = t - 2048, i = t2 >> 8, v = t2 & 255; pair = 2 * (v >> 5) + i; qb = v & 31; seq = SEQ_P; seqrow0 = (pair >> 3) * SEQ_P; }
                const int h = pair & 7; const size_t row0 = (size_t)seqrow0 + (size_t)qb * 128;
                if (negmb >= -64.0f)
                att::attn_unit<false>(PROJ + row0 * INW + OFF_Q + h * 128, PROJ + (size_t)seqrow0 * INW + OFF_K + h * 128, PROJ + (size_t)seqrow0 * INW + OFF_V + h * 128,
                               MIX + row0 * DM + MIX_B + h * 128, seq, (char*)lds, 0.f, lam, args.in[11] + l * 128, 1.0f - linit);
                else
                att::attn_unit<true>(PROJ + row0 * INW + OFF_Q + h * 128, PROJ + (size_t)seqrow0 * INW + OFF_K + h * 128, PROJ + (size_t)seqrow0 * INW + OFF_V + h * 128,
                               MIX + row0 * DM + MIX_B + h * 128, seq, (char*)lds, negmb, lam, args.in[11] + l * 128, 1.0f - linit);
            }
#endif
        } else if (k == 3 || k == 5) {
#if PHM & 16
            pg8::Gemm g; if (k == 3) g = pg8::Gemm{MIX, (const bf16*)(wl + WT_OUT), M_ALL, DM, DM, DM, DM}; else g = pg8::Gemm{HB, (const bf16*)(wl + WT_DN), M_ALL, DM, DFF, LDH, LDH};
            pg8::StaticOrder S; S.init(M_ALL, DM, G, bx);
            pg8::EpiResF32 E;
            if (k == 3 && l == 0) E = pg8::EpiResF32{xp, xs, MP / 256, nullptr, nullptr, DM, XN, DM, RS + (size_t)1 * M_ALL};
            else if (k == 3) E = pg8::EpiResF32{nullptr, nullptr, 0, XN, nullptr, DM, XN, DM, RS + (size_t)3 * M_ALL};
            else if (l == 0) E = pg8::EpiResF32{nullptr, nullptr, 0, XN, nullptr, DM, XN, DM, RS + (size_t)2 * M_ALL};
            else E = pg8::EpiResF32{nullptr, nullptr, 0, XN, out, DM, nullptr, DM, nullptr};
            pg8::gemm_phase<pg8::EpiResF32, pg8::StaticOrder, true, true>((PG8_LAS unsigned char*)lds, g, S, E);
#endif
        } else {
#if PHM & 64
            pg8::Gemm g{XN, (const bf16*)(wl + WT_UP), M_ALL, DFF, DM, DM, DM}; pg8::StaticOrder S; S.init(M_ALL, DFF, G, bx);
            pg8::EpiBf16<2> E{HB, LDH, RS + (size_t)(2 * l + 1) * M_ALL};
            for (int rep = 0; rep < PROBE_REP_UP; ++rep)
            pg8::gemm_phase<pg8::EpiBf16<2>, pg8::StaticOrder, true, true>((PG8_LAS unsigned char*)lds, g, S, E);
#endif
        }
        if (ph + 1 < args.ph_hi) { if (ph == args.ph_lo) grid.sync(); else xcd_barrier(bar); }
    }
}

extern "C" void kernel_launch(void* const* d_in, const int* in_sizes, int n_in, void* d_out, int out_size, void* d_ws, size_t ws_size, hipStream_t stream) {
    static int grid = 0;
    if (grid == 0) {
        if (n_in != 19 || out_size != M_ALL * DM || ws_size < WS_END) { fprintf(stderr, "kernel_launch: unexpected shapes: n_in %d out %d ws %zu (need %zu)\n", n_in, out_size, ws_size, (size_t)WS_END); grid = -1; return; }
        int dev = 0, cus = 0, per_cu = 0;
        if (hipGetDevice(&dev) != hipSuccess || hipDeviceGetAttribute(&cus, hipDeviceAttributeMultiprocessorCount, dev) != hipSuccess) { fprintf(stderr, "kernel_launch: device query failed\n"); grid = -1; return; }
        if (hipFuncSetAttribute((const void*)mk_fwd, hipFuncAttributeMaxDynamicSharedMemorySize, LDS_BYTES) != hipSuccess) { fprintf(stderr, "kernel_launch: hipFuncSetAttribute failed\n"); grid = -1; return; }
        if (hipOccupancyMaxActiveBlocksPerMultiprocessor(&per_cu, (const void*)mk_fwd, NWAVES * 64, LDS_BYTES) != hipSuccess || per_cu < 1) { fprintf(stderr, "kernel_launch: occupancy query gave %d\n", per_cu); per_cu = 1; }
        (void)hipGetLastError();
        grid = cus * 1;
        fprintf(stderr, "kernel_launch: grid %d (cus %d, per_cu %d)\n", grid, cus, per_cu);
    }
    if (grid < 0) return;
    if (hipMemsetAsync(d_ws, 0, 65536, stream) != hipSuccess) { fprintf(stderr, "kernel_launch: memset failed\n"); return; }
    Args a{};
    for (int i = 0; i < 19; ++i) a.in[i] = (const float*)d_in[i];
    a.out = (float*)d_out; a.ws = (unsigned char*)d_ws;
#if MK_SINGLE
    a.ph_lo = 0; a.ph_hi = N_PHASES;
    { void* kargs[] = {&a}; hipError_t e = hipLaunchCooperativeKernel((const void*)mk_fwd, dim3(grid), dim3(NWAVES * 64), kargs, LDS_BYTES, stream);
      if (e != hipSuccess) fprintf(stderr, "kernel_launch: cooperative launch failed: %s\n", hipGetErrorString(e)); }
#else
    for (int ph = 0; ph < N_PHASES; ++ph) { a.ph_lo = ph; a.ph_hi = ph + 1; void* kargs[] = {&a};
        hipError_t e = hipLaunchCooperativeKernel((const void*)mk_fwd, dim3(grid), dim3(NWAVES * 64), kargs, LDS_BYTES, stream);
        if (e != hipSuccess) { fprintf(stderr, "kernel_launch: cooperative launch %d failed: %s\n", ph, hipGetErrorString(e)); break; } }
#endif
}
```

```cpp
#include <hip/hip_runtime.h>
#include <hip/hip_cooperative_groups.h>
#include <hip/hip_bf16.h>
#include <cstdio>
#include <cstdint>
namespace cg = cooperative_groups;
namespace pg8 {
#define PG8_LAS __attribute__((address_space(3)))
typedef unsigned short bf16_t;
typedef short bf16x8 __attribute__((ext_vector_type(8)));
typedef float f32x4 __attribute__((ext_vector_type(4)));
typedef unsigned u32x4 __attribute__((ext_vector_type(4)));
constexpr int BM = 256, BK = 64, HALF = 128, HTB = HALF * BK * 2  , STAGE_BYTES = 8 * HTB, NXCD = 8, WGM = 8;

__host__ __device__ __forceinline__ int lds_byte(int r, int c) { const int st = (r >> 4) * 2 + (c >> 5), rr = r & 15, cc = c & 31, ob = rr * 64 + cc * 2; return st * 1024 + (ob ^ (((ob >> 9) & 1) << 5)); }
__host__ __device__ __forceinline__ void stage_rc(int b, int& R, int& C) { const int st = b / 1024, sb = b % 1024, swz = sb ^ (((sb >> 9) & 1) << 5); R = (st >> 1) * 16 + swz / 64; C = (st & 1) * 32 + (swz % 64) / 2; }
__host__ __device__ __forceinline__ int perm32(int rho) { const int n = rho >> 4, i = rho & 15; return 8 * (i >> 2) + 4 * n + (i & 3); }

struct Unit { int pm, pn; };
struct Gemm { const bf16_t* A; const bf16_t* Bt; int M, N, K, lda, ldb; };

struct StaticOrder {
    int nM, nN, nwg, G, c;
    __host__ __device__ void init(int M, int N, int G_, int c_) { nM = M / BM; nN = N / BM; nwg = nM * nN; G = G_; c = c_; }
    __host__ __device__ bool next(int i, Unit& u) const {
        const long L = (long)i * G + c; if (L >= nwg) return false;
        int wgid = (int)L; { const int q = nwg / NXCD, r = nwg % NXCD, xcd = wgid % NXCD, off = wgid / NXCD; wgid = (xcd < r ? xcd * (q + 1) : r * (q + 1) + (xcd - r) * q) + off; }
        const int nig = WGM * nN, gid = wgid / nig, fm = gid * WGM, gsz = (nM - fm) < WGM ? (nM - fm) : WGM;
        u.pm = fm + ((wgid % nig) % gsz); u.pn = (wgid % nig) / gsz; return true;
    }
    __device__ __forceinline__ void a_ready(const Unit&) const {}
    __device__ __forceinline__ void done(const Unit&) const {}
};

__device__ __forceinline__ unsigned cvt_pk_bf16(float lo, float hi) { unsigned r; asm volatile("v_cvt_pk_bf16_f32 %0, %1, %2" : "=v"(r) : "v"(lo), "v"(hi)); return r; }
typedef float f32x2 __attribute__((ext_vector_type(2)));
typedef unsigned u32x2 __attribute__((ext_vector_type(2)));
template <int ACT> struct EpiBf16 {
    static constexpr bool PERM = true, AFTER_DRAIN = false;
    bf16_t* O; int ldc; const float* rowss;
    __device__ __forceinline__ void operator()(const f32x4 (&acc)[2][2][4][2], const Unit& u, int wr, int wc, int fr, int fq) const {
        const int row0 = u.pm * BM + wr * 64 + fr; const int col0 = u.pn * BM + wc * 32 + 8 * fq;
        float rs[2][4];
#pragma unroll
        for (int ai = 0; ai < 2; ++ai)
#pragma unroll
            for (int m = 0; m < 4; ++m) rs[ai][m] = rowss[row0 + ai * HALF + m * 16];
#pragma unroll
        for (int ai = 0; ai < 2; ++ai)
#pragma unroll
            for (int m = 0; m < 4; ++m) { bf16_t* rowp = O + (size_t)(row0 + ai * HALF + m * 16) * ldc + col0;
                const float sc = 1.0f / sqrtf(rs[ai][m] * (1.0f / 2048.0f) + 1e-6f);
#pragma unroll
                for (int bj = 0; bj < 2; ++bj) { f32x4 v0 = acc[ai][bj][m][0] * sc, v1 = acc[ai][bj][m][1] * sc;
                    if (ACT == 2) {
#pragma unroll
                        for (int e = 0; e < 4; ++e) { float a = fmaxf(v0[e], 0.f), b = fmaxf(v1[e], 0.f); v0[e] = a * a; v1[e] = b * b; } }
                    u32x4 w; w.x = cvt_pk_bf16(v0[0], v0[1]); w.y = cvt_pk_bf16(v0[2], v0[3]); w.z = cvt_pk_bf16(v1[0], v1[1]); w.w = cvt_pk_bf16(v1[2], v1[3]);
                    *(u32x4*)(rowp + bj * HALF) = w; } }
    }
};
struct EpiResF32 {
    static constexpr bool PERM = true, AFTER_DRAIN = false;
    const float* res_lo; const float* res_hi; int split_pm; const bf16_t* resb; float* out; int ldc; bf16_t* xb; int ldx; float* rowss;
    __device__ __forceinline__ void operator()(const f32x4 (&acc)[2][2][4][2], const Unit& u, int wr, int wc, int fr, int fq) const {
        const float* rbase = (u.pm < split_pm) ? res_lo : (res_hi - (size_t)split_pm * BM * ldc);
        const int col0 = u.pn * BM + wc * 32 + 8 * fq;
#pragma unroll
        for (int ai = 0; ai < 2; ++ai)
#pragma unroll
            for (int m = 0; m < 4; ++m) { const int row = u.pm * BM + ai * HALF + wr * 64 + m * 16 + fr; const size_t off = (size_t)row * ldc + col0, offb = (size_t)row * ldx + col0; float ss = 0.f;
#pragma unroll
                for (int bj = 0; bj < 2; ++bj) {
                    f32x4 v0, v1;
                    if (resb) { const u32x4 r = *(const u32x4*)(resb + offb + bj * HALF);
                        v0 = (f32x4){__uint_as_float(r.x << 16), __uint_as_float(r.x & 0xffff0000u), __uint_as_float(r.y << 16), __uint_as_float(r.y & 0xffff0000u)};
                        v1 = (f32x4){__uint_as_float(r.z << 16), __uint_as_float(r.z & 0xffff0000u), __uint_as_float(r.w << 16), __uint_as_float(r.w & 0xffff0000u)}; }
                    else { v0 = *(const f32x4*)(rbase + off + bj * HALF); v1 = *(const f32x4*)(rbase + off + bj * HALF + 4); }
                    v0 += acc[ai][bj][m][0]; v1 += acc[ai][bj][m][1];
                    if (out) { *(f32x4*)(out + off + bj * HALF) = v0; *(f32x4*)(out + off + bj * HALF + 4) = v1; }
                    if (xb) { u32x4 w; w.x = cvt_pk_bf16(v0[0], v0[1]); w.y = cvt_pk_bf16(v0[2], v0[3]); w.z = cvt_pk_bf16(v1[0], v1[1]); w.w = cvt_pk_bf16(v1[2], v1[3]);
                        *(u32x4*)(xb + offb + bj * HALF) = w;
                        ss += (v0[0] * v0[0] + v0[1] * v0[1]) + (v0[2] * v0[2] + v0[3] * v0[3]) + (v1[0] * v1[0] + v1[1] * v1[1]) + (v1[2] * v1[2] + v1[3] * v1[3]); } }
                if (xb) { ss += __shfl_xor(ss, 16); ss += __shfl_xor(ss, 32);
                    if (fq == 0) __hip_atomic_fetch_add(rowss + row, ss, __ATOMIC_RELAXED, __HIP_MEMORY_SCOPE_AGENT); }
                if (m == 3) asm volatile("" ::: "memory"); }
    }
};
template <class Epi, class Sched, bool ALIGN_EPI = false, bool SP2 = false>
__device__ __forceinline__ void gemm_phase(PG8_LAS unsigned char* lds, const Gemm g, const Sched& S, const Epi& E) {
    int tid = threadIdx.x; asm volatile("" : "+v"(tid));
    const int wid = __builtin_amdgcn_readfirstlane(tid >> 6), lane = tid & 63, wr = wid >> 2, wc = wid & 3, fr = lane & 15, fq = lane >> 4;
    const int K = g.K, nt = K / BK;
    unsigned voffA[2], voffB[2];
#pragma unroll
    for (int i = 0; i < 2; ++i) { int R, C; stage_rc(tid * 16 + i * 8192, R, C); const int Rb = Epi::PERM ? ((R & ~31) + perm32(R & 31)) : R;
        voffA[i] = (unsigned)(R * g.lda + C) * 2u; voffB[i] = (unsigned)(Rb * g.ldb + C) * 2u; }
    const size_t kstep = (size_t)(BK * 2);
    const size_t hstepA = (size_t)HALF * g.lda * 2, hstepB = (size_t)HALF * g.ldb * 2;
    const size_t tstepA = 2 * hstepA, tstepB = 2 * hstepB;
    const unsigned ldsw = (unsigned)wid * 1024u;
    const int aoff = lds_byte(wr * 64 + fr, fq * 8), boff = lds_byte(wc * 32 + fr, fq * 8);
#define PG8_SA(b, h) (((b) * 2 + (h)) * HTB)
#define PG8_SB(b, h) ((4 + (b) * 2 + (h)) * HTB)
#define PG8_STAGE(bufoff, gbase, voff) do { _Pragma("unroll") for (int _i = 0; _i < 2; ++_i) \
        __builtin_amdgcn_global_load_lds((const unsigned*)((const char*)(gbase) + (voff)[_i]), (PG8_LAS unsigned*)(lds + (bufoff) + ldsw + _i * 8192), 16, 0, 0); } while (0)
#define PG8_LDA(dst, b, h) do { _Pragma("unroll") for (int m = 0; m < 4; ++m) _Pragma("unroll") for (int k = 0; k < 2; ++k) dst[m][k] = *(const PG8_LAS bf16x8*)(lds + PG8_SA(b, h) + aoff + m * 2048 + k * 1024); } while (0)
#define PG8_LDB(dst, b, h) do { _Pragma("unroll") for (int n = 0; n < 2; ++n) _Pragma("unroll") for (int k = 0; k < 2; ++k) dst[n][k] = *(const PG8_LAS bf16x8*)(lds + PG8_SB(b, h) + boff + n * 2048 + k * 1024); } while (0)
#define PG8_MMA(ai, bj, At, Bt) do { __builtin_amdgcn_s_setprio(1); _Pragma("unroll") for (int m = 0; m < 4; ++m) _Pragma("unroll") for (int n = 0; n < 2; ++n) _Pragma("unroll") for (int k = 0; k < 2; ++k) \
        acc[ai][bj][m][n] = __builtin_amdgcn_mfma_f32_16x16x32_bf16(Bt[n][k], At[m][k], acc[ai][bj][m][n], 0, 0, 0); __builtin_amdgcn_s_setprio(0); } while (0)
#define PG8_WAIT_V(n) asm volatile("s_waitcnt vmcnt(" #n ")" ::: "memory")
#define PG8_WAIT_L(n) asm volatile("s_waitcnt lgkmcnt(" #n ")" ::: "memory")
#define PG8_BAR __builtin_amdgcn_s_barrier()
#define PG8_SCHED __builtin_amdgcn_sched_barrier(0)
    Unit cur, nxt; int ui = 0;
    if (!S.next(0, cur)) return;
    f32x4 acc[2][2][4][2];
#pragma unroll
    for (int a = 0; a < 2; ++a)
#pragma unroll
        for (int b = 0; b < 2; ++b)
#pragma unroll
            for (int m = 0; m < 4; ++m)
#pragma unroll
                for (int n = 0; n < 2; ++n) acc[a][b][m][n] = (f32x4){0.f, 0.f, 0.f, 0.f};
    bf16x8 At[4][2], B0[2][2], B1[2][2];
    const char* cA = (const char*)g.A + (size_t)cur.pm * tstepA; const char* cB = (const char*)g.Bt + (size_t)cur.pn * tstepB;
    S.a_ready(cur);
    if constexpr (SP2) {
        PG8_STAGE(PG8_SB(0, 0), cB, voffB); PG8_STAGE(PG8_SB(0, 1), cB + hstepB, voffB); PG8_STAGE(PG8_SA(0, 0), cA, voffA); PG8_STAGE(PG8_SA(0, 1), cA + hstepA, voffA);
        if (wr == 1) PG8_BAR;
        PG8_WAIT_V(2); PG8_BAR;
        PG8_STAGE(PG8_SB(1, 0), cB + kstep, voffB); PG8_STAGE(PG8_SA(1, 0), cA + kstep, voffA); PG8_STAGE(PG8_SB(1, 1), cB + hstepB + kstep, voffB);
        PG8_WAIT_V(6); PG8_BAR;
    } else {
        PG8_STAGE(PG8_SB(0, 0), cB, voffB); PG8_STAGE(PG8_SA(0, 0), cA, voffA); PG8_STAGE(PG8_SB(0, 1), cB + hstepB, voffB); PG8_STAGE(PG8_SA(0, 1), cA + hstepA, voffA);
        if (wr == 1) PG8_BAR;
        PG8_WAIT_V(4); PG8_BAR;
        PG8_STAGE(PG8_SB(1, 0), cB + kstep, voffB); PG8_STAGE(PG8_SA(1, 0), cA + kstep, voffA); PG8_STAGE(PG8_SB(1, 1), cB + hstepB + kstep, voffB);
        PG8_WAIT_V(6); PG8_BAR;
    }
    for (;;) {
        const bool has_next = S.next(ui + 1, nxt);
        const char* nA = has_next ? (const char*)g.A + (size_t)nxt.pm * tstepA : cA; const char* nB = has_next ? (const char*)g.Bt + (size_t)nxt.pn * tstepB : cB;
        for (int t = 0; t < nt; t += 2) {
            const bool last = (t == nt - 2);
            const char* a1 = cA + (size_t)(t + 1) * kstep;
            const char* a2 = last ? nA : cA + (size_t)(t + 2) * kstep; const char* b2 = last ? nB : cB + (size_t)(t + 2) * kstep;
            const char* a3 = a2 + kstep; const char* b3 = b2 + kstep;
            if (last && has_next) S.a_ready(nxt);
            if constexpr (SP2) {
            PG8_LDB(B0, 0, 0); PG8_LDB(B1, 0, 1); PG8_SCHED; PG8_LDA(At, 0, 0); PG8_STAGE(PG8_SA(1, 1), a1 + hstepA, voffA);
            PG8_WAIT_V(8); PG8_WAIT_L(0); PG8_BAR; PG8_MMA(0, 0, At, B0); PG8_MMA(0, 1, At, B1); PG8_BAR; PG8_SCHED;
            PG8_LDA(At, 0, 1); PG8_STAGE(PG8_SB(0, 0), b2, voffB); PG8_STAGE(PG8_SB(0, 1), b2 + hstepB, voffB); PG8_STAGE(PG8_SA(0, 0), a2, voffA);
            PG8_WAIT_V(8); PG8_WAIT_L(0); PG8_BAR; PG8_MMA(1, 0, At, B0); PG8_MMA(1, 1, At, B1); PG8_BAR; PG8_SCHED;
            PG8_LDB(B0, 1, 0); PG8_LDB(B1, 1, 1); PG8_SCHED; PG8_LDA(At, 1, 0); PG8_STAGE(PG8_SA(0, 1), a2 + hstepA, voffA);
            PG8_WAIT_V(8); PG8_WAIT_L(0); PG8_BAR; PG8_MMA(0, 0, At, B0); PG8_MMA(0, 1, At, B1); PG8_BAR; PG8_SCHED;
            PG8_LDA(At, 1, 1); PG8_STAGE(PG8_SB(1, 0), b3, voffB); PG8_STAGE(PG8_SB(1, 1), b3 + hstepB, voffB); PG8_STAGE(PG8_SA(1, 0), a3, voffA);
            PG8_WAIT_V(8); PG8_WAIT_L(0); PG8_BAR; PG8_MMA(1, 0, At, B0); PG8_MMA(1, 1, At, B1); PG8_BAR; PG8_SCHED;
            } else {
            PG8_LDB(B0, 0, 0); PG8_SCHED; PG8_LDA(At, 0, 0); PG8_STAGE(PG8_SA(1, 1), a1 + hstepA, voffA);
            PG8_WAIT_L(8); PG8_BAR; PG8_WAIT_L(0); PG8_MMA(0, 0, At, B0); PG8_BAR; PG8_SCHED;
            PG8_LDB(B1, 0, 1); PG8_STAGE(PG8_SB(0, 0), b2, voffB);
            PG8_BAR; PG8_WAIT_L(0); PG8_MMA(0, 1, At, B1); PG8_BAR;
            PG8_LDA(At, 0, 1); PG8_STAGE(PG8_SA(0, 0), a2, voffA);
            PG8_BAR; PG8_WAIT_L(0); PG8_MMA(1, 0, At, B0); PG8_BAR; PG8_SCHED;
            PG8_STAGE(PG8_SB(0, 1), b2 + hstepB, voffB);
            PG8_WAIT_V(6); PG8_BAR; PG8_MMA(1, 1, At, B1); PG8_BAR;
            PG8_LDB(B0, 1, 0); PG8_SCHED; PG8_LDA(At, 1, 0); PG8_STAGE(PG8_SA(0, 1), a2 + hstepA, voffA);
            PG8_WAIT_L(8); PG8_BAR; PG8_WAIT_L(0); PG8_MMA(0, 0, At, B0); PG8_BAR; PG8_SCHED;
            PG8_LDB(B1, 1, 1); PG8_STAGE(PG8_SB(1, 0), b3, voffB);
            PG8_BAR; PG8_WAIT_L(0); PG8_MMA(0, 1, At, B1); PG8_BAR;
            PG8_LDA(At, 1, 1); PG8_STAGE(PG8_SA(1, 0), a3, voffA);
            PG8_BAR; PG8_WAIT_L(0); PG8_MMA(1, 0, At, B0); PG8_BAR; PG8_SCHED;
            PG8_STAGE(PG8_SB(1, 1), b3 + hstepB, voffB);
            PG8_WAIT_V(6); PG8_BAR; PG8_MMA(1, 1, At, B1); PG8_BAR;
            }
        }
        if constexpr (ALIGN_EPI) { if (wr == 0) PG8_BAR; }
        if constexpr (!Epi::AFTER_DRAIN) { E(acc, cur, wr, wc, fr, fq); S.done(cur); }
        if (!has_next) break;
#pragma unroll
        for (int a = 0; a < 2; ++a)
#pragma unroll
            for (int b = 0; b < 2; ++b)
#pragma unroll
                for (int m = 0; m < 4; ++m)
#pragma unroll
                    for (int n = 0; n < 2; ++n) acc[a][b][m][n] = (f32x4){0.f, 0.f, 0.f, 0.f};
        cur = nxt; cA = nA; cB = nB; ++ui;
        if constexpr (ALIGN_EPI) { if (wr == 1) PG8_BAR; }
    }
    PG8_WAIT_V(0);
    if constexpr (!ALIGN_EPI) { if (wr == 0) PG8_BAR; }
    PG8_BAR;
    if constexpr (Epi::AFTER_DRAIN) { E.fused(acc, cur, wr, wc, fr, fq, lds, wid, lane); S.done(cur); }
#undef PG8_SA
#undef PG8_SB
#undef PG8_STAGE
#undef PG8_LDA
#undef PG8_LDB
#undef PG8_MMA
#undef PG8_WAIT_V
#undef PG8_WAIT_L
#undef PG8_BAR
#undef PG8_SCHED
}
}

#ifndef PROBE_REP_ATT
#define PROBE_REP_ATT 1
#endif
#ifndef PROBE_REP_UP
#define PROBE_REP_UP 1
#endif
#ifndef PROBE_XSYNC
#define PROBE_XSYNC 0
#endif
#ifndef PROBE_REP_MISC
#define PROBE_REP_MISC 1
#endif
#ifndef PROBE_REP_WIN
#define PROBE_REP_WIN 1
#endif
#ifndef PHM
#define PHM 127
#endif
#ifndef MK_SINGLE
#define MK_SINGLE 1
#endif
constexpr int DM = 2048, MP = 8192, M_ALL = 40960, SEQ_P = 4096, SEQ_S = 16384, INW = 5632, DFF = 8192, NLAYER = 2;
constexpr int OFF_AX = 0, OFF_AB = 512, OFF_AC = 1024, OFF_Q = 1536, OFF_K = 2560, OFF_V = 3584, OFF_CU = 4608, OFF_CV = 5120;
constexpr int MIX_A = 0, MIX_B = 512, MIX_C = 1536;
constexpr float EPS = 1e-6f;
constexpr float C2 = 0.18033688011112042f;
constexpr size_t MiB = 1u << 20;
constexpr int LDH = DFF + 128;
constexpr size_t WS_WT = 1 * MiB, WT_LAYER = 96 * MiB, WT_IN = 0, WT_OUT = 22 * MiB, WT_UP = 30 * MiB, WT_DN = 62 * MiB;
constexpr size_t WS_XN = 194 * MiB, WS_H = 356 * MiB, WS_PROJ = 356 * MiB, WS_MIX = 796 * MiB, WS_END = 1008 * MiB;
static_assert(WT_DN + (size_t)DM * LDH * 2 <= WT_LAYER && WS_WT + 2 * WT_LAYER <= WS_XN && WS_XN + (size_t)M_ALL * DM * 2 <= WS_H && WS_PROJ + (size_t)M_ALL * INW * 2 <= WS_MIX && WS_MIX + (size_t)M_ALL * DM * 2 <= WS_END && WS_H + (size_t)M_ALL * LDH * 2 <= WS_END, "ws map");
constexpr int NWAVES = 8, LDS_BYTES = 147456;

typedef unsigned short bf16;
typedef unsigned v4u __attribute__((ext_vector_type(4)));
typedef unsigned v2u __attribute__((ext_vector_type(2)));
typedef float f32x4 __attribute__((ext_vector_type(4)));
#define DI __device__ __forceinline__

DI unsigned pk2(float lo, float hi) { return pg8::cvt_pk_bf16(lo, hi); }
DI float bflo(unsigned u) { return __uint_as_float(u << 16); }
DI float bfhi(unsigned u) { return __uint_as_float(u & 0xffff0000u); }
DI float wave_sum(float v) {
#pragma unroll
    for (int o = 1; o < 64; o <<= 1) v += __shfl_xor(v, o);
    return v;
}
DI float wave_max(float v) {
#pragma unroll
    for (int o = 1; o < 64; o <<= 1) v = fmaxf(v, __shfl_xor(v, o));
    return v;
}
DI float gelu_tanh(float x) {
    const float z = x * (0.7978845608028654f + 0.035677408136300125f * x * x);
    const float e = __builtin_amdgcn_exp2f(-2.8853900817779268f * z);
    return x * __builtin_amdgcn_rcpf(1.0f + e);
}

DI void transpose_item(const float* W, int K, int N, bf16* WT, int ldt, const float* gain, float* scr, int item, int lane) {
    const int nblk = N / 32, kb = item / nblk, nb = item % nblk, k0 = 64 * kb, n0 = 32 * nb;
#pragma unroll 32
    for (int i = 0; i < 32; ++i) { const int kk = 2 * i + (lane >> 5); scr[kk * 33 + (lane & 31)] = W[(size_t)(k0 + kk) * N + n0 + (lane & 31)] * (gain ? gain[k0 + kk] : 1.0f); }
    asm volatile("s_waitcnt lgkmcnt(0)" ::: "memory");
    const int c = lane & 7;
#pragma unroll
    for (int j = 0; j < 4; ++j) { const int n = (lane >> 3) + 8 * j; const float* s = scr + (8 * c) * 33 + n;
        v4u o; o.x = pk2(s[0 * 33], s[1 * 33]); o.y = pk2(s[2 * 33], s[3 * 33]); o.z = pk2(s[4 * 33], s[5 * 33]); o.w = pk2(s[6 * 33], s[7 * 33]);
        *(v4u*)(WT + (size_t)(n0 + n) * ldt + k0 + 8 * c) = o; }
    asm volatile("s_waitcnt lgkmcnt(0)" ::: "memory");
}
DI void xb_row(const float* xrow, bf16* orow, float* ssp, int lane) {
    const f32x4* xr = (const f32x4*)xrow + lane;
    f32x4 v[8]; float s = 0.f;
#pragma unroll
    for (int j = 0; j < 8; ++j) { v[j] = xr[64 * j]; s += (v[j].x * v[j].x + v[j].y * v[j].y) + (v[j].z * v[j].z + v[j].w * v[j].w); }
    s = wave_sum(s);
    if (lane == 0) *ssp = s;
    v2u* o8 = (v2u*)orow + lane;
#pragma unroll
    for (int j = 0; j < 8; ++j) { v2u w; w.x = pk2(v[j].x, v[j].y); w.y = pk2(v[j].z, v[j].w); o8[64 * j] = w; }
}

__constant__ double ROPE_INV[8] = {1.0, 0.19392274474868576, 0.03760603093086393, 0.007292664737217109, 0.001414213562373095, 0.0002742481756762073, 5.318295896944988e-05, 1.031338537721246e-05};
DI void qk_row(bf16* P, int row, int pos, const float* qg, const float* kg, int lane) {
    bf16* p = P + (size_t)row * INW + OFF_Q + lane * 32;
    v4u raw[4];
#pragma unroll
    for (int i = 0; i < 4; ++i) raw[i] = *(const v4u*)(p + 8 * i);
    float x[32];
#pragma unroll
    for (int i = 0; i < 4; ++i) { x[8 * i + 0] = bflo(raw[i].x); x[8 * i + 1] = bfhi(raw[i].x); x[8 * i + 2] = bflo(raw[i].y); x[8 * i + 3] = bfhi(raw[i].y);
        x[8 * i + 4] = bflo(raw[i].z); x[8 * i + 5] = bfhi(raw[i].z); x[8 * i + 6] = bflo(raw[i].w); x[8 * i + 7] = bfhi(raw[i].w); }
    float ss = 0.f;
#pragma unroll
    for (int i = 0; i < 32; ++i) ss += x[i] * x[i];
    ss += __shfl_xor(ss, 1);
    const float rstd = 1.0f / sqrtf(ss * (1.f / 64.f) + EPS);
    const bool isq = lane < 32; const int half = lane & 1;
    const float* g = (isq ? qg : kg) + half * 32;
#pragma unroll
    for (int i = 0; i < 8; ++i) { const f32x4 gg = *(const f32x4*)(g + 4 * i); x[4 * i] *= rstd * gg.x; x[4 * i + 1] *= rstd * gg.y; x[4 * i + 2] *= rstd * gg.z; x[4 * i + 3] *= rstd * gg.w; }
    const double t = (double)pos * ROPE_INV[lane & 7] * 0.15915494309189535;
    const float fr = (float)(t - rint(t));
    const float cs = __builtin_amdgcn_cosf(fr), sn = __builtin_amdgcn_sinf(fr);
#pragma unroll
    for (int i = 0; i < 8; ++i) { const float c = __shfl(cs, i), s = __shfl(sn, i);
        if (half == 0) { const float a = x[i], b = x[i + 8]; x[i] = a * c - b * s; x[i + 8] = b * c + a * s; } }
    const float sc = isq ? C2 : 1.0f;
#pragma unroll
    for (int i = 0; i < 4; ++i) { v4u w; w.x = pk2(x[8 * i] * sc, x[8 * i + 1] * sc); w.y = pk2(x[8 * i + 2] * sc, x[8 * i + 3] * sc); w.z = pk2(x[8 * i + 4] * sc, x[8 * i + 5] * sc); w.w = pk2(x[8 * i + 6] * sc, x[8 * i + 7] * sc);
        *(v4u*)(p + 8 * i) = w; }
}
DI void unpack8(const v4u r, float* x) { x[0] = bflo(r.x); x[1] = bfhi(r.x); x[2] = bflo(r.y); x[3] = bfhi(r.y); x[4] = bflo(r.z); x[5] = bfhi(r.z); x[6] = bflo(r.w); x[7] = bfhi(r.w); }
DI void conv_row(const bf16* P, bf16* MIX, int row, int pos, int S, const float* cw, int lane) {
    const bf16* p = P + (size_t)row * INW + lane * 8;
    const v4u z4 = {0u, 0u, 0u, 0u};
    const v4u xa0 = *(const v4u*)(p + OFF_AX), gc0 = *(const v4u*)(p + OFF_AC), gb0 = *(const v4u*)(p + OFF_AB);
    const v4u xam = pos > 0 ? *(const v4u*)(p - INW + OFF_AX) : z4, gcm = pos > 0 ? *(const v4u*)(p - INW + OFF_AC) : z4;
    const v4u xap = pos < S - 1 ? *(const v4u*)(p + INW + OFF_AX) : z4, gcp = pos < S - 1 ? *(const v4u*)(p + INW + OFF_AC) : z4;
    float a0[8], c0[8], b0[8], am[8], cm[8], ap[8], cp[8];
    unpack8(xa0, a0); unpack8(gc0, c0); unpack8(gb0, b0); unpack8(xam, am); unpack8(gcm, cm); unpack8(xap, ap); unpack8(gcp, cp);
    float w0[8], w1[8], w2[8];
#pragma unroll
    for (int i = 0; i < 2; ++i) { const f32x4 a = *(const f32x4*)(cw + lane * 8 + 4 * i), b = *(const f32x4*)(cw + 512 + lane * 8 + 4 * i), c = *(const f32x4*)(cw + 1024 + lane * 8 + 4 * i);
        w0[4 * i] = a.x; w0[4 * i + 1] = a.y; w0[4 * i + 2] = a.z; w0[4 * i + 3] = a.w; w1[4 * i] = b.x; w1[4 * i + 1] = b.y; w1[4 * i + 2] = b.z; w1[4 * i + 3] = b.w;
        w2[4 * i] = c.x; w2[4 * i + 1] = c.y; w2[4 * i + 2] = c.z; w2[4 * i + 3] = c.w; }
    float o[8];
#pragma unroll
    for (int j = 0; j < 8; ++j) o[j] = b0[j] * (w0[j] * (cm[j] * am[j]) + w1[j] * (c0[j] * a0[j]) + w2[j] * (cp[j] * ap[j]));
    v4u w; w.x = pk2(o[0], o[1]); w.y = pk2(o[2], o[3]); w.z = pk2(o[4], o[5]); w.w = pk2(o[6], o[7]);
    *(v4u*)(MIX + (size_t)row * DM + MIX_A + lane * 8) = w;
}

namespace att {
using bf16x8 = __attribute__((ext_vector_type(8))) short;
using s16x4  = __attribute__((ext_vector_type(4))) short;
using f32x16 = __attribute__((ext_vector_type(16))) float;
using u32x4  = __attribute__((ext_vector_type(4))) unsigned;
constexpr int KVBLK = 64;
constexpr int SHM_V = 16384, SHM_K = 16384, SCR_OFF = 133120;
#define KSWZ(row, colB) ((row) * 256 + ((colB) ^ (((row) & 15) << 4)))
#define SBAR() __builtin_amdgcn_sched_barrier(0)
DI int crow(int r, int hi) { return (r & 3) + 8 * (r >> 2) + 4 * hi; }
DI unsigned cvtpk(float lo, float hi) { unsigned r; asm volatile("v_cvt_pk_bf16_f32 %0, %1, %2" : "=v"(r) : "v"(lo), "v"(hi)); return r; }
DI int v_st(int k, int c) { const int kk = (k & ~0xC) | ((k & 4) << 1) | ((k & 8) >> 1); return ((kk >> 3) * 4 + (c >> 5)) * 512 + ((kk & 7) * 32 + (c & 31)) * 2; }
DI int v_rd_base(int lane) { return ((lane & 3) << 3) | (((lane >> 2) & 3) << 6) | (((lane >> 4) & 1) << 5) | (((lane >> 5) & 1) << 8); }
constexpr int v_rd_off(int d0, int ks, int half) { return d0 * 512 + ks * 4096 + half * 2048; }
template <int OFF> DI s16x4 tr_read(int vb) { s16x4 r; asm volatile("ds_read_b64_tr_b16 %0, %1 offset:%2" : "=&v"(r) : "v"(vb), "i"(OFF) : "memory"); return r; }
template <int D0> DI void pv_one(f32x16& od, int vb, bf16x8 pa0, bf16x8 pa1, bf16x8 pa2, bf16x8 pa3) {
  const s16x4 l0 = tr_read<v_rd_off(D0, 0, 0)>(vb), h0 = tr_read<v_rd_off(D0, 0, 1)>(vb), l1 = tr_read<v_rd_off(D0, 1, 0)>(vb), h1 = tr_read<v_rd_off(D0, 1, 1)>(vb);
  const s16x4 l2 = tr_read<v_rd_off(D0, 2, 0)>(vb), h2 = tr_read<v_rd_off(D0, 2, 1)>(vb), l3 = tr_read<v_rd_off(D0, 3, 0)>(vb), h3 = tr_read<v_rd_off(D0, 3, 1)>(vb);
  asm volatile("s_waitcnt lgkmcnt(0)" ::: "memory"); SBAR();
#define PK(L, H) (bf16x8){L[0], L[1], L[2], L[3], H[0], H[1], H[2], H[3]}
  od = __builtin_amdgcn_mfma_f32_32x32x16_bf16(pa0, PK(l0, h0), od, 0, 0, 0);
  od = __builtin_amdgcn_mfma_f32_32x32x16_bf16(pa1, PK(l1, h1), od, 0, 0, 0);
  od = __builtin_amdgcn_mfma_f32_32x32x16_bf16(pa2, PK(l2, h2), od, 0, 0, 0);
  od = __builtin_amdgcn_mfma_f32_32x32x16_bf16(pa3, PK(l3, h3), od, 0, 0, 0);
#undef PK
}
DI void pv_d0(f32x16* o, int vb, bf16x8 pa0, bf16x8 pa1, bf16x8 pa2, bf16x8 pa3) {
  pv_one<0>(o[0], vb, pa0, pa1, pa2, pa3); pv_one<1>(o[1], vb, pa0, pa1, pa2, pa3); pv_one<2>(o[2], vb, pa0, pa1, pa2, pa3); pv_one<3>(o[3], vb, pa0, pa1, pa2, pa3);
}
template <bool SHIFT> DI void qkt(f32x16& p0, f32x16& p1, const char* Ks, const bf16x8* qr, int r32, int hi, int c, float negmb) {
  if constexpr (SHIFT) {
#pragma unroll
    for (int r = 0; r < 16; ++r) { p0[r] = negmb; p1[r] = negmb; }
  } else { p0 = f32x16{}; p1 = f32x16{}; }
#pragma unroll
  for (int d0 = 0; d0 < 4; ++d0) { const int cb = (c * 64 + d0 * 16 + hi * 8) * 2;
    const bf16x8 b0 = *reinterpret_cast<const bf16x8*>(Ks + KSWZ(r32, cb));
    const bf16x8 b1 = *reinterpret_cast<const bf16x8*>(Ks + KSWZ(32 + r32, cb));
    p0 = __builtin_amdgcn_mfma_f32_32x32x16_bf16(b0, qr[d0], p0, 0, 0, 0);
    p1 = __builtin_amdgcn_mfma_f32_32x32x16_bf16(b1, qr[d0], p1, 0, 0, 0); }
}
DI void expA(f32x16& p0) {
#pragma unroll
  for (int r = 0; r < 16; ++r) p0[r] = __builtin_amdgcn_exp2f(p0[r]);
}
DI void finishSM(f32x16& p0, f32x16& p1, float& l_reg, bf16x8& pa0, bf16x8& pa1, bf16x8& pa2, bf16x8& pa3) {
#pragma unroll
  for (int r = 0; r < 16; ++r) p1[r] = __builtin_amdgcn_exp2f(p1[r]);
  float ps = 0.f;
#pragma unroll
  for (int r = 0; r < 16; ++r) ps += p0[r];
#pragma unroll
  for (int r = 0; r < 16; ++r) ps += p1[r];
  l_reg += ps;
#define PK4(P, BASE, OUT) do { unsigned a0 = cvtpk(P[BASE + 0], P[BASE + 1]), a1 = cvtpk(P[BASE + 2], P[BASE + 3]);   \
    unsigned b0 = cvtpk(P[BASE + 4], P[BASE + 5]), b1 = cvtpk(P[BASE + 6], P[BASE + 7]);                              \
    auto r0 = __builtin_amdgcn_permlane32_swap(a0, b0, false, false); auto r1 = __builtin_amdgcn_permlane32_swap(a1, b1, false, false); \
    u32x4 w = {r0[0], r1[0], r0[1], r1[1]}; OUT = *reinterpret_cast<bf16x8*>(&w); } while (0)
  PK4(p0, 0, pa0); PK4(p0, 8, pa1); PK4(p1, 0, pa2); PK4(p1, 8, pa3);
#undef PK4
}
DI unsigned cvtpk2(float lo, float hi) { typedef float f2_t __attribute__((ext_vector_type(2))); typedef __bf16 b2_t __attribute__((ext_vector_type(2))); f2_t v = {lo, hi}; b2_t b = __builtin_convertvector(v, b2_t); return __builtin_bit_cast(unsigned, b); }
template <int I> DI void vrd(s16x4& l, s16x4& h, int vb) { constexpr int ks = I >> 2, d0 = I & 3; l = tr_read<v_rd_off(d0, ks, 0)>(vb); h = tr_read<v_rd_off(d0, ks, 1)>(vb); }
#define TIEWAIT(N, L, H) asm volatile("s_waitcnt lgkmcnt(" #N ")" : "+v"(L), "+v"(H))
#define PK4B(P, BASE, OUT) do { unsigned a0 = cvtpk2(P[BASE + 0], P[BASE + 1]), a1 = cvtpk2(P[BASE + 2], P[BASE + 3]);   \
    unsigned b0 = cvtpk2(P[BASE + 4], P[BASE + 5]), b1 = cvtpk2(P[BASE + 6], P[BASE + 7]);                              \
    auto r0 = __builtin_amdgcn_permlane32_swap(a0, b0, false, false); auto r1 = __builtin_amdgcn_permlane32_swap(a1, b1, false, false); \
    u32x4 w = {r0[0], r1[0], r0[1], r1[1]}; OUT = *reinterpret_cast<bf16x8*>(&w); } while (0)
#define PKV(L, H) (bf16x8){L[0], L[1], L[2], L[3], H[0], H[1], H[2], H[3]}
#define PVSTEP(i, N, PA, SL, SH, NL, NH) do { TIEWAIT(N, SL, SH); o[(i) & 3] = __builtin_amdgcn_mfma_f32_32x32x16_bf16(PA, PKV(SL, SH), o[(i) & 3], 0, 0, 0); \
    if constexpr ((i) + 3 < 16) vrd<((i) + 3 < 16 ? (i) + 3 : 15)>(NL, NH, vb); } while (0)
DI void finish_pv(f32x16& p0, f32x16& p1, float& l_reg, f32x16* o, int vb) {
  s16x4 l0, h0, l1, h1, l2, h2, l3, h3;
  vrd<0>(l0, h0, vb); vrd<1>(l1, h1, vb); vrd<2>(l2, h2, vb);
  bf16x8 pa0, pa1, pa2, pa3;
  PK4B(p0, 0, pa0); PK4B(p0, 8, pa1);
  PVSTEP(0, 4, pa0, l0, h0, l3, h3); PVSTEP(1, 4, pa0, l1, h1, l0, h0); PVSTEP(2, 4, pa0, l2, h2, l1, h1); PVSTEP(3, 4, pa0, l3, h3, l2, h2);
  PVSTEP(4, 4, pa1, l0, h0, l3, h3); PVSTEP(5, 4, pa1, l1, h1, l0, h0); PVSTEP(6, 4, pa1, l2, h2, l1, h1); PVSTEP(7, 4, pa1, l3, h3, l2, h2);
  PK4B(p1, 0, pa2); PK4B(p1, 8, pa3);
  PVSTEP(8, 4, pa2, l0, h0, l3, h3); PVSTEP(9, 4, pa2, l1, h1, l0, h0); PVSTEP(10, 4, pa2, l2, h2, l1, h1); PVSTEP(11, 4, pa2, l3, h3, l2, h2);
  PVSTEP(12, 4, pa3, l0, h0, l3, h3); PVSTEP(13, 4, pa3, l1, h1, l0, h0); PVSTEP(14, 2, pa3, l2, h2, l1, h1); PVSTEP(15, 0, pa3, l3, h3, l2, h2);
  float ps = 0.f;
#pragma unroll
  for (int r = 0; r < 16; ++r) ps += p0[r];
#pragma unroll
  for (int r = 0; r < 16; ++r) ps += p1[r];
  l_reg += ps;
}
DI void glds16(const void* gsrc, unsigned lds_dst) { unsigned keep;
  asm volatile("s_mov_b32 %0, m0\n\ts_mov_b32 m0, %2\n\ts_nop 0\n\tglobal_load_lds_dwordx4 %1, off\n\ts_mov_b32 m0, %0" : "=&s"(keep) : "v"(gsrc), "s"(lds_dst) : "memory"); }
#define WAIT_BAR(N) asm volatile("s_waitcnt vmcnt(" #N ") lgkmcnt(0)\n\ts_barrier" ::: "memory")
template <bool SHIFT> DI void attn_unit(const bf16* __restrict__ Qb, const bf16* __restrict__ Kh, const bf16* __restrict__ Vh, bf16* __restrict__ Ob, int seq, char* lds,
                  float negmb, float lam, const float* __restrict__ gsub, float post) {
  int tid = threadIdx.x; asm volatile("" : "+v"(tid));
  const int lane = tid & 63, r32 = lane & 31, hi = lane >> 5; const int wid = __builtin_amdgcn_readfirstlane(tid >> 6), c = wid >> 2, wq = wid & 3;
  char* K_ring = lds; char* V_ring = lds + 3 * SHM_K;
  float* wsf = (float*)(lds + SCR_OFF) + wid * 64;
  const unsigned lds0 = (unsigned)(uintptr_t)lds;
  float l_reg = 0.f; f32x16 o[4] = {}; bf16x8 qr[4];
  const bf16* Qw = Qb + (size_t)(wq * 32 + r32) * INW + c * 64 + hi * 8;
#pragma unroll
  for (int d0 = 0; d0 < 4; ++d0) qr[d0] = *reinterpret_cast<const bf16x8*>(Qw + d0 * 16);
  const bf16* ksrc0; const bf16* ksrc1; const bf16* vsrc0; const bf16* vsrc1;
  { const int row0 = 8 * wid + (lane >> 4), row1 = row0 + 4, cp = lane & 15;
    ksrc0 = Kh + (size_t)row0 * INW + ((cp ^ (row0 & 15)) << 3); ksrc1 = Kh + (size_t)row1 * INW + ((cp ^ (row1 & 15)) << 3);
    const int kk = 8 * wid + ((lane & 31) >> 2), kkey = (kk & ~0xC) | ((kk & 4) << 1) | ((kk & 8) >> 1), cc = (lane >> 5) * 32 + (lane & 3) * 8;
    vsrc0 = Vh + (size_t)kkey * INW + cc; vsrc1 = vsrc0 + 64; }
  const unsigned kdst = lds0 + (unsigned)wid * 2048u, vdst = lds0 + 3u * SHM_K + (unsigned)wid * 2048u;
#define DMA_K(t, slot) do { const size_t to_ = (size_t)(t) * (KVBLK * INW); const unsigned d_ = (unsigned)__builtin_amdgcn_readfirstlane(kdst + (unsigned)(slot)); glds16(ksrc0 + to_, d_); glds16(ksrc1 + to_, d_ + 1024u); } while (0)
#define DMA_V(t, slot) do { const size_t to_ = (size_t)(t) * (KVBLK * INW); const unsigned d_ = (unsigned)__builtin_amdgcn_readfirstlane(vdst + (unsigned)(slot)); glds16(vsrc0 + to_, d_); glds16(vsrc1 + to_, d_ + 1024u); } while (0)
  const int vb0 = (int)(lds0 + 3u * SHM_K) + v_rd_base(lane);
  f32x16 pA0, pA1, pB0, pB1; const int NT = seq / KVBLK;
  int s0 = 0, s1 = SHM_K, s2 = 2 * SHM_K;
#define ROT() do { const int t_ = s0; s0 = s1; s1 = s2; s2 = t_; } while (0)
  DMA_K(0, 0); DMA_K(1, SHM_K); DMA_V(0, 0);
  WAIT_BAR(4);
  DMA_K(2, 2 * SHM_K); DMA_V(1, SHM_K);
  qkt<SHIFT>(pA0, pA1, K_ring, qr, r32, hi, c, negmb); expA(pA0); expA(pA1);
#define ITER(CUR0, CUR1, PRV0, PRV1, j) do { \
    WAIT_BAR(4); \
    { const int tk_ = ((j) + 2 < NT) ? (j) + 2 : NT - 1, tv_ = ((j) + 1 < NT) ? (j) + 1 : NT - 1; DMA_K(tk_, s0); DMA_V(tv_, s2); } \
    SBAR(); qkt<SHIFT>(CUR0, CUR1, K_ring + s1, qr, r32, hi, c, negmb); \
    finish_pv(PRV0, PRV1, l_reg, o, vb0 + s0); expA(CUR0); expA(CUR1); \
    ROT(); } while (0)
  for (int j = 1; j + 1 < NT; j += 2) {
    ITER(pB0, pB1, pA0, pA1, j);
    ITER(pA0, pA1, pB0, pB1, j + 1);
  }
  ITER(pB0, pB1, pA0, pA1, NT - 1);
  WAIT_BAR(0);
  finish_pv(pB0, pB1, l_reg, o, vb0 + s0);
#undef ITER
#undef ROT
#undef DMA_K
#undef DMA_V
  int lane_e = lane; asm volatile("" : "+v"(lane_e));
  {
  const int lane = lane_e, r32 = lane & 31, hi = lane >> 5;
  { auto rr = __builtin_amdgcn_permlane32_swap(__float_as_uint(l_reg), __float_as_uint(l_reg), false, false); l_reg = __uint_as_float(rr[0]) + __uint_as_float(rr[1]); }
  if (hi == 0) wsf[r32] = l_reg;
  asm volatile("s_waitcnt lgkmcnt(0)" ::: "memory");
  __syncthreads();
  float* XY = (float*)lds + (c == 0 ? 16384 : 0) + wq * 4096;
#pragma unroll
  for (int r = 0; r < 16; ++r) { const float rl = __builtin_amdgcn_rcpf(wsf[crow(r, hi)]);
#pragma unroll
    for (int d0 = 0; d0 < 4; ++d0) XY[(d0 * 16 + r) * 64 + lane] = o[d0][r] * rl; }
  }
  __syncthreads();
  { int tid2 = threadIdx.x; asm volatile("" : "+v"(tid2));
    const int ch = tid2 & 15; const f32x4 g0 = *(const f32x4*)(gsub + ch * 8), g1 = *(const f32x4*)(gsub + ch * 8 + 4);
#pragma unroll
    for (int j = 0; j < 4; ++j) {
      const int row = (tid2 >> 4) + 32 * j, rr = row & 31;
      const int fi = (row >> 5) * 4096 + ((ch >> 2) * 16 + (rr & 3) + 4 * (rr >> 3)) * 64 + ((rr >> 2) & 1) * 32 + (ch & 3) * 8;
      const float* xp_ = (const float*)lds + fi;
      const f32x4 x0 = *(const f32x4*)(xp_), x1 = *(const f32x4*)(xp_ + 4), y0 = *(const f32x4*)(xp_ + 16384), y1 = *(const f32x4*)(xp_ + 16384 + 4);
      const f32x4 d0v = y0 - x0 * lam, d1v = y1 - x1 * lam;
      float ss = (d0v[0] * d0v[0] + d0v[1] * d0v[1]) + (d0v[2] * d0v[2] + d0v[3] * d0v[3]) + (d1v[0] * d1v[0] + d1v[1] * d1v[1]) + (d1v[2] * d1v[2] + d1v[3] * d1v[3]);
      ss += __shfl_xor(ss, 1); ss += __shfl_xor(ss, 2); ss += __shfl_xor(ss, 4); ss += __shfl_xor(ss, 8);
      const float rs = post / sqrtf(ss * (1.f / 128.f) + EPS);
      const f32x4 e0 = d0v * g0 * rs, e1 = d1v * g1 * rs;
      v4u w; w.x = pk2(e0[0], e0[1]); w.y = pk2(e0[2], e0[3]); w.z = pk2(e1[0], e1[1]); w.w = pk2(e1[2], e1[3]);
      *(v4u*)(Ob + (size_t)row * DM + ch * 8) = w; }
  }
  __syncthreads();
}
#undef SBAR
}

DI void sgu_unit(const bf16* P, bf16* MIX, int chunk, int hd, const float* Ws, const float* bs, const float* gv, char* lds) {
    using att::bf16x8; using att::f32x16;
    int tid = threadIdx.x; asm volatile("" : "+v"(tid));
    const int wid = tid >> 6, lane = tid & 63, r32 = lane & 31, hi = lane >> 5;
    bf16* vnT = (bf16*)lds;
    { const int p = tid >> 2, qtr = tid & 3; const bf16* src = P + (size_t)(chunk * 128 + p) * INW + OFF_CV + hd * 128 + qtr * 32;
      v4u raw[4];
#pragma unroll
      for (int i = 0; i < 4; ++i) raw[i] = *(const v4u*)(src + 8 * i);
      float x[32];
#pragma unroll
      for (int i = 0; i < 4; ++i) unpack8(raw[i], x + 8 * i);
      float ss = 0.f;
#pragma unroll
      for (int i = 0; i < 32; ++i) { x[i] = gelu_tanh(x[i]); ss += x[i] * x[i]; }
      ss += __shfl_xor(ss, 1); ss += __shfl_xor(ss, 2);
      const float rstd = 1.0f / sqrtf(ss * (1.f / 128.f) + EPS);
#pragma unroll
      for (int i = 0; i < 32; ++i) { const float v = x[i] * rstd * gv[qtr * 32 + i]; vnT[(qtr * 32 + i) * 136 + p] = (bf16)(pk2(v, 0.f) & 0xffffu); }
    }
    __syncthreads();
    const int qb = wid >> 1;
    bf16x8 a[8];
#pragma unroll
    for (int ks = 0; ks < 8; ++ks) { const float* w = Ws + (size_t)(32 * qb + r32) * 128 + 16 * ks + 8 * hi; const f32x4 w0 = *(const f32x4*)w, w1 = *(const f32x4*)(w + 4);
        att::u32x4 u = {pk2(w0.x, w0.y), pk2(w0.z, w0.w), pk2(w1.x, w1.y), pk2(w1.z, w1.w)}; a[ks] = *reinterpret_cast<bf16x8*>(&u); }
#pragma unroll
    for (int dd = 0; dd < 2; ++dd) { const int db = 2 * (wid & 1) + dd;
        f32x16 acc = {};
#pragma unroll
        for (int ks = 0; ks < 8; ++ks) { const bf16x8 b = *reinterpret_cast<const bf16x8*>(vnT + (32 * db + r32) * 136 + 16 * ks + 8 * hi);
            acc = __builtin_amdgcn_mfma_f32_32x32x16_bf16(a[ks], b, acc, 0, 0, 0); }
        const int d = 32 * db + r32;
#pragma unroll
        for (int i = 0; i < 16; ++i) { const int q = 32 * qb + att::crow(i, hi); const size_t tok = (size_t)chunk * 128 + q;
            const float uval = gelu_tanh(__uint_as_float((unsigned)P[tok * INW + OFF_CU + hd * 128 + d] << 16));
            MIX[tok * DM + MIX_C + hd * 128 + d] = (bf16)(pk2(uval * (acc[i] + bs[q]), 0.f) & 0xffffu); }
    }
    __syncthreads();
}

#define LAS __attribute__((address_space(3)))
#define XB_TMO      128
#define XB_XCNT(j)  (256  + 64 * (j))
#define XB_XSUB(j)  (1280 + 64 * (j))
#define XB_XGEN(j)  (2304 + 64 * (j))
#define XB_TOP      3328
#define XB_TOPGEN   3392
#define XCD_BAR_WORDS 3456
#define XB_SPIN_CAP (1u << 18)

__device__ __forceinline__ unsigned xb_ld(unsigned* p)              { return __hip_atomic_load(p, __ATOMIC_RELAXED, __HIP_MEMORY_SCOPE_AGENT); }
__device__ __forceinline__ unsigned xb_add(unsigned* p, unsigned v) { return __hip_atomic_fetch_add(p, v, __ATOMIC_RELAXED, __HIP_MEMORY_SCOPE_AGENT); }
__device__ __forceinline__ unsigned xb_xcc_id() { return (unsigned)__builtin_amdgcn_s_getreg((3 << 11) | 20) & 0xFu; }
#define XB_SPIN(cond, bar) do { unsigned _sp = 0; while (cond) { __builtin_amdgcn_s_sleep(1); \
    if ((++_sp & 255u) == 0u) { if (xb_ld(&(bar)[XB_TMO])) break; if (_sp > XB_SPIN_CAP) { atomicAdd(&(bar)[XB_TMO], 1u); break; } } } } while (0)

struct XcdBarrier {
    unsigned* bar; unsigned x;
    volatile LAS unsigned* st;
};

__device__ __forceinline__ XcdBarrier xcd_barrier_post(unsigned* bar, volatile LAS unsigned* st) {
    XcdBarrier b; b.bar = bar; b.x = xb_xcc_id(); b.st = st;
    if (threadIdx.x == 0) (void)xb_add(&bar[XB_XCNT(b.x)], 1u);
    return b;
}
__device__ __forceinline__ void xcd_barrier_complete(unsigned* bar, unsigned x, unsigned& nloc, unsigned& nx) {
    const unsigned G = gridDim.x * gridDim.y * gridDim.z;
    unsigned sum, cnt, mine, sp = 0u;
    for (;;) {
        sum = 0u; cnt = 0u; mine = 0u;
#pragma unroll
        for (unsigned j = 0; j < 16; ++j) { const unsigned c = xb_ld(&bar[XB_XCNT(j)]); sum += c; cnt += (c > 0u) ? 1u : 0u; mine = (j == x) ? c : mine; }
        if (sum == G) break;
        __builtin_amdgcn_s_sleep(1);
        if ((++sp & 255u) == 0u) { if (xb_ld(&bar[XB_TMO])) break; if (sp > XB_SPIN_CAP) { atomicAdd(&bar[XB_TMO], 1u); break; } }
    }
    nloc = mine > 0u ? mine : 1u; nx = cnt > 0u ? cnt : 1u;
}

__device__ __forceinline__ void xcd_barrier(const XcdBarrier& b) {
    asm volatile("s_waitcnt vmcnt(0)" ::: "memory");
    __syncthreads();
    if (threadIdx.x == 0) {
        unsigned* bar = b.bar;
        __builtin_amdgcn_s_waitcnt(0);
        unsigned nloc = b.st[0], nx = b.st[1];
        if (nloc == 0u) { xcd_barrier_complete(bar, b.x, nloc, nx); b.st[0] = nloc; b.st[1] = nx; }
        const unsigned old = xb_add(&bar[XB_XSUB(b.x)], 1u);
        const unsigned gen = old / nloc;
        if (old + 1u == (gen + 1u) * nloc) {
            __builtin_amdgcn_fence(__ATOMIC_RELEASE, "agent");
            asm volatile("s_waitcnt vmcnt(0)" ::: "memory");
            const unsigned og = xb_add(&bar[XB_TOP], 1u);
            const unsigned tg = og / nx;
            if (og + 1u == (tg + 1u) * nx) xb_add(&bar[XB_TOPGEN], 1u);
            else XB_SPIN(xb_ld(&bar[XB_TOPGEN]) == tg, bar);
            __builtin_amdgcn_fence(__ATOMIC_ACQUIRE, "agent");
            xb_add(&bar[XB_XGEN(b.x)], 1u);
            asm volatile("s_waitcnt vmcnt(0)" ::: "memory");
        } else {
            XB_SPIN(xb_ld(&bar[XB_XGEN(b.x)]) == gen, bar);
            __builtin_amdgcn_fence(__ATOMIC_ACQUIRE, "agent");
            asm volatile("s_waitcnt vmcnt(0)" ::: "memory");
        }
    }
    __syncthreads();
}

struct Args { const float* in[19]; float* out; unsigned char* ws; int ph_lo, ph_hi; };
constexpr int N_PHASES = 1 + 6 * NLAYER;

__global__ void __launch_bounds__(NWAVES * 64, 2) mk_fwd(Args args) {
    extern __shared__ __attribute__((aligned(16))) unsigned char lds[];
    cg::grid_group grid = cg::this_grid();
    const int G = gridDim.x; const int bx = blockIdx.x; const int vcu = (G % 8 == 0) ? (bx % 8) * (G / 8) + bx / 8 : bx;
    const int NGW = G * NWAVES;
    unsigned char* ws = args.ws;
    const float* xp = args.in[0]; const float* xs = args.in[1];
    float* out = args.out;
    bf16* XN = (bf16*)(ws + WS_XN); bf16* PROJ = (bf16*)(ws + WS_PROJ); bf16* MIX = (bf16*)(ws + WS_MIX); bf16* HB = (bf16*)(ws + WS_H);

    volatile LAS unsigned* MISC = (volatile LAS unsigned*)((LAS unsigned char*)lds + 131072 + 320);
    if (threadIdx.x < 32) MISC[threadIdx.x] = 0u;
    __syncthreads();
    const XcdBarrier bar = xcd_barrier_post((unsigned*)ws, MISC + 8);
    for (int ph = args.ph_lo; ph < args.ph_hi; ++ph) {
        int tid = threadIdx.x; asm volatile("" : "+v"(tid));
        const int lane = tid & 63, wave = __builtin_amdgcn_readfirstlane(tid >> 6), gw = vcu * NWAVES + wave;
        const int l = (ph - 1) / 6, k = (ph == 0) ? -1 : ((ph - 1) % 6);
        float* const RS = (float*)(ws + 65536);
        const unsigned char* wl = ws + WS_WT + (size_t)(l < 0 ? 0 : l) * WT_LAYER;
        if (ph == 0) {
#if PHM & 1
            for (int rep = 0; rep < PROBE_REP_MISC; ++rep) {
            float* scr = (float*)(lds + wave * 16384);
            constexpr int I_IN = 32 * 176, I_OUT = 32 * 64, I_UP = 32 * 256, I_DN = 128 * 64, I_L = I_IN + I_OUT + I_UP + I_DN;
            for (int it = gw; it < NLAYER * I_L; it += NGW) {
                const int ll = it / I_L; int r = it % I_L; unsigned char* wb = ws + WS_WT + (size_t)ll * WT_LAYER;
                if (r < I_IN) { transpose_item(args.in[3] + (size_t)ll * DM * INW, DM, INW, (bf16*)(wb + WT_IN), DM, args.in[2] + ll * DM, scr, r, lane); continue; } r -= I_IN;
                if (r < I_OUT) { transpose_item(args.in[15] + (size_t)ll * DM * DM, DM, DM, (bf16*)(wb + WT_OUT), DM, nullptr, scr, r, lane); continue; } r -= I_OUT;
                if (r < I_UP) { transpose_item(args.in[17] + (size_t)ll * DM * DFF, DM, DFF, (bf16*)(wb + WT_UP), DM, args.in[16] + ll * DM, scr, r, lane); continue; } r -= I_UP;
                transpose_item(args.in[18] + (size_t)ll * DFF * DM, DFF, DM, (bf16*)(wb + WT_DN), LDH, nullptr, scr, r, lane);
            }
            for (int m = gw; m < M_ALL; m += NGW) xb_row(m < MP ? xp + (size_t)m * DM : xs + (size_t)(m - MP) * DM, XN + (size_t)m * DM, RS + m, lane);
            for (int i = gw * 64 + lane; i < 3 * M_ALL; i += NGW * 64) RS[M_ALL + i] = 0.f;
            }
#endif
        } else if (k == 0) {
#if PHM & 2
            pg8::Gemm g{XN, (const bf16*)(wl + WT_IN), M_ALL, INW, DM, DM, DM}; pg8::StaticOrder S; S.init(M_ALL, INW, G, bx);
            pg8::EpiBf16<0> E{PROJ, INW, RS + (size_t)(2 * l) * M_ALL};
            for (int rep = 0; rep < PROBE_REP_WIN; ++rep)
            pg8::gemm_phase<pg8::EpiBf16<0>, pg8::StaticOrder, true, true>((PG8_LAS unsigned char*)lds, g, S, E);
#endif
        } else if (k == 1) {
#if PHM & 4
            const float* qg = args.in[5] + l * 64; const float* kg = args.in[6] + l * 64; const float* cw = args.in[4] + l * 1536;
            for (int m = gw; m < M_ALL; m += NGW) {
                const int pos = m < MP ? (m & (SEQ_P - 1)) : ((m - MP) & (SEQ_S - 1)); const int S = m < MP ? SEQ_P : SEQ_S;
                qk_row(PROJ, m, pos, qg, kg, lane);
                conv_row(PROJ, MIX, m, pos, S, cw, lane);
            }
            for (int u = vcu; u < (M_ALL / 128) * 4; u += G) { const int chunk = u >> 2, hd = u & 3;
                sgu_unit(PROJ, MIX, chunk, hd, args.in[13] + ((size_t)l * 4 + hd) * 128 * 128, args.in[14] + (l * 4 + hd) * 128, args.in[12] + l * 128, (char*)lds); }
#endif
        } else if (k == 2) {
#if PHM & 8
            const float linit = (l == 0) ? 0.2f : 0.35550906759096934f;
            const float s1 = wave_sum(args.in[7][l * 64 + lane] * args.in[8][l * 64 + lane]), s2 = wave_sum(args.in[9][l * 64 + lane] * args.in[10][l * 64 + lane]);
            const float lam = __uint_as_float(__builtin_amdgcn_readfirstlane(__float_as_uint(expf(s1) - expf(s2) + linit)));
            const float gq = wave_max(fabsf(args.in[5][l * 64 + lane])), gk = wave_max(fabsf(args.in[6][l * 64 + lane]));
            const float negmb = __uint_as_float(__builtin_amdgcn_readfirstlane(__float_as_uint(-(C2 * 64.0f * gq * gk))));
            for (int rep = 0; rep < PROBE_REP_ATT; ++rep)
            for (int t = vcu; t < 2560; t += G) {
                int pair, qb, seq, seqrow0;
                if (t < 2048) { const int i = t >> 8, v = t & 255; const int idx = (v >> 5) * 256 + i * 32 + (v & 31); pair = idx >> 7; qb = idx & 127; seq = SEQ_S; seqrow0 = MP + (pair >> 3) * SEQ_S; }
                else { const int t2 = t - 2048, i = t2 >> 8, v = t2 & 255; pair = 2 * (v >> 5) + i; qb = v & 31; seq = SEQ_P; seqrow0 = (pair >> 3) * SEQ_P; }
                const int h = pair & 7; const size_t row0 = (size_t)seqrow0 + (size_t)qb * 128;
                if (negmb >= -64.0f)
                att::attn_unit<false>(PROJ + row0 * INW + OFF_Q + h * 128, PROJ + (size_t)seqrow0 * INW + OFF_K + h * 128, PROJ + (size_t)seqrow0 * INW + OFF_V + h * 128,
                               MIX + row0 * DM + MIX_B + h * 128, seq, (char*)lds, 0.f, lam, args.in[11] + l * 128, 1.0f - linit);
                else
                att::attn_unit<true>(PROJ + row0 * INW + OFF_Q + h * 128, PROJ + (size_t)seqrow0 * INW + OFF_K + h * 128, PROJ + (size_t)seqrow0 * INW + OFF_V + h * 128,
                               MIX + row0 * DM + MIX_B + h * 128, seq, (char*)lds, negmb, lam, args.in[11] + l * 128, 1.0f - linit);
            }
#endif
        } else if (k == 3 || k == 5) {
#if PHM & 16
            pg8::Gemm g; if (k == 3) g = pg8::Gemm{MIX, (const bf16*)(wl + WT_OUT), M_ALL, DM, DM, DM, DM}; else g = pg8::Gemm{HB, (const bf16*)(wl + WT_DN), M_ALL, DM, DFF, LDH, LDH};
            pg8::StaticOrder S; S.init(M_ALL, DM, G, bx);
            pg8::EpiResF32 E;
            if (k == 3 && l == 0) E = pg8::EpiResF32{xp, xs, MP / 256, nullptr, nullptr, DM, XN, DM, RS + (size_t)1 * M_ALL};
            else if (k == 3) E = pg8::EpiResF32{nullptr, nullptr, 0, XN, nullptr, DM, XN, DM, RS + (size_t)3 * M_ALL};
            else if (l == 0) E = pg8::EpiResF32{nullptr, nullptr, 0, XN, nullptr, DM, XN, DM, RS + (size_t)2 * M_ALL};
            else E = pg8::EpiResF32{nullptr, nullptr, 0, XN, out, DM, nullptr, DM, nullptr};
            pg8::gemm_phase<pg8::EpiResF32, pg8::StaticOrder, true, true>((PG8_LAS unsigned char*)lds, g, S, E);
#endif
        } else {
#if PHM & 64
            pg8::Gemm g{XN, (const bf16*)(wl + WT_UP), M_ALL, DFF, DM, DM, DM}; pg8::StaticOrder S; S.init(M_ALL, DFF, G, bx);
            pg8::EpiBf16<2> E{HB, LDH, RS + (size_t)(2 * l + 1) * M_ALL};
            for (int rep = 0; rep < PROBE_REP_UP; ++rep)
            pg8::gemm_phase<pg8::EpiBf16<2>, pg8::StaticOrder, true, true>((PG8_LAS unsigned char*)lds, g, S, E);
#endif
        }
        if (ph + 1 < args.ph_hi) { if (ph == args.ph_lo) grid.sync(); else xcd_barrier(bar); }
    }
}

extern "C" void kernel_launch(void* const* d_in, const int* in_sizes, int n_in, void* d_out, int out_size, void* d_ws, size_t ws_size, hipStream_t stream) {
    static int grid = 0;
    if (grid == 0) {
        if (n_in != 19 || out_size != M_ALL * DM || ws_size < WS_END) { fprintf(stderr, "kernel_launch: unexpected shapes: n_in %d out %d ws %zu (need %zu)\n", n_in, out_size, ws_size, (size_t)WS_END); grid = -1; return; }
        int dev = 0, cus = 0, per_cu = 0;
        if (hipGetDevice(&dev) != hipSuccess || hipDeviceGetAttribute(&cus, hipDeviceAttributeMultiprocessorCount, dev) != hipSuccess) { fprintf(stderr, "kernel_launch: device query failed\n"); grid = -1; return; }
        if (hipFuncSetAttribute((const void*)mk_fwd, hipFuncAttributeMaxDynamicSharedMemorySize, LDS_BYTES) != hipSuccess) { fprintf(stderr, "kernel_launch: hipFuncSetAttribute failed\n"); grid = -1; return; }
        if (hipOccupancyMaxActiveBlocksPerMultiprocessor(&per_cu, (const void*)mk_fwd, NWAVES * 64, LDS_BYTES) != hipSuccess || per_cu < 1) { fprintf(stderr, "kernel_launch: occupancy query gave %d\n", per_cu); per_cu = 1; }
        (void)hipGetLastError();
        grid = cus * 1;
        fprintf(stderr, "kernel_launch: grid %d (cus %d, per_cu %d)\n", grid, cus, per_cu);
    }
    if (grid < 0) return;
    if (hipMemsetAsync(d_ws, 0, 65536, stream) != hipSuccess) { fprintf(stderr, "kernel_launch: memset failed\n"); return; }
    Args a{};
    for (int i = 0; i < 19; ++i) a.in[i] = (const float*)d_in[i];
    a.out = (float*)d_out; a.ws = (unsigned char*)d_ws;
#if MK_SINGLE
    a.ph_lo = 0; a.ph_hi = N_PHASES;
    { void* kargs[] = {&a}; hipError_t e = hipLaunchCooperativeKernel((const void*)mk_fwd, dim3(grid), dim3(NWAVES * 64), kargs, LDS_BYTES, stream);
      if (e != hipSuccess) fprintf(stderr, "kernel_launch: cooperative launch failed: %s\n", hipGetErrorString(e)); }
#else
    for (int ph = 0; ph < N_PHASES; ++ph) { a.ph_lo = ph; a.ph_hi = ph + 1; void* kargs[] = {&a};
        hipError_t e = hipLaunchCooperativeKernel((const void*)mk_fwd, dim3(grid), dim3(NWAVES * 64), kargs, LDS_BYTES, stream);
        if (e != hipSuccess) { fprintf(stderr, "kernel_launch: cooperative launch %d failed: %s\n", ph, hipGetErrorString(e)); break; } }
#endif
}
```

```cpp
#include <hip/hip_runtime.h>
#include <hip/hip_cooperative_groups.h>
#include <hip/hip_bf16.h>
#include <cstdio>
#include <cstdint>
namespace cg = cooperative_groups;
namespace pg8 {
#define PG8_LAS __attribute__((address_space(3)))
typedef unsigned short bf16_t;
typedef short bf16x8 __attribute__((ext_vector_type(8)));
typedef float f32x4 __attribute__((ext_vector_type(4)));
typedef unsigned u32x4 __attribute__((ext_vector_type(4)));
constexpr int BM = 256, BK = 64, HALF = 128, HTB = HALF * BK * 2  , STAGE_BYTES = 8 * HTB, NXCD = 8, WGM = 8;

__host__ __device__ __forceinline__ int lds_byte(int r, int c) { const int st = (r >> 4) * 2 + (c >> 5), rr = r & 15, cc = c & 31, ob = rr * 64 + cc * 2; return st * 1024 + (ob ^ (((ob >> 9) & 1) << 5)); }
__host__ __device__ __forceinline__ void stage_rc(int b, int& R, int& C) { const int st = b / 1024, sb = b % 1024, swz = sb ^ (((sb >> 9) & 1) << 5); R = (st >> 1) * 16 + swz / 64; C = (st & 1) * 32 + (swz % 64) / 2; }
__host__ __device__ __forceinline__ int perm32(int rho) { const int n = rho >> 4, i = rho & 15; return 8 * (i >> 2) + 4 * n + (i & 3); }

struct Unit { int pm, pn; };
struct Gemm { const bf16_t* A; const bf16_t* Bt; int M, N, K, lda, ldb; };

struct StaticOrder {
    int nM, nN, nwg, G, c;
    __host__ __device__ void init(int M, int N, int G_, int c_) { nM = M / BM; nN = N / BM; nwg = nM * nN; G = G_; c = c_; }
    __host__ __device__ bool next(int i, Unit& u) const {
        const long L = (long)i * G + c; if (L >= nwg) return false;
        int wgid = (int)L; { const int q = nwg / NXCD, r = nwg % NXCD, xcd = wgid % NXCD, off = wgid / NXCD; wgid = (xcd < r ? xcd * (q + 1) : r * (q + 1) + (xcd - r) * q) + off; }
        const int nig = WGM * nN, gid = wgid / nig, fm = gid * WGM, gsz = (nM - fm) < WGM ? (nM - fm) : WGM;
        u.pm = fm + ((wgid % nig) % gsz); u.pn = (wgid % nig) / gsz; return true;
    }
    __device__ __forceinline__ void a_ready(const Unit&) const {}
    __device__ __forceinline__ void done(const Unit&) const {}
};

__device__ __forceinline__ unsigned cvt_pk_bf16(float lo, float hi) { unsigned r; asm volatile("v_cvt_pk_bf16_f32 %0, %1, %2" : "=v"(r) : "v"(lo), "v"(hi)); return r; }
typedef float f32x2 __attribute__((ext_vector_type(2)));
typedef unsigned u32x2 __attribute__((ext_vector_type(2)));
template <int ACT> struct EpiBf16 {
    static constexpr bool PERM = true, AFTER_DRAIN = false;
    bf16_t* O; int ldc; const float* rowss;
    __device__ __forceinline__ void operator()(const f32x4 (&acc)[2][2][4][2], const Unit& u, int wr, int wc, int fr, int fq) const {
        const int row0 = u.pm * BM + wr * 64 + fr; const int col0 = u.pn * BM + wc * 32 + 8 * fq;
        float rs[2][4];
#pragma unroll
        for (int ai = 0; ai < 2; ++ai)
#pragma unroll
            for (int m = 0; m < 4; ++m) rs[ai][m] = rowss[row0 + ai * HALF + m * 16];
#pragma unroll
        for (int ai = 0; ai < 2; ++ai)
#pragma unroll
            for (int m = 0; m < 4; ++m) { bf16_t* rowp = O + (size_t)(row0 + ai * HALF + m * 16) * ldc + col0;
                const float sc = 1.0f / sqrtf(rs[ai][m] * (1.0f / 2048.0f) + 1e-6f);
#pragma unroll
                for (int bj = 0; bj < 2; ++bj) { f32x4 v0 = acc[ai][bj][m][0] * sc, v1 = acc[ai][bj][m][1] * sc;
                    if (ACT == 2) {
#pragma unroll
                        for (int e = 0; e < 4; ++e) { float a = fmaxf(v0[e], 0.f), b = fmaxf(v1[e], 0.f); v0[e] = a * a; v1[e] = b * b; } }
                    u32x4 w; w.x = cvt_pk_bf16(v0[0], v0[1]); w.y = cvt_pk_bf16(v0[2], v0[3]); w.z = cvt_pk_bf16(v1[0], v1[1]); w.w = cvt_pk_bf16(v1[2], v1[3]);
                    *(u32x4*)(rowp + bj * HALF) = w; } }
    }
};
struct EpiResF32 {
    static constexpr bool PERM = true, AFTER_DRAIN = false;
    const float* res_lo; const float* res_hi; int split_pm; const bf16_t* resb; float* out; int ldc; bf16_t* xb; int ldx; float* rowss;
    __device__ __forceinline__ void operator()(const f32x4 (&acc)[2][2][4][2], const Unit& u, int wr, int wc, int fr, int fq) const {
        const float* rbase = (u.pm < split_pm) ? res_lo : (res_hi - (size_t)split_pm * BM * ldc);
        const int col0 = u.pn * BM + wc * 32 + 8 * fq;
#pragma unroll
        for (int ai = 0; ai < 2; ++ai)
#pragma unroll
            for (int m = 0; m < 4; ++m) { const int row = u.pm * BM + ai * HALF + wr * 64 + m * 16 + fr; const size_t off = (size_t)row * ldc + col0, offb = (size_t)row * ldx + col0; float ss = 0.f;
#pragma unroll
                for (int bj = 0; bj < 2; ++bj) {
                    f32x4 v0, v1;
                    if (resb) { const u32x4 r = *(const u32x4*)(resb + offb + bj * HALF);
                        v0 = (f32x4){__uint_as_float(r.x << 16), __uint_as_float(r.x & 0xffff0000u), __uint_as_float(r.y << 16), __uint_as_float(r.y & 0xffff0000u)};
                        v1 = (f32x4){__uint_as_float(r.z << 16), __uint_as_float(r.z & 0xffff0000u), __uint_as_float(r.w << 16), __uint_as_float(r.w & 0xffff0000u)}; }
                    else { v0 = *(const f32x4*)(rbase + off + bj * HALF); v1 = *(const f32x4*)(rbase + off + bj * HALF + 4); }
                    v0 += acc[ai][bj][m][0]; v1 += acc[ai][bj][m][1];
                    if (out) { *(f32x4*)(out + off + bj * HALF) = v0; *(f32x4*)(out + off + bj * HALF + 4) = v1; }
                    if (xb) { u32x4 w; w.x = cvt_pk_bf16(v0[0], v0[1]); w.y = cvt_pk_bf16(v0[2], v0[3]); w.z = cvt_pk_bf16(v1[0], v1[1]); w.w = cvt_pk_bf16(v1[2], v1[3]);
                        *(u32x4*)(xb + offb + bj * HALF) = w;
                        ss += (v0[0] * v0[0] + v0[1] * v0[1]) + (v0[2] * v0[2] + v0[3] * v0[3]) + (v1[0] * v1[0] + v1[1] * v1[1]) + (v1[2] * v1[2] + v1[3] * v1[3]); } }
                if (xb) { ss += __shfl_xor(ss, 16); ss += __shfl_xor(ss, 32);
                    if (fq == 0) __hip_atomic_fetch_add(rowss + row, ss, __ATOMIC_RELAXED, __HIP_MEMORY_SCOPE_AGENT); }
                if (m == 3) asm volatile("" ::: "memory"); }
    }
};
template <class Epi, class Sched, bool ALIGN_EPI = false, bool SP2 = false>
__device__ __forceinline__ void gemm_phase(PG8_LAS unsigned char* lds, const Gemm g, const Sched& S, const Epi& E) {
    int tid = threadIdx.x; asm volatile("" : "+v"(tid));
    const int wid = __builtin_amdgcn_readfirstlane(tid >> 6), lane = tid & 63, wr = wid >> 2, wc = wid & 3, fr = lane & 15, fq = lane >> 4;
    const int K = g.K, nt = K / BK;
    unsigned voffA[2], voffB[2];
#pragma unroll
    for (int i = 0; i < 2; ++i) { int R, C; stage_rc(tid * 16 + i * 8192, R, C); const int Rb = Epi::PERM ? ((R & ~31) + perm32(R & 31)) : R;
        voffA[i] = (unsigned)(R * g.lda + C) * 2u; voffB[i] = (unsigned)(Rb * g.ldb + C) * 2u; }
    const size_t kstep = (size_t)(BK * 2);
    const size_t hstepA = (size_t)HALF * g.lda * 2, hstepB = (size_t)HALF * g.ldb * 2;
    const size_t tstepA = 2 * hstepA, tstepB = 2 * hstepB;
    const unsigned ldsw = (unsigned)wid * 1024u;
    const int aoff = lds_byte(wr * 64 + fr, fq * 8), boff = lds_byte(wc * 32 + fr, fq * 8);
#define PG8_SA(b, h) (((b) * 2 + (h)) * HTB)
#define PG8_SB(b, h) ((4 + (b) * 2 + (h)) * HTB)
#define PG8_STAGE(bufoff, gbase, voff) do { _Pragma("unroll") for (int _i = 0; _i < 2; ++_i) \
        __builtin_amdgcn_global_load_lds((const unsigned*)((const char*)(gbase) + (voff)[_i]), (PG8_LAS unsigned*)(lds + (bufoff) + ldsw + _i * 8192), 16, 0, 0); } while (0)
#define PG8_LDA(dst, b, h) do { _Pragma("unroll") for (int m = 0; m < 4; ++m) _Pragma("unroll") for (int k = 0; k < 2; ++k) dst[m][k] = *(const PG8_LAS bf16x8*)(lds + PG8_SA(b, h) + aoff + m * 2048 + k * 1024); } while (0)
#define PG8_LDB(dst, b, h) do { _Pragma("unroll") for (int n = 0; n < 2; ++n) _Pragma("unroll") for (int k = 0; k < 2; ++k) dst[n][k] = *(const PG8_LAS bf16x8*)(lds + PG8_SB(b, h) + boff + n * 2048 + k * 1024); } while (0)
#define PG8_MMA(ai, bj, At, Bt) do { __builtin_amdgcn_s_setprio(1); _Pragma("unroll") for (int m = 0; m < 4; ++m) _Pragma("unroll") for (int n = 0; n < 2; ++n) _Pragma("unroll") for (int k = 0; k < 2; ++k) \
        acc[ai][bj][m][n] = __builtin_amdgcn_mfma_f32_16x16x32_bf16(Bt[n][k], At[m][k], acc[ai][bj][m][n], 0, 0, 0); __builtin_amdgcn_s_setprio(0); } while (0)
#define PG8_WAIT_V(n) asm volatile("s_waitcnt vmcnt(" #n ")" ::: "memory")
#define PG8_WAIT_L(n) asm volatile("s_waitcnt lgkmcnt(" #n ")" ::: "memory")
#define PG8_BAR __builtin_amdgcn_s_barrier()
#define PG8_SCHED __builtin_amdgcn_sched_barrier(0)
    Unit cur, nxt; int ui = 0;
    if (!S.next(0, cur)) return;
    f32x4 acc[2][2][4][2];
#pragma unroll
    for (int a = 0; a < 2; ++a)
#pragma unroll
        for (int b = 0; b < 2; ++b)
#pragma unroll
            for (int m = 0; m < 4; ++m)
#pragma unroll
                for (int n = 0; n < 2; ++n) acc[a][b][m][n] = (f32x4){0.f, 0.f, 0.f, 0.f};
    bf16x8 At[4][2], B0[2][2], B1[2][2];
    const char* cA = (const char*)g.A + (size_t)cur.pm * tstepA; const char* cB = (const char*)g.Bt + (size_t)cur.pn * tstepB;
    S.a_ready(cur);
    if constexpr (SP2) {
        PG8_STAGE(PG8_SB(0, 0), cB, voffB); PG8_STAGE(PG8_SB(0, 1), cB + hstepB, voffB); PG8_STAGE(PG8_SA(0, 0), cA, voffA); PG8_STAGE(PG8_SA(0, 1), cA + hstepA, voffA);
        if (wr == 1) PG8_BAR;
        PG8_WAIT_V(2); PG8_BAR;
        PG8_STAGE(PG8_SB(1, 0), cB + kstep, voffB); PG8_STAGE(PG8_SA(1, 0), cA + kstep, voffA); PG8_STAGE(PG8_SB(1, 1), cB + hstepB + kstep, voffB);
        PG8_WAIT_V(6); PG8_BAR;
    } else {
        PG8_STAGE(PG8_SB(0, 0), cB, voffB); PG8_STAGE(PG8_SA(0, 0), cA, voffA); PG8_STAGE(PG8_SB(0, 1), cB + hstepB, voffB); PG8_STAGE(PG8_SA(0, 1), cA + hstepA, voffA);
        if (wr == 1) PG8_BAR;
        PG8_WAIT_V(4); PG8_BAR;
        PG8_STAGE(PG8_SB(1, 0), cB + kstep, voffB); PG8_STAGE(PG8_SA(1, 0), cA + kstep, voffA); PG8_STAGE(PG8_SB(1, 1), cB + hstepB + kstep, voffB);
        PG8_WAIT_V(6); PG8_BAR;
    }
    for (;;) {
        const bool has_next = S.next(ui + 1, nxt);
        const char* nA = has_next ? (const char*)g.A + (size_t)nxt.pm * tstepA : cA; const char* nB = has_next ? (const char*)g.Bt + (size_t)nxt.pn * tstepB : cB;
        for (int t = 0; t < nt; t += 2) {
            const bool last = (t == nt - 2);
            const char* a1 = cA + (size_t)(t + 1) * kstep;
            const char* a2 = last ? nA : cA + (size_t)(t + 2) * kstep; const char* b2 = last ? nB : cB + (size_t)(t + 2) * kstep;
            const char* a3 = a2 + kstep; const char* b3 = b2 + kstep;
            if (last && has_next) S.a_ready(nxt);
            if constexpr (SP2) {
            PG8_LDB(B0, 0, 0); PG8_LDB(B1, 0, 1); PG8_SCHED; PG8_LDA(At, 0, 0); PG8_STAGE(PG8_SA(1, 1), a1 + hstepA, voffA);
            PG8_WAIT_V(8); PG8_WAIT_L(0); PG8_BAR; PG8_MMA(0, 0, At, B0); PG8_MMA(0, 1, At, B1); PG8_BAR; PG8_SCHED;
            PG8_LDA(At, 0, 1); PG8_STAGE(PG8_SB(0, 0), b2, voffB); PG8_STAGE(PG8_SB(0, 1), b2 + hstepB, voffB); PG8_STAGE(PG8_SA(0, 0), a2, voffA);
            PG8_WAIT_V(8); PG8_WAIT_L(0); PG8_BAR; PG8_MMA(1, 0, At, B0); PG8_MMA(1, 1, At, B1); PG8_BAR; PG8_SCHED;
            PG8_LDB(B0, 1, 0); PG8_LDB(B1, 1, 1); PG8_SCHED; PG8_LDA(At, 1, 0); PG8_STAGE(PG8_SA(0, 1), a2 + hstepA, voffA);
            PG8_WAIT_V(8); PG8_WAIT_L(0); PG8_BAR; PG8_MMA(0, 0, At, B0); PG8_MMA(0, 1, At, B1); PG8_BAR; PG8_SCHED;
            PG8_LDA(At, 1, 1); PG8_STAGE(PG8_SB(1, 0), b3, voffB); PG8_STAGE(PG8_SB(1, 1), b3 + hstepB, voffB); PG8_STAGE(PG8_SA(1, 0), a3, voffA);
            PG8_WAIT_V(8); PG8_WAIT_L(0); PG8_BAR; PG8_MMA(1, 0, At, B0); PG8_MMA(1, 1, At, B1); PG8_BAR; PG8_SCHED;
            } else {
            PG8_LDB(B0, 0, 0); PG8_SCHED; PG8_LDA(At, 0, 0); PG8_STAGE(PG8_SA(1, 1), a1 + hstepA, voffA);
            PG8_WAIT_L(8); PG8_BAR; PG8_WAIT_L(0); PG8_MMA(0, 0, At, B0); PG8_BAR; PG8_SCHED;
            PG8_LDB(B1, 0, 1); PG8_STAGE(PG8_SB(0, 0), b2, voffB);
            PG8_BAR; PG8_WAIT_L(0); PG8_MMA(0, 1, At, B1); PG8_BAR;
            PG8_LDA(At, 0, 1); PG8_STAGE(PG8_SA(0, 0), a2, voffA);
            PG8_BAR; PG8_WAIT_L(0); PG8_MMA(1, 0, At, B0); PG8_BAR; PG8_SCHED;
            PG8_STAGE(PG8_SB(0, 1), b2 + hstepB, voffB);
            PG8_WAIT_V(6); PG8_BAR; PG8_MMA(1, 1, At, B1); PG8_BAR;
            PG8_LDB(B0, 1, 0); PG8_SCHED; PG8_LDA(At, 1, 0); PG8_STAGE(PG8_SA(0, 1), a2 + hstepA, voffA);
            PG8_WAIT_L(8); PG8_BAR; PG8_WAIT_L(0); PG8_MMA(0, 0, At, B0); PG8_BAR; PG8_SCHED;
            PG8_LDB(B1, 1, 1); PG8_STAGE(PG8_SB(1, 0), b3, voffB);
            PG8_BAR; PG8_WAIT_L(0); PG8_MMA(0, 1, At, B1); PG8_BAR;
            PG8_LDA(At, 1, 1); PG8_STAGE(PG8_SA(1, 0), a3, voffA);
            PG8_BAR; PG8_WAIT_L(0); PG8_MMA(1, 0, At, B0); PG8_BAR; PG8_SCHED;
            PG8_STAGE(PG8_SB(1, 1), b3 + hstepB, voffB);
            PG8_WAIT_V(6); PG8_BAR; PG8_MMA(1, 1, At, B1); PG8_BAR;
            }
        }
        if constexpr (ALIGN_EPI) { if (wr == 0) PG8_BAR; }
        if constexpr (!Epi::AFTER_DRAIN) { E(acc, cur, wr, wc, fr, fq); S.done(cur); }
        if (!has_next) break;
#pragma unroll
        for (int a = 0; a < 2; ++a)
#pragma unroll
            for (int b = 0; b < 2; ++b)
#pragma unroll
                for (int m = 0; m < 4; ++m)
#pragma unroll
                    for (int n = 0; n < 2; ++n) acc[a][b][m][n] = (f32x4){0.f, 0.f, 0.f, 0.f};
        cur = nxt; cA = nA; cB = nB; ++ui;
        if constexpr (ALIGN_EPI) { if (wr == 1) PG8_BAR; }
    }
    PG8_WAIT_V(0);
    if constexpr (!ALIGN_EPI) { if (wr == 0) PG8_BAR; }
    PG8_BAR;
    if constexpr (Epi::AFTER_DRAIN) { E.fused(acc, cur, wr, wc, fr, fq, lds, wid, lane); S.done(cur); }
#undef PG8_SA
#undef PG8_SB
#undef PG8_STAGE
#undef PG8_LDA
#undef PG8_LDB
#undef PG8_MMA
#undef PG8_WAIT_V
#undef PG8_WAIT_L
#undef PG8_BAR
#undef PG8_SCHED
}
}

#ifndef PROBE_REP_ATT
#define PROBE_REP_ATT 1
#endif
#ifndef PROBE_REP_UP
#define PROBE_REP_UP 1
#endif
#ifndef PROBE_XSYNC
#define PROBE_XSYNC 0
#endif
#ifndef PROBE_REP_MISC
#define PROBE_REP_MISC 1
#endif
#ifndef PROBE_REP_WIN
#define PROBE_REP_WIN 1
#endif
#ifndef PHM
#define PHM 127
#endif
#ifndef MK_SINGLE
#define MK_SINGLE 1
#endif
constexpr int DM = 2048, MP = 8192, M_ALL = 40960, SEQ_P = 4096, SEQ_S = 16384, INW = 5632, DFF = 8192, NLAYER = 2;
constexpr int OFF_AX = 0, OFF_AB = 512, OFF_AC = 1024, OFF_Q = 1536, OFF_K = 2560, OFF_V = 3584, OFF_CU = 4608, OFF_CV = 5120;
constexpr int MIX_A = 0, MIX_B = 512, MIX_C = 1536;
constexpr float EPS = 1e-6f;
constexpr float C2 = 0.18033688011112042f;
constexpr size_t MiB = 1u << 20;
constexpr int LDH = DFF + 128;
constexpr size_t WS_WT = 1 * MiB, WT_LAYER = 96 * MiB, WT_IN = 0, WT_OUT = 22 * MiB, WT_UP = 30 * MiB, WT_DN = 62 * MiB;
constexpr size_t WS_XN = 194 * MiB, WS_H = 356 * MiB, WS_PROJ = 356 * MiB, WS_MIX = 796 * MiB, WS_END = 1008 * MiB;
static_assert(WT_DN + (size_t)DM * LDH * 2 <= WT_LAYER && WS_WT + 2 * WT_LAYER <= WS_XN && WS_XN + (size_t)M_ALL * DM * 2 <= WS_H && WS_PROJ + (size_t)M_ALL * INW * 2 <= WS_MIX && WS_MIX + (size_t)M_ALL * DM * 2 <= WS_END && WS_H + (size_t)M_ALL * LDH * 2 <= WS_END, "ws map");
constexpr int NWAVES = 8, LDS_BYTES = 147456;

typedef unsigned short bf16;
typedef unsigned v4u __attribute__((ext_vector_type(4)));
typedef unsigned v2u __attribute__((ext_vector_type(2)));
typedef float f32x4 __attribute__((ext_vector_type(4)));
#define DI __device__ __forceinline__

DI unsigned pk2(float lo, float hi) { return pg8::cvt_pk_bf16(lo, hi); }
DI float bflo(unsigned u) { return __uint_as_float(u << 16); }
DI float bfhi(unsigned u) { return __uint_as_float(u & 0xffff0000u); }
DI float wave_sum(float v) {
#pragma unroll
    for (int o = 1; o < 64; o <<= 1) v += __shfl_xor(v, o);
    return v;
}
DI float wave_max(float v) {
#pragma unroll
    for (int o = 1; o < 64; o <<= 1) v = fmaxf(v, __shfl_xor(v, o));
    return v;
}
DI float gelu_tanh(float x) {
    const float z = x * (0.7978845608028654f + 0.035677408136300125f * x * x);
    const float e = __builtin_amdgcn_exp2f(-2.8853900817779268f * z);
    return x * __builtin_amdgcn_rcpf(1.0f + e);
}

DI void transpose_item(const float* W, int K, int N, bf16* WT, int ldt, const float* gain, float* scr, int item, int lane) {
    const int nblk = N / 32, kb = item / nblk, nb = item % nblk, k0 = 64 * kb, n0 = 32 * nb;
#pragma unroll 32
    for (int i = 0; i < 32; ++i) { const int kk = 2 * i + (lane >> 5); scr[kk * 33 + (lane & 31)] = W[(size_t)(k0 + kk) * N + n0 + (lane & 31)] * (gain ? gain[k0 + kk] : 1.0f); }
    asm volatile("s_waitcnt lgkmcnt(0)" ::: "memory");
    const int c = lane & 7;
#pragma unroll
    for (int j = 0; j < 4; ++j) { const int n = (lane >> 3) + 8 * j; const float* s = scr + (8 * c) * 33 + n;
        v4u o; o.x = pk2(s[0 * 33], s[1 * 33]); o.y = pk2(s[2 * 33], s[3 * 33]); o.z = pk2(s[4 * 33], s[5 * 33]); o.w = pk2(s[6 * 33], s[7 * 33]);
        *(v4u*)(WT + (size_t)(n0 + n) * ldt + k0 + 8 * c) = o; }
    asm volatile("s_waitcnt lgkmcnt(0)" ::: "memory");
}
DI void xb_row(const float* xrow, bf16* orow, float* ssp, int lane) {
    const f32x4* xr = (const f32x4*)xrow + lane;
    f32x4 v[8]; float s = 0.f;
#pragma unroll
    for (int j = 0; j < 8; ++j) { v[j] = xr[64 * j]; s += (v[j].x * v[j].x + v[j].y * v[j].y) + (v[j].z * v[j].z + v[j].w * v[j].w); }
    s = wave_sum(s);
    if (lane == 0) *ssp = s;
    v2u* o8 = (v2u*)orow + lane;
#pragma unroll
    for (int j = 0; j < 8; ++j) { v2u w; w.x = pk2(v[j].x, v[j].y); w.y = pk2(v[j].z, v[j].w); o8[64 * j] = w; }
}

__constant__ double ROPE_INV[8] = {1.0, 0.19392274474868576, 0.03760603093086393, 0.007292664737217109, 0.001414213562373095, 0.0002742481756762073, 5.318295896944988e-05, 1.031338537721246e-05};
DI void k_rows(bf16* P, int row2, const float* kg, int lane) {
    const int row = row2 + (lane >> 5), l5 = lane & 31;
    const int pos = row < MP ? (row & (SEQ_P - 1)) : ((row - MP) & (SEQ_S - 1));
    bf16* p = P + (size_t)row * INW + OFF_K + l5 * 32;
    v4u raw[4];
#pragma unroll
    for (int i = 0; i < 4; ++i) raw[i] = *(const v4u*)(p + 8 * i);
    float x[32];
#pragma unroll
    for (int i = 0; i < 4; ++i) { x[8 * i + 0] = bflo(raw[i].x); x[8 * i + 1] = bfhi(raw[i].x); x[8 * i + 2] = bflo(raw[i].y); x[8 * i + 3] = bfhi(raw[i].y);
        x[8 * i + 4] = bflo(raw[i].z); x[8 * i + 5] = bfhi(raw[i].z); x[8 * i + 6] = bflo(raw[i].w); x[8 * i + 7] = bfhi(raw[i].w); }
    float ss = 0.f;
#pragma unroll
    for (int i = 0; i < 32; ++i) ss += x[i] * x[i];
    ss += __shfl_xor(ss, 1);
    const float rstd = 1.0f / sqrtf(ss * (1.f / 64.f) + EPS);
    const int half = l5 & 1;
    const float* g = kg + half * 32;
#pragma unroll
    for (int i = 0; i < 8; ++i) { const f32x4 gg = *(const f32x4*)(g + 4 * i); x[4 * i] *= rstd * gg.x; x[4 * i + 1] *= rstd * gg.y; x[4 * i + 2] *= rstd * gg.z; x[4 * i + 3] *= rstd * gg.w; }
    const double t = (double)pos * ROPE_INV[lane & 7] * 0.15915494309189535;
    const float fr = (float)(t - rint(t));
    const float cs = __builtin_amdgcn_cosf(fr), sn = __builtin_amdgcn_sinf(fr);
#pragma unroll
    for (int i = 0; i < 8; ++i) { const float c = __shfl(cs, (lane & 32) + i), s_ = __shfl(sn, (lane & 32) + i);
        if (half == 0) { const float a = x[i], b = x[i + 8]; x[i] = a * c - b * s_; x[i + 8] = b * c + a * s_; } }
#pragma unroll
    for (int i = 0; i < 4; ++i) { v4u w; w.x = pk2(x[8 * i], x[8 * i + 1]); w.y = pk2(x[8 * i + 2], x[8 * i + 3]); w.z = pk2(x[8 * i + 4], x[8 * i + 5]); w.w = pk2(x[8 * i + 6], x[8 * i + 7]);
        *(v4u*)(p + 8 * i) = w; }
}
DI void unpack8(const v4u r, float* x) { x[0] = bflo(r.x); x[1] = bfhi(r.x); x[2] = bflo(r.y); x[3] = bfhi(r.y); x[4] = bflo(r.z); x[5] = bfhi(r.z); x[6] = bflo(r.w); x[7] = bfhi(r.w); }
DI void conv_row(const bf16* P, bf16* MIX, int row, int pos, int S, const float* cw, int lane) {
    const bf16* p = P + (size_t)row * INW + lane * 8;
    const v4u z4 = {0u, 0u, 0u, 0u};
    const v4u xa0 = *(const v4u*)(p + OFF_AX), gc0 = *(const v4u*)(p + OFF_AC), gb0 = *(const v4u*)(p + OFF_AB);
    const v4u xam = pos > 0 ? *(const v4u*)(p - INW + OFF_AX) : z4, gcm = pos > 0 ? *(const v4u*)(p - INW + OFF_AC) : z4;
    const v4u xap = pos < S - 1 ? *(const v4u*)(p + INW + OFF_AX) : z4, gcp = pos < S - 1 ? *(const v4u*)(p + INW + OFF_AC) : z4;
    float a0[8], c0[8], b0[8], am[8], cm[8], ap[8], cp[8];
    unpack8(xa0, a0); unpack8(gc0, c0); unpack8(gb0, b0); unpack8(xam, am); unpack8(gcm, cm); unpack8(xap, ap); unpack8(gcp, cp);
    float w0[8], w1[8], w2[8];
#pragma unroll
    for (int i = 0; i < 2; ++i) { const f32x4 a = *(const f32x4*)(cw + lane * 8 + 4 * i), b = *(const f32x4*)(cw + 512 + lane * 8 + 4 * i), c = *(const f32x4*)(cw + 1024 + lane * 8 + 4 * i);
        w0[4 * i] = a.x; w0[4 * i + 1] = a.y; w0[4 * i + 2] = a.z; w0[4 * i + 3] = a.w; w1[4 * i] = b.x; w1[4 * i + 1] = b.y; w1[4 * i + 2] = b.z; w1[4 * i + 3] = b.w;
        w2[4 * i] = c.x; w2[4 * i + 1] = c.y; w2[4 * i + 2] = c.z; w2[4 * i + 3] = c.w; }
    float o[8];
#pragma unroll
    for (int j = 0; j < 8; ++j) o[j] = b0[j] * (w0[j] * (cm[j] * am[j]) + w1[j] * (c0[j] * a0[j]) + w2[j] * (cp[j] * ap[j]));
    v4u w; w.x = pk2(o[0], o[1]); w.y = pk2(o[2], o[3]); w.z = pk2(o[4], o[5]); w.w = pk2(o[6], o[7]);
    *(v4u*)(MIX + (size_t)row * DM + MIX_A + lane * 8) = w;
}

namespace att {
using bf16x8 = __attribute__((ext_vector_type(8))) short;
using s16x4  = __attribute__((ext_vector_type(4))) short;
using f32x16 = __attribute__((ext_vector_type(16))) float;
using u32x4  = __attribute__((ext_vector_type(4))) unsigned;
constexpr int KVBLK = 64;
constexpr int SHM_V = 16384, SHM_K = 16384, SCR_OFF = 133120;
#define KSWZ(row, colB) ((row) * 256 + ((colB) ^ (((row) & 15) << 4)))
#define SBAR() __builtin_amdgcn_sched_barrier(0)
DI int crow(int r, int hi) { return (r & 3) + 8 * (r >> 2) + 4 * hi; }
DI unsigned cvtpk(float lo, float hi) { unsigned r; asm volatile("v_cvt_pk_bf16_f32 %0, %1, %2" : "=v"(r) : "v"(lo), "v"(hi)); return r; }
DI int v_st(int k, int c) { const int kk = (k & ~0xC) | ((k & 4) << 1) | ((k & 8) >> 1); return ((kk >> 3) * 4 + (c >> 5)) * 512 + ((kk & 7) * 32 + (c & 31)) * 2; }
DI int v_rd_base(int lane) { return ((lane & 3) << 3) | (((lane >> 2) & 3) << 6) | (((lane >> 4) & 1) << 5) | (((lane >> 5) & 1) << 8); }
constexpr int v_rd_off(int d0, int ks, int half) { return d0 * 512 + ks * 4096 + half * 2048; }
template <int OFF> DI s16x4 tr_read(int vb) { s16x4 r; asm volatile("ds_read_b64_tr_b16 %0, %1 offset:%2" : "=&v"(r) : "v"(vb), "i"(OFF) : "memory"); return r; }
template <int D0> DI void pv_one(f32x16& od, int vb, bf16x8 pa0, bf16x8 pa1, bf16x8 pa2, bf16x8 pa3) {
  const s16x4 l0 = tr_read<v_rd_off(D0, 0, 0)>(vb), h0 = tr_read<v_rd_off(D0, 0, 1)>(vb), l1 = tr_read<v_rd_off(D0, 1, 0)>(vb), h1 = tr_read<v_rd_off(D0, 1, 1)>(vb);
  const s16x4 l2 = tr_read<v_rd_off(D0, 2, 0)>(vb), h2 = tr_read<v_rd_off(D0, 2, 1)>(vb), l3 = tr_read<v_rd_off(D0, 3, 0)>(vb), h3 = tr_read<v_rd_off(D0, 3, 1)>(vb);
  asm volatile("s_waitcnt lgkmcnt(0)" ::: "memory"); SBAR();
#define PK(L, H) (bf16x8){L[0], L[1], L[2], L[3], H[0], H[1], H[2], H[3]}
  od = __builtin_amdgcn_mfma_f32_32x32x16_bf16(pa0, PK(l0, h0), od, 0, 0, 0);
  od = __builtin_amdgcn_mfma_f32_32x32x16_bf16(pa1, PK(l1, h1), od, 0, 0, 0);
  od = __builtin_amdgcn_mfma_f32_32x32x16_bf16(pa2, PK(l2, h2), od, 0, 0, 0);
  od = __builtin_amdgcn_mfma_f32_32x32x16_bf16(pa3, PK(l3, h3), od, 0, 0, 0);
#undef PK
}
DI void pv_d0(f32x16* o, int vb, bf16x8 pa0, bf16x8 pa1, bf16x8 pa2, bf16x8 pa3) {
  pv_one<0>(o[0], vb, pa0, pa1, pa2, pa3); pv_one<1>(o[1], vb, pa0, pa1, pa2, pa3); pv_one<2>(o[2], vb, pa0, pa1, pa2, pa3); pv_one<3>(o[3], vb, pa0, pa1, pa2, pa3);
}
template <bool SHIFT> DI void qkt(f32x16& p0, f32x16& p1, const char* Ks, const bf16x8* qr, int r32, int hi, int c, float negmb) {
  if constexpr (SHIFT) {
#pragma unroll
    for (int r = 0; r < 16; ++r) { p0[r] = negmb; p1[r] = negmb; }
  } else { p0 = f32x16{}; p1 = f32x16{}; }
#pragma unroll
  for (int d0 = 0; d0 < 4; ++d0) { const int cb = (c * 64 + d0 * 16 + hi * 8) * 2;
    const bf16x8 b0 = *reinterpret_cast<const bf16x8*>(Ks + KSWZ(r32, cb));
    const bf16x8 b1 = *reinterpret_cast<const bf16x8*>(Ks + KSWZ(32 + r32, cb));
    p0 = __builtin_amdgcn_mfma_f32_32x32x16_bf16(b0, qr[d0], p0, 0, 0, 0);
    p1 = __builtin_amdgcn_mfma_f32_32x32x16_bf16(b1, qr[d0], p1, 0, 0, 0); }
}
DI void expA(f32x16& p0) {
#pragma unroll
  for (int r = 0; r < 16; ++r) p0[r] = __builtin_amdgcn_exp2f(p0[r]);
}
DI void finishSM(f32x16& p0, f32x16& p1, float& l_reg, bf16x8& pa0, bf16x8& pa1, bf16x8& pa2, bf16x8& pa3) {
#pragma unroll
  for (int r = 0; r < 16; ++r) p1[r] = __builtin_amdgcn_exp2f(p1[r]);
  float ps = 0.f;
#pragma unroll
  for (int r = 0; r < 16; ++r) ps += p0[r];
#pragma unroll
  for (int r = 0; r < 16; ++r) ps += p1[r];
  l_reg += ps;
#define PK4(P, BASE, OUT) do { unsigned a0 = cvtpk(P[BASE + 0], P[BASE + 1]), a1 = cvtpk(P[BASE + 2], P[BASE + 3]);   \
    unsigned b0 = cvtpk(P[BASE + 4], P[BASE + 5]), b1 = cvtpk(P[BASE + 6], P[BASE + 7]);                              \
    auto r0 = __builtin_amdgcn_permlane32_swap(a0, b0, false, false); auto r1 = __builtin_amdgcn_permlane32_swap(a1, b1, false, false); \
    u32x4 w = {r0[0], r1[0], r0[1], r1[1]}; OUT = *reinterpret_cast<bf16x8*>(&w); } while (0)
  PK4(p0, 0, pa0); PK4(p0, 8, pa1); PK4(p1, 0, pa2); PK4(p1, 8, pa3);
#undef PK4
}
DI unsigned cvtpk2(float lo, float hi) { typedef float f2_t __attribute__((ext_vector_type(2))); typedef __bf16 b2_t __attribute__((ext_vector_type(2))); f2_t v = {lo, hi}; b2_t b = __builtin_convertvector(v, b2_t); return __builtin_bit_cast(unsigned, b); }
template <int I> DI void vrd(s16x4& l, s16x4& h, int vb) { constexpr int ks = I >> 2, d0 = I & 3; l = tr_read<v_rd_off(d0, ks, 0)>(vb); h = tr_read<v_rd_off(d0, ks, 1)>(vb); }
#define TIEWAIT(N, L, H) asm volatile("s_waitcnt lgkmcnt(" #N ")" : "+v"(L), "+v"(H))
#define PK4B(P, BASE, OUT) do { unsigned a0 = cvtpk2(P[BASE + 0], P[BASE + 1]), a1 = cvtpk2(P[BASE + 2], P[BASE + 3]);   \
    unsigned b0 = cvtpk2(P[BASE + 4], P[BASE + 5]), b1 = cvtpk2(P[BASE + 6], P[BASE + 7]);                              \
    auto r0 = __builtin_amdgcn_permlane32_swap(a0, b0, false, false); auto r1 = __builtin_amdgcn_permlane32_swap(a1, b1, false, false); \
    u32x4 w = {r0[0], r1[0], r0[1], r1[1]}; OUT = *reinterpret_cast<bf16x8*>(&w); } while (0)
#define PKV(L, H) (bf16x8){L[0], L[1], L[2], L[3], H[0], H[1], H[2], H[3]}
#define PVSTEP(i, N, PA, SL, SH, NL, NH) do { TIEWAIT(N, SL, SH); o[(i) & 3] = __builtin_amdgcn_mfma_f32_32x32x16_bf16(PA, PKV(SL, SH), o[(i) & 3], 0, 0, 0); \
    if constexpr ((i) + 3 < 16) vrd<((i) + 3 < 16 ? (i) + 3 : 15)>(NL, NH, vb); } while (0)
DI void finish_pv(f32x16& p0, f32x16& p1, float& l_reg, f32x16* o, int vb) {
  s16x4 l0, h0, l1, h1, l2, h2, l3, h3;
  vrd<0>(l0, h0, vb); vrd<1>(l1, h1, vb); vrd<2>(l2, h2, vb);
  bf16x8 pa0, pa1, pa2, pa3;
  PK4B(p0, 0, pa0); PK4B(p0, 8, pa1);
  PVSTEP(0, 4, pa0, l0, h0, l3, h3); PVSTEP(1, 4, pa0, l1, h1, l0, h0); PVSTEP(2, 4, pa0, l2, h2, l1, h1); PVSTEP(3, 4, pa0, l3, h3, l2, h2);
  PVSTEP(4, 4, pa1, l0, h0, l3, h3); PVSTEP(5, 4, pa1, l1, h1, l0, h0); PVSTEP(6, 4, pa1, l2, h2, l1, h1); PVSTEP(7, 4, pa1, l3, h3, l2, h2);
  PK4B(p1, 0, pa2); PK4B(p1, 8, pa3);
  PVSTEP(8, 4, pa2, l0, h0, l3, h3); PVSTEP(9, 4, pa2, l1, h1, l0, h0); PVSTEP(10, 4, pa2, l2, h2, l1, h1); PVSTEP(11, 4, pa2, l3, h3, l2, h2);
  PVSTEP(12, 4, pa3, l0, h0, l3, h3); PVSTEP(13, 4, pa3, l1, h1, l0, h0); PVSTEP(14, 2, pa3, l2, h2, l1, h1); PVSTEP(15, 0, pa3, l3, h3, l2, h2);
  float ps = 0.f;
#pragma unroll
  for (int r = 0; r < 16; ++r) ps += p0[r];
#pragma unroll
  for (int r = 0; r < 16; ++r) ps += p1[r];
  l_reg += ps;
}
DI void glds16(const void* gsrc, unsigned lds_dst) { unsigned keep;
  asm volatile("s_mov_b32 %0, m0\n\ts_mov_b32 m0, %2\n\ts_nop 0\n\tglobal_load_lds_dwordx4 %1, off\n\ts_mov_b32 m0, %0" : "=&s"(keep) : "v"(gsrc), "s"(lds_dst) : "memory"); }
#define WAIT_BAR(N) asm volatile("s_waitcnt vmcnt(" #N ") lgkmcnt(0)\n\ts_barrier" ::: "memory")
template <bool SHIFT> DI void attn_unit(const bf16* __restrict__ Qb, const bf16* __restrict__ Kh, const bf16* __restrict__ Vh, bf16* __restrict__ Ob, int seq, char* lds,
                  float negmb, float lam, const float* __restrict__ gsub, float post, const float* __restrict__ qg, int qpos0) {
  int tid = threadIdx.x; asm volatile("" : "+v"(tid));
  const int lane = tid & 63, r32 = lane & 31, hi = lane >> 5; const int wid = __builtin_amdgcn_readfirstlane(tid >> 6), c = wid >> 2, wq = wid & 3;
  char* K_ring = lds; char* V_ring = lds + 3 * SHM_K;
  float* wsf = (float*)(lds + SCR_OFF) + wid * 64;
  const unsigned lds0 = (unsigned)(uintptr_t)lds;
  float l_reg = 0.f; f32x16 o[4] = {}; bf16x8 qr[4];
  const bf16* Qw = Qb + (size_t)(wq * 32 + r32) * INW + c * 64 + hi * 8;
#pragma unroll
  for (int d0 = 0; d0 < 4; ++d0) qr[d0] = *reinterpret_cast<const bf16x8*>(Qw + d0 * 16);
  const bf16* ksrc0; const bf16* ksrc1; const bf16* vsrc0; const bf16* vsrc1;
  { const int row0 = 8 * wid + (lane >> 4), row1 = row0 + 4, cp = lane & 15;
    ksrc0 = Kh + (size_t)row0 * INW + ((cp ^ (row0 & 15)) << 3); ksrc1 = Kh + (size_t)row1 * INW + ((cp ^ (row1 & 15)) << 3);
    const int kk = 8 * wid + ((lane & 31) >> 2), kkey = (kk & ~0xC) | ((kk & 4) << 1) | ((kk & 8) >> 1), cc = (lane >> 5) * 32 + (lane & 3) * 8;
    vsrc0 = Vh + (size_t)kkey * INW + cc; vsrc1 = vsrc0 + 64; }
  const unsigned kdst = lds0 + (unsigned)wid * 2048u, vdst = lds0 + 3u * SHM_K + (unsigned)wid * 2048u;
#define DMA_K(t, slot) do { const size_t to_ = (size_t)(t) * (KVBLK * INW); const unsigned d_ = (unsigned)__builtin_amdgcn_readfirstlane(kdst + (unsigned)(slot)); glds16(ksrc0 + to_, d_); glds16(ksrc1 + to_, d_ + 1024u); } while (0)
#define DMA_V(t, slot) do { const size_t to_ = (size_t)(t) * (KVBLK * INW); const unsigned d_ = (unsigned)__builtin_amdgcn_readfirstlane(vdst + (unsigned)(slot)); glds16(vsrc0 + to_, d_); glds16(vsrc1 + to_, d_ + 1024u); } while (0)
  const int vb0 = (int)(lds0 + 3u * SHM_K) + v_rd_base(lane);
  f32x16 pA0, pA1, pB0, pB1; const int NT = seq / KVBLK;
  int s0 = 0, s1 = SHM_K, s2 = 2 * SHM_K;
#define ROT() do { const int t_ = s0; s0 = s1; s1 = s2; s2 = t_; } while (0)
  DMA_K(0, 0); DMA_K(1, SHM_K); DMA_V(0, 0);
  { float x[4][8]; float ss = 0.f;
#pragma unroll
    for (int d0 = 0; d0 < 4; ++d0) { const u32x4 u = __builtin_bit_cast(u32x4, qr[d0]);
      x[d0][0] = __uint_as_float(u.x << 16); x[d0][1] = __uint_as_float(u.x & 0xffff0000u); x[d0][2] = __uint_as_float(u.y << 16); x[d0][3] = __uint_as_float(u.y & 0xffff0000u);
      x[d0][4] = __uint_as_float(u.z << 16); x[d0][5] = __uint_as_float(u.z & 0xffff0000u); x[d0][6] = __uint_as_float(u.w << 16); x[d0][7] = __uint_as_float(u.w & 0xffff0000u);
#pragma unroll
      for (int e = 0; e < 8; ++e) ss += x[d0][e] * x[d0][e]; }
    ss += __shfl_xor(ss, 32);
    const float rstd = 1.0f / sqrtf(ss * (1.f / 64.f) + EPS);
#pragma unroll
    for (int d0 = 0; d0 < 4; ++d0) { const f32x4 g0 = *(const f32x4*)(qg + 16 * d0 + 8 * hi), g1 = *(const f32x4*)(qg + 16 * d0 + 8 * hi + 4);
#pragma unroll
      for (int e = 0; e < 4; ++e) { x[d0][e] *= rstd * g0[e]; x[d0][4 + e] *= rstd * g1[e]; } }
    const double pos_d = (double)(qpos0 + wq * 32 + r32);
#pragma unroll
    for (int i = 0; i < 8; ++i) { const double t = pos_d * ROPE_INV[i] * 0.15915494309189535; const float fr = (float)(t - rint(t));
      const float cs = __builtin_amdgcn_cosf(fr), sn = __builtin_amdgcn_sinf(fr);
      const float y = __shfl_xor(x[0][i], 32);
      x[0][i] = x[0][i] * cs + (hi ? y : -y) * sn; }
#pragma unroll
    for (int d0 = 0; d0 < 4; ++d0) { u32x4 w = {pk2(x[d0][0] * C2, x[d0][1] * C2), pk2(x[d0][2] * C2, x[d0][3] * C2), pk2(x[d0][4] * C2, x[d0][5] * C2), pk2(x[d0][6] * C2, x[d0][7] * C2)};
      qr[d0] = __builtin_bit_cast(bf16x8, w); } }
  WAIT_BAR(4);
  DMA_K(2, 2 * SHM_K); DMA_V(1, SHM_K);
  qkt<SHIFT>(pA0, pA1, K_ring, qr, r32, hi, c, negmb); expA(pA0); expA(pA1);
#define ITER(CUR0, CUR1, PRV0, PRV1, j) do { \
    WAIT_BAR(4); \
    { const int tk_ = ((j) + 2 < NT) ? (j) + 2 : NT - 1, tv_ = ((j) + 1 < NT) ? (j) + 1 : NT - 1; DMA_K(tk_, s0); DMA_V(tv_, s2); } \
    SBAR(); qkt<SHIFT>(CUR0, CUR1, K_ring + s1, qr, r32, hi, c, negmb); \
    finish_pv(PRV0, PRV1, l_reg, o, vb0 + s0); expA(CUR0); expA(CUR1); \
    ROT(); } while (0)
  for (int j = 1; j + 1 < NT; j += 2) {
    ITER(pB0, pB1, pA0, pA1, j);
    ITER(pA0, pA1, pB0, pB1, j + 1);
  }
  ITER(pB0, pB1, pA0, pA1, NT - 1);
  WAIT_BAR(0);
  finish_pv(pB0, pB1, l_reg, o, vb0 + s0);
#undef ITER
#undef ROT
#undef DMA_K
#undef DMA_V
  int lane_e = lane; asm volatile("" : "+v"(lane_e));
  {
  const int lane = lane_e, r32 = lane & 31, hi = lane >> 5;
  { auto rr = __builtin_amdgcn_permlane32_swap(__float_as_uint(l_reg), __float_as_uint(l_reg), false, false); l_reg = __uint_as_float(rr[0]) + __uint_as_float(rr[1]); }
  if (hi == 0) wsf[r32] = l_reg;
  asm volatile("s_waitcnt lgkmcnt(0)" ::: "memory");
  __syncthreads();
  float* XY = (float*)lds + (c == 0 ? 16384 : 0) + wq * 4096;
#pragma unroll
  for (int r = 0; r < 16; ++r) { const float rl = __builtin_amdgcn_rcpf(wsf[crow(r, hi)]);
#pragma unroll
    for (int d0 = 0; d0 < 4; ++d0) XY[(d0 * 16 + r) * 64 + lane] = o[d0][r] * rl; }
  }
  __syncthreads();
  { int tid2 = threadIdx.x; asm volatile("" : "+v"(tid2));
    const int ch = tid2 & 15; const f32x4 g0 = *(const f32x4*)(gsub + ch * 8), g1 = *(const f32x4*)(gsub + ch * 8 + 4);
#pragma unroll
    for (int j = 0; j < 4; ++j) {
      const int row = (tid2 >> 4) + 32 * j, rr = row & 31;
      const int fi = (row >> 5) * 4096 + ((ch >> 2) * 16 + (rr & 3) + 4 * (rr >> 3)) * 64 + ((rr >> 2) & 1) * 32 + (ch & 3) * 8;
      const float* xp_ = (const float*)lds + fi;
      const f32x4 x0 = *(const f32x4*)(xp_), x1 = *(const f32x4*)(xp_ + 4), y0 = *(const f32x4*)(xp_ + 16384), y1 = *(const f32x4*)(xp_ + 16384 + 4);
      const f32x4 d0v = y0 - x0 * lam, d1v = y1 - x1 * lam;
      float ss = (d0v[0] * d0v[0] + d0v[1] * d0v[1]) + (d0v[2] * d0v[2] + d0v[3] * d0v[3]) + (d1v[0] * d1v[0] + d1v[1] * d1v[1]) + (d1v[2] * d1v[2] + d1v[3] * d1v[3]);
      ss += __shfl_xor(ss, 1); ss += __shfl_xor(ss, 2); ss += __shfl_xor(ss, 4); ss += __shfl_xor(ss, 8);
      const float rs = post / sqrtf(ss * (1.f / 128.f) + EPS);
      const f32x4 e0 = d0v * g0 * rs, e1 = d1v * g1 * rs;
      v4u w; w.x = pk2(e0[0], e0[1]); w.y = pk2(e0[2], e0[3]); w.z = pk2(e1[0], e1[1]); w.w = pk2(e1[2], e1[3]);
      *(v4u*)(Ob + (size_t)row * DM + ch * 8) = w; }
  }
  __syncthreads();
}
#undef SBAR
}

DI void sgu_unit(const bf16* P, bf16* MIX, int chunk, int hd, const float* Ws, const float* bs, const float* gv, char* lds) {
    using att::bf16x8; using att::f32x16;
    int tid = threadIdx.x; asm volatile("" : "+v"(tid));
    const int wid = tid >> 6, lane = tid & 63, r32 = lane & 31, hi = lane >> 5;
    bf16* vnT = (bf16*)lds;
    { const int p = tid >> 2, qtr = tid & 3; const bf16* src = P + (size_t)(chunk * 128 + p) * INW + OFF_CV + hd * 128 + qtr * 32;
      v4u raw[4];
#pragma unroll
      for (int i = 0; i < 4; ++i) raw[i] = *(const v4u*)(src + 8 * i);
      float x[32];
#pragma unroll
      for (int i = 0; i < 4; ++i) unpack8(raw[i], x + 8 * i);
      float ss = 0.f;
#pragma unroll
      for (int i = 0; i < 32; ++i) { x[i] = gelu_tanh(x[i]); ss += x[i] * x[i]; }
      ss += __shfl_xor(ss, 1); ss += __shfl_xor(ss, 2);
      const float rstd = 1.0f / sqrtf(ss * (1.f / 128.f) + EPS);
#pragma unroll
      for (int i = 0; i < 32; ++i) { const float v = x[i] * rstd * gv[qtr * 32 + i]; vnT[(qtr * 32 + i) * 136 + p] = (bf16)(pk2(v, 0.f) & 0xffffu); }
    }
    __syncthreads();
    const int qb = wid >> 1;
    bf16x8 a[8];
#pragma unroll
    for (int ks = 0; ks < 8; ++ks) { const float* w = Ws + (size_t)(32 * qb + r32) * 128 + 16 * ks + 8 * hi; const f32x4 w0 = *(const f32x4*)w, w1 = *(const f32x4*)(w + 4);
        att::u32x4 u = {pk2(w0.x, w0.y), pk2(w0.z, w0.w), pk2(w1.x, w1.y), pk2(w1.z, w1.w)}; a[ks] = *reinterpret_cast<bf16x8*>(&u); }
#pragma unroll
    for (int dd = 0; dd < 2; ++dd) { const int db = 2 * (wid & 1) + dd;
        f32x16 acc = {};
#pragma unroll
        for (int ks = 0; ks < 8; ++ks) { const bf16x8 b = *reinterpret_cast<const bf16x8*>(vnT + (32 * db + r32) * 136 + 16 * ks + 8 * hi);
            acc = __builtin_amdgcn_mfma_f32_32x32x16_bf16(a[ks], b, acc, 0, 0, 0); }
        const int d = 32 * db + r32;
#pragma unroll
        for (int i = 0; i < 16; ++i) { const int q = 32 * qb + att::crow(i, hi); const size_t tok = (size_t)chunk * 128 + q;
            const float uval = gelu_tanh(__uint_as_float((unsigned)P[tok * INW + OFF_CU + hd * 128 + d] << 16));
            MIX[tok * DM + MIX_C + hd * 128 + d] = (bf16)(pk2(uval * (acc[i] + bs[q]), 0.f) & 0xffffu); }
    }
    __syncthreads();
}

#define LAS __attribute__((address_space(3)))
#define XB_TMO      128
#define XB_XCNT(j)  (256  + 64 * (j))
#define XB_XSUB(j)  (1280 + 64 * (j))
#define XB_XGEN(j)  (2304 + 64 * (j))
#define XB_TOP      3328
#define XB_TOPGEN   3392
#define XCD_BAR_WORDS 3456
#define XB_SPIN_CAP (1u << 18)

__device__ __forceinline__ unsigned xb_ld(unsigned* p)              { return __hip_atomic_load(p, __ATOMIC_RELAXED, __HIP_MEMORY_SCOPE_AGENT); }
__device__ __forceinline__ unsigned xb_add(unsigned* p, unsigned v) { return __hip_atomic_fetch_add(p, v, __ATOMIC_RELAXED, __HIP_MEMORY_SCOPE_AGENT); }
__device__ __forceinline__ unsigned xb_xcc_id() { return (unsigned)__builtin_amdgcn_s_getreg((3 << 11) | 20) & 0xFu; }
#define XB_SPIN(cond, bar) do { unsigned _sp = 0; while (cond) { __builtin_amdgcn_s_sleep(1); \
    if ((++_sp & 255u) == 0u) { if (xb_ld(&(bar)[XB_TMO])) break; if (_sp > XB_SPIN_CAP) { atomicAdd(&(bar)[XB_TMO], 1u); break; } } } } while (0)

struct XcdBarrier {
    unsigned* bar; unsigned x;
    volatile LAS unsigned* st;
};

__device__ __forceinline__ XcdBarrier xcd_barrier_post(unsigned* bar, volatile LAS unsigned* st) {
    XcdBarrier b; b.bar = bar; b.x = xb_xcc_id(); b.st = st;
    if (threadIdx.x == 0) (void)xb_add(&bar[XB_XCNT(b.x)], 1u);
    return b;
}
__device__ __forceinline__ void xcd_barrier_complete(unsigned* bar, unsigned x, unsigned& nloc, unsigned& nx) {
    const unsigned G = gridDim.x * gridDim.y * gridDim.z;
    unsigned sum, cnt, mine, sp = 0u;
    for (;;) {
        sum = 0u; cnt = 0u; mine = 0u;
#pragma unroll
        for (unsigned j = 0; j < 16; ++j) { const unsigned c = xb_ld(&bar[XB_XCNT(j)]); sum += c; cnt += (c > 0u) ? 1u : 0u; mine = (j == x) ? c : mine; }
        if (sum == G) break;
        __builtin_amdgcn_s_sleep(1);
        if ((++sp & 255u) == 0u) { if (xb_ld(&bar[XB_TMO])) break; if (sp > XB_SPIN_CAP) { atomicAdd(&bar[XB_TMO], 1u); break; } }
    }
    nloc = mine > 0u ? mine : 1u; nx = cnt > 0u ? cnt : 1u;
}

__device__ __forceinline__ void xcd_barrier(const XcdBarrier& b) {
    asm volatile("s_waitcnt vmcnt(0)" ::: "memory");
    __syncthreads();
    if (threadIdx.x == 0) {
        unsigned* bar = b.bar;
        __builtin_amdgcn_s_waitcnt(0);
        unsigned nloc = b.st[0], nx = b.st[1];
        if (nloc == 0u) { xcd_barrier_complete(bar, b.x, nloc, nx); b.st[0] = nloc; b.st[1] = nx; }
        const unsigned old = xb_add(&bar[XB_XSUB(b.x)], 1u);
        const unsigned gen = old / nloc;
        if (old + 1u == (gen + 1u) * nloc) {
            __builtin_amdgcn_fence(__ATOMIC_RELEASE, "agent");
            asm volatile("s_waitcnt vmcnt(0)" ::: "memory");
            const unsigned og = xb_add(&bar[XB_TOP], 1u);
            const unsigned tg = og / nx;
            if (og + 1u == (tg + 1u) * nx) xb_add(&bar[XB_TOPGEN], 1u);
            else XB_SPIN(xb_ld(&bar[XB_TOPGEN]) == tg, bar);
            __builtin_amdgcn_fence(__ATOMIC_ACQUIRE, "agent");
            xb_add(&bar[XB_XGEN(b.x)], 1u);
            asm volatile("s_waitcnt vmcnt(0)" ::: "memory");
        } else {
            XB_SPIN(xb_ld(&bar[XB_XGEN(b.x)]) == gen, bar);
            __builtin_amdgcn_fence(__ATOMIC_ACQUIRE, "agent");
            asm volatile("s_waitcnt vmcnt(0)" ::: "memory");
        }
    }
    __syncthreads();
}

struct Args { const float* in[19]; float* out; unsigned char* ws; int ph_lo, ph_hi; };
constexpr int N_PHASES = 1 + 6 * NLAYER;

__global__ void __launch_bounds__(NWAVES * 64, 2) mk_fwd(Args args) {
    extern __shared__ __attribute__((aligned(16))) unsigned char lds[];
    cg::grid_group grid = cg::this_grid();
    const int G = gridDim.x; const int bx = blockIdx.x; const int vcu = (G % 8 == 0) ? (bx % 8) * (G / 8) + bx / 8 : bx;
    const int NGW = G * NWAVES;
    unsigned char* ws = args.ws;
    const float* xp = args.in[0]; const float* xs = args.in[1];
    float* out = args.out;
    bf16* XN = (bf16*)(ws + WS_XN); bf16* PROJ = (bf16*)(ws + WS_PROJ); bf16* MIX = (bf16*)(ws + WS_MIX); bf16* HB = (bf16*)(ws + WS_H);

    volatile LAS unsigned* MISC = (volatile LAS unsigned*)((LAS unsigned char*)lds + 131072 + 320);
    if (threadIdx.x < 32) MISC[threadIdx.x] = 0u;
    __syncthreads();
    const XcdBarrier bar = xcd_barrier_post((unsigned*)ws, MISC + 8);
    for (int ph = args.ph_lo; ph < args.ph_hi; ++ph) {
        int tid = threadIdx.x; asm volatile("" : "+v"(tid));
        const int lane = tid & 63, wave = __builtin_amdgcn_readfirstlane(tid >> 6), gw = vcu * NWAVES + wave;
        const int l = (ph - 1) / 6, k = (ph == 0) ? -1 : ((ph - 1) % 6);
        float* const RS = (float*)(ws + 65536);
        const unsigned char* wl = ws + WS_WT + (size_t)(l < 0 ? 0 : l) * WT_LAYER;
        if (ph == 0) {
#if PHM & 1
            for (int rep = 0; rep < PROBE_REP_MISC; ++rep) {
            float* scr = (float*)(lds + wave * 16384);
            constexpr int I_IN = 32 * 176, I_OUT = 32 * 64, I_UP = 32 * 256, I_DN = 128 * 64, I_L = I_IN + I_OUT + I_UP + I_DN;
            for (int it = gw; it < NLAYER * I_L; it += NGW) {
                const int ll = it / I_L; int r = it % I_L; unsigned char* wb = ws + WS_WT + (size_t)ll * WT_LAYER;
                if (r < I_IN) { transpose_item(args.in[3] + (size_t)ll * DM * INW, DM, INW, (bf16*)(wb + WT_IN), DM, args.in[2] + ll * DM, scr, r, lane); continue; } r -= I_IN;
                if (r < I_OUT) { transpose_item(args.in[15] + (size_t)ll * DM * DM, DM, DM, (bf16*)(wb + WT_OUT), DM, nullptr, scr, r, lane); continue; } r -= I_OUT;
                if (r < I_UP) { transpose_item(args.in[17] + (size_t)ll * DM * DFF, DM, DFF, (bf16*)(wb + WT_UP), DM, args.in[16] + ll * DM, scr, r, lane); continue; } r -= I_UP;
                transpose_item(args.in[18] + (size_t)ll * DFF * DM, DFF, DM, (bf16*)(wb + WT_DN), LDH, nullptr, scr, r, lane);
            }
            for (int m = gw; m < M_ALL; m += NGW) xb_row(m < MP ? xp + (size_t)m * DM : xs + (size_t)(m - MP) * DM, XN + (size_t)m * DM, RS + m, lane);
            for (int i = gw * 64 + lane; i < 3 * M_ALL; i += NGW * 64) RS[M_ALL + i] = 0.f;
            }
#endif
        } else if (k == 0) {
#if PHM & 2
            pg8::Gemm g{XN, (const bf16*)(wl + WT_IN), M_ALL, INW, DM, DM, DM}; pg8::StaticOrder S; S.init(M_ALL, INW, G, bx);
            pg8::EpiBf16<0> E{PROJ, INW, RS + (size_t)(2 * l) * M_ALL};
            for (int rep = 0; rep < PROBE_REP_WIN; ++rep)
            pg8::gemm_phase<pg8::EpiBf16<0>, pg8::StaticOrder, true, true>((PG8_LAS unsigned char*)lds, g, S, E);
#endif
        } else if (k == 1) {
#if PHM & 4
            const float* kg = args.in[6] + l * 64; const float* cw = args.in[4] + l * 1536;
            for (int m = 2 * gw; m < M_ALL; m += 2 * NGW) k_rows(PROJ, m, kg, lane);
            for (int m = gw; m < M_ALL; m += NGW) {
                const int pos = m < MP ? (m & (SEQ_P - 1)) : ((m - MP) & (SEQ_S - 1)); const int S = m < MP ? SEQ_P : SEQ_S;
                conv_row(PROJ, MIX, m, pos, S, cw, lane);
            }
            for (int u = vcu; u < (M_ALL / 128) * 4; u += G) { const int chunk = u >> 2, hd = u & 3;
                sgu_unit(PROJ, MIX, chunk, hd, args.in[13] + ((size_t)l * 4 + hd) * 128 * 128, args.in[14] + (l * 4 + hd) * 128, args.in[12] + l * 128, (char*)lds); }
#endif
        } else if (k == 2) {
#if PHM & 8
            const float linit = (l == 0) ? 0.2f : 0.35550906759096934f;
            const float s1 = wave_sum(args.in[7][l * 64 + lane] * args.in[8][l * 64 + lane]), s2 = wave_sum(args.in[9][l * 64 + lane] * args.in[10][l * 64 + lane]);
            const float lam = __uint_as_float(__builtin_amdgcn_readfirstlane(__float_as_uint(expf(s1) - expf(s2) + linit)));
            const float gq = wave_max(fabsf(args.in[5][l * 64 + lane])), gk = wave_max(fabsf(args.in[6][l * 64 + lane]));
            const float negmb = __uint_as_float(__builtin_amdgcn_readfirstlane(__float_as_uint(-(C2 * 64.0f * gq * gk))));
            for (int rep = 0; rep < PROBE_REP_ATT; ++rep)
            for (int t = vcu; t < 2560; t += G) {
                int pair, qb, seq, seqrow0;
                if (t < 2048) { const int i = t >> 8, v = t & 255; const int idx = (v >> 5) * 256 + i * 32 + (v & 31); pair = idx >> 7; qb = idx & 127; seq = SEQ_S; seqrow0 = MP + (pair >> 3) * SEQ_S; }
                else { const int t2 = t - 2048, i = t2 >> 8, v = t2 & 255; pair = 2 * (v >> 5) + i; qb = v & 31; seq = SEQ_P; seqrow0 = (pair >> 3) * SEQ_P; }
                const int h = pair & 7; const size_t row0 = (size_t)seqrow0 + (size_t)qb * 128;
                if (negmb >= -64.0f)
                att::attn_unit<false>(PROJ + row0 * INW + OFF_Q + h * 128, PROJ + (size_t)seqrow0 * INW + OFF_K + h * 128, PROJ + (size_t)seqrow0 * INW + OFF_V + h * 128,
                               MIX + row0 * DM + MIX_B + h * 128, seq, (char*)lds, 0.f, lam, args.in[11] + l * 128, 1.0f - linit, args.in[5] + l * 64, qb * 128);
                else
                att::attn_unit<true>(PROJ + row0 * INW + OFF_Q + h * 128, PROJ + (size_t)seqrow0 * INW + OFF_K + h * 128, PROJ + (size_t)seqrow0 * INW + OFF_V + h * 128,
                               MIX + row0 * DM + MIX_B + h * 128, seq, (char*)lds, negmb, lam, args.in[11] + l * 128, 1.0f - linit, args.in[5] + l * 64, qb * 128);
            }
#endif
        } else if (k == 3 || k == 5) {
#if PHM & 16
            pg8::Gemm g; if (k == 3) g = pg8::Gemm{MIX, (const bf16*)(wl + WT_OUT), M_ALL, DM, DM, DM, DM}; else g = pg8::Gemm{HB, (const bf16*)(wl + WT_DN), M_ALL, DM, DFF, LDH, LDH};
            pg8::StaticOrder S; S.init(M_ALL, DM, G, bx);
            pg8::EpiResF32 E;
            if (k == 3 && l == 0) E = pg8::EpiResF32{xp, xs, MP / 256, nullptr, nullptr, DM, XN, DM, RS + (size_t)1 * M_ALL};
            else if (k == 3) E = pg8::EpiResF32{nullptr, nullptr, 0, XN, nullptr, DM, XN, DM, RS + (size_t)3 * M_ALL};
            else if (l == 0) E = pg8::EpiResF32{nullptr, nullptr, 0, XN, nullptr, DM, XN, DM, RS + (size_t)2 * M_ALL};
            else E = pg8::EpiResF32{nullptr, nullptr, 0, XN, out, DM, nullptr, DM, nullptr};
            pg8::gemm_phase<pg8::EpiResF32, pg8::StaticOrder, true, true>((PG8_LAS unsigned char*)lds, g, S, E);
#endif
        } else {
#if PHM & 64
            pg8::Gemm g{XN, (const bf16*)(wl + WT_UP), M_ALL, DFF, DM, DM, DM}; pg8::StaticOrder S; S.init(M_ALL, DFF, G, bx);
            pg8::EpiBf16<2> E{HB, LDH, RS + (size_t)(2 * l + 1) * M_ALL};
            for (int rep = 0; rep < PROBE_REP_UP; ++rep)
            pg8::gemm_phase<pg8::EpiBf16<2>, pg8::StaticOrder, true, true>((PG8_LAS unsigned char*)lds, g, S, E);
#endif
        }
        if (ph + 1 < args.ph_hi) { if (ph == args.ph_lo) grid.sync(); else xcd_barrier(bar); }
    }
}

extern "C" void kernel_launch(void* const* d_in, const int* in_sizes, int n_in, void* d_out, int out_size, void* d_ws, size_t ws_size, hipStream_t stream) {
    static int grid = 0;
    if (grid == 0) {
        if (n_in != 19 || out_size != M_ALL * DM || ws_size < WS_END) { fprintf(stderr, "kernel_launch: unexpected shapes: n_in %d out %d ws %zu (need %zu)\n", n_in, out_size, ws_size, (size_t)WS_END); grid = -1; return; }
        int dev = 0, cus = 0, per_cu = 0;
        if (hipGetDevice(&dev) != hipSuccess || hipDeviceGetAttribute(&cus, hipDeviceAttributeMultiprocessorCount, dev) != hipSuccess) { fprintf(stderr, "kernel_launch: device query failed\n"); grid = -1; return; }
        if (hipFuncSetAttribute((const void*)mk_fwd, hipFuncAttributeMaxDynamicSharedMemorySize, LDS_BYTES) != hipSuccess) { fprintf(stderr, "kernel_launch: hipFuncSetAttribute failed\n"); grid = -1; return; }
        if (hipOccupancyMaxActiveBlocksPerMultiprocessor(&per_cu, (const void*)mk_fwd, NWAVES * 64, LDS_BYTES) != hipSuccess || per_cu < 1) { fprintf(stderr, "kernel_launch: occupancy query gave %d\n", per_cu); per_cu = 1; }
        (void)hipGetLastError();
        grid = cus * 1;
        fprintf(stderr, "kernel_launch: grid %d (cus %d, per_cu %d)\n", grid, cus, per_cu);
    }
    if (grid < 0) return;
    if (hipMemsetAsync(d_ws, 0, 65536, stream) != hipSuccess) { fprintf(stderr, "kernel_launch: memset failed\n"); return; }
    Args a{};
    for (int i = 0; i < 19; ++i) a.in[i] = (const float*)d_in[i];
    a.out = (float*)d_out; a.ws = (unsigned char*)d_ws;
#if MK_SINGLE
    a.ph_lo = 0; a.ph_hi = N_PHASES;
    { void* kargs[] = {&a}; hipError_t e = hipLaunchCooperativeKernel((const void*)mk_fwd, dim3(grid), dim3(NWAVES * 64), kargs, LDS_BYTES, stream);
      if (e != hipSuccess) fprintf(stderr, "kernel_launch: cooperative launch failed: %s\n", hipGetErrorString(e)); }
#else
    for (int ph = 0; ph < N_PHASES; ++ph) { a.ph_lo = ph; a.ph_hi = ph + 1; void* kargs[] = {&a};
        hipError_t e = hipLaunchCooperativeKernel((const void*)mk_fwd, dim3(grid), dim3(NWAVES * 64), kargs, LDS_BYTES, stream);
        if (e != hipSuccess) { fprintf(stderr, "kernel_launch: cooperative launch %d failed: %s\n", ph, hipGetErrorString(e)); break; } }
#endif
}
```

```cpp
#include <hip/hip_runtime.h>
#include <hip/hip_cooperative_groups.h>
#include <hip/hip_bf16.h>
#include <cstdio>
#include <cstdint>
namespace cg = cooperative_groups;
namespace pg8 {
#define PG8_LAS __attribute__((address_space(3)))
typedef unsigned short bf16_t;
typedef short bf16x8 __attribute__((ext_vector_type(8)));
typedef float f32x4 __attribute__((ext_vector_type(4)));
typedef unsigned u32x4 __attribute__((ext_vector_type(4)));
constexpr int BM = 256, BK = 64, HALF = 128, HTB = HALF * BK * 2  , STAGE_BYTES = 8 * HTB, NXCD = 8, WGM = 8;

__host__ __device__ __forceinline__ int lds_byte(int r, int c) { const int st = (r >> 4) * 2 + (c >> 5), rr = r & 15, cc = c & 31, ob = rr * 64 + cc * 2; return st * 1024 + (ob ^ (((ob >> 9) & 1) << 5)); }
__host__ __device__ __forceinline__ void stage_rc(int b, int& R, int& C) { const int st = b / 1024, sb = b % 1024, swz = sb ^ (((sb >> 9) & 1) << 5); R = (st >> 1) * 16 + swz / 64; C = (st & 1) * 32 + (swz % 64) / 2; }
__host__ __device__ __forceinline__ int perm32(int rho) { const int n = rho >> 4, i = rho & 15; return 8 * (i >> 2) + 4 * n + (i & 3); }

struct Unit { int pm, pn; };
struct Gemm { const bf16_t* A; const bf16_t* Bt; int M, N, K, lda, ldb; };

struct StaticOrder {
    int nM, nN, nwg, G, c;
    __host__ __device__ void init(int M, int N, int G_, int c_) { nM = M / BM; nN = N / BM; nwg = nM * nN; G = G_; c = c_; }
    __host__ __device__ bool next(int i, Unit& u) const {
        const long L = (long)i * G + c; if (L >= nwg) return false;
        int wgid = (int)L; { const int q = nwg / NXCD, r = nwg % NXCD, xcd = wgid % NXCD, off = wgid / NXCD; wgid = (xcd < r ? xcd * (q + 1) : r * (q + 1) + (xcd - r) * q) + off; }
        const int nig = WGM * nN, gid = wgid / nig, fm = gid * WGM, gsz = (nM - fm) < WGM ? (nM - fm) : WGM;
        u.pm = fm + ((wgid % nig) % gsz); u.pn = (wgid % nig) / gsz; return true;
    }
    __device__ __forceinline__ void a_ready(const Unit&) const {}
    __device__ __forceinline__ void done(const Unit&) const {}
};

__device__ __forceinline__ unsigned cvt_pk_bf16(float lo, float hi) { unsigned r; asm volatile("v_cvt_pk_bf16_f32 %0, %1, %2" : "=v"(r) : "v"(lo), "v"(hi)); return r; }
typedef float f32x2 __attribute__((ext_vector_type(2)));
typedef unsigned u32x2 __attribute__((ext_vector_type(2)));
template <int ACT> struct EpiBf16 {
    static constexpr bool PERM = true, AFTER_DRAIN = false;
    bf16_t* O; int ldc; const float* rowss;
    __device__ __forceinline__ void operator()(const f32x4 (&acc)[2][2][4][2], const Unit& u, int wr, int wc, int fr, int fq) const {
        const int row0 = u.pm * BM + wr * 64 + fr; const int col0 = u.pn * BM + wc * 32 + 8 * fq;
        float rs[2][4];
#pragma unroll
        for (int ai = 0; ai < 2; ++ai)
#pragma unroll
            for (int m = 0; m < 4; ++m) rs[ai][m] = rowss[row0 + ai * HALF + m * 16];
#pragma unroll
        for (int ai = 0; ai < 2; ++ai)
#pragma unroll
            for (int m = 0; m < 4; ++m) { bf16_t* rowp = O + (size_t)(row0 + ai * HALF + m * 16) * ldc + col0;
                const float sc = 1.0f / sqrtf(rs[ai][m] * (1.0f / 2048.0f) + 1e-6f);
#pragma unroll
                for (int bj = 0; bj < 2; ++bj) { f32x4 v0 = acc[ai][bj][m][0] * sc, v1 = acc[ai][bj][m][1] * sc;
                    if (ACT == 2) {
#pragma unroll
                        for (int e = 0; e < 4; ++e) { float a = fmaxf(v0[e], 0.f), b = fmaxf(v1[e], 0.f); v0[e] = a * a; v1[e] = b * b; } }
                    u32x4 w; w.x = cvt_pk_bf16(v0[0], v0[1]); w.y = cvt_pk_bf16(v0[2], v0[3]); w.z = cvt_pk_bf16(v1[0], v1[1]); w.w = cvt_pk_bf16(v1[2], v1[3]);
                    *(u32x4*)(rowp + bj * HALF) = w; } }
    }
};
struct EpiResF32 {
    static constexpr bool PERM = true, AFTER_DRAIN = false;
    const float* res_lo; const float* res_hi; int split_pm; const bf16_t* resb; float* out; int ldc; bf16_t* xb; int ldx; float* rowss;
    __device__ __forceinline__ void operator()(const f32x4 (&acc)[2][2][4][2], const Unit& u, int wr, int wc, int fr, int fq) const {
        const float* rbase = (u.pm < split_pm) ? res_lo : (res_hi - (size_t)split_pm * BM * ldc);
        const int col0 = u.pn * BM + wc * 32 + 8 * fq;
#pragma unroll
        for (int ai = 0; ai < 2; ++ai)
#pragma unroll
            for (int m = 0; m < 4; ++m) { const int row = u.pm * BM + ai * HALF + wr * 64 + m * 16 + fr; const size_t off = (size_t)row * ldc + col0, offb = (size_t)row * ldx + col0; float ss = 0.f;
#pragma unroll
                for (int bj = 0; bj < 2; ++bj) {
                    f32x4 v0, v1;
                    if (resb) { const u32x4 r = *(const u32x4*)(resb + offb + bj * HALF);
                        v0 = (f32x4){__uint_as_float(r.x << 16), __uint_as_float(r.x & 0xffff0000u), __uint_as_float(r.y << 16), __uint_as_float(r.y & 0xffff0000u)};
                        v1 = (f32x4){__uint_as_float(r.z << 16), __uint_as_float(r.z & 0xffff0000u), __uint_as_float(r.w << 16), __uint_as_float(r.w & 0xffff0000u)}; }
                    else { v0 = *(const f32x4*)(rbase + off + bj * HALF); v1 = *(const f32x4*)(rbase + off + bj * HALF + 4); }
                    v0 += acc[ai][bj][m][0]; v1 += acc[ai][bj][m][1];
                    if (out) { *(f32x4*)(out + off + bj * HALF) = v0; *(f32x4*)(out + off + bj * HALF + 4) = v1; }
                    if (xb) { u32x4 w; w.x = cvt_pk_bf16(v0[0], v0[1]); w.y = cvt_pk_bf16(v0[2], v0[3]); w.z = cvt_pk_bf16(v1[0], v1[1]); w.w = cvt_pk_bf16(v1[2], v1[3]);
                        *(u32x4*)(xb + offb + bj * HALF) = w;
                        ss += (v0[0] * v0[0] + v0[1] * v0[1]) + (v0[2] * v0[2] + v0[3] * v0[3]) + (v1[0] * v1[0] + v1[1] * v1[1]) + (v1[2] * v1[2] + v1[3] * v1[3]); } }
                if (xb) { ss += __shfl_xor(ss, 16); ss += __shfl_xor(ss, 32);
                    if (fq == 0) __hip_atomic_fetch_add(rowss + row, ss, __ATOMIC_RELAXED, __HIP_MEMORY_SCOPE_AGENT); }
                if (m == 3) asm volatile("" ::: "memory"); }
    }
};
template <class Epi, class Sched, bool ALIGN_EPI = false, bool SP2 = false>
__device__ __forceinline__ void gemm_phase(PG8_LAS unsigned char* lds, const Gemm g, const Sched& S, const Epi& E) {
    int tid = threadIdx.x; asm volatile("" : "+v"(tid));
    const int wid = __builtin_amdgcn_readfirstlane(tid >> 6), lane = tid & 63, wr = wid >> 2, wc = wid & 3, fr = lane & 15, fq = lane >> 4;
    const int K = g.K, nt = K / BK;
    unsigned voffA[2], voffB[2];
#pragma unroll
    for (int i = 0; i < 2; ++i) { int R, C; stage_rc(tid * 16 + i * 8192, R, C); const int Rb = Epi::PERM ? ((R & ~31) + perm32(R & 31)) : R;
        voffA[i] = (unsigned)(R * g.lda + C) * 2u; voffB[i] = (unsigned)(Rb * g.ldb + C) * 2u; }
    const size_t kstep = (size_t)(BK * 2);
    const size_t hstepA = (size_t)HALF * g.lda * 2, hstepB = (size_t)HALF * g.ldb * 2;
    const size_t tstepA = 2 * hstepA, tstepB = 2 * hstepB;
    const unsigned ldsw = (unsigned)wid * 1024u;
    const int aoff = lds_byte(wr * 64 + fr, fq * 8), boff = lds_byte(wc * 32 + fr, fq * 8);
#define PG8_SA(b, h) (((b) * 2 + (h)) * HTB)
#define PG8_SB(b, h) ((4 + (b) * 2 + (h)) * HTB)
#define PG8_STAGE(bufoff, gbase, voff) do { _Pragma("unroll") for (int _i = 0; _i < 2; ++_i) \
        __builtin_amdgcn_global_load_lds((const unsigned*)((const char*)(gbase) + (voff)[_i]), (PG8_LAS unsigned*)(lds + (bufoff) + ldsw + _i * 8192), 16, 0, 0); } while (0)
#define PG8_LDA(dst, b, h) do { _Pragma("unroll") for (int m = 0; m < 4; ++m) _Pragma("unroll") for (int k = 0; k < 2; ++k) dst[m][k] = *(const PG8_LAS bf16x8*)(lds + PG8_SA(b, h) + aoff + m * 2048 + k * 1024); } while (0)
#define PG8_LDB(dst, b, h) do { _Pragma("unroll") for (int n = 0; n < 2; ++n) _Pragma("unroll") for (int k = 0; k < 2; ++k) dst[n][k] = *(const PG8_LAS bf16x8*)(lds + PG8_SB(b, h) + boff + n * 2048 + k * 1024); } while (0)
#define PG8_MMA(ai, bj, At, Bt) do { __builtin_amdgcn_s_setprio(1); _Pragma("unroll") for (int m = 0; m < 4; ++m) _Pragma("unroll") for (int n = 0; n < 2; ++n) _Pragma("unroll") for (int k = 0; k < 2; ++k) \
        acc[ai][bj][m][n] = __builtin_amdgcn_mfma_f32_16x16x32_bf16(Bt[n][k], At[m][k], acc[ai][bj][m][n], 0, 0, 0); __builtin_amdgcn_s_setprio(0); } while (0)
#define PG8_WAIT_V(n) asm volatile("s_waitcnt vmcnt(" #n ")" ::: "memory")
#define PG8_WAIT_L(n) asm volatile("s_waitcnt lgkmcnt(" #n ")" ::: "memory")
#define PG8_BAR __builtin_amdgcn_s_barrier()
#define PG8_SCHED __builtin_amdgcn_sched_barrier(0)
    Unit cur, nxt; int ui = 0;
    if (!S.next(0, cur)) return;
    f32x4 acc[2][2][4][2];
#pragma unroll
    for (int a = 0; a < 2; ++a)
#pragma unroll
        for (int b = 0; b < 2; ++b)
#pragma unroll
            for (int m = 0; m < 4; ++m)
#pragma unroll
                for (int n = 0; n < 2; ++n) acc[a][b][m][n] = (f32x4){0.f, 0.f, 0.f, 0.f};
    bf16x8 At[4][2], B0[2][2], B1[2][2];
    const char* cA = (const char*)g.A + (size_t)cur.pm * tstepA; const char* cB = (const char*)g.Bt + (size_t)cur.pn * tstepB;
    S.a_ready(cur);
    if constexpr (SP2) {
        PG8_STAGE(PG8_SB(0, 0), cB, voffB); PG8_STAGE(PG8_SB(0, 1), cB + hstepB, voffB); PG8_STAGE(PG8_SA(0, 0), cA, voffA); PG8_STAGE(PG8_SA(0, 1), cA + hstepA, voffA);
        if (wr == 1) PG8_BAR;
        PG8_WAIT_V(2); PG8_BAR;
        PG8_STAGE(PG8_SB(1, 0), cB + kstep, voffB); PG8_STAGE(PG8_SA(1, 0), cA + kstep, voffA); PG8_STAGE(PG8_SB(1, 1), cB + hstepB + kstep, voffB);
        PG8_WAIT_V(6); PG8_BAR;
    } else {
        PG8_STAGE(PG8_SB(0, 0), cB, voffB); PG8_STAGE(PG8_SA(0, 0), cA, voffA); PG8_STAGE(PG8_SB(0, 1), cB + hstepB, voffB); PG8_STAGE(PG8_SA(0, 1), cA + hstepA, voffA);
        if (wr == 1) PG8_BAR;
        PG8_WAIT_V(4); PG8_BAR;
        PG8_STAGE(PG8_SB(1, 0), cB + kstep, voffB); PG8_STAGE(PG8_SA(1, 0), cA + kstep, voffA); PG8_STAGE(PG8_SB(1, 1), cB + hstepB + kstep, voffB);
        PG8_WAIT_V(6); PG8_BAR;
    }
    for (;;) {
        const bool has_next = S.next(ui + 1, nxt);
        const char* nA = has_next ? (const char*)g.A + (size_t)nxt.pm * tstepA : cA; const char* nB = has_next ? (const char*)g.Bt + (size_t)nxt.pn * tstepB : cB;
        for (int t = 0; t < nt; t += 2) {
            const bool last = (t == nt - 2);
            const char* a1 = cA + (size_t)(t + 1) * kstep;
            const char* a2 = last ? nA : cA + (size_t)(t + 2) * kstep; const char* b2 = last ? nB : cB + (size_t)(t + 2) * kstep;
            const char* a3 = a2 + kstep; const char* b3 = b2 + kstep;
            if (last && has_next) S.a_ready(nxt);
            if constexpr (SP2) {
            PG8_LDB(B0, 0, 0); PG8_LDB(B1, 0, 1); PG8_SCHED; PG8_LDA(At, 0, 0); PG8_STAGE(PG8_SA(1, 1), a1 + hstepA, voffA);
            PG8_WAIT_V(8); PG8_WAIT_L(0); PG8_BAR; PG8_MMA(0, 0, At, B0); PG8_MMA(0, 1, At, B1); PG8_BAR; PG8_SCHED;
            PG8_LDA(At, 0, 1); PG8_STAGE(PG8_SB(0, 0), b2, voffB); PG8_STAGE(PG8_SB(0, 1), b2 + hstepB, voffB); PG8_STAGE(PG8_SA(0, 0), a2, voffA);
            PG8_WAIT_V(8); PG8_WAIT_L(0); PG8_BAR; PG8_MMA(1, 0, At, B0); PG8_MMA(1, 1, At, B1); PG8_BAR; PG8_SCHED;
            PG8_LDB(B0, 1, 0); PG8_LDB(B1, 1, 1); PG8_SCHED; PG8_LDA(At, 1, 0); PG8_STAGE(PG8_SA(0, 1), a2 + hstepA, voffA);
            PG8_WAIT_V(8); PG8_WAIT_L(0); PG8_BAR; PG8_MMA(0, 0, At, B0); PG8_MMA(0, 1, At, B1); PG8_BAR; PG8_SCHED;
            PG8_LDA(At, 1, 1); PG8_STAGE(PG8_SB(1, 0), b3, voffB); PG8_STAGE(PG8_SB(1, 1), b3 + hstepB, voffB); PG8_STAGE(PG8_SA(1, 0), a3, voffA);
            PG8_WAIT_V(8); PG8_WAIT_L(0); PG8_BAR; PG8_MMA(1, 0, At, B0); PG8_MMA(1, 1, At, B1); PG8_BAR; PG8_SCHED;
            } else {
            PG8_LDB(B0, 0, 0); PG8_SCHED; PG8_LDA(At, 0, 0); PG8_STAGE(PG8_SA(1, 1), a1 + hstepA, voffA);
            PG8_WAIT_L(8); PG8_BAR; PG8_WAIT_L(0); PG8_MMA(0, 0, At, B0); PG8_BAR; PG8_SCHED;
            PG8_LDB(B1, 0, 1); PG8_STAGE(PG8_SB(0, 0), b2, voffB);
            PG8_BAR; PG8_WAIT_L(0); PG8_MMA(0, 1, At, B1); PG8_BAR;
            PG8_LDA(At, 0, 1); PG8_STAGE(PG8_SA(0, 0), a2, voffA);
            PG8_BAR; PG8_WAIT_L(0); PG8_MMA(1, 0, At, B0); PG8_BAR; PG8_SCHED;
            PG8_STAGE(PG8_SB(0, 1), b2 + hstepB, voffB);
            PG8_WAIT_V(6); PG8_BAR; PG8_MMA(1, 1, At, B1); PG8_BAR;
            PG8_LDB(B0, 1, 0); PG8_SCHED; PG8_LDA(At, 1, 0); PG8_STAGE(PG8_SA(0, 1), a2 + hstepA, voffA);
            PG8_WAIT_L(8); PG8_BAR; PG8_WAIT_L(0); PG8_MMA(0, 0, At, B0); PG8_BAR; PG8_SCHED;
            PG8_LDB(B1, 1, 1); PG8_STAGE(PG8_SB(1, 0), b3, voffB);
            PG8_BAR; PG8_WAIT_L(0); PG8_MMA(0, 1, At, B1); PG8_BAR;
            PG8_LDA(At, 1, 1); PG8_STAGE(PG8_SA(1, 0), a3, voffA);
            PG8_BAR; PG8_WAIT_L(0); PG8_MMA(1, 0, At, B0); PG8_BAR; PG8_SCHED;
            PG8_STAGE(PG8_SB(1, 1), b3 + hstepB, voffB);
            PG8_WAIT_V(6); PG8_BAR; PG8_MMA(1, 1, At, B1); PG8_BAR;
            }
        }
        if constexpr (ALIGN_EPI) { if (wr == 0) PG8_BAR; }
        if constexpr (!Epi::AFTER_DRAIN) { E(acc, cur, wr, wc, fr, fq); S.done(cur); }
        if (!has_next) break;
#pragma unroll
        for (int a = 0; a < 2; ++a)
#pragma unroll
            for (int b = 0; b < 2; ++b)
#pragma unroll
                for (int m = 0; m < 4; ++m)
#pragma unroll
                    for (int n = 0; n < 2; ++n) acc[a][b][m][n] = (f32x4){0.f, 0.f, 0.f, 0.f};
        cur = nxt; cA = nA; cB = nB; ++ui;
        if constexpr (ALIGN_EPI) { if (wr == 1) PG8_BAR; }
    }
    PG8_WAIT_V(0);
    if constexpr (!ALIGN_EPI) { if (wr == 0) PG8_BAR; }
    PG8_BAR;
    if constexpr (Epi::AFTER_DRAIN) { E.fused(acc, cur, wr, wc, fr, fq, lds, wid, lane); S.done(cur); }
#undef PG8_SA
#undef PG8_SB
#undef PG8_STAGE
#undef PG8_LDA
#undef PG8_LDB
#undef PG8_MMA
#undef PG8_WAIT_V
#undef PG8_WAIT_L
#undef PG8_BAR
#undef PG8_SCHED
}
}

#ifndef PROBE_REP_ATT
#define PROBE_REP_ATT 1
#endif
#ifndef PROBE_REP_UP
#define PROBE_REP_UP 1
#endif
#ifndef PROBE_XSYNC
#define PROBE_XSYNC 0
#endif
#ifndef PROBE_REP_MISC
#define PROBE_REP_MISC 1
#endif
#ifndef PROBE_REP_WIN
#define PROBE_REP_WIN 1
#endif
#ifndef PHM
#define PHM 127
#endif
#ifndef MK_SINGLE
#define MK_SINGLE 1
#endif
constexpr int DM = 2048, MP = 8192, M_ALL = 40960, SEQ_P = 4096, SEQ_S = 16384, INW = 5632, DFF = 8192, NLAYER = 2;
constexpr int OFF_AX = 0, OFF_AB = 512, OFF_AC = 1024, OFF_Q = 1536, OFF_K = 2560, OFF_V = 3584, OFF_CU = 4608, OFF_CV = 5120;
constexpr int MIX_A = 0, MIX_B = 512, MIX_C = 1536;
constexpr float EPS = 1e-6f;
constexpr float C2 = 0.18033688011112042f;
constexpr size_t MiB = 1u << 20;
constexpr int LDH = DFF + 128;
constexpr size_t WS_WT = 1 * MiB, WT_LAYER = 96 * MiB, WT_IN = 0, WT_OUT = 22 * MiB, WT_UP = 30 * MiB, WT_DN = 62 * MiB;
constexpr size_t WS_XN = 194 * MiB, WS_H = 356 * MiB, WS_PROJ = 356 * MiB, WS_MIX = 796 * MiB, WS_END = 1008 * MiB;
static_assert(WT_DN + (size_t)DM * LDH * 2 <= WT_LAYER && WS_WT + 2 * WT_LAYER <= WS_XN && WS_XN + (size_t)M_ALL * DM * 2 <= WS_H && WS_PROJ + (size_t)M_ALL * INW * 2 <= WS_MIX && WS_MIX + (size_t)M_ALL * DM * 2 <= WS_END && WS_H + (size_t)M_ALL * LDH * 2 <= WS_END, "ws map");
constexpr int NWAVES = 8, LDS_BYTES = 147456;

typedef unsigned short bf16;
typedef unsigned v4u __attribute__((ext_vector_type(4)));
typedef unsigned v2u __attribute__((ext_vector_type(2)));
typedef float f32x4 __attribute__((ext_vector_type(4)));
#define DI __device__ __forceinline__

DI unsigned pk2(float lo, float hi) { return pg8::cvt_pk_bf16(lo, hi); }
DI float bflo(unsigned u) { return __uint_as_float(u << 16); }
DI float bfhi(unsigned u) { return __uint_as_float(u & 0xffff0000u); }
DI float wave_sum(float v) {
#pragma unroll
    for (int o = 1; o < 64; o <<= 1) v += __shfl_xor(v, o);
    return v;
}
DI float wave_max(float v) {
#pragma unroll
    for (int o = 1; o < 64; o <<= 1) v = fmaxf(v, __shfl_xor(v, o));
    return v;
}
DI float gelu_tanh(float x) {
    const float z = x * (0.7978845608028654f + 0.035677408136300125f * x * x);
    const float e = __builtin_amdgcn_exp2f(-2.8853900817779268f * z);
    return x * __builtin_amdgcn_rcpf(1.0f + e);
}

DI void transpose_item(const float* W, int K, int N, bf16* WT, int ldt, const float* gain, float* scr, int item, int lane) {
    const int nblk = N / 32, kb = item / nblk, nb = item % nblk, k0 = 64 * kb, n0 = 32 * nb;
#pragma unroll 32
    for (int i = 0; i < 32; ++i) { const int kk = 2 * i + (lane >> 5); scr[kk * 33 + (lane & 31)] = W[(size_t)(k0 + kk) * N + n0 + (lane & 31)] * (gain ? gain[k0 + kk] : 1.0f); }
    asm volatile("s_waitcnt lgkmcnt(0)" ::: "memory");
    const int c = lane & 7;
#pragma unroll
    for (int j = 0; j < 4; ++j) { const int n = (lane >> 3) + 8 * j; const float* s = scr + (8 * c) * 33 + n;
        v4u o; o.x = pk2(s[0 * 33], s[1 * 33]); o.y = pk2(s[2 * 33], s[3 * 33]); o.z = pk2(s[4 * 33], s[5 * 33]); o.w = pk2(s[6 * 33], s[7 * 33]);
        *(v4u*)(WT + (size_t)(n0 + n) * ldt + k0 + 8 * c) = o; }
    asm volatile("s_waitcnt lgkmcnt(0)" ::: "memory");
}
DI void xb_row(const float* xrow, bf16* orow, float* ssp, int lane) {
    const f32x4* xr = (const f32x4*)xrow + lane;
    f32x4 v[8]; float s = 0.f;
#pragma unroll
    for (int j = 0; j < 8; ++j) { v[j] = xr[64 * j]; s += (v[j].x * v[j].x + v[j].y * v[j].y) + (v[j].z * v[j].z + v[j].w * v[j].w); }
    s = wave_sum(s);
    if (lane == 0) *ssp = s;
    v2u* o8 = (v2u*)orow + lane;
#pragma unroll
    for (int j = 0; j < 8; ++j) { v2u w; w.x = pk2(v[j].x, v[j].y); w.y = pk2(v[j].z, v[j].w); o8[64 * j] = w; }
}

__constant__ double ROPE_INV[8] = {1.0, 0.19392274474868576, 0.03760603093086393, 0.007292664737217109, 0.001414213562373095, 0.0002742481756762073, 5.318295896944988e-05, 1.031338537721246e-05};
DI void k_rows(bf16* P, int row2, const float* kg, int lane) {
    const int row = row2 + (lane >> 5), l5 = lane & 31;
    const int pos = row < MP ? (row & (SEQ_P - 1)) : ((row - MP) & (SEQ_S - 1));
    bf16* p = P + (size_t)row * INW + OFF_K + l5 * 32;
    v4u raw[4];
#pragma unroll
    for (int i = 0; i < 4; ++i) raw[i] = *(const v4u*)(p + 8 * i);
    float x[32];
#pragma unroll
    for (int i = 0; i < 4; ++i) { x[8 * i + 0] = bflo(raw[i].x); x[8 * i + 1] = bfhi(raw[i].x); x[8 * i + 2] = bflo(raw[i].y); x[8 * i + 3] = bfhi(raw[i].y);
        x[8 * i + 4] = bflo(raw[i].z); x[8 * i + 5] = bfhi(raw[i].z); x[8 * i + 6] = bflo(raw[i].w); x[8 * i + 7] = bfhi(raw[i].w); }
    float ss = 0.f;
#pragma unroll
    for (int i = 0; i < 32; ++i) ss += x[i] * x[i];
    ss += __shfl_xor(ss, 1);
    const float rstd = 1.0f / sqrtf(ss * (1.f / 64.f) + EPS);
    const int half = l5 & 1;
    const float* g = kg + half * 32;
#pragma unroll
    for (int i = 0; i < 8; ++i) { const f32x4 gg = *(const f32x4*)(g + 4 * i); x[4 * i] *= rstd * gg.x; x[4 * i + 1] *= rstd * gg.y; x[4 * i + 2] *= rstd * gg.z; x[4 * i + 3] *= rstd * gg.w; }
    const double t = (double)pos * ROPE_INV[lane & 7] * 0.15915494309189535;
    const float fr = (float)(t - rint(t));
    const float cs = __builtin_amdgcn_cosf(fr), sn = __builtin_amdgcn_sinf(fr);
#pragma unroll
    for (int i = 0; i < 8; ++i) { const float c = __shfl(cs, (lane & 32) + i), s_ = __shfl(sn, (lane & 32) + i);
        if (half == 0) { const float a = x[i], b = x[i + 8]; x[i] = a * c - b * s_; x[i + 8] = b * c + a * s_; } }
#pragma unroll
    for (int i = 0; i < 4; ++i) { v4u w; w.x = pk2(x[8 * i], x[8 * i + 1]); w.y = pk2(x[8 * i + 2], x[8 * i + 3]); w.z = pk2(x[8 * i + 4], x[8 * i + 5]); w.w = pk2(x[8 * i + 6], x[8 * i + 7]);
        *(v4u*)(p + 8 * i) = w; }
}
DI void unpack8(const v4u r, float* x) { x[0] = bflo(r.x); x[1] = bfhi(r.x); x[2] = bflo(r.y); x[3] = bfhi(r.y); x[4] = bflo(r.z); x[5] = bfhi(r.z); x[6] = bflo(r.w); x[7] = bfhi(r.w); }
DI void conv_row(const bf16* P, bf16* MIX, int row, int pos, int S, const float* cw, int lane) {
    const bf16* p = P + (size_t)row * INW + lane * 8;
    const v4u z4 = {0u, 0u, 0u, 0u};
    const v4u xa0 = *(const v4u*)(p + OFF_AX), gc0 = *(const v4u*)(p + OFF_AC), gb0 = *(const v4u*)(p + OFF_AB);
    const v4u xam = pos > 0 ? *(const v4u*)(p - INW + OFF_AX) : z4, gcm = pos > 0 ? *(const v4u*)(p - INW + OFF_AC) : z4;
    const v4u xap = pos < S - 1 ? *(const v4u*)(p + INW + OFF_AX) : z4, gcp = pos < S - 1 ? *(const v4u*)(p + INW + OFF_AC) : z4;
    float a0[8], c0[8], b0[8], am[8], cm[8], ap[8], cp[8];
    unpack8(xa0, a0); unpack8(gc0, c0); unpack8(gb0, b0); unpack8(xam, am); unpack8(gcm, cm); unpack8(xap, ap); unpack8(gcp, cp);
    float w0[8], w1[8], w2[8];
#pragma unroll
    for (int i = 0; i < 2; ++i) { const f32x4 a = *(const f32x4*)(cw + lane * 8 + 4 * i), b = *(const f32x4*)(cw + 512 + lane * 8 + 4 * i), c = *(const f32x4*)(cw + 1024 + lane * 8 + 4 * i);
        w0[4 * i] = a.x; w0[4 * i + 1] = a.y; w0[4 * i + 2] = a.z; w0[4 * i + 3] = a.w; w1[4 * i] = b.x; w1[4 * i + 1] = b.y; w1[4 * i + 2] = b.z; w1[4 * i + 3] = b.w;
        w2[4 * i] = c.x; w2[4 * i + 1] = c.y; w2[4 * i + 2] = c.z; w2[4 * i + 3] = c.w; }
    float o[8];
#pragma unroll
    for (int j = 0; j < 8; ++j) o[j] = b0[j] * (w0[j] * (cm[j] * am[j]) + w1[j] * (c0[j] * a0[j]) + w2[j] * (cp[j] * ap[j]));
    v4u w; w.x = pk2(o[0], o[1]); w.y = pk2(o[2], o[3]); w.z = pk2(o[4], o[5]); w.w = pk2(o[6], o[7]);
    *(v4u*)(MIX + (size_t)row * DM + MIX_A + lane * 8) = w;
}

namespace att {
using bf16x8 = __attribute__((ext_vector_type(8))) short;
using s16x4  = __attribute__((ext_vector_type(4))) short;
using f32x16 = __attribute__((ext_vector_type(16))) float;
using u32x4  = __attribute__((ext_vector_type(4))) unsigned;
constexpr int KVBLK = 64;
constexpr int SHM_V = 16384, SHM_K = 16384, SCR_OFF = 133120;
#define KSWZ(row, colB) ((row) * 256 + ((colB) ^ (((row) & 15) << 4)))
#define SBAR() __builtin_amdgcn_sched_barrier(0)
DI int crow(int r, int hi) { return (r & 3) + 8 * (r >> 2) + 4 * hi; }
DI unsigned cvtpk(float lo, float hi) { unsigned r; asm volatile("v_cvt_pk_bf16_f32 %0, %1, %2" : "=v"(r) : "v"(lo), "v"(hi)); return r; }
DI int v_st(int k, int c) { const int kk = (k & ~0xC) | ((k & 4) << 1) | ((k & 8) >> 1); return ((kk >> 3) * 4 + (c >> 5)) * 512 + ((kk & 7) * 32 + (c & 31)) * 2; }
DI int v_rd_base(int lane) { return ((lane & 3) << 3) | (((lane >> 2) & 3) << 6) | (((lane >> 4) & 1) << 5) | (((lane >> 5) & 1) << 8); }
constexpr int v_rd_off(int d0, int ks, int half) { return d0 * 512 + ks * 4096 + half * 2048; }
template <int OFF> DI s16x4 tr_read(int vb) { s16x4 r; asm volatile("ds_read_b64_tr_b16 %0, %1 offset:%2" : "=&v"(r) : "v"(vb), "i"(OFF) : "memory"); return r; }
template <int D0> DI void pv_one(f32x16& od, int vb, bf16x8 pa0, bf16x8 pa1, bf16x8 pa2, bf16x8 pa3) {
  const s16x4 l0 = tr_read<v_rd_off(D0, 0, 0)>(vb), h0 = tr_read<v_rd_off(D0, 0, 1)>(vb), l1 = tr_read<v_rd_off(D0, 1, 0)>(vb), h1 = tr_read<v_rd_off(D0, 1, 1)>(vb);
  const s16x4 l2 = tr_read<v_rd_off(D0, 2, 0)>(vb), h2 = tr_read<v_rd_off(D0, 2, 1)>(vb), l3 = tr_read<v_rd_off(D0, 3, 0)>(vb), h3 = tr_read<v_rd_off(D0, 3, 1)>(vb);
  asm volatile("s_waitcnt lgkmcnt(0)" ::: "memory"); SBAR();
#define PK(L, H) (bf16x8){L[0], L[1], L[2], L[3], H[0], H[1], H[2], H[3]}
  od = __builtin_amdgcn_mfma_f32_32x32x16_bf16(pa0, PK(l0, h0), od, 0, 0, 0);
  od = __builtin_amdgcn_mfma_f32_32x32x16_bf16(pa1, PK(l1, h1), od, 0, 0, 0);
  od = __builtin_amdgcn_mfma_f32_32x32x16_bf16(pa2, PK(l2, h2), od, 0, 0, 0);
  od = __builtin_amdgcn_mfma_f32_32x32x16_bf16(pa3, PK(l3, h3), od, 0, 0, 0);
#undef PK
}
DI void pv_d0(f32x16* o, int vb, bf16x8 pa0, bf16x8 pa1, bf16x8 pa2, bf16x8 pa3) {
  pv_one<0>(o[0], vb, pa0, pa1, pa2, pa3); pv_one<1>(o[1], vb, pa0, pa1, pa2, pa3); pv_one<2>(o[2], vb, pa0, pa1, pa2, pa3); pv_one<3>(o[3], vb, pa0, pa1, pa2, pa3);
}
template <bool SHIFT> DI void qkt(f32x16& p0, f32x16& p1, const char* Ks, const bf16x8* qr, int r32, int hi, int c, float negmb) {
  if constexpr (SHIFT) {
#pragma unroll
    for (int r = 0; r < 16; ++r) { p0[r] = negmb; p1[r] = negmb; }
  } else { p0 = f32x16{}; p1 = f32x16{}; }
#pragma unroll
  for (int d0 = 0; d0 < 4; ++d0) { const int cb = (c * 64 + d0 * 16 + hi * 8) * 2;
    const bf16x8 b0 = *reinterpret_cast<const bf16x8*>(Ks + KSWZ(r32, cb));
    const bf16x8 b1 = *reinterpret_cast<const bf16x8*>(Ks + KSWZ(32 + r32, cb));
    p0 = __builtin_amdgcn_mfma_f32_32x32x16_bf16(b0, qr[d0], p0, 0, 0, 0);
    p1 = __builtin_amdgcn_mfma_f32_32x32x16_bf16(b1, qr[d0], p1, 0, 0, 0); }
}
DI void expA(f32x16& p0) {
#pragma unroll
  for (int r = 0; r < 16; ++r) p0[r] = __builtin_amdgcn_exp2f(p0[r]);
}
DI void finishSM(f32x16& p0, f32x16& p1, float& l_reg, bf16x8& pa0, bf16x8& pa1, bf16x8& pa2, bf16x8& pa3) {
#pragma unroll
  for (int r = 0; r < 16; ++r) p1[r] = __builtin_amdgcn_exp2f(p1[r]);
  float ps = 0.f;
#pragma unroll
  for (int r = 0; r < 16; ++r) ps += p0[r];
#pragma unroll
  for (int r = 0; r < 16; ++r) ps += p1[r];
  l_reg += ps;
#define PK4(P, BASE, OUT) do { unsigned a0 = cvtpk(P[BASE + 0], P[BASE + 1]), a1 = cvtpk(P[BASE + 2], P[BASE + 3]);   \
    unsigned b0 = cvtpk(P[BASE + 4], P[BASE + 5]), b1 = cvtpk(P[BASE + 6], P[BASE + 7]);                              \
    auto r0 = __builtin_amdgcn_permlane32_swap(a0, b0, false, false); auto r1 = __builtin_amdgcn_permlane32_swap(a1, b1, false, false); \
    u32x4 w = {r0[0], r1[0], r0[1], r1[1]}; OUT = *reinterpret_cast<bf16x8*>(&w); } while (0)
  PK4(p0, 0, pa0); PK4(p0, 8, pa1); PK4(p1, 0, pa2); PK4(p1, 8, pa3);
#undef PK4
}
DI unsigned cvtpk2(float lo, float hi) { typedef float f2_t __attribute__((ext_vector_type(2))); typedef __bf16 b2_t __attribute__((ext_vector_type(2))); f2_t v = {lo, hi}; b2_t b = __builtin_convertvector(v, b2_t); return __builtin_bit_cast(unsigned, b); }
template <int I> DI void vrd(s16x4& l, s16x4& h, int vb) { constexpr int ks = I >> 2, d0 = I & 3; l = tr_read<v_rd_off(d0, ks, 0)>(vb); h = tr_read<v_rd_off(d0, ks, 1)>(vb); }
#define TIEWAIT(N, L, H) asm volatile("s_waitcnt lgkmcnt(" #N ")" : "+v"(L), "+v"(H))
#define PK4B(P, BASE, OUT) do { u32x4 w = {cvtpk2(P[BASE + 0], P[BASE + 1]), cvtpk2(P[BASE + 2], P[BASE + 3]), cvtpk2(P[BASE + 4], P[BASE + 5]), cvtpk2(P[BASE + 6], P[BASE + 7])}; \
    OUT = *reinterpret_cast<bf16x8*>(&w); } while (0)
#define PKV(L, H) (bf16x8){L[0], L[1], L[2], L[3], H[0], H[1], H[2], H[3]}
#define PVSTEP(i, N, PA, SL, SH, NL, NH) do { TIEWAIT(N, SL, SH); o[(i) & 3] = __builtin_amdgcn_mfma_f32_32x32x16_bf16(PA, PKV(SL, SH), o[(i) & 3], 0, 0, 0); \
    if constexpr ((i) + 3 < 16) vrd<((i) + 3 < 16 ? (i) + 3 : 15)>(NL, NH, vb); } while (0)
DI void finish_pv(f32x16& p0, f32x16& p1, float& l_reg, f32x16* o, int vb) {
  s16x4 l0, h0, l1, h1, l2, h2, l3, h3;
  vrd<0>(l0, h0, vb); vrd<1>(l1, h1, vb); vrd<2>(l2, h2, vb);
  bf16x8 pa0, pa1, pa2, pa3;
  PK4B(p0, 0, pa0); PK4B(p0, 8, pa1);
  PVSTEP(0, 4, pa0, l0, h0, l3, h3); PVSTEP(1, 4, pa0, l1, h1, l0, h0); PVSTEP(2, 4, pa0, l2, h2, l1, h1); PVSTEP(3, 4, pa0, l3, h3, l2, h2);
  PVSTEP(4, 4, pa1, l0, h0, l3, h3); PVSTEP(5, 4, pa1, l1, h1, l0, h0); PVSTEP(6, 4, pa1, l2, h2, l1, h1); PVSTEP(7, 4, pa1, l3, h3, l2, h2);
  PK4B(p1, 0, pa2); PK4B(p1, 8, pa3);
  PVSTEP(8, 4, pa2, l0, h0, l3, h3); PVSTEP(9, 4, pa2, l1, h1, l0, h0); PVSTEP(10, 4, pa2, l2, h2, l1, h1); PVSTEP(11, 4, pa2, l3, h3, l2, h2);
  PVSTEP(12, 4, pa3, l0, h0, l3, h3); PVSTEP(13, 4, pa3, l1, h1, l0, h0); PVSTEP(14, 2, pa3, l2, h2, l1, h1); PVSTEP(15, 0, pa3, l3, h3, l2, h2);
  float ps = 0.f;
#pragma unroll
  for (int r = 0; r < 16; ++r) ps += p0[r];
#pragma unroll
  for (int r = 0; r < 16; ++r) ps += p1[r];
  l_reg += ps;
}
DI void glds16(const void* gsrc, unsigned lds_dst) { unsigned keep;
  asm volatile("s_mov_b32 %0, m0\n\ts_mov_b32 m0, %2\n\ts_nop 0\n\tglobal_load_lds_dwordx4 %1, off\n\ts_mov_b32 m0, %0" : "=&s"(keep) : "v"(gsrc), "s"(lds_dst) : "memory"); }
#define WAIT_BAR(N) asm volatile("s_waitcnt vmcnt(" #N ") lgkmcnt(0)\n\ts_barrier" ::: "memory")
template <bool SHIFT> DI void attn_unit(const bf16* __restrict__ Qb, const bf16* __restrict__ Kh, const bf16* __restrict__ Vh, bf16* __restrict__ Ob, int seq, char* lds,
                  float negmb, float lam, const float* __restrict__ gsub, float post, const float* __restrict__ qg, int qpos0) {
  int tid = threadIdx.x; asm volatile("" : "+v"(tid));
  const int lane = tid & 63, r32 = lane & 31, hi = lane >> 5; const int wid = __builtin_amdgcn_readfirstlane(tid >> 6), c = wid >> 2, wq = wid & 3;
  char* K_ring = lds; char* V_ring = lds + 3 * SHM_K;
  float* wsf = (float*)(lds + SCR_OFF) + wid * 64;
  const unsigned lds0 = (unsigned)(uintptr_t)lds;
  float l_reg = 0.f; f32x16 o[4] = {}; bf16x8 qr[4];
  const bf16* Qw = Qb + (size_t)(wq * 32 + r32) * INW + c * 64 + hi * 8;
#pragma unroll
  for (int d0 = 0; d0 < 4; ++d0) qr[d0] = *reinterpret_cast<const bf16x8*>(Qw + d0 * 16);
  const bf16* ksrc0; const bf16* ksrc1; const bf16* vsrc0; const bf16* vsrc1;
  { const int row0 = 8 * wid + (lane >> 4), row1 = row0 + 4, cp = lane & 15;
    ksrc0 = Kh + (size_t)row0 * INW + ((cp ^ (row0 & 15)) << 3); ksrc1 = Kh + (size_t)row1 * INW + ((cp ^ (row1 & 15)) << 3);
    const int kk = 8 * wid + ((lane & 31) >> 2), kkey = kk  , cc = (lane >> 5) * 32 + (lane & 3) * 8;
    vsrc0 = Vh + (size_t)kkey * INW + cc; vsrc1 = vsrc0 + 64; }
  const unsigned kdst = lds0 + (unsigned)wid * 2048u, vdst = lds0 + 3u * SHM_K + (unsigned)wid * 2048u;
#define DMA_K(t, slot) do { const size_t to_ = (size_t)(t) * (KVBLK * INW); const unsigned d_ = (unsigned)__builtin_amdgcn_readfirstlane(kdst + (unsigned)(slot)); glds16(ksrc0 + to_, d_); glds16(ksrc1 + to_, d_ + 1024u); } while (0)
#define DMA_V(t, slot) do { const size_t to_ = (size_t)(t) * (KVBLK * INW); const unsigned d_ = (unsigned)__builtin_amdgcn_readfirstlane(vdst + (unsigned)(slot)); glds16(vsrc0 + to_, d_); glds16(vsrc1 + to_, d_ + 1024u); } while (0)
  const int vb0 = (int)(lds0 + 3u * SHM_K) + v_rd_base(lane);
  f32x16 pA0, pA1, pB0, pB1; const int NT = seq / KVBLK;
  int s0 = 0, s1 = SHM_K, s2 = 2 * SHM_K;
#define ROT() do { const int t_ = s0; s0 = s1; s1 = s2; s2 = t_; } while (0)
  DMA_K(0, 0); DMA_K(1, SHM_K); DMA_V(0, 0);
  { float x[4][8]; float ss = 0.f;
#pragma unroll
    for (int d0 = 0; d0 < 4; ++d0) { const u32x4 u = __builtin_bit_cast(u32x4, qr[d0]);
      x[d0][0] = __uint_as_float(u.x << 16); x[d0][1] = __uint_as_float(u.x & 0xffff0000u); x[d0][2] = __uint_as_float(u.y << 16); x[d0][3] = __uint_as_float(u.y & 0xffff0000u);
      x[d0][4] = __uint_as_float(u.z << 16); x[d0][5] = __uint_as_float(u.z & 0xffff0000u); x[d0][6] = __uint_as_float(u.w << 16); x[d0][7] = __uint_as_float(u.w & 0xffff0000u);
#pragma unroll
      for (int e = 0; e < 8; ++e) ss += x[d0][e] * x[d0][e]; }
    ss += __shfl_xor(ss, 32);
    const float rstd = 1.0f / sqrtf(ss * (1.f / 64.f) + EPS);
#pragma unroll
    for (int d0 = 0; d0 < 4; ++d0) { const f32x4 g0 = *(const f32x4*)(qg + 16 * d0 + 8 * hi), g1 = *(const f32x4*)(qg + 16 * d0 + 8 * hi + 4);
#pragma unroll
      for (int e = 0; e < 4; ++e) { x[d0][e] *= rstd * g0[e]; x[d0][4 + e] *= rstd * g1[e]; } }
    const double pos_d = (double)(qpos0 + wq * 32 + r32);
#pragma unroll
    for (int i = 0; i < 8; ++i) { const double t = pos_d * ROPE_INV[i] * 0.15915494309189535; const float fr = (float)(t - rint(t));
      const float cs = __builtin_amdgcn_cosf(fr), sn = __builtin_amdgcn_sinf(fr);
      const float y = __shfl_xor(x[0][i], 32);
      x[0][i] = x[0][i] * cs + (hi ? y : -y) * sn; }
#pragma unroll
    for (int d0 = 0; d0 < 4; ++d0) { u32x4 w = {pk2(x[d0][0] * C2, x[d0][1] * C2), pk2(x[d0][2] * C2, x[d0][3] * C2), pk2(x[d0][4] * C2, x[d0][5] * C2), pk2(x[d0][6] * C2, x[d0][7] * C2)};
      qr[d0] = __builtin_bit_cast(bf16x8, w); } }
  WAIT_BAR(4);
  DMA_K(2, 2 * SHM_K); DMA_V(1, SHM_K);
  qkt<SHIFT>(pA0, pA1, K_ring, qr, r32, hi, c, negmb); expA(pA0); expA(pA1);
#define ITER(CUR0, CUR1, PRV0, PRV1, j) do { \
    WAIT_BAR(4); \
    { const int tk_ = ((j) + 2 < NT) ? (j) + 2 : NT - 1, tv_ = ((j) + 1 < NT) ? (j) + 1 : NT - 1; DMA_K(tk_, s0); DMA_V(tv_, s2); } \
    SBAR(); qkt<SHIFT>(CUR0, CUR1, K_ring + s1, qr, r32, hi, c, negmb); \
    finish_pv(PRV0, PRV1, l_reg, o, vb0 + s0); expA(CUR0); expA(CUR1); \
    ROT(); } while (0)
  for (int j = 1; j + 1 < NT; j += 2) {
    ITER(pB0, pB1, pA0, pA1, j);
    ITER(pA0, pA1, pB0, pB1, j + 1);
  }
  ITER(pB0, pB1, pA0, pA1, NT - 1);
  WAIT_BAR(0);
  finish_pv(pB0, pB1, l_reg, o, vb0 + s0);
#undef ITER
#undef ROT
#undef DMA_K
#undef DMA_V
  int lane_e = lane; asm volatile("" : "+v"(lane_e));
  {
  const int lane = lane_e, r32 = lane & 31, hi = lane >> 5;
  { auto rr = __builtin_amdgcn_permlane32_swap(__float_as_uint(l_reg), __float_as_uint(l_reg), false, false); l_reg = __uint_as_float(rr[0]) + __uint_as_float(rr[1]); }
  if (hi == 0) wsf[r32] = l_reg;
  asm volatile("s_waitcnt lgkmcnt(0)" ::: "memory");
  __syncthreads();
  float* XY = (float*)lds + (c == 0 ? 16384 : 0) + wq * 4096;
#pragma unroll
  for (int r = 0; r < 16; ++r) { const float rl = __builtin_amdgcn_rcpf(wsf[crow(r, hi)]);
#pragma unroll
    for (int d0 = 0; d0 < 4; ++d0) XY[(d0 * 16 + r) * 64 + lane] = o[d0][r] * rl; }
  }
  __syncthreads();
  { int tid2 = threadIdx.x; asm volatile("" : "+v"(tid2));
    const int ch = tid2 & 15; const f32x4 g0 = *(const f32x4*)(gsub + ch * 8), g1 = *(const f32x4*)(gsub + ch * 8 + 4);
#pragma unroll
    for (int j = 0; j < 4; ++j) {
      const int row = (tid2 >> 4) + 32 * j, rr = row & 31;
      const int fi = (row >> 5) * 4096 + ((ch >> 2) * 16 + (rr & 3) + 4 * (rr >> 3)) * 64 + ((rr >> 2) & 1) * 32 + (ch & 3) * 8;
      const float* xp_ = (const float*)lds + fi;
      const f32x4 x0 = *(const f32x4*)(xp_), x1 = *(const f32x4*)(xp_ + 4), y0 = *(const f32x4*)(xp_ + 16384), y1 = *(const f32x4*)(xp_ + 16384 + 4);
      const f32x4 d0v = y0 - x0 * lam, d1v = y1 - x1 * lam;
      float ss = (d0v[0] * d0v[0] + d0v[1] * d0v[1]) + (d0v[2] * d0v[2] + d0v[3] * d0v[3]) + (d1v[0] * d1v[0] + d1v[1] * d1v[1]) + (d1v[2] * d1v[2] + d1v[3] * d1v[3]);
      ss += __shfl_xor(ss, 1); ss += __shfl_xor(ss, 2); ss += __shfl_xor(ss, 4); ss += __shfl_xor(ss, 8);
      const float rs = post / sqrtf(ss * (1.f / 128.f) + EPS);
      const f32x4 e0 = d0v * g0 * rs, e1 = d1v * g1 * rs;
      v4u w; w.x = pk2(e0[0], e0[1]); w.y = pk2(e0[2], e0[3]); w.z = pk2(e1[0], e1[1]); w.w = pk2(e1[2], e1[3]);
      *(v4u*)(Ob + (size_t)row * DM + ch * 8) = w; }
  }
  __syncthreads();
}
#undef SBAR
}

DI void sgu_unit(const bf16* P, bf16* MIX, int chunk, int hd, const float* Ws, const float* bs, const float* gv, char* lds) {
    using att::bf16x8; using att::f32x16;
    int tid = threadIdx.x; asm volatile("" : "+v"(tid));
    const int wid = tid >> 6, lane = tid & 63, r32 = lane & 31, hi = lane >> 5;
    bf16* vnT = (bf16*)lds;
    { const int p = tid >> 2, qtr = tid & 3; const bf16* src = P + (size_t)(chunk * 128 + p) * INW + OFF_CV + hd * 128 + qtr * 32;
      v4u raw[4];
#pragma unroll
      for (int i = 0; i < 4; ++i) raw[i] = *(const v4u*)(src + 8 * i);
      float x[32];
#pragma unroll
      for (int i = 0; i < 4; ++i) unpack8(raw[i], x + 8 * i);
      float ss = 0.f;
#pragma unroll
      for (int i = 0; i < 32; ++i) { x[i] = gelu_tanh(x[i]); ss += x[i] * x[i]; }
      ss += __shfl_xor(ss, 1); ss += __shfl_xor(ss, 2);
      const float rstd = 1.0f / sqrtf(ss * (1.f / 128.f) + EPS);
#pragma unroll
      for (int i = 0; i < 32; ++i) { const float v = x[i] * rstd * gv[qtr * 32 + i]; vnT[(qtr * 32 + i) * 136 + p] = (bf16)(pk2(v, 0.f) & 0xffffu); }
    }
    __syncthreads();
    const int qb = wid >> 1;
    bf16x8 a[8];
#pragma unroll
    for (int ks = 0; ks < 8; ++ks) { const float* w = Ws + (size_t)(32 * qb + r32) * 128 + 16 * ks + 8 * hi; const f32x4 w0 = *(const f32x4*)w, w1 = *(const f32x4*)(w + 4);
        att::u32x4 u = {pk2(w0.x, w0.y), pk2(w0.z, w0.w), pk2(w1.x, w1.y), pk2(w1.z, w1.w)}; a[ks] = *reinterpret_cast<bf16x8*>(&u); }
#pragma unroll
    for (int dd = 0; dd < 2; ++dd) { const int db = 2 * (wid & 1) + dd;
        f32x16 acc = {};
#pragma unroll
        for (int ks = 0; ks < 8; ++ks) { const bf16x8 b = *reinterpret_cast<const bf16x8*>(vnT + (32 * db + r32) * 136 + 16 * ks + 8 * hi);
            acc = __builtin_amdgcn_mfma_f32_32x32x16_bf16(a[ks], b, acc, 0, 0, 0); }
        const int d = 32 * db + r32;
#pragma unroll
        for (int i = 0; i < 16; ++i) { const int q = 32 * qb + att::crow(i, hi); const size_t tok = (size_t)chunk * 128 + q;
            const float uval = gelu_tanh(__uint_as_float((unsigned)P[tok * INW + OFF_CU + hd * 128 + d] << 16));
            MIX[tok * DM + MIX_C + hd * 128 + d] = (bf16)(pk2(uval * (acc[i] + bs[q]), 0.f) & 0xffffu); }
    }
    __syncthreads();
}

#define LAS __attribute__((address_space(3)))
#define XB_TMO      128
#define XB_XCNT(j)  (256  + 64 * (j))
#define XB_XSUB(j)  (1280 + 64 * (j))
#define XB_XGEN(j)  (2304 + 64 * (j))
#define XB_TOP      3328
#define XB_TOPGEN   3392
#define XCD_BAR_WORDS 3456
#define XB_SPIN_CAP (1u << 18)

__device__ __forceinline__ unsigned xb_ld(unsigned* p)              { return __hip_atomic_load(p, __ATOMIC_RELAXED, __HIP_MEMORY_SCOPE_AGENT); }
__device__ __forceinline__ unsigned xb_add(unsigned* p, unsigned v) { return __hip_atomic_fetch_add(p, v, __ATOMIC_RELAXED, __HIP_MEMORY_SCOPE_AGENT); }
__device__ __forceinline__ unsigned xb_xcc_id() { return (unsigned)__builtin_amdgcn_s_getreg((3 << 11) | 20) & 0xFu; }
#define XB_SPIN(cond, bar) do { unsigned _sp = 0; while (cond) { __builtin_amdgcn_s_sleep(1); \
    if ((++_sp & 255u) == 0u) { if (xb_ld(&(bar)[XB_TMO])) break; if (_sp > XB_SPIN_CAP) { atomicAdd(&(bar)[XB_TMO], 1u); break; } } } } while (0)

struct XcdBarrier {
    unsigned* bar; unsigned x;
    volatile LAS unsigned* st;
};

__device__ __forceinline__ XcdBarrier xcd_barrier_post(unsigned* bar, volatile LAS unsigned* st) {
    XcdBarrier b; b.bar = bar; b.x = xb_xcc_id(); b.st = st;
    if (threadIdx.x == 0) (void)xb_add(&bar[XB_XCNT(b.x)], 1u);
    return b;
}
__device__ __forceinline__ void xcd_barrier_complete(unsigned* bar, unsigned x, unsigned& nloc, unsigned& nx) {
    const unsigned G = gridDim.x * gridDim.y * gridDim.z;
    unsigned sum, cnt, mine, sp = 0u;
    for (;;) {
        sum = 0u; cnt = 0u; mine = 0u;
#pragma unroll
        for (unsigned j = 0; j < 16; ++j) { const unsigned c = xb_ld(&bar[XB_XCNT(j)]); sum += c; cnt += (c > 0u) ? 1u : 0u; mine = (j == x) ? c : mine; }
        if (sum == G) break;
        __builtin_amdgcn_s_sleep(1);
        if ((++sp & 255u) == 0u) { if (xb_ld(&bar[XB_TMO])) break; if (sp > XB_SPIN_CAP) { atomicAdd(&bar[XB_TMO], 1u); break; } }
    }
    nloc = mine > 0u ? mine : 1u; nx = cnt > 0u ? cnt : 1u;
}

__device__ __forceinline__ void xcd_barrier(const XcdBarrier& b) {
    asm volatile("s_waitcnt vmcnt(0)" ::: "memory");
    __syncthreads();
    if (threadIdx.x == 0) {
        unsigned* bar = b.bar;
        __builtin_amdgcn_s_waitcnt(0);
        unsigned nloc = b.st[0], nx = b.st[1];
        if (nloc == 0u) { xcd_barrier_complete(bar, b.x, nloc, nx); b.st[0] = nloc; b.st[1] = nx; }
        const unsigned old = xb_add(&bar[XB_XSUB(b.x)], 1u);
        const unsigned gen = old / nloc;
        if (old + 1u == (gen + 1u) * nloc) {
            __builtin_amdgcn_fence(__ATOMIC_RELEASE, "agent");
            asm volatile("s_waitcnt vmcnt(0)" ::: "memory");
            const unsigned og = xb_add(&bar[XB_TOP], 1u);
            const unsigned tg = og / nx;
            if (og + 1u == (tg + 1u) * nx) xb_add(&bar[XB_TOPGEN], 1u);
            else XB_SPIN(xb_ld(&bar[XB_TOPGEN]) == tg, bar);
            __builtin_amdgcn_fence(__ATOMIC_ACQUIRE, "agent");
            xb_add(&bar[XB_XGEN(b.x)], 1u);
            asm volatile("s_waitcnt vmcnt(0)" ::: "memory");
        } else {
            XB_SPIN(xb_ld(&bar[XB_XGEN(b.x)]) == gen, bar);
            __builtin_amdgcn_fence(__ATOMIC_ACQUIRE, "agent");
            asm volatile("s_waitcnt vmcnt(0)" ::: "memory");
        }
    }
    __syncthreads();
}

struct Args { const float* in[19]; float* out; unsigned char* ws; int ph_lo, ph_hi; };
constexpr int N_PHASES = 1 + 6 * NLAYER;

__global__ void __launch_bounds__(NWAVES * 64, 2) mk_fwd(Args args) {
    extern __shared__ __attribute__((aligned(16))) unsigned char lds[];
    cg::grid_group grid = cg::this_grid();
    const int G = gridDim.x; const int bx = blockIdx.x; const int vcu = (G % 8 == 0) ? (bx % 8) * (G / 8) + bx / 8 : bx;
    const int NGW = G * NWAVES;
    unsigned char* ws = args.ws;
    const float* xp = args.in[0]; const float* xs = args.in[1];
    float* out = args.out;
    bf16* XN = (bf16*)(ws + WS_XN); bf16* PROJ = (bf16*)(ws + WS_PROJ); bf16* MIX = (bf16*)(ws + WS_MIX); bf16* HB = (bf16*)(ws + WS_H);

    volatile LAS unsigned* MISC = (volatile LAS unsigned*)((LAS unsigned char*)lds + 131072 + 320);
    if (threadIdx.x < 32) MISC[threadIdx.x] = 0u;
    __syncthreads();
    const XcdBarrier bar = xcd_barrier_post((unsigned*)ws, MISC + 8);
    for (int ph = args.ph_lo; ph < args.ph_hi; ++ph) {
        int tid = threadIdx.x; asm volatile("" : "+v"(tid));
        const int lane = tid & 63, wave = __builtin_amdgcn_readfirstlane(tid >> 6), gw = vcu * NWAVES + wave;
        const int l = (ph - 1) / 6, k = (ph == 0) ? -1 : ((ph - 1) % 6);
        float* const RS = (float*)(ws + 65536);
        const unsigned char* wl = ws + WS_WT + (size_t)(l < 0 ? 0 : l) * WT_LAYER;
        if (ph == 0) {
#if PHM & 1
            for (int rep = 0; rep < PROBE_REP_MISC; ++rep) {
            float* scr = (float*)(lds + wave * 16384);
            constexpr int I_IN = 32 * 176, I_OUT = 32 * 64, I_UP = 32 * 256, I_DN = 128 * 64, I_L = I_IN + I_OUT + I_UP + I_DN;
            for (int it = gw; it < NLAYER * I_L; it += NGW) {
                const int ll = it / I_L; int r = it % I_L; unsigned char* wb = ws + WS_WT + (size_t)ll * WT_LAYER;
                if (r < I_IN) { transpose_item(args.in[3] + (size_t)ll * DM * INW, DM, INW, (bf16*)(wb + WT_IN), DM, args.in[2] + ll * DM, scr, r, lane); continue; } r -= I_IN;
                if (r < I_OUT) { transpose_item(args.in[15] + (size_t)ll * DM * DM, DM, DM, (bf16*)(wb + WT_OUT), DM, nullptr, scr, r, lane); continue; } r -= I_OUT;
                if (r < I_UP) { transpose_item(args.in[17] + (size_t)ll * DM * DFF, DM, DFF, (bf16*)(wb + WT_UP), DM, args.in[16] + ll * DM, scr, r, lane); continue; } r -= I_UP;
                transpose_item(args.in[18] + (size_t)ll * DFF * DM, DFF, DM, (bf16*)(wb + WT_DN), LDH, nullptr, scr, r, lane);
            }
            for (int m = gw; m < M_ALL; m += NGW) xb_row(m < MP ? xp + (size_t)m * DM : xs + (size_t)(m - MP) * DM, XN + (size_t)m * DM, RS + m, lane);
            for (int i = gw * 64 + lane; i < 3 * M_ALL; i += NGW * 64) RS[M_ALL + i] = 0.f;
            }
#endif
        } else if (k == 0) {
#if PHM & 2
            pg8::Gemm g{XN, (const bf16*)(wl + WT_IN), M_ALL, INW, DM, DM, DM}; pg8::StaticOrder S; S.init(M_ALL, INW, G, bx);
            pg8::EpiBf16<0> E{PROJ, INW, RS + (size_t)(2 * l) * M_ALL};
            for (int rep = 0; rep < PROBE_REP_WIN; ++rep)
            pg8::gemm_phase<pg8::EpiBf16<0>, pg8::StaticOrder, true, true>((PG8_LAS unsigned char*)lds, g, S, E);
#endif
        } else if (k == 1) {
#if PHM & 4
            const float* kg = args.in[6] + l * 64; const float* cw = args.in[4] + l * 1536;
            for (int m = 2 * gw; m < M_ALL; m += 2 * NGW) k_rows(PROJ, m, kg, lane);
            for (int m = gw; m < M_ALL; m += NGW) {
                const int pos = m < MP ? (m & (SEQ_P - 1)) : ((m - MP) & (SEQ_S - 1)); const int S = m < MP ? SEQ_P : SEQ_S;
                conv_row(PROJ, MIX, m, pos, S, cw, lane);
            }
            for (int u = vcu; u < (M_ALL / 128) * 4; u += G) { const int chunk = u >> 2, hd = u & 3;
                sgu_unit(PROJ, MIX, chunk, hd, args.in[13] + ((size_t)l * 4 + hd) * 128 * 128, args.in[14] + (l * 4 + hd) * 128, args.in[12] + l * 128, (char*)lds); }
#endif
        } else if (k == 2) {
#if PHM & 8
            const float linit = (l == 0) ? 0.2f : 0.35550906759096934f;
            const float s1 = wave_sum(args.in[7][l * 64 + lane] * args.in[8][l * 64 + lane]), s2 = wave_sum(args.in[9][l * 64 + lane] * args.in[10][l * 64 + lane]);
            const float lam = __uint_as_float(__builtin_amdgcn_readfirstlane(__float_as_uint(expf(s1) - expf(s2) + linit)));
            const float gq = wave_max(fabsf(args.in[5][l * 64 + lane])), gk = wave_max(fabsf(args.in[6][l * 64 + lane]));
            const float negmb = __uint_as_float(__builtin_amdgcn_readfirstlane(__float_as_uint(-(C2 * 64.0f * gq * gk))));
            for (int rep = 0; rep < PROBE_REP_ATT; ++rep)
            for (int t = vcu; t < 2560; t += G) {
                int pair, qb, seq, seqrow0;
                if (t < 2048) { const int i = t >> 8, v = t & 255; const int idx = (v >> 5) * 256 + i * 32 + (v & 31); pair = idx >> 7; qb = idx & 127; seq = SEQ_S; seqrow0 = MP + (pair >> 3) * SEQ_S; }
                else { const int t2 = t - 2048, i = t2 >> 8, v = t2 & 255; pair = 2 * (v >> 5) + i; qb = v & 31; seq = SEQ_P; seqrow0 = (pair >> 3) * SEQ_P; }
                const int h = pair & 7; const size_t row0 = (size_t)seqrow0 + (size_t)qb * 128;
                if (negmb >= -64.0f)
                att::attn_unit<false>(PROJ + row0 * INW + OFF_Q + h * 128, PROJ + (size_t)seqrow0 * INW + OFF_K + h * 128, PROJ + (size_t)seqrow0 * INW + OFF_V + h * 128,
                               MIX + row0 * DM + MIX_B + h * 128, seq, (char*)lds, 0.f, lam, args.in[11] + l * 128, 1.0f - linit, args.in[5] + l * 64, qb * 128);
                else
                att::attn_unit<true>(PROJ + row0 * INW + OFF_Q + h * 128, PROJ + (size_t)seqrow0 * INW + OFF_K + h * 128, PROJ + (size_t)seqrow0 * INW + OFF_V + h * 128,
                               MIX + row0 * DM + MIX_B + h * 128, seq, (char*)lds, negmb, lam, args.in[11] + l * 128, 1.0f - linit, args.in[5] + l * 64, qb * 128);
            }
#endif
        } else if (k == 3 || k == 5) {
#if PHM & 16
            pg8::Gemm g; if (k == 3) g = pg8::Gemm{MIX, (const bf16*)(wl + WT_OUT), M_ALL, DM, DM, DM, DM}; else g = pg8::Gemm{HB, (const bf16*)(wl + WT_DN), M_ALL, DM, DFF, LDH, LDH};
            pg8::StaticOrder S; S.init(M_ALL, DM, G, bx);
            pg8::EpiResF32 E;
            if (k == 3 && l == 0) E = pg8::EpiResF32{xp, xs, MP / 256, nullptr, nullptr, DM, XN, DM, RS + (size_t)1 * M_ALL};
            else if (k == 3) E = pg8::EpiResF32{nullptr, nullptr, 0, XN, nullptr, DM, XN, DM, RS + (size_t)3 * M_ALL};
            else if (l == 0) E = pg8::EpiResF32{nullptr, nullptr, 0, XN, nullptr, DM, XN, DM, RS + (size_t)2 * M_ALL};
            else E = pg8::EpiResF32{nullptr, nullptr, 0, XN, out, DM, nullptr, DM, nullptr};
            pg8::gemm_phase<pg8::EpiResF32, pg8::StaticOrder, true, true>((PG8_LAS unsigned char*)lds, g, S, E);
#endif
        } else {
#if PHM & 64
            pg8::Gemm g{XN, (const bf16*)(wl + WT_UP), M_ALL, DFF, DM, DM, DM}; pg8::StaticOrder S; S.init(M_ALL, DFF, G, bx);
            pg8::EpiBf16<2> E{HB, LDH, RS + (size_t)(2 * l + 1) * M_ALL};
            for (int rep = 0; rep < PROBE_REP_UP; ++rep)
            pg8::gemm_phase<pg8::EpiBf16<2>, pg8::StaticOrder, true, true>((PG8_LAS unsigned char*)lds, g, S, E);
#endif
        }
        if (ph + 1 < args.ph_hi) { if (ph == args.ph_lo) grid.sync(); else xcd_barrier(bar); }
    }
}

extern "C" void kernel_launch(void* const* d_in, const int* in_sizes, int n_in, void* d_out, int out_size, void* d_ws, size_t ws_size, hipStream_t stream) {
    static int grid = 0;
    if (grid == 0) {
        if (n_in != 19 || out_size != M_ALL * DM || ws_size < WS_END) { fprintf(stderr, "kernel_launch: unexpected shapes: n_in %d out %d ws %zu (need %zu)\n", n_in, out_size, ws_size, (size_t)WS_END); grid = -1; return; }
        int dev = 0, cus = 0, per_cu = 0;
        if (hipGetDevice(&dev) != hipSuccess || hipDeviceGetAttribute(&cus, hipDeviceAttributeMultiprocessorCount, dev) != hipSuccess) { fprintf(stderr, "kernel_launch: device query failed\n"); grid = -1; return; }
        if (hipFuncSetAttribute((const void*)mk_fwd, hipFuncAttributeMaxDynamicSharedMemorySize, LDS_BYTES) != hipSuccess) { fprintf(stderr, "kernel_launch: hipFuncSetAttribute failed\n"); grid = -1; return; }
        if (hipOccupancyMaxActiveBlocksPerMultiprocessor(&per_cu, (const void*)mk_fwd, NWAVES * 64, LDS_BYTES) != hipSuccess || per_cu < 1) { fprintf(stderr, "kernel_launch: occupancy query gave %d\n", per_cu); per_cu = 1; }
        (void)hipGetLastError();
        grid = cus * 1;
        fprintf(stderr, "kernel_launch: grid %d (cus %d, per_cu %d)\n", grid, cus, per_cu);
    }
    if (grid < 0) return;
    if (hipMemsetAsync(d_ws, 0, 65536, stream) != hipSuccess) { fprintf(stderr, "kernel_launch: memset failed\n"); return; }
    Args a{};
    for (int i = 0; i < 19; ++i) a.in[i] = (const float*)d_in[i];
    a.out = (float*)d_out; a.ws = (unsigned char*)d_ws;
#if MK_SINGLE
    a.ph_lo = 0; a.ph_hi = N_PHASES;
    { void* kargs[] = {&a}; hipError_t e = hipLaunchCooperativeKernel((const void*)mk_fwd, dim3(grid), dim3(NWAVES * 64), kargs, LDS_BYTES, stream);
      if (e != hipSuccess) fprintf(stderr, "kernel_launch: cooperative launch failed: %s\n", hipGetErrorString(e)); }
#else
    for (int ph = 0; ph < N_PHASES; ++ph) { a.ph_lo = ph; a.ph_hi = ph + 1; void* kargs[] = {&a};
        hipError_t e = hipLaunchCooperativeKernel((const void*)mk_fwd, dim3(grid), dim3(NWAVES * 64), kargs, LDS_BYTES, stream);
        if (e != hipSuccess) { fprintf(stderr, "kernel_launch: cooperative launch %d failed: %s\n", ph, hipGetErrorString(e)); break; } }
#endif
}
```

```cpp
#include <hip/hip_runtime.h>
#include <hip/hip_cooperative_groups.h>
#include <hip/hip_bf16.h>
#include <cstdio>
#include <cstdint>
namespace cg = cooperative_groups;
namespace pg8 {
#define PG8_LAS __attribute__((address_space(3)))
typedef unsigned short bf16_t;
typedef short bf16x8 __attribute__((ext_vector_type(8)));
typedef float f32x4 __attribute__((ext_vector_type(4)));
typedef unsigned u32x4 __attribute__((ext_vector_type(4)));
constexpr int BM = 256, BK = 64, HALF = 128, HTB = HALF * BK * 2  , STAGE_BYTES = 8 * HTB, NXCD = 8, WGM = 8;

__host__ __device__ __forceinline__ int lds_byte(int r, int c) { const int st = (r >> 4) * 2 + (c >> 5), rr = r & 15, cc = c & 31, ob = rr * 64 + cc * 2; return st * 1024 + (ob ^ (((ob >> 9) & 1) << 5)); }
__host__ __device__ __forceinline__ void stage_rc(int b, int& R, int& C) { const int st = b / 1024, sb = b % 1024, swz = sb ^ (((sb >> 9) & 1) << 5); R = (st >> 1) * 16 + swz / 64; C = (st & 1) * 32 + (swz % 64) / 2; }
__host__ __device__ __forceinline__ int perm32(int rho) { const int n = rho >> 4, i = rho & 15; return 8 * (i >> 2) + 4 * n + (i & 3); }

struct Unit { int pm, pn; };
struct Gemm { const bf16_t* A; const bf16_t* Bt; int M, N, K, lda, ldb; };

struct StaticOrder {
    int nM, nN, nwg, G, c;
    __host__ __device__ void init(int M, int N, int G_, int c_) { nM = M / BM; nN = N / BM; nwg = nM * nN; G = G_; c = c_; }
    __host__ __device__ bool next(int i, Unit& u) const {
        const long L = (long)i * G + c; if (L >= nwg) return false;
        int wgid = (int)L; { const int q = nwg / NXCD, r = nwg % NXCD, xcd = wgid % NXCD, off = wgid / NXCD; wgid = (xcd < r ? xcd * (q + 1) : r * (q + 1) + (xcd - r) * q) + off; }
        const int nig = WGM * nN, gid = wgid / nig, fm = gid * WGM, gsz = (nM - fm) < WGM ? (nM - fm) : WGM;
        u.pm = fm + ((wgid % nig) % gsz); u.pn = (wgid % nig) / gsz; return true;
    }
    __device__ __forceinline__ void a_ready(const Unit&) const {}
    __device__ __forceinline__ void done(const Unit&) const {}
};

__device__ __forceinline__ unsigned cvt_pk_bf16(float lo, float hi) { unsigned r; asm volatile("v_cvt_pk_bf16_f32 %0, %1, %2" : "=v"(r) : "v"(lo), "v"(hi)); return r; }
typedef float f32x2 __attribute__((ext_vector_type(2)));
typedef unsigned u32x2 __attribute__((ext_vector_type(2)));
template <int ACT> struct EpiBf16 {
    static constexpr bool PERM = true, AFTER_DRAIN = false;
    bf16_t* O; int ldc; const float* rowss;
    __device__ __forceinline__ void operator()(const f32x4 (&acc)[2][2][4][2], const Unit& u, int wr, int wc, int fr, int fq) const {
        const int row0 = u.pm * BM + wr * 64 + fr; const int col0 = u.pn * BM + wc * 32 + 8 * fq;
        float rs[2][4];
#pragma unroll
        for (int ai = 0; ai < 2; ++ai)
#pragma unroll
            for (int m = 0; m < 4; ++m) rs[ai][m] = rowss[row0 + ai * HALF + m * 16];
#pragma unroll
        for (int ai = 0; ai < 2; ++ai)
#pragma unroll
            for (int m = 0; m < 4; ++m) { bf16_t* rowp = O + (size_t)(row0 + ai * HALF + m * 16) * ldc + col0;
                const float sc = 1.0f / sqrtf(rs[ai][m] * (1.0f / 2048.0f) + 1e-6f);
#pragma unroll
                for (int bj = 0; bj < 2; ++bj) { f32x4 v0 = acc[ai][bj][m][0] * sc, v1 = acc[ai][bj][m][1] * sc;
                    if (ACT == 2) {
#pragma unroll
                        for (int e = 0; e < 4; ++e) { float a = fmaxf(v0[e], 0.f), b = fmaxf(v1[e], 0.f); v0[e] = a * a; v1[e] = b * b; } }
                    u32x4 w; w.x = cvt_pk_bf16(v0[0], v0[1]); w.y = cvt_pk_bf16(v0[2], v0[3]); w.z = cvt_pk_bf16(v1[0], v1[1]); w.w = cvt_pk_bf16(v1[2], v1[3]);
                    *(u32x4*)(rowp + bj * HALF) = w; } }
    }
};
struct EpiResF32 {
    static constexpr bool PERM = true, AFTER_DRAIN = false;
    const float* res_lo; const float* res_hi; int split_pm; const bf16_t* resb; float* out; int ldc; bf16_t* xb; int ldx; float* rowss;
    __device__ __forceinline__ void operator()(const f32x4 (&acc)[2][2][4][2], const Unit& u, int wr, int wc, int fr, int fq) const {
        const float* rbase = (u.pm < split_pm) ? res_lo : (res_hi - (size_t)split_pm * BM * ldc);
        const int col0 = u.pn * BM + wc * 32 + 8 * fq;
#pragma unroll
        for (int ai = 0; ai < 2; ++ai)
#pragma unroll
            for (int m = 0; m < 4; ++m) { const int row = u.pm * BM + ai * HALF + wr * 64 + m * 16 + fr; const size_t off = (size_t)row * ldc + col0, offb = (size_t)row * ldx + col0; float ss = 0.f;
#pragma unroll
                for (int bj = 0; bj < 2; ++bj) {
                    f32x4 v0, v1;
                    if (resb) { const u32x4 r = *(const u32x4*)(resb + offb + bj * HALF);
                        v0 = (f32x4){__uint_as_float(r.x << 16), __uint_as_float(r.x & 0xffff0000u), __uint_as_float(r.y << 16), __uint_as_float(r.y & 0xffff0000u)};
                        v1 = (f32x4){__uint_as_float(r.z << 16), __uint_as_float(r.z & 0xffff0000u), __uint_as_float(r.w << 16), __uint_as_float(r.w & 0xffff0000u)}; }
                    else { v0 = *(const f32x4*)(rbase + off + bj * HALF); v1 = *(const f32x4*)(rbase + off + bj * HALF + 4); }
                    v0 += acc[ai][bj][m][0]; v1 += acc[ai][bj][m][1];
                    if (out) { *(f32x4*)(out + off + bj * HALF) = v0; *(f32x4*)(out + off + bj * HALF + 4) = v1; }
                    if (xb) { u32x4 w; w.x = cvt_pk_bf16(v0[0], v0[1]); w.y = cvt_pk_bf16(v0[2], v0[3]); w.z = cvt_pk_bf16(v1[0], v1[1]); w.w = cvt_pk_bf16(v1[2], v1[3]);
                        *(u32x4*)(xb + offb + bj * HALF) = w;
                        ss += (v0[0] * v0[0] + v0[1] * v0[1]) + (v0[2] * v0[2] + v0[3] * v0[3]) + (v1[0] * v1[0] + v1[1] * v1[1]) + (v1[2] * v1[2] + v1[3] * v1[3]); } }
                if (xb) { ss += __shfl_xor(ss, 16); ss += __shfl_xor(ss, 32);
                    if (fq == 0) __hip_atomic_fetch_add(rowss + row, ss, __ATOMIC_RELAXED, __HIP_MEMORY_SCOPE_AGENT); }
                if (m == 3) asm volatile("" ::: "memory"); }
    }
};
template <class Epi, class Sched, bool ALIGN_EPI = false, bool SP2 = false>
__device__ __forceinline__ void gemm_phase(PG8_LAS unsigned char* lds, const Gemm g, const Sched& S, const Epi& E) {
    int tid = threadIdx.x; asm volatile("" : "+v"(tid));
    const int wid = __builtin_amdgcn_readfirstlane(tid >> 6), lane = tid & 63, wr = wid >> 2, wc = wid & 3, fr = lane & 15, fq = lane >> 4;
    const int K = g.K, nt = K / BK;
    unsigned voffA[2], voffB[2];
#pragma unroll
    for (int i = 0; i < 2; ++i) { int R, C; stage_rc(tid * 16 + i * 8192, R, C); const int Rb = Epi::PERM ? ((R & ~31) + perm32(R & 31)) : R;
        voffA[i] = (unsigned)(R * g.lda + C) * 2u; voffB[i] = (unsigned)(Rb * g.ldb + C) * 2u; }
    const size_t kstep = (size_t)(BK * 2);
    const size_t hstepA = (size_t)HALF * g.lda * 2, hstepB = (size_t)HALF * g.ldb * 2;
    const size_t tstepA = 2 * hstepA, tstepB = 2 * hstepB;
    const unsigned ldsw = (unsigned)wid * 1024u;
    const int aoff = lds_byte(wr * 64 + fr, fq * 8), boff = lds_byte(wc * 32 + fr, fq * 8);
#define PG8_SA(b, h) (((b) * 2 + (h)) * HTB)
#define PG8_SB(b, h) ((4 + (b) * 2 + (h)) * HTB)
#define PG8_STAGE(bufoff, gbase, voff) do { _Pragma("unroll") for (int _i = 0; _i < 2; ++_i) \
        __builtin_amdgcn_global_load_lds((const unsigned*)((const char*)(gbase) + (voff)[_i]), (PG8_LAS unsigned*)(lds + (bufoff) + ldsw + _i * 8192), 16, 0, 0); } while (0)
#define PG8_LDA(dst, b, h) do { _Pragma("unroll") for (int m = 0; m < 4; ++m) _Pragma("unroll") for (int k = 0; k < 2; ++k) dst[m][k] = *(const PG8_LAS bf16x8*)(lds + PG8_SA(b, h) + aoff + m * 2048 + k * 1024); } while (0)
#define PG8_LDB(dst, b, h) do { _Pragma("unroll") for (int n = 0; n < 2; ++n) _Pragma("unroll") for (int k = 0; k < 2; ++k) dst[n][k] = *(const PG8_LAS bf16x8*)(lds + PG8_SB(b, h) + boff + n * 2048 + k * 1024); } while (0)
#define PG8_MMA(ai, bj, At, Bt) do { __builtin_amdgcn_s_setprio(1); _Pragma("unroll") for (int m = 0; m < 4; ++m) _Pragma("unroll") for (int n = 0; n < 2; ++n) _Pragma("unroll") for (int k = 0; k < 2; ++k) \
        acc[ai][bj][m][n] = __builtin_amdgcn_mfma_f32_16x16x32_bf16(Bt[n][k], At[m][k], acc[ai][bj][m][n], 0, 0, 0); __builtin_amdgcn_s_setprio(0); } while (0)
#define PG8_WAIT_V(n) asm volatile("s_waitcnt vmcnt(" #n ")" ::: "memory")
#define PG8_WAIT_L(n) asm volatile("s_waitcnt lgkmcnt(" #n ")" ::: "memory")
#define PG8_BAR __builtin_amdgcn_s_barrier()
#define PG8_SCHED __builtin_amdgcn_sched_barrier(0)
    Unit cur, nxt; int ui = 0;
    if (!S.next(0, cur)) return;
    f32x4 acc[2][2][4][2];
#pragma unroll
    for (int a = 0; a < 2; ++a)
#pragma unroll
        for (int b = 0; b < 2; ++b)
#pragma unroll
            for (int m = 0; m < 4; ++m)
#pragma unroll
                for (int n = 0; n < 2; ++n) acc[a][b][m][n] = (f32x4){0.f, 0.f, 0.f, 0.f};
    bf16x8 At[4][2], B0[2][2], B1[2][2];
    const char* cA = (const char*)g.A + (size_t)cur.pm * tstepA; const char* cB = (const char*)g.Bt + (size_t)cur.pn * tstepB;
    S.a_ready(cur);
    if constexpr (SP2) {
        PG8_STAGE(PG8_SB(0, 0), cB, voffB); PG8_STAGE(PG8_SB(0, 1), cB + hstepB, voffB); PG8_STAGE(PG8_SA(0, 0), cA, voffA); PG8_STAGE(PG8_SA(0, 1), cA + hstepA, voffA);
        if (wr == 1) PG8_BAR;
        PG8_WAIT_V(2); PG8_BAR;
        PG8_STAGE(PG8_SB(1, 0), cB + kstep, voffB); PG8_STAGE(PG8_SA(1, 0), cA + kstep, voffA); PG8_STAGE(PG8_SB(1, 1), cB + hstepB + kstep, voffB);
        PG8_WAIT_V(6); PG8_BAR;
    } else {
        PG8_STAGE(PG8_SB(0, 0), cB, voffB); PG8_STAGE(PG8_SA(0, 0), cA, voffA); PG8_STAGE(PG8_SB(0, 1), cB + hstepB, voffB); PG8_STAGE(PG8_SA(0, 1), cA + hstepA, voffA);
        if (wr == 1) PG8_BAR;
        PG8_WAIT_V(4); PG8_BAR;
        PG8_STAGE(PG8_SB(1, 0), cB + kstep, voffB); PG8_STAGE(PG8_SA(1, 0), cA + kstep, voffA); PG8_STAGE(PG8_SB(1, 1), cB + hstepB + kstep, voffB);
        PG8_WAIT_V(6); PG8_BAR;
    }
    for (;;) {
        const bool has_next = S.next(ui + 1, nxt);
        const char* nA = has_next ? (const char*)g.A + (size_t)nxt.pm * tstepA : cA; const char* nB = has_next ? (const char*)g.Bt + (size_t)nxt.pn * tstepB : cB;
        for (int t = 0; t < nt; t += 2) {
            const bool last = (t == nt - 2);
            const char* a1 = cA + (size_t)(t + 1) * kstep;
            const char* a2 = last ? nA : cA + (size_t)(t + 2) * kstep; const char* b2 = last ? nB : cB + (size_t)(t + 2) * kstep;
            const char* a3 = a2 + kstep; const char* b3 = b2 + kstep;
            if (last && has_next) S.a_ready(nxt);
            if constexpr (SP2) {
            PG8_LDB(B0, 0, 0); PG8_LDB(B1, 0, 1); PG8_SCHED; PG8_LDA(At, 0, 0); PG8_STAGE(PG8_SA(1, 1), a1 + hstepA, voffA);
            PG8_WAIT_V(8); PG8_WAIT_L(0); PG8_BAR; PG8_MMA(0, 0, At, B0); PG8_MMA(0, 1, At, B1); PG8_BAR; PG8_SCHED;
            PG8_LDA(At, 0, 1); PG8_STAGE(PG8_SB(0, 0), b2, voffB); PG8_STAGE(PG8_SB(0, 1), b2 + hstepB, voffB); PG8_STAGE(PG8_SA(0, 0), a2, voffA);
            PG8_WAIT_V(8); PG8_WAIT_L(0); PG8_BAR; PG8_MMA(1, 0, At, B0); PG8_MMA(1, 1, At, B1); PG8_BAR; PG8_SCHED;
            PG8_LDB(B0, 1, 0); PG8_LDB(B1, 1, 1); PG8_SCHED; PG8_LDA(At, 1, 0); PG8_STAGE(PG8_SA(0, 1), a2 + hstepA, voffA);
            PG8_WAIT_V(8); PG8_WAIT_L(0); PG8_BAR; PG8_MMA(0, 0, At, B0); PG8_MMA(0, 1, At, B1); PG8_BAR; PG8_SCHED;
            PG8_LDA(At, 1, 1); PG8_STAGE(PG8_SB(1, 0), b3, voffB); PG8_STAGE(PG8_SB(1, 1), b3 + hstepB, voffB); PG8_STAGE(PG8_SA(1, 0), a3, voffA);
            PG8_WAIT_V(8); PG8_WAIT_L(0); PG8_BAR; PG8_MMA(1, 0, At, B0); PG8_MMA(1, 1, At, B1); PG8_BAR; PG8_SCHED;
            } else {
            PG8_LDB(B0, 0, 0); PG8_SCHED; PG8_LDA(At, 0, 0); PG8_STAGE(PG8_SA(1, 1), a1 + hstepA, voffA);
            PG8_WAIT_L(8); PG8_BAR; PG8_WAIT_L(0); PG8_MMA(0, 0, At, B0); PG8_BAR; PG8_SCHED;
            PG8_LDB(B1, 0, 1); PG8_STAGE(PG8_SB(0, 0), b2, voffB);
            PG8_BAR; PG8_WAIT_L(0); PG8_MMA(0, 1, At, B1); PG8_BAR;
            PG8_LDA(At, 0, 1); PG8_STAGE(PG8_SA(0, 0), a2, voffA);
            PG8_BAR; PG8_WAIT_L(0); PG8_MMA(1, 0, At, B0); PG8_BAR; PG8_SCHED;
            PG8_STAGE(PG8_SB(0, 1), b2 + hstepB, voffB);
            PG8_WAIT_V(6); PG8_BAR; PG8_MMA(1, 1, At, B1); PG8_BAR;
            PG8_LDB(B0, 1, 0); PG8_SCHED; PG8_LDA(At, 1, 0); PG8_STAGE(PG8_SA(0, 1), a2 + hstepA, voffA);
            PG8_WAIT_L(8); PG8_BAR; PG8_WAIT_L(0); PG8_MMA(0, 0, At, B0); PG8_BAR; PG8_SCHED;
            PG8_LDB(B1, 1, 1); PG8_STAGE(PG8_SB(1, 0), b3, voffB);
            PG8_BAR; PG8_WAIT_L(0); PG8_MMA(0, 1, At, B1); PG8_BAR;
            PG8_LDA(At, 1, 1); PG8_STAGE(PG8_SA(1, 0), a3, voffA);
            PG8_BAR; PG8_WAIT_L(0); PG8_MMA(1, 0, At, B0); PG8_BAR; PG8_SCHED;
            PG8_STAGE(PG8_SB(1, 1), b3 + hstepB, voffB);
            PG8_WAIT_V(6); PG8_BAR; PG8_MMA(1, 1, At, B1); PG8_BAR;
            }
        }
        if constexpr (ALIGN_EPI) { if (wr == 0) PG8_BAR; }
        if constexpr (!Epi::AFTER_DRAIN) { E(acc, cur, wr, wc, fr, fq); S.done(cur); }
        if (!has_next) break;
#pragma unroll
        for (int a = 0; a < 2; ++a)
#pragma unroll
            for (int b = 0; b < 2; ++b)
#pragma unroll
                for (int m = 0; m < 4; ++m)
#pragma unroll
                    for (int n = 0; n < 2; ++n) acc[a][b][m][n] = (f32x4){0.f, 0.f, 0.f, 0.f};
        cur = nxt; cA = nA; cB = nB; ++ui;
        if constexpr (ALIGN_EPI) { if (wr == 1) PG8_BAR; }
    }
    PG8_WAIT_V(0);
    if constexpr (!ALIGN_EPI) { if (wr == 0) PG8_BAR; }
    PG8_BAR;
    if constexpr (Epi::AFTER_DRAIN) { E.fused(acc, cur, wr, wc, fr, fq, lds, wid, lane); S.done(cur); }
#undef PG8_SA
#undef PG8_SB
#undef PG8_STAGE
#undef PG8_LDA
#undef PG8_LDB
#undef PG8_MMA
#undef PG8_WAIT_V
#undef PG8_WAIT_L
#undef PG8_BAR
#undef PG8_SCHED
}
}

#ifndef PROBE_REP_ATT
#define PROBE_REP_ATT 1
#endif
#ifndef PROBE_REP_UP
#define PROBE_REP_UP 1
#endif
#ifndef PROBE_XSYNC
#define PROBE_XSYNC 0
#endif
#ifndef PROBE_REP_MISC
#define PROBE_REP_MISC 1
#endif
#ifndef PROBE_REP_WIN
#define PROBE_REP_WIN 1
#endif
#ifndef PHM
#define PHM 127
#endif
#ifndef MK_SINGLE
#define MK_SINGLE 1
#endif
constexpr int DM = 2048, MP = 8192, M_ALL = 40960, SEQ_P = 4096, SEQ_S = 16384, INW = 5632, DFF = 8192, NLAYER = 2;
constexpr int OFF_AX = 0, OFF_AB = 512, OFF_AC = 1024, OFF_Q = 1536, OFF_K = 2560, OFF_V = 3584, OFF_CU = 4608, OFF_CV = 5120;
constexpr int MIX_A = 0, MIX_B = 512, MIX_C = 1536;
constexpr float EPS = 1e-6f;
constexpr float C2 = 0.18033688011112042f;
constexpr size_t MiB = 1u << 20;
constexpr int LDH = DFF + 128;
constexpr size_t WS_WT = 1 * MiB, WT_LAYER = 96 * MiB, WT_IN = 0, WT_OUT = 22 * MiB, WT_UP = 30 * MiB, WT_DN = 62 * MiB;
constexpr size_t WS_XN = 194 * MiB, WS_H = 356 * MiB, WS_PROJ = 356 * MiB, WS_MIX = 796 * MiB, WS_END = 1008 * MiB;
static_assert(WT_DN + (size_t)DM * LDH * 2 <= WT_LAYER && WS_WT + 2 * WT_LAYER <= WS_XN && WS_XN + (size_t)M_ALL * DM * 2 <= WS_H && WS_PROJ + (size_t)M_ALL * INW * 2 <= WS_MIX && WS_MIX + (size_t)M_ALL * DM * 2 <= WS_END && WS_H + (size_t)M_ALL * LDH * 2 <= WS_END, "ws map");
constexpr int NWAVES = 8, LDS_BYTES = 147456;

typedef unsigned short bf16;
typedef unsigned v4u __attribute__((ext_vector_type(4)));
typedef unsigned v2u __attribute__((ext_vector_type(2)));
typedef float f32x4 __attribute__((ext_vector_type(4)));
#define DI __device__ __forceinline__

DI unsigned pk2(float lo, float hi) { return pg8::cvt_pk_bf16(lo, hi); }
DI float bflo(unsigned u) { return __uint_as_float(u << 16); }
DI float bfhi(unsigned u) { return __uint_as_float(u & 0xffff0000u); }
DI float wave_sum(float v) {
#pragma unroll
    for (int o = 1; o < 64; o <<= 1) v += __shfl_xor(v, o);
    return v;
}
DI float wave_max(float v) {
#pragma unroll
    for (int o = 1; o < 64; o <<= 1) v = fmaxf(v, __shfl_xor(v, o));
    return v;
}
DI float gelu_tanh(float x) {
    const float z = x * (0.7978845608028654f + 0.035677408136300125f * x * x);
    const float e = __builtin_amdgcn_exp2f(-2.8853900817779268f * z);
    return x * __builtin_amdgcn_rcpf(1.0f + e);
}

DI void transpose_item(const float* W, int K, int N, bf16* WT, int ldt, const float* gain, float* scr, int item, int lane) {
    const int nblk = N / 32, kb = item / nblk, nb = item % nblk, k0 = 64 * kb, n0 = 32 * nb;
#pragma unroll 32
    for (int i = 0; i < 32; ++i) { const int kk = 2 * i + (lane >> 5); scr[kk * 33 + (lane & 31)] = W[(size_t)(k0 + kk) * N + n0 + (lane & 31)] * (gain ? gain[k0 + kk] : 1.0f); }
    asm volatile("s_waitcnt lgkmcnt(0)" ::: "memory");
    const int c = lane & 7;
#pragma unroll
    for (int j = 0; j < 4; ++j) { const int n = (lane >> 3) + 8 * j; const float* s = scr + (8 * c) * 33 + n;
        v4u o; o.x = pk2(s[0 * 33], s[1 * 33]); o.y = pk2(s[2 * 33], s[3 * 33]); o.z = pk2(s[4 * 33], s[5 * 33]); o.w = pk2(s[6 * 33], s[7 * 33]);
        *(v4u*)(WT + (size_t)(n0 + n) * ldt + k0 + 8 * c) = o; }
    asm volatile("s_waitcnt lgkmcnt(0)" ::: "memory");
}
DI void xb_row(const float* xrow, bf16* orow, float* ssp, int lane) {
    const f32x4* xr = (const f32x4*)xrow + lane;
    f32x4 v[8]; float s = 0.f;
#pragma unroll
    for (int j = 0; j < 8; ++j) { v[j] = xr[64 * j]; s += (v[j].x * v[j].x + v[j].y * v[j].y) + (v[j].z * v[j].z + v[j].w * v[j].w); }
    s = wave_sum(s);
    if (lane == 0) *ssp = s;
    v2u* o8 = (v2u*)orow + lane;
#pragma unroll
    for (int j = 0; j < 8; ++j) { v2u w; w.x = pk2(v[j].x, v[j].y); w.y = pk2(v[j].z, v[j].w); o8[64 * j] = w; }
}

__constant__ double ROPE_INV[8] = {1.0, 0.19392274474868576, 0.03760603093086393, 0.007292664737217109, 0.001414213562373095, 0.0002742481756762073, 5.318295896944988e-05, 1.031338537721246e-05};
DI void k_rows(bf16* P, int row2, const float* kg, int lane) {
    const int row = row2 + (lane >> 5), l5 = lane & 31;
    const int pos = row < MP ? (row & (SEQ_P - 1)) : ((row - MP) & (SEQ_S - 1));
    bf16* p = P + (size_t)row * INW + OFF_K + l5 * 32;
    v4u raw[4];
#pragma unroll
    for (int i = 0; i < 4; ++i) raw[i] = *(const v4u*)(p + 8 * i);
    float x[32];
#pragma unroll
    for (int i = 0; i < 4; ++i) { x[8 * i + 0] = bflo(raw[i].x); x[8 * i + 1] = bfhi(raw[i].x); x[8 * i + 2] = bflo(raw[i].y); x[8 * i + 3] = bfhi(raw[i].y);
        x[8 * i + 4] = bflo(raw[i].z); x[8 * i + 5] = bfhi(raw[i].z); x[8 * i + 6] = bflo(raw[i].w); x[8 * i + 7] = bfhi(raw[i].w); }
    float ss = 0.f;
#pragma unroll
    for (int i = 0; i < 32; ++i) ss += x[i] * x[i];
    ss += __shfl_xor(ss, 1);
    const float rstd = 1.0f / sqrtf(ss * (1.f / 64.f) + EPS);
    const int half = l5 & 1;
    const float* g = kg + half * 32;
#pragma unroll
    for (int i = 0; i < 8; ++i) { const f32x4 gg = *(const f32x4*)(g + 4 * i); x[4 * i] *= rstd * gg.x; x[4 * i + 1] *= rstd * gg.y; x[4 * i + 2] *= rstd * gg.z; x[4 * i + 3] *= rstd * gg.w; }
    const double t = (double)pos * ROPE_INV[lane & 7] * 0.15915494309189535;
    const float fr = (float)(t - rint(t));
    const float cs = __builtin_amdgcn_cosf(fr), sn = __builtin_amdgcn_sinf(fr);
#pragma unroll
    for (int i = 0; i < 8; ++i) { const float c = __shfl(cs, (lane & 32) + i), s_ = __shfl(sn, (lane & 32) + i);
        if (half == 0) { const float a = x[i], b = x[i + 8]; x[i] = a * c - b * s_; x[i + 8] = b * c + a * s_; } }
#pragma unroll
    for (int i = 0; i < 4; ++i) { v4u w; w.x = pk2(x[8 * i], x[8 * i + 1]); w.y = pk2(x[8 * i + 2], x[8 * i + 3]); w.z = pk2(x[8 * i + 4], x[8 * i + 5]); w.w = pk2(x[8 * i + 6], x[8 * i + 7]);
        *(v4u*)(p + 8 * i) = w; }
}
DI void unpack8(const v4u r, float* x) { x[0] = bflo(r.x); x[1] = bfhi(r.x); x[2] = bflo(r.y); x[3] = bfhi(r.y); x[4] = bflo(r.z); x[5] = bfhi(r.z); x[6] = bflo(r.w); x[7] = bfhi(r.w); }
DI void conv_row(const bf16* P, bf16* MIX, int row, int pos, int S, const float* cw, int lane) {
    const bf16* p = P + (size_t)row * INW + lane * 8;
    const v4u z4 = {0u, 0u, 0u, 0u};
    const v4u xa0 = *(const v4u*)(p + OFF_AX), gc0 = *(const v4u*)(p + OFF_AC), gb0 = *(const v4u*)(p + OFF_AB);
    const v4u xam = pos > 0 ? *(const v4u*)(p - INW + OFF_AX) : z4, gcm = pos > 0 ? *(const v4u*)(p - INW + OFF_AC) : z4;
    const v4u xap = pos < S - 1 ? *(const v4u*)(p + INW + OFF_AX) : z4, gcp = pos < S - 1 ? *(const v4u*)(p + INW + OFF_AC) : z4;
    float a0[8], c0[8], b0[8], am[8], cm[8], ap[8], cp[8];
    unpack8(xa0, a0); unpack8(gc0, c0); unpack8(gb0, b0); unpack8(xam, am); unpack8(gcm, cm); unpack8(xap, ap); unpack8(gcp, cp);
    float w0[8], w1[8], w2[8];
#pragma unroll
    for (int i = 0; i < 2; ++i) { const f32x4 a = *(const f32x4*)(cw + lane * 8 + 4 * i), b = *(const f32x4*)(cw + 512 + lane * 8 + 4 * i), c = *(const f32x4*)(cw + 1024 + lane * 8 + 4 * i);
        w0[4 * i] = a.x; w0[4 * i + 1] = a.y; w0[4 * i + 2] = a.z; w0[4 * i + 3] = a.w; w1[4 * i] = b.x; w1[4 * i + 1] = b.y; w1[4 * i + 2] = b.z; w1[4 * i + 3] = b.w;
        w2[4 * i] = c.x; w2[4 * i + 1] = c.y; w2[4 * i + 2] = c.z; w2[4 * i + 3] = c.w; }
    float o[8];
#pragma unroll
    for (int j = 0; j < 8; ++j) o[j] = b0[j] * (w0[j] * (cm[j] * am[j]) + w1[j] * (c0[j] * a0[j]) + w2[j] * (cp[j] * ap[j]));
    v4u w; w.x = pk2(o[0], o[1]); w.y = pk2(o[2], o[3]); w.z = pk2(o[4], o[5]); w.w = pk2(o[6], o[7]);
    *(v4u*)(MIX + (size_t)row * DM + MIX_A + lane * 8) = w;
}

namespace att {
using bf16x8 = __attribute__((ext_vector_type(8))) short;
using s16x4  = __attribute__((ext_vector_type(4))) short;
using f32x16 = __attribute__((ext_vector_type(16))) float;
using u32x4  = __attribute__((ext_vector_type(4))) unsigned;
constexpr int KVBLK = 64;
constexpr int SHM_V = 16384, SHM_K = 16384, SCR_OFF = 133120;
#define KSWZ(row, colB) ((row) * 256 + ((colB) ^ (((row) & 15) << 4)))
#define SBAR() __builtin_amdgcn_sched_barrier(0)
DI int crow(int r, int hi) { return (r & 3) + 8 * (r >> 2) + 4 * hi; }
DI unsigned cvtpk(float lo, float hi) { unsigned r; asm volatile("v_cvt_pk_bf16_f32 %0, %1, %2" : "=v"(r) : "v"(lo), "v"(hi)); return r; }
DI int v_st(int k, int c) { const int kk = (k & ~0xC) | ((k & 4) << 1) | ((k & 8) >> 1); return ((kk >> 3) * 4 + (c >> 5)) * 512 + ((kk & 7) * 32 + (c & 31)) * 2; }
DI int v_rd_base(int lane) { return ((lane & 3) << 3) | (((lane >> 2) & 3) << 6) | (((lane >> 4) & 1) << 5) | (((lane >> 5) & 1) << 8); }
constexpr int v_rd_off(int d0, int ks, int half) { return d0 * 512 + ks * 4096 + half * 2048; }
template <int OFF> DI s16x4 tr_read(int vb) { s16x4 r; asm volatile("ds_read_b64_tr_b16 %0, %1 offset:%2" : "=&v"(r) : "v"(vb), "i"(OFF) : "memory"); return r; }
template <int D0> DI void pv_one(f32x16& od, int vb, bf16x8 pa0, bf16x8 pa1, bf16x8 pa2, bf16x8 pa3) {
  const s16x4 l0 = tr_read<v_rd_off(D0, 0, 0)>(vb), h0 = tr_read<v_rd_off(D0, 0, 1)>(vb), l1 = tr_read<v_rd_off(D0, 1, 0)>(vb), h1 = tr_read<v_rd_off(D0, 1, 1)>(vb);
  const s16x4 l2 = tr_read<v_rd_off(D0, 2, 0)>(vb), h2 = tr_read<v_rd_off(D0, 2, 1)>(vb), l3 = tr_read<v_rd_off(D0, 3, 0)>(vb), h3 = tr_read<v_rd_off(D0, 3, 1)>(vb);
  asm volatile("s_waitcnt lgkmcnt(0)" ::: "memory"); SBAR();
#define PK(L, H) (bf16x8){L[0], L[1], L[2], L[3], H[0], H[1], H[2], H[3]}
  od = __builtin_amdgcn_mfma_f32_32x32x16_bf16(pa0, PK(l0, h0), od, 0, 0, 0);
  od = __builtin_amdgcn_mfma_f32_32x32x16_bf16(pa1, PK(l1, h1), od, 0, 0, 0);
  od = __builtin_amdgcn_mfma_f32_32x32x16_bf16(pa2, PK(l2, h2), od, 0, 0, 0);
  od = __builtin_amdgcn_mfma_f32_32x32x16_bf16(pa3, PK(l3, h3), od, 0, 0, 0);
#undef PK
}
DI void pv_d0(f32x16* o, int vb, bf16x8 pa0, bf16x8 pa1, bf16x8 pa2, bf16x8 pa3) {
  pv_one<0>(o[0], vb, pa0, pa1, pa2, pa3); pv_one<1>(o[1], vb, pa0, pa1, pa2, pa3); pv_one<2>(o[2], vb, pa0, pa1, pa2, pa3); pv_one<3>(o[3], vb, pa0, pa1, pa2, pa3);
}
template <bool SHIFT> DI void qkt(f32x16& p0, f32x16& p1, const char* Ks, const bf16x8* qr, int r32, int hi, int c, float negmb) {
  if constexpr (SHIFT) {
#pragma unroll
    for (int r = 0; r < 16; ++r) { p0[r] = negmb; p1[r] = negmb; }
  } else { p0 = f32x16{}; p1 = f32x16{}; }
#pragma unroll
  for (int d0 = 0; d0 < 4; ++d0) { const int cb = (c * 64 + d0 * 16 + hi * 8) * 2;
    const bf16x8 b0 = *reinterpret_cast<const bf16x8*>(Ks + KSWZ(r32, cb));
    const bf16x8 b1 = *reinterpret_cast<const bf16x8*>(Ks + KSWZ(32 + r32, cb));
    p0 = __builtin_amdgcn_mfma_f32_32x32x16_bf16(b0, qr[d0], p0, 0, 0, 0);
    p1 = __builtin_amdgcn_mfma_f32_32x32x16_bf16(b1, qr[d0], p1, 0, 0, 0); }
}
DI void expA(f32x16& p0) {
#pragma unroll
  for (int r = 0; r < 16; ++r) p0[r] = __builtin_amdgcn_exp2f(p0[r]);
}
DI void finishSM(f32x16& p0, f32x16& p1, float& l_reg, bf16x8& pa0, bf16x8& pa1, bf16x8& pa2, bf16x8& pa3) {
#pragma unroll
  for (int r = 0; r < 16; ++r) p1[r] = __builtin_amdgcn_exp2f(p1[r]);
  float ps = 0.f;
#pragma unroll
  for (int r = 0; r < 16; ++r) ps += p0[r];
#pragma unroll
  for (int r = 0; r < 16; ++r) ps += p1[r];
  l_reg += ps;
#define PK4(P, BASE, OUT) do { unsigned a0 = cvtpk(P[BASE + 0], P[BASE + 1]), a1 = cvtpk(P[BASE + 2], P[BASE + 3]);   \
    unsigned b0 = cvtpk(P[BASE + 4], P[BASE + 5]), b1 = cvtpk(P[BASE + 6], P[BASE + 7]);                              \
    auto r0 = __builtin_amdgcn_permlane32_swap(a0, b0, false, false); auto r1 = __builtin_amdgcn_permlane32_swap(a1, b1, false, false); \
    u32x4 w = {r0[0], r1[0], r0[1], r1[1]}; OUT = *reinterpret_cast<bf16x8*>(&w); } while (0)
  PK4(p0, 0, pa0); PK4(p0, 8, pa1); PK4(p1, 0, pa2); PK4(p1, 8, pa3);
#undef PK4
}
DI unsigned cvtpk2(float lo, float hi) { typedef float f2_t __attribute__((ext_vector_type(2))); typedef __bf16 b2_t __attribute__((ext_vector_type(2))); f2_t v = {lo, hi}; b2_t b = __builtin_convertvector(v, b2_t); return __builtin_bit_cast(unsigned, b); }
template <int I> DI void vrd(s16x4& l, s16x4& h, int vb) { constexpr int ks = I >> 2, d0 = I & 3; l = tr_read<v_rd_off(d0, ks, 0)>(vb); h = tr_read<v_rd_off(d0, ks, 1)>(vb); }
#define TIEWAIT(N, L, H) asm volatile("s_waitcnt lgkmcnt(" #N ")" : "+v"(L), "+v"(H))
#define PK4B(P, BASE, OUT) do { u32x4 w = {cvtpk2(P[BASE + 0], P[BASE + 1]), cvtpk2(P[BASE + 2], P[BASE + 3]), cvtpk2(P[BASE + 4], P[BASE + 5]), cvtpk2(P[BASE + 6], P[BASE + 7])}; \
    OUT = *reinterpret_cast<bf16x8*>(&w); } while (0)
#define PKV(L, H) (bf16x8){L[0], L[1], L[2], L[3], H[0], H[1], H[2], H[3]}
#define PVSTEP(i, N, PA, SL, SH, NL, NH) do { TIEWAIT(N, SL, SH); o[(i) & 3] = __builtin_amdgcn_mfma_f32_32x32x16_bf16(PA, PKV(SL, SH), o[(i) & 3], 0, 0, 0); \
    if constexpr ((i) + 3 < 16) vrd<((i) + 3 < 16 ? (i) + 3 : 15)>(NL, NH, vb); } while (0)
DI void finish_pv(f32x16& p0, f32x16& p1, float& l_reg, f32x16* o, int vb) {
  s16x4 l0, h0, l1, h1, l2, h2, l3, h3;
  vrd<0>(l0, h0, vb); vrd<1>(l1, h1, vb); vrd<2>(l2, h2, vb);
  bf16x8 pa0, pa1, pa2, pa3;
  PK4B(p0, 0, pa0); PK4B(p0, 8, pa1);
  PVSTEP(0, 4, pa0, l0, h0, l3, h3); PVSTEP(1, 4, pa0, l1, h1, l0, h0); PVSTEP(2, 4, pa0, l2, h2, l1, h1); PVSTEP(3, 4, pa0, l3, h3, l2, h2);
  PVSTEP(4, 4, pa1, l0, h0, l3, h3); PVSTEP(5, 4, pa1, l1, h1, l0, h0); PVSTEP(6, 4, pa1, l2, h2, l1, h1); PVSTEP(7, 4, pa1, l3, h3, l2, h2);
  PK4B(p1, 0, pa2); PK4B(p1, 8, pa3);
  PVSTEP(8, 4, pa2, l0, h0, l3, h3); PVSTEP(9, 4, pa2, l1, h1, l0, h0); PVSTEP(10, 4, pa2, l2, h2, l1, h1); PVSTEP(11, 4, pa2, l3, h3, l2, h2);
  PVSTEP(12, 4, pa3, l0, h0, l3, h3); PVSTEP(13, 4, pa3, l1, h1, l0, h0); PVSTEP(14, 2, pa3, l2, h2, l1, h1); PVSTEP(15, 0, pa3, l3, h3, l2, h2);
  float ps = 0.f;
#pragma unroll
  for (int r = 0; r < 16; ++r) ps += p0[r];
#pragma unroll
  for (int r = 0; r < 16; ++r) ps += p1[r];
  l_reg += ps;
}
DI void glds16(const void* gsrc, unsigned lds_dst) { unsigned keep;
  asm volatile("s_mov_b32 %0, m0\n\ts_mov_b32 m0, %2\n\ts_nop 0\n\tglobal_load_lds_dwordx4 %1, off\n\ts_mov_b32 m0, %0" : "=&s"(keep) : "v"(gsrc), "s"(lds_dst) : "memory"); }
DI void glds_pair(unsigned voff0, unsigned voff1, const void* base, unsigned lds_dst) { unsigned keep;
  asm volatile("s_mov_b32 %0, m0\n\ts_mov_b32 m0, %4\n\ts_nop 0\n\tglobal_load_lds_dwordx4 %1, %3\n\ts_add_u32 m0, m0, 0x400\n\ts_nop 0\n\tglobal_load_lds_dwordx4 %2, %3\n\ts_mov_b32 m0, %0"
               : "=&s"(keep) : "v"(voff0), "v"(voff1), "s"(base), "s"(lds_dst) : "memory", "scc"); }
#define WAIT_BAR(N) asm volatile("s_waitcnt vmcnt(" #N ") lgkmcnt(0)\n\ts_barrier" ::: "memory")
template <bool SHIFT> DI void attn_unit(const bf16* __restrict__ Qb, const bf16* __restrict__ Kh, const bf16* __restrict__ Vh, bf16* __restrict__ Ob, int seq, char* lds,
                  float negmb, float lam, const float* __restrict__ gsub, float post, const float* __restrict__ qg, int qpos0) {
  int tid = threadIdx.x; asm volatile("" : "+v"(tid));
  const int lane = tid & 63, r32 = lane & 31, hi = lane >> 5; const int wid = __builtin_amdgcn_readfirstlane(tid >> 6), c = wid >> 2, wq = wid & 3;
  char* K_ring = lds; char* V_ring = lds + 3 * SHM_K;
  float* wsf = (float*)(lds + SCR_OFF) + wid * 64;
  const unsigned lds0 = (unsigned)(uintptr_t)lds;
  float l_reg = 0.f; f32x16 o[4] = {}; bf16x8 qr[4];
  const bf16* Qw = Qb + (size_t)(wq * 32 + r32) * INW + c * 64 + hi * 8;
#pragma unroll
  for (int d0 = 0; d0 < 4; ++d0) qr[d0] = *reinterpret_cast<const bf16x8*>(Qw + d0 * 16);
  unsigned kof0, kof1, vof0, vof1;
  { const int row0 = 8 * wid + (lane >> 4), row1 = row0 + 4, cp = lane & 15;
    kof0 = (unsigned)(row0 * INW + ((cp ^ (row0 & 15)) << 3)) * 2u; kof1 = (unsigned)(row1 * INW + ((cp ^ (row1 & 15)) << 3)) * 2u;
    const int kk = 8 * wid + ((lane & 31) >> 2), cc = (lane >> 5) * 32 + (lane & 3) * 8;
    vof0 = (unsigned)(kk * INW + cc) * 2u; vof1 = vof0 + 128u; }
  const unsigned kdst = lds0 + (unsigned)wid * 2048u, vdst = lds0 + 3u * SHM_K + (unsigned)wid * 2048u;
#define DMA_K(t, slot) glds_pair(kof0, kof1, (const char*)Kh + (size_t)(t) * (KVBLK * INW * 2), (unsigned)__builtin_amdgcn_readfirstlane(kdst + (unsigned)(slot)))
#define DMA_V(t, slot) glds_pair(vof0, vof1, (const char*)Vh + (size_t)(t) * (KVBLK * INW * 2), (unsigned)__builtin_amdgcn_readfirstlane(vdst + (unsigned)(slot)))
  const int vb0 = (int)(lds0 + 3u * SHM_K) + v_rd_base(lane);
  f32x16 pA0, pA1, pB0, pB1; const int NT = seq / KVBLK;
  int s0 = 0, s1 = SHM_K, s2 = 2 * SHM_K;
#define ROT() do { const int t_ = s0; s0 = s1; s1 = s2; s2 = t_; } while (0)
  DMA_K(0, 0); DMA_K(1, SHM_K); DMA_V(0, 0);
  { float x[4][8]; float ss = 0.f;
#pragma unroll
    for (int d0 = 0; d0 < 4; ++d0) { const u32x4 u = __builtin_bit_cast(u32x4, qr[d0]);
      x[d0][0] = __uint_as_float(u.x << 16); x[d0][1] = __uint_as_float(u.x & 0xffff0000u); x[d0][2] = __uint_as_float(u.y << 16); x[d0][3] = __uint_as_float(u.y & 0xffff0000u);
      x[d0][4] = __uint_as_float(u.z << 16); x[d0][5] = __uint_as_float(u.z & 0xffff0000u); x[d0][6] = __uint_as_float(u.w << 16); x[d0][7] = __uint_as_float(u.w & 0xffff0000u);
#pragma unroll
      for (int e = 0; e < 8; ++e) ss += x[d0][e] * x[d0][e]; }
    ss += __shfl_xor(ss, 32);
    const float rstd = 1.0f / sqrtf(ss * (1.f / 64.f) + EPS);
#pragma unroll
    for (int d0 = 0; d0 < 4; ++d0) { const f32x4 g0 = *(const f32x4*)(qg + 16 * d0 + 8 * hi), g1 = *(const f32x4*)(qg + 16 * d0 + 8 * hi + 4);
#pragma unroll
      for (int e = 0; e < 4; ++e) { x[d0][e] *= rstd * g0[e]; x[d0][4 + e] *= rstd * g1[e]; } }
    const double pos_d = (double)(qpos0 + wq * 32 + r32);
#pragma unroll
    for (int i = 0; i < 8; ++i) { const double t = pos_d * ROPE_INV[i] * 0.15915494309189535; const float fr = (float)(t - rint(t));
      const float cs = __builtin_amdgcn_cosf(fr), sn = __builtin_amdgcn_sinf(fr);
      const float y = __shfl_xor(x[0][i], 32);
      x[0][i] = x[0][i] * cs + (hi ? y : -y) * sn; }
#pragma unroll
    for (int d0 = 0; d0 < 4; ++d0) { u32x4 w = {pk2(x[d0][0] * C2, x[d0][1] * C2), pk2(x[d0][2] * C2, x[d0][3] * C2), pk2(x[d0][4] * C2, x[d0][5] * C2), pk2(x[d0][6] * C2, x[d0][7] * C2)};
      qr[d0] = __builtin_bit_cast(bf16x8, w); } }
  WAIT_BAR(4);
  DMA_K(2, 2 * SHM_K); DMA_V(1, SHM_K);
  qkt<SHIFT>(pA0, pA1, K_ring, qr, r32, hi, c, negmb); expA(pA0); expA(pA1);
#define ITER(CUR0, CUR1, PRV0, PRV1, j) do { \
    WAIT_BAR(4); \
    { const int tk_ = ((j) + 2 < NT) ? (j) + 2 : NT - 1, tv_ = ((j) + 1 < NT) ? (j) + 1 : NT - 1; DMA_K(tk_, s0); DMA_V(tv_, s2); } \
    SBAR(); qkt<SHIFT>(CUR0, CUR1, K_ring + s1, qr, r32, hi, c, negmb); \
    finish_pv(PRV0, PRV1, l_reg, o, vb0 + s0); expA(CUR0); expA(CUR1); \
    ROT(); } while (0)
  for (int j = 1; j + 1 < NT; j += 2) {
    ITER(pB0, pB1, pA0, pA1, j);
    ITER(pA0, pA1, pB0, pB1, j + 1);
  }
  ITER(pB0, pB1, pA0, pA1, NT - 1);
  WAIT_BAR(0);
  finish_pv(pB0, pB1, l_reg, o, vb0 + s0);
#undef ITER
#undef ROT
#undef DMA_K
#undef DMA_V
  int lane_e = lane; asm volatile("" : "+v"(lane_e));
  {
  const int lane = lane_e, r32 = lane & 31, hi = lane >> 5;
  { auto rr = __builtin_amdgcn_permlane32_swap(__float_as_uint(l_reg), __float_as_uint(l_reg), false, false); l_reg = __uint_as_float(rr[0]) + __uint_as_float(rr[1]); }
  if (hi == 0) wsf[r32] = l_reg;
  asm volatile("s_waitcnt lgkmcnt(0)" ::: "memory");
  __syncthreads();
  float* XY = (float*)lds + (c == 0 ? 16384 : 0) + wq * 4096;
#pragma unroll
  for (int r = 0; r < 16; ++r) { const float rl = __builtin_amdgcn_rcpf(wsf[crow(r, hi)]);
#pragma unroll
    for (int d0 = 0; d0 < 4; ++d0) XY[(d0 * 16 + r) * 64 + lane] = o[d0][r] * rl; }
  }
  __syncthreads();
  { int tid2 = threadIdx.x; asm volatile("" : "+v"(tid2));
    const int ch = tid2 & 15; const f32x4 g0 = *(const f32x4*)(gsub + ch * 8), g1 = *(const f32x4*)(gsub + ch * 8 + 4);
#pragma unroll
    for (int j = 0; j < 4; ++j) {
      const int row = (tid2 >> 4) + 32 * j, rr = row & 31;
      const int fi = (row >> 5) * 4096 + ((ch >> 2) * 16 + (rr & 3) + 4 * (rr >> 3)) * 64 + ((rr >> 2) & 1) * 32 + (ch & 3) * 8;
      const float* xp_ = (const float*)lds + fi;
      const f32x4 x0 = *(const f32x4*)(xp_), x1 = *(const f32x4*)(xp_ + 4), y0 = *(const f32x4*)(xp_ + 16384), y1 = *(const f32x4*)(xp_ + 16384 + 4);
      const f32x4 d0v = y0 - x0 * lam, d1v = y1 - x1 * lam;
      float ss = (d0v[0] * d0v[0] + d0v[1] * d0v[1]) + (d0v[2] * d0v[2] + d0v[3] * d0v[3]) + (d1v[0] * d1v[0] + d1v[1] * d1v[1]) + (d1v[2] * d1v[2] + d1v[3] * d1v[3]);
      ss += __shfl_xor(ss, 1); ss += __shfl_xor(ss, 2); ss += __shfl_xor(ss, 4); ss += __shfl_xor(ss, 8);
      const float rs = post / sqrtf(ss * (1.f / 128.f) + EPS);
      const f32x4 e0 = d0v * g0 * rs, e1 = d1v * g1 * rs;
      v4u w; w.x = pk2(e0[0], e0[1]); w.y = pk2(e0[2], e0[3]); w.z = pk2(e1[0], e1[1]); w.w = pk2(e1[2], e1[3]);
      *(v4u*)(Ob + (size_t)row * DM + ch * 8) = w; }
  }
  __syncthreads();
}
#undef SBAR
}

DI void sgu_unit(const bf16* P, bf16* MIX, int chunk, int hd, const float* Ws, const float* bs, const float* gv, char* lds) {
    using att::bf16x8; using att::f32x16;
    int tid = threadIdx.x; asm volatile("" : "+v"(tid));
    const int wid = tid >> 6, lane = tid & 63, r32 = lane & 31, hi = lane >> 5;
    bf16* vnT = (bf16*)lds;
    { const int p = tid >> 2, qtr = tid & 3; const bf16* src = P + (size_t)(chunk * 128 + p) * INW + OFF_CV + hd * 128 + qtr * 32;
      v4u raw[4];
#pragma unroll
      for (int i = 0; i < 4; ++i) raw[i] = *(const v4u*)(src + 8 * i);
      float x[32];
#pragma unroll
      for (int i = 0; i < 4; ++i) unpack8(raw[i], x + 8 * i);
      float ss = 0.f;
#pragma unroll
      for (int i = 0; i < 32; ++i) { x[i] = gelu_tanh(x[i]); ss += x[i] * x[i]; }
      ss += __shfl_xor(ss, 1); ss += __shfl_xor(ss, 2);
      const float rstd = 1.0f / sqrtf(ss * (1.f / 128.f) + EPS);
#pragma unroll
      for (int i = 0; i < 32; ++i) { const float v = x[i] * rstd * gv[qtr * 32 + i]; vnT[(qtr * 32 + i) * 136 + p] = (bf16)(pk2(v, 0.f) & 0xffffu); }
    }
    __syncthreads();
    const int qb = wid >> 1;
    bf16x8 a[8];
#pragma unroll
    for (int ks = 0; ks < 8; ++ks) { const float* w = Ws + (size_t)(32 * qb + r32) * 128 + 16 * ks + 8 * hi; const f32x4 w0 = *(const f32x4*)w, w1 = *(const f32x4*)(w + 4);
        att::u32x4 u = {pk2(w0.x, w0.y), pk2(w0.z, w0.w), pk2(w1.x, w1.y), pk2(w1.z, w1.w)}; a[ks] = *reinterpret_cast<bf16x8*>(&u); }
#pragma unroll
    for (int dd = 0; dd < 2; ++dd) { const int db = 2 * (wid & 1) + dd;
        f32x16 acc = {};
#pragma unroll
        for (int ks = 0; ks < 8; ++ks) { const bf16x8 b = *reinterpret_cast<const bf16x8*>(vnT + (32 * db + r32) * 136 + 16 * ks + 8 * hi);
            acc = __builtin_amdgcn_mfma_f32_32x32x16_bf16(a[ks], b, acc, 0, 0, 0); }
        const int d = 32 * db + r32;
#pragma unroll
        for (int i = 0; i < 16; ++i) { const int q = 32 * qb + att::crow(i, hi); const size_t tok = (size_t)chunk * 128 + q;
            const float uval = gelu_tanh(__uint_as_float((unsigned)P[tok * INW + OFF_CU + hd * 128 + d] << 16));
            MIX[tok * DM + MIX_C + hd * 128 + d] = (bf16)(pk2(uval * (acc[i] + bs[q]), 0.f) & 0xffffu); }
    }
    __syncthreads();
}

#define LAS __attribute__((address_space(3)))
#define XB_TMO      128
#define XB_XCNT(j)  (256  + 64 * (j))
#define XB_XSUB(j)  (1280 + 64 * (j))
#define XB_XGEN(j)  (2304 + 64 * (j))
#define XB_TOP      3328
#define XB_TOPGEN   3392
#define XCD_BAR_WORDS 3456
#define XB_SPIN_CAP (1u << 18)

__device__ __forceinline__ unsigned xb_ld(unsigned* p)              { return __hip_atomic_load(p, __ATOMIC_RELAXED, __HIP_MEMORY_SCOPE_AGENT); }
__device__ __forceinline__ unsigned xb_add(unsigned* p, unsigned v) { return __hip_atomic_fetch_add(p, v, __ATOMIC_RELAXED, __HIP_MEMORY_SCOPE_AGENT); }
__device__ __forceinline__ unsigned xb_xcc_id() { return (unsigned)__builtin_amdgcn_s_getreg((3 << 11) | 20) & 0xFu; }
#define XB_SPIN(cond, bar) do { unsigned _sp = 0; while (cond) { __builtin_amdgcn_s_sleep(1); \
    if ((++_sp & 255u) == 0u) { if (xb_ld(&(bar)[XB_TMO])) break; if (_sp > XB_SPIN_CAP) { atomicAdd(&(bar)[XB_TMO], 1u); break; } } } } while (0)

struct XcdBarrier {
    unsigned* bar; unsigned x;
    volatile LAS unsigned* st;
};

__device__ __forceinline__ XcdBarrier xcd_barrier_post(unsigned* bar, volatile LAS unsigned* st) {
    XcdBarrier b; b.bar = bar; b.x = xb_xcc_id(); b.st = st;
    if (threadIdx.x == 0) (void)xb_add(&bar[XB_XCNT(b.x)], 1u);
    return b;
}
__device__ __forceinline__ void xcd_barrier_complete(unsigned* bar, unsigned x, unsigned& nloc, unsigned& nx) {
    const unsigned G = gridDim.x * gridDim.y * gridDim.z;
    unsigned sum, cnt, mine, sp = 0u;
    for (;;) {
        sum = 0u; cnt = 0u; mine = 0u;
#pragma unroll
        for (unsigned j = 0; j < 16; ++j) { const unsigned c = xb_ld(&bar[XB_XCNT(j)]); sum += c; cnt += (c > 0u) ? 1u : 0u; mine = (j == x) ? c : mine; }
        if (sum == G) break;
        __builtin_amdgcn_s_sleep(1);
        if ((++sp & 255u) == 0u) { if (xb_ld(&bar[XB_TMO])) break; if (sp > XB_SPIN_CAP) { atomicAdd(&bar[XB_TMO], 1u); break; } }
    }
    nloc = mine > 0u ? mine : 1u; nx = cnt > 0u ? cnt : 1u;
}

__device__ __forceinline__ void xcd_barrier(const XcdBarrier& b) {
    asm volatile("s_waitcnt vmcnt(0)" ::: "memory");
    __syncthreads();
    if (threadIdx.x == 0) {
        unsigned* bar = b.bar;
        __builtin_amdgcn_s_waitcnt(0);
        unsigned nloc = b.st[0], nx = b.st[1];
        if (nloc == 0u) { xcd_barrier_complete(bar, b.x, nloc, nx); b.st[0] = nloc; b.st[1] = nx; }
        const unsigned old = xb_add(&bar[XB_XSUB(b.x)], 1u);
        const unsigned gen = old / nloc;
        if (old + 1u == (gen + 1u) * nloc) {
            __builtin_amdgcn_fence(__ATOMIC_RELEASE, "agent");
            asm volatile("s_waitcnt vmcnt(0)" ::: "memory");
            const unsigned og = xb_add(&bar[XB_TOP], 1u);
            const unsigned tg = og / nx;
            if (og + 1u == (tg + 1u) * nx) xb_add(&bar[XB_TOPGEN], 1u);
            else XB_SPIN(xb_ld(&bar[XB_TOPGEN]) == tg, bar);
            __builtin_amdgcn_fence(__ATOMIC_ACQUIRE, "agent");
            xb_add(&bar[XB_XGEN(b.x)], 1u);
            asm volatile("s_waitcnt vmcnt(0)" ::: "memory");
        } else {
            XB_SPIN(xb_ld(&bar[XB_XGEN(b.x)]) == gen, bar);
            __builtin_amdgcn_fence(__ATOMIC_ACQUIRE, "agent");
            asm volatile("s_waitcnt vmcnt(0)" ::: "memory");
        }
    }
    __syncthreads();
}

struct Args { const float* in[19]; float* out; unsigned char* ws; int ph_lo, ph_hi; };
constexpr int N_PHASES = 1 + 6 * NLAYER;

__global__ void __launch_bounds__(NWAVES * 64, 2) mk_fwd(Args args) {
    extern __shared__ __attribute__((aligned(16))) unsigned char lds[];
    cg::grid_group grid = cg::this_grid();
    const int G = gridDim.x; const int bx = blockIdx.x; const int vcu = (G % 8 == 0) ? (bx % 8) * (G / 8) + bx / 8 : bx;
    const int NGW = G * NWAVES;
    unsigned char* ws = args.ws;
    const float* xp = args.in[0]; const float* xs = args.in[1];
    float* out = args.out;
    bf16* XN = (bf16*)(ws + WS_XN); bf16* PROJ = (bf16*)(ws + WS_PROJ); bf16* MIX = (bf16*)(ws + WS_MIX); bf16* HB = (bf16*)(ws + WS_H);

    volatile LAS unsigned* MISC = (volatile LAS unsigned*)((LAS unsigned char*)lds + 131072 + 320);
    if (threadIdx.x < 32) MISC[threadIdx.x] = 0u;
    __syncthreads();
    const XcdBarrier bar = xcd_barrier_post((unsigned*)ws, MISC + 8);
    for (int ph = args.ph_lo; ph < args.ph_hi; ++ph) {
        int tid = threadIdx.x; asm volatile("" : "+v"(tid));
        const int lane = tid & 63, wave = __builtin_amdgcn_readfirstlane(tid >> 6), gw = vcu * NWAVES + wave;
        const int l = (ph - 1) / 6, k = (ph == 0) ? -1 : ((ph - 1) % 6);
        float* const RS = (float*)(ws + 65536);
        const unsigned char* wl = ws + WS_WT + (size_t)(l < 0 ? 0 : l) * WT_LAYER;
        if (ph == 0) {
#if PHM & 1
            for (int rep = 0; rep < PROBE_REP_MISC; ++rep) {
            float* scr = (float*)(lds + wave * 16384);
            constexpr int I_IN = 32 * 176, I_OUT = 32 * 64, I_UP = 32 * 256, I_DN = 128 * 64, I_L = I_IN + I_OUT + I_UP + I_DN;
            for (int it = gw; it < NLAYER * I_L; it += NGW) {
                const int ll = it / I_L; int r = it % I_L; unsigned char* wb = ws + WS_WT + (size_t)ll * WT_LAYER;
                if (r < I_IN) { transpose_item(args.in[3] + (size_t)ll * DM * INW, DM, INW, (bf16*)(wb + WT_IN), DM, args.in[2] + ll * DM, scr, r, lane); continue; } r -= I_IN;
                if (r < I_OUT) { transpose_item(args.in[15] + (size_t)ll * DM * DM, DM, DM, (bf16*)(wb + WT_OUT), DM, nullptr, scr, r, lane); continue; } r -= I_OUT;
                if (r < I_UP) { transpose_item(args.in[17] + (size_t)ll * DM * DFF, DM, DFF, (bf16*)(wb + WT_UP), DM, args.in[16] + ll * DM, scr, r, lane); continue; } r -= I_UP;
                transpose_item(args.in[18] + (size_t)ll * DFF * DM, DFF, DM, (bf16*)(wb + WT_DN), LDH, nullptr, scr, r, lane);
            }
            for (int m = gw; m < M_ALL; m += NGW) xb_row(m < MP ? xp + (size_t)m * DM : xs + (size_t)(m - MP) * DM, XN + (size_t)m * DM, RS + m, lane);
            for (int i = gw * 64 + lane; i < 3 * M_ALL; i += NGW * 64) RS[M_ALL + i] = 0.f;
            }
#endif
        } else if (k == 0) {
#if PHM & 2
            pg8::Gemm g{XN, (const bf16*)(wl + WT_IN), M_ALL, INW, DM, DM, DM}; pg8::StaticOrder S; S.init(M_ALL, INW, G, bx);
            pg8::EpiBf16<0> E{PROJ, INW, RS + (size_t)(2 * l) * M_ALL};
            for (int rep = 0; rep < PROBE_REP_WIN; ++rep)
            pg8::gemm_phase<pg8::EpiBf16<0>, pg8::StaticOrder, true, true>((PG8_LAS unsigned char*)lds, g, S, E);
#endif
        } else if (k == 1) {
#if PHM & 4
            const float* kg = args.in[6] + l * 64; const float* cw = args.in[4] + l * 1536;
            for (int m = 2 * gw; m < M_ALL; m += 2 * NGW) k_rows(PROJ, m, kg, lane);
            for (int m = gw; m < M_ALL; m += NGW) {
                const int pos = m < MP ? (m & (SEQ_P - 1)) : ((m - MP) & (SEQ_S - 1)); const int S = m < MP ? SEQ_P : SEQ_S;
                conv_row(PROJ, MIX, m, pos, S, cw, lane);
            }
            for (int u = vcu; u < (M_ALL / 128) * 4; u += G) { const int chunk = u >> 2, hd = u & 3;
                sgu_unit(PROJ, MIX, chunk, hd, args.in[13] + ((size_t)l * 4 + hd) * 128 * 128, args.in[14] + (l * 4 + hd) * 128, args.in[12] + l * 128, (char*)lds); }
#endif
        } else if (k == 2) {
#if PHM & 8
            const float linit = (l == 0) ? 0.2f : 0.35550906759096934f;
            const float s1 = wave_sum(args.in[7][l * 64 + lane] * args.in[8][l * 64 + lane]), s2 = wave_sum(args.in[9][l * 64 + lane] * args.in[10][l * 64 + lane]);
            const float lam = __uint_as_float(__builtin_amdgcn_readfirstlane(__float_as_uint(expf(s1) - expf(s2) + linit)));
            const float gq = wave_max(fabsf(args.in[5][l * 64 + lane])), gk = wave_max(fabsf(args.in[6][l * 64 + lane]));
            const float negmb = __uint_as_float(__builtin_amdgcn_readfirstlane(__float_as_uint(-(C2 * 64.0f * gq * gk))));
            for (int rep = 0; rep < PROBE_REP_ATT; ++rep)
            for (int t = vcu; t < 2560; t += G) {
                int pair, qb, seq, seqrow0;
                if (t < 2048) { const int i = t >> 8, v = t & 255; const int idx = (v >> 5) * 256 + i * 32 + (v & 31); pair = idx >> 7; qb = idx & 127; seq = SEQ_S; seqrow0 = MP + (pair >> 3) * SEQ_S; }
                else { const int t2 = t - 2048, i = t2 >> 8, v = t2 & 255; pair = 2 * (v >> 5) + i; qb = v & 31; seq = SEQ_P; seqrow0 = (pair >> 3) * SEQ_P; }
                const int h = pair & 7; const size_t row0 = (size_t)seqrow0 + (size_t)qb * 128;
                if (negmb >= -64.0f)
                att::attn_unit<false>(PROJ + row0 * INW + OFF_Q + h * 128, PROJ + (size_t)seqrow0 * INW + OFF_K + h * 128, PROJ + (size_t)seqrow0 * INW + OFF_V + h * 128,
                               MIX + row0 * DM + MIX_B + h * 128, seq, (char*)lds, 0.f, lam, args.in[11] + l * 128, 1.0f - linit, args.in[5] + l * 64, qb * 128);
                else
                att::attn_unit<true>(PROJ + row0 * INW + OFF_Q + h * 128, PROJ + (size_t)seqrow0 * INW + OFF_K + h * 128, PROJ + (size_t)seqrow0 * INW + OFF_V + h * 128,
                               MIX + row0 * DM + MIX_B + h * 128, seq, (char*)lds, negmb, lam, args.in[11] + l * 128, 1.0f - linit, args.in[5] + l * 64, qb * 128);
            }
#endif
        } else if (k == 3 || k == 5) {
#if PHM & 16
            pg8::Gemm g; if (k == 3) g = pg8::Gemm{MIX, (const bf16*)(wl + WT_OUT), M_ALL, DM, DM, DM, DM}; else g = pg8::Gemm{HB, (const bf16*)(wl + WT_DN), M_ALL, DM, DFF, LDH, LDH};
            pg8::StaticOrder S; S.init(M_ALL, DM, G, bx);
            pg8::EpiResF32 E;
            if (k == 3 && l == 0) E = pg8::EpiResF32{xp, xs, MP / 256, nullptr, nullptr, DM, XN, DM, RS + (size_t)1 * M_ALL};
            else if (k == 3) E = pg8::EpiResF32{nullptr, nullptr, 0, XN, nullptr, DM, XN, DM, RS + (size_t)3 * M_ALL};
            else if (l == 0) E = pg8::EpiResF32{nullptr, nullptr, 0, XN, nullptr, DM, XN, DM, RS + (size_t)2 * M_ALL};
            else E = pg8::EpiResF32{nullptr, nullptr, 0, XN, out, DM, nullptr, DM, nullptr};
            pg8::gemm_phase<pg8::EpiResF32, pg8::StaticOrder, true, true>((PG8_LAS unsigned char*)lds, g, S, E);
#endif
        } else {
#if PHM & 64
            pg8::Gemm g{XN, (const bf16*)(wl + WT_UP), M_ALL, DFF, DM, DM, DM}; pg8::StaticOrder S; S.init(M_ALL, DFF, G, bx);
            pg8::EpiBf16<2> E{HB, LDH, RS + (size_t)(2 * l + 1) * M_ALL};
            for (int rep = 0; rep < PROBE_REP_UP; ++rep)
            pg8::gemm_phase<pg8::EpiBf16<2>, pg8::StaticOrder, true, true>((PG8_LAS unsigned char*)lds, g, S, E);
#endif
        }
        if (ph + 1 < args.ph_hi) { if (ph == args.ph_lo) grid.sync(); else xcd_barrier(bar); }
    }
}

extern "C" void kernel_launch(void* const* d_in, const int* in_sizes, int n_in, void* d_out, int out_size, void* d_ws, size_t ws_size, hipStream_t stream) {
    static int grid = 0;
    if (grid == 0) {
        if (n_in != 19 || out_size != M_ALL * DM || ws_size < WS_END) { fprintf(stderr, "kernel_launch: unexpected shapes: n_in %d out %d ws %zu (need %zu)\n", n_in, out_size, ws_size, (size_t)WS_END); grid = -1; return; }
        int dev = 0, cus = 0, per_cu = 0;
        if (hipGetDevice(&dev) != hipSuccess || hipDeviceGetAttribute(&cus, hipDeviceAttributeMultiprocessorCount, dev) != hipSuccess) { fprintf(stderr, "kernel_launch: device query failed\n"); grid = -1; return; }
        if (hipFuncSetAttribute((const void*)mk_fwd, hipFuncAttributeMaxDynamicSharedMemorySize, LDS_BYTES) != hipSuccess) { fprintf(stderr, "kernel_launch: hipFuncSetAttribute failed\n"); grid = -1; return; }
        if (hipOccupancyMaxActiveBlocksPerMultiprocessor(&per_cu, (const void*)mk_fwd, NWAVES * 64, LDS_BYTES) != hipSuccess || per_cu < 1) { fprintf(stderr, "kernel_launch: occupancy query gave %d\n", per_cu); per_cu = 1; }
        (void)hipGetLastError();
        grid = cus * 1;
        fprintf(stderr, "kernel_launch: grid %d (cus %d, per_cu %d)\n", grid, cus, per_cu);
    }
    if (grid < 0) return;
    if (hipMemsetAsync(d_ws, 0, 65536, stream) != hipSuccess) { fprintf(stderr, "kernel_launch: memset failed\n"); return; }
    Args a{};
    for (int i = 0; i < 19; ++i) a.in[i] = (const float*)d_in[i];
    a.out = (float*)d_out; a.ws = (unsigned char*)d_ws;
#if MK_SINGLE
    a.ph_lo = 0; a.ph_hi = N_PHASES;
    { void* kargs[] = {&a}; hipError_t e = hipLaunchCooperativeKernel((const void*)mk_fwd, dim3(grid), dim3(NWAVES * 64), kargs, LDS_BYTES, stream);
      if (e != hipSuccess) fprintf(stderr, "kernel_launch: cooperative launch failed: %s\n", hipGetErrorString(e)); }
#else
    for (int ph = 0; ph < N_PHASES; ++ph) { a.ph_lo = ph; a.ph_hi = ph + 1; void* kargs[] = {&a};
        hipError_t e = hipLaunchCooperativeKernel((const void*)mk_fwd, dim3(grid), dim3(NWAVES * 64), kargs, LDS_BYTES, stream);
        if (e != hipSuccess) { fprintf(stderr, "kernel_launch: cooperative launch %d failed: %s\n", ph, hipGetErrorString(e)); break; } }
#endif
}
```

```cpp
#include <hip/hip_runtime.h>
#include <hip/hip_cooperative_groups.h>
#include <hip/hip_bf16.h>
#include <cstdio>
#include <cstdint>
namespace cg = cooperative_groups;
namespace pg8 {
#define PG8_LAS __attribute__((address_space(3)))
typedef unsigned short bf16_t;
typedef short bf16x8 __attribute__((ext_vector_type(8)));
typedef float f32x4 __attribute__((ext_vector_type(4)));
typedef unsigned u32x4 __attribute__((ext_vector_type(4)));
constexpr int BM = 256, BK = 64, HALF = 128, HTB = HALF * BK * 2  , STAGE_BYTES = 8 * HTB, NXCD = 8, WGM = 8;

__host__ __device__ __forceinline__ int lds_byte(int r, int c) { const int st = (r >> 4) * 2 + (c >> 5), rr = r & 15, cc = c & 31, ob = rr * 64 + cc * 2; return st * 1024 + (ob ^ (((ob >> 9) & 1) << 5)); }
__host__ __device__ __forceinline__ void stage_rc(int b, int& R, int& C) { const int st = b / 1024, sb = b % 1024, swz = sb ^ (((sb >> 9) & 1) << 5); R = (st >> 1) * 16 + swz / 64; C = (st & 1) * 32 + (swz % 64) / 2; }
__host__ __device__ __forceinline__ int perm32(int rho) { const int n = rho >> 4, i = rho & 15; return 8 * (i >> 2) + 4 * n + (i & 3); }

struct Unit { int pm, pn; };
struct Gemm { const bf16_t* A; const bf16_t* Bt; int M, N, K, lda, ldb; };

struct StaticOrder {
    int nM, nN, nwg, G, c;
    __host__ __device__ void init(int M, int N, int G_, int c_) { nM = M / BM; nN = N / BM; nwg = nM * nN; G = G_; c = c_; }
    __host__ __device__ bool next(int i, Unit& u) const {
        const long L = (long)i * G + c; if (L >= nwg) return false;
        int wgid = (int)L; { const int q = nwg / NXCD, r = nwg % NXCD, xcd = wgid % NXCD, off = wgid / NXCD; wgid = (xcd < r ? xcd * (q + 1) : r * (q + 1) + (xcd - r) * q) + off; }
        const int nig = WGM * nN, gid = wgid / nig, fm = gid * WGM, gsz = (nM - fm) < WGM ? (nM - fm) : WGM;
        u.pm = fm + ((wgid % nig) % gsz); u.pn = (wgid % nig) / gsz; return true;
    }
    __device__ __forceinline__ void a_ready(const Unit&) const {}
    __device__ __forceinline__ void done(const Unit&) const {}
};

__device__ __forceinline__ unsigned cvt_pk_bf16(float lo, float hi) { unsigned r; asm volatile("v_cvt_pk_bf16_f32 %0, %1, %2" : "=v"(r) : "v"(lo), "v"(hi)); return r; }
typedef float f32x2 __attribute__((ext_vector_type(2)));
typedef unsigned u32x2 __attribute__((ext_vector_type(2)));
template <int ACT> struct EpiBf16 {
    static constexpr bool PERM = true, AFTER_DRAIN = false;
    bf16_t* O; int ldc; const float* rowss;
    __device__ __forceinline__ void operator()(const f32x4 (&acc)[2][2][4][2], const Unit& u, int wr, int wc, int fr, int fq) const {
        const int row0 = u.pm * BM + wr * 64 + fr; const int col0 = u.pn * BM + wc * 32 + 8 * fq;
        float rs[2][4];
#pragma unroll
        for (int ai = 0; ai < 2; ++ai)
#pragma unroll
            for (int m = 0; m < 4; ++m) rs[ai][m] = rowss[row0 + ai * HALF + m * 16];
#pragma unroll
        for (int ai = 0; ai < 2; ++ai)
#pragma unroll
            for (int m = 0; m < 4; ++m) { bf16_t* rowp = O + (size_t)(row0 + ai * HALF + m * 16) * ldc + col0;
                const float sc = 1.0f / sqrtf(rs[ai][m] * (1.0f / 2048.0f) + 1e-6f);
#pragma unroll
                for (int bj = 0; bj < 2; ++bj) { f32x4 v0 = acc[ai][bj][m][0] * sc, v1 = acc[ai][bj][m][1] * sc;
                    if (ACT == 2) {
#pragma unroll
                        for (int e = 0; e < 4; ++e) { float a = fmaxf(v0[e], 0.f), b = fmaxf(v1[e], 0.f); v0[e] = a * a; v1[e] = b * b; } }
                    u32x4 w; w.x = cvt_pk_bf16(v0[0], v0[1]); w.y = cvt_pk_bf16(v0[2], v0[3]); w.z = cvt_pk_bf16(v1[0], v1[1]); w.w = cvt_pk_bf16(v1[2], v1[3]);
                    *(u32x4*)(rowp + bj * HALF) = w; } }
    }
};
struct EpiResF32 {
    static constexpr bool PERM = true, AFTER_DRAIN = false;
    const float* res_lo; const float* res_hi; int split_pm; const bf16_t* resb; float* out; int ldc; bf16_t* xb; int ldx; float* rowss;
    __device__ __forceinline__ void operator()(const f32x4 (&acc)[2][2][4][2], const Unit& u, int wr, int wc, int fr, int fq) const {
        const float* rbase = (u.pm < split_pm) ? res_lo : (res_hi - (size_t)split_pm * BM * ldc);
        const int col0 = u.pn * BM + wc * 32 + 8 * fq;
#pragma unroll
        for (int ai = 0; ai < 2; ++ai)
#pragma unroll
            for (int m = 0; m < 4; ++m) { const int row = u.pm * BM + ai * HALF + wr * 64 + m * 16 + fr; const size_t off = (size_t)row * ldc + col0, offb = (size_t)row * ldx + col0; float ss = 0.f;
#pragma unroll
                for (int bj = 0; bj < 2; ++bj) {
                    f32x4 v0, v1;
                    if (resb) { const u32x4 r = *(const u32x4*)(resb + offb + bj * HALF);
                        v0 = (f32x4){__uint_as_float(r.x << 16), __uint_as_float(r.x & 0xffff0000u), __uint_as_float(r.y << 16), __uint_as_float(r.y & 0xffff0000u)};
                        v1 = (f32x4){__uint_as_float(r.z << 16), __uint_as_float(r.z & 0xffff0000u), __uint_as_float(r.w << 16), __uint_as_float(r.w & 0xffff0000u)}; }
                    else { v0 = *(const f32x4*)(rbase + off + bj * HALF); v1 = *(const f32x4*)(rbase + off + bj * HALF + 4); }
                    v0 += acc[ai][bj][m][0]; v1 += acc[ai][bj][m][1];
                    if (out) { *(f32x4*)(out + off + bj * HALF) = v0; *(f32x4*)(out + off + bj * HALF + 4) = v1; }
                    if (xb) { u32x4 w; w.x = cvt_pk_bf16(v0[0], v0[1]); w.y = cvt_pk_bf16(v0[2], v0[3]); w.z = cvt_pk_bf16(v1[0], v1[1]); w.w = cvt_pk_bf16(v1[2], v1[3]);
                        *(u32x4*)(xb + offb + bj * HALF) = w;
                        ss += (v0[0] * v0[0] + v0[1] * v0[1]) + (v0[2] * v0[2] + v0[3] * v0[3]) + (v1[0] * v1[0] + v1[1] * v1[1]) + (v1[2] * v1[2] + v1[3] * v1[3]); } }
                if (xb) { ss += __shfl_xor(ss, 16); ss += __shfl_xor(ss, 32);
                    if (fq == 0) __hip_atomic_fetch_add(rowss + row, ss, __ATOMIC_RELAXED, __HIP_MEMORY_SCOPE_AGENT); }
                if (m == 3) asm volatile("" ::: "memory"); }
    }
};
template <class Epi, class Sched, bool ALIGN_EPI = false, bool SP2 = false>
__device__ __forceinline__ void gemm_phase(PG8_LAS unsigned char* lds, const Gemm g, const Sched& S, const Epi& E) {
    int tid = threadIdx.x; asm volatile("" : "+v"(tid));
    const int wid = __builtin_amdgcn_readfirstlane(tid >> 6), lane = tid & 63, wr = wid >> 2, wc = wid & 3, fr = lane & 15, fq = lane >> 4;
    const int K = g.K, nt = K / BK;
    unsigned voffA[2], voffB[2];
#pragma unroll
    for (int i = 0; i < 2; ++i) { int R, C; stage_rc(tid * 16 + i * 8192, R, C); const int Rb = Epi::PERM ? ((R & ~31) + perm32(R & 31)) : R;
        voffA[i] = (unsigned)(R * g.lda + C) * 2u; voffB[i] = (unsigned)(Rb * g.ldb + C) * 2u; }
    const size_t kstep = (size_t)(BK * 2);
    const size_t hstepA = (size_t)HALF * g.lda * 2, hstepB = (size_t)HALF * g.ldb * 2;
    const size_t tstepA = 2 * hstepA, tstepB = 2 * hstepB;
    const unsigned ldsw = (unsigned)wid * 1024u;
    const int aoff = lds_byte(wr * 64 + fr, fq * 8), boff = lds_byte(wc * 32 + fr, fq * 8);
#define PG8_SA(b, h) (((b) * 2 + (h)) * HTB)
#define PG8_SB(b, h) ((4 + (b) * 2 + (h)) * HTB)
#define PG8_STAGE(bufoff, gbase, voff) do { _Pragma("unroll") for (int _i = 0; _i < 2; ++_i) \
        __builtin_amdgcn_global_load_lds((const unsigned*)((const char*)(gbase) + (voff)[_i]), (PG8_LAS unsigned*)(lds + (bufoff) + ldsw + _i * 8192), 16, 0, 0); } while (0)
#define PG8_LDA(dst, b, h) do { _Pragma("unroll") for (int m = 0; m < 4; ++m) _Pragma("unroll") for (int k = 0; k < 2; ++k) dst[m][k] = *(const PG8_LAS bf16x8*)(lds + PG8_SA(b, h) + aoff + m * 2048 + k * 1024); } while (0)
#define PG8_LDB(dst, b, h) do { _Pragma("unroll") for (int n = 0; n < 2; ++n) _Pragma("unroll") for (int k = 0; k < 2; ++k) dst[n][k] = *(const PG8_LAS bf16x8*)(lds + PG8_SB(b, h) + boff + n * 2048 + k * 1024); } while (0)
#define PG8_MMA(ai, bj, At, Bt) do { __builtin_amdgcn_s_setprio(1); _Pragma("unroll") for (int m = 0; m < 4; ++m) _Pragma("unroll") for (int n = 0; n < 2; ++n) _Pragma("unroll") for (int k = 0; k < 2; ++k) \
        acc[ai][bj][m][n] = __builtin_amdgcn_mfma_f32_16x16x32_bf16(Bt[n][k], At[m][k], acc[ai][bj][m][n], 0, 0, 0); __builtin_amdgcn_s_setprio(0); } while (0)
#define PG8_WAIT_V(n) asm volatile("s_waitcnt vmcnt(" #n ")" ::: "memory")
#define PG8_WAIT_L(n) asm volatile("s_waitcnt lgkmcnt(" #n ")" ::: "memory")
#define PG8_BAR __builtin_amdgcn_s_barrier()
#define PG8_SCHED __builtin_amdgcn_sched_barrier(0)
    Unit cur, nxt; int ui = 0;
    if (!S.next(0, cur)) return;
    f32x4 acc[2][2][4][2];
#pragma unroll
    for (int a = 0; a < 2; ++a)
#pragma unroll
        for (int b = 0; b < 2; ++b)
#pragma unroll
            for (int m = 0; m < 4; ++m)
#pragma unroll
                for (int n = 0; n < 2; ++n) acc[a][b][m][n] = (f32x4){0.f, 0.f, 0.f, 0.f};
    bf16x8 At[4][2], B0[2][2], B1[2][2];
    const char* cA = (const char*)g.A + (size_t)cur.pm * tstepA; const char* cB = (const char*)g.Bt + (size_t)cur.pn * tstepB;
    S.a_ready(cur);
    if constexpr (SP2) {
        PG8_STAGE(PG8_SB(0, 0), cB, voffB); PG8_STAGE(PG8_SB(0, 1), cB + hstepB, voffB); PG8_STAGE(PG8_SA(0, 0), cA, voffA); PG8_STAGE(PG8_SA(0, 1), cA + hstepA, voffA);
        if (wr == 1) PG8_BAR;
        PG8_WAIT_V(2); PG8_BAR;
        PG8_STAGE(PG8_SB(1, 0), cB + kstep, voffB); PG8_STAGE(PG8_SA(1, 0), cA + kstep, voffA); PG8_STAGE(PG8_SB(1, 1), cB + hstepB + kstep, voffB);
        PG8_WAIT_V(6); PG8_BAR;
    } else {
        PG8_STAGE(PG8_SB(0, 0), cB, voffB); PG8_STAGE(PG8_SA(0, 0), cA, voffA); PG8_STAGE(PG8_SB(0, 1), cB + hstepB, voffB); PG8_STAGE(PG8_SA(0, 1), cA + hstepA, voffA);
        if (wr == 1) PG8_BAR;
        PG8_WAIT_V(4); PG8_BAR;
        PG8_STAGE(PG8_SB(1, 0), cB + kstep, voffB); PG8_STAGE(PG8_SA(1, 0), cA + kstep, voffA); PG8_STAGE(PG8_SB(1, 1), cB + hstepB + kstep, voffB);
        PG8_WAIT_V(6); PG8_BAR;
    }
    for (;;) {
        const bool has_next = S.next(ui + 1, nxt);
        const char* nA = has_next ? (const char*)g.A + (size_t)nxt.pm * tstepA : cA; const char* nB = has_next ? (const char*)g.Bt + (size_t)nxt.pn * tstepB : cB;
        for (int t = 0; t < nt; t += 2) {
            const bool last = (t == nt - 2);
            const char* a1 = cA + (size_t)(t + 1) * kstep;
            const char* a2 = last ? nA : cA + (size_t)(t + 2) * kstep; const char* b2 = last ? nB : cB + (size_t)(t + 2) * kstep;
            const char* a3 = a2 + kstep; const char* b3 = b2 + kstep;
            if (last && has_next) S.a_ready(nxt);
            if constexpr (SP2) {
            PG8_LDB(B0, 0, 0); PG8_LDB(B1, 0, 1); PG8_SCHED; PG8_LDA(At, 0, 0); PG8_STAGE(PG8_SA(1, 1), a1 + hstepA, voffA);
            PG8_WAIT_V(8); PG8_WAIT_L(0); PG8_BAR; PG8_MMA(0, 0, At, B0); PG8_MMA(0, 1, At, B1); PG8_BAR; PG8_SCHED;
            PG8_LDA(At, 0, 1); PG8_STAGE(PG8_SB(0, 0), b2, voffB); PG8_STAGE(PG8_SB(0, 1), b2 + hstepB, voffB); PG8_STAGE(PG8_SA(0, 0), a2, voffA);
            PG8_WAIT_V(8); PG8_WAIT_L(0); PG8_BAR; PG8_MMA(1, 0, At, B0); PG8_MMA(1, 1, At, B1); PG8_BAR; PG8_SCHED;
            PG8_LDB(B0, 1, 0); PG8_LDB(B1, 1, 1); PG8_SCHED; PG8_LDA(At, 1, 0); PG8_STAGE(PG8_SA(0, 1), a2 + hstepA, voffA);
            PG8_WAIT_V(8); PG8_WAIT_L(0); PG8_BAR; PG8_MMA(0, 0, At, B0); PG8_MMA(0, 1, At, B1); PG8_BAR; PG8_SCHED;
            PG8_LDA(At, 1, 1); PG8_STAGE(PG8_SB(1, 0), b3, voffB); PG8_STAGE(PG8_SB(1, 1), b3 + hstepB, voffB); PG8_STAGE(PG8_SA(1, 0), a3, voffA);
            PG8_WAIT_V(8); PG8_WAIT_L(0); PG8_BAR; PG8_MMA(1, 0, At, B0); PG8_MMA(1, 1, At, B1); PG8_BAR; PG8_SCHED;
            } else {
            PG8_LDB(B0, 0, 0); PG8_SCHED; PG8_LDA(At, 0, 0); PG8_STAGE(PG8_SA(1, 1), a1 + hstepA, voffA);
            PG8_WAIT_L(8); PG8_BAR; PG8_WAIT_L(0); PG8_MMA(0, 0, At, B0); PG8_BAR; PG8_SCHED;
            PG8_LDB(B1, 0, 1); PG8_STAGE(PG8_SB(0, 0), b2, voffB);
            PG8_BAR; PG8_WAIT_L(0); PG8_MMA(0, 1, At, B1); PG8_BAR;
            PG8_LDA(At, 0, 1); PG8_STAGE(PG8_SA(0, 0), a2, voffA);
            PG8_BAR; PG8_WAIT_L(0); PG8_MMA(1, 0, At, B0); PG8_BAR; PG8_SCHED;
            PG8_STAGE(PG8_SB(0, 1), b2 + hstepB, voffB);
            PG8_WAIT_V(6); PG8_BAR; PG8_MMA(1, 1, At, B1); PG8_BAR;
            PG8_LDB(B0, 1, 0); PG8_SCHED; PG8_LDA(At, 1, 0); PG8_STAGE(PG8_SA(0, 1), a2 + hstepA, voffA);
            PG8_WAIT_L(8); PG8_BAR; PG8_WAIT_L(0); PG8_MMA(0, 0, At, B0); PG8_BAR; PG8_SCHED;
            PG8_LDB(B1, 1, 1); PG8_STAGE(PG8_SB(1, 0), b3, voffB);
            PG8_BAR; PG8_WAIT_L(0); PG8_MMA(0, 1, At, B1); PG8_BAR;
            PG8_LDA(At, 1, 1); PG8_STAGE(PG8_SA(1, 0), a3, voffA);
            PG8_BAR; PG8_WAIT_L(0); PG8_MMA(1, 0, At, B0); PG8_BAR; PG8_SCHED;
            PG8_STAGE(PG8_SB(1, 1), b3 + hstepB, voffB);
            PG8_WAIT_V(6); PG8_BAR; PG8_MMA(1, 1, At, B1); PG8_BAR;
            }
        }
        if constexpr (ALIGN_EPI) { if (wr == 0) PG8_BAR; }
        if constexpr (!Epi::AFTER_DRAIN) { E(acc, cur, wr, wc, fr, fq); S.done(cur); }
        if (!has_next) break;
#pragma unroll
        for (int a = 0; a < 2; ++a)
#pragma unroll
            for (int b = 0; b < 2; ++b)
#pragma unroll
                for (int m = 0; m < 4; ++m)
#pragma unroll
                    for (int n = 0; n < 2; ++n) acc[a][b][m][n] = (f32x4){0.f, 0.f, 0.f, 0.f};
        cur = nxt; cA = nA; cB = nB; ++ui;
        if constexpr (ALIGN_EPI) { if (wr == 1) PG8_BAR; }
    }
    PG8_WAIT_V(0);
    if constexpr (!ALIGN_EPI) { if (wr == 0) PG8_BAR; }
    PG8_BAR;
    if constexpr (Epi::AFTER_DRAIN) { E.fused(acc, cur, wr, wc, fr, fq, lds, wid, lane); S.done(cur); }
#undef PG8_SA
#undef PG8_SB
#undef PG8_STAGE
#undef PG8_LDA
#undef PG8_LDB
#undef PG8_MMA
#undef PG8_WAIT_V
#undef PG8_WAIT_L
#undef PG8_BAR
#undef PG8_SCHED
}
}

#ifndef PROBE_REP_ATT
#define PROBE_REP_ATT 1
#endif
#ifndef PROBE_REP_UP
#define PROBE_REP_UP 1
#endif
#ifndef PROBE_XSYNC
#define PROBE_XSYNC 0
#endif
#ifndef PROBE_REP_MISC
#define PROBE_REP_MISC 1
#endif
#ifndef PROBE_REP_WIN
#define PROBE_REP_WIN 1
#endif
#ifndef PHM
#define PHM 127
#endif
#ifndef MK_SINGLE
#define MK_SINGLE 1
#endif
constexpr int DM = 2048, MP = 8192, M_ALL = 40960, SEQ_P = 4096, SEQ_S = 16384, INW = 5632, DFF = 8192, NLAYER = 2;
constexpr int OFF_AX = 0, OFF_AB = 512, OFF_AC = 1024, OFF_Q = 1536, OFF_K = 2560, OFF_V = 3584, OFF_CU = 4608, OFF_CV = 5120;
constexpr int MIX_A = 0, MIX_B = 512, MIX_C = 1536;
constexpr float EPS = 1e-6f;
constexpr float C2 = 0.18033688011112042f;
constexpr size_t MiB = 1u << 20;
constexpr int LDH = DFF + 128;
constexpr size_t WS_WT = 1 * MiB, WT_LAYER = 96 * MiB, WT_IN = 0, WT_OUT = 22 * MiB, WT_UP = 30 * MiB, WT_DN = 62 * MiB;
constexpr size_t WS_XN = 194 * MiB, WS_H = 356 * MiB, WS_PROJ = 356 * MiB, WS_MIX = 796 * MiB, WS_END = 1008 * MiB;
static_assert(WT_DN + (size_t)DM * LDH * 2 <= WT_LAYER && WS_WT + 2 * WT_LAYER <= WS_XN && WS_XN + (size_t)M_ALL * DM * 2 <= WS_H && WS_PROJ + (size_t)M_ALL * INW * 2 <= WS_MIX && WS_MIX + (size_t)M_ALL * DM * 2 <= WS_END && WS_H + (size_t)M_ALL * LDH * 2 <= WS_END, "ws map");
constexpr int NWAVES = 8, LDS_BYTES = 147456;

typedef unsigned short bf16;
typedef unsigned v4u __attribute__((ext_vector_type(4)));
typedef unsigned v2u __attribute__((ext_vector_type(2)));
typedef float f32x4 __attribute__((ext_vector_type(4)));
#define DI __device__ __forceinline__

DI unsigned pk2(float lo, float hi) { return pg8::cvt_pk_bf16(lo, hi); }
DI float bflo(unsigned u) { return __uint_as_float(u << 16); }
DI float bfhi(unsigned u) { return __uint_as_float(u & 0xffff0000u); }
DI float wave_sum(float v) {
#pragma unroll
    for (int o = 1; o < 64; o <<= 1) v += __shfl_xor(v, o);
    return v;
}
DI float wave_max(float v) {
#pragma unroll
    for (int o = 1; o < 64; o <<= 1) v = fmaxf(v, __shfl_xor(v, o));
    return v;
}
DI float gelu_tanh(float x) {
    const float z = x * (0.7978845608028654f + 0.035677408136300125f * x * x);
    const float e = __builtin_amdgcn_exp2f(-2.8853900817779268f * z);
    return x * __builtin_amdgcn_rcpf(1.0f + e);
}

DI void transpose_item(const float* W, int K, int N, bf16* WT, int ldt, const float* gain, float* scr, int item, int lane) {
    const int nblk = N / 32, kb = item / nblk, nb = item % nblk, k0 = 64 * kb, n0 = 32 * nb;
#pragma unroll 32
    for (int i = 0; i < 32; ++i) { const int kk = 2 * i + (lane >> 5); scr[kk * 33 + (lane & 31)] = W[(size_t)(k0 + kk) * N + n0 + (lane & 31)] * (gain ? gain[k0 + kk] : 1.0f); }
    asm volatile("s_waitcnt lgkmcnt(0)" ::: "memory");
    const int c = lane & 7;
#pragma unroll
    for (int j = 0; j < 4; ++j) { const int n = (lane >> 3) + 8 * j; const float* s = scr + (8 * c) * 33 + n;
        v4u o; o.x = pk2(s[0 * 33], s[1 * 33]); o.y = pk2(s[2 * 33], s[3 * 33]); o.z = pk2(s[4 * 33], s[5 * 33]); o.w = pk2(s[6 * 33], s[7 * 33]);
        *(v4u*)(WT + (size_t)(n0 + n) * ldt + k0 + 8 * c) = o; }
    asm volatile("s_waitcnt lgkmcnt(0)" ::: "memory");
}
DI void xb_row(const float* xrow, bf16* orow, float* ssp, int lane) {
    const f32x4* xr = (const f32x4*)xrow + lane;
    f32x4 v[8]; float s = 0.f;
#pragma unroll
    for (int j = 0; j < 8; ++j) { v[j] = xr[64 * j]; s += (v[j].x * v[j].x + v[j].y * v[j].y) + (v[j].z * v[j].z + v[j].w * v[j].w); }
    s = wave_sum(s);
    if (lane == 0) *ssp = s;
    v2u* o8 = (v2u*)orow + lane;
#pragma unroll
    for (int j = 0; j < 8; ++j) { v2u w; w.x = pk2(v[j].x, v[j].y); w.y = pk2(v[j].z, v[j].w); o8[64 * j] = w; }
}

__constant__ double ROPE_INV[8] = {1.0, 0.19392274474868576, 0.03760603093086393, 0.007292664737217109, 0.001414213562373095, 0.0002742481756762073, 5.318295896944988e-05, 1.031338537721246e-05};
DI void k_rows(bf16* P, int row2, const float* kg, int lane) {
    const int row = row2 + (lane >> 5), l5 = lane & 31;
    const int pos = row < MP ? (row & (SEQ_P - 1)) : ((row - MP) & (SEQ_S - 1));
    bf16* p = P + (size_t)row * INW + OFF_K + l5 * 32;
    v4u raw[4];
#pragma unroll
    for (int i = 0; i < 4; ++i) raw[i] = *(const v4u*)(p + 8 * i);
    float x[32];
#pragma unroll
    for (int i = 0; i < 4; ++i) { x[8 * i + 0] = bflo(raw[i].x); x[8 * i + 1] = bfhi(raw[i].x); x[8 * i + 2] = bflo(raw[i].y); x[8 * i + 3] = bfhi(raw[i].y);
        x[8 * i + 4] = bflo(raw[i].z); x[8 * i + 5] = bfhi(raw[i].z); x[8 * i + 6] = bflo(raw[i].w); x[8 * i + 7] = bfhi(raw[i].w); }
    float ss = 0.f;
#pragma unroll
    for (int i = 0; i < 32; ++i) ss += x[i] * x[i];
    ss += __shfl_xor(ss, 1);
    const float rstd = 1.0f / sqrtf(ss * (1.f / 64.f) + EPS);
    const int half = l5 & 1;
    const float* g = kg + half * 32;
#pragma unroll
    for (int i = 0; i < 8; ++i) { const f32x4 gg = *(const f32x4*)(g + 4 * i); x[4 * i] *= rstd * gg.x; x[4 * i + 1] *= rstd * gg.y; x[4 * i + 2] *= rstd * gg.z; x[4 * i + 3] *= rstd * gg.w; }
    const double t = (double)pos * ROPE_INV[lane & 7] * 0.15915494309189535;
    const float fr = (float)(t - rint(t));
    const float cs = __builtin_amdgcn_cosf(fr), sn = __builtin_amdgcn_sinf(fr);
#pragma unroll
    for (int i = 0; i < 8; ++i) { const float c = __shfl(cs, (lane & 32) + i), s_ = __shfl(sn, (lane & 32) + i);
        if (half == 0) { const float a = x[i], b = x[i + 8]; x[i] = a * c - b * s_; x[i + 8] = b * c + a * s_; } }
#pragma unroll
    for (int i = 0; i < 4; ++i) { v4u w; w.x = pk2(x[8 * i], x[8 * i + 1]); w.y = pk2(x[8 * i + 2], x[8 * i + 3]); w.z = pk2(x[8 * i + 4], x[8 * i + 5]); w.w = pk2(x[8 * i + 6], x[8 * i + 7]);
        *(v4u*)(p + 8 * i) = w; }
}
DI void unpack8(const v4u r, float* x) { x[0] = bflo(r.x); x[1] = bfhi(r.x); x[2] = bflo(r.y); x[3] = bfhi(r.y); x[4] = bflo(r.z); x[5] = bfhi(r.z); x[6] = bflo(r.w); x[7] = bfhi(r.w); }
DI void conv_row(const bf16* P, bf16* MIX, int row, int pos, int S, const float* cw, int lane) {
    const bf16* p = P + (size_t)row * INW + lane * 8;
    const v4u z4 = {0u, 0u, 0u, 0u};
    const v4u xa0 = *(const v4u*)(p + OFF_AX), gc0 = *(const v4u*)(p + OFF_AC), gb0 = *(const v4u*)(p + OFF_AB);
    const v4u xam = pos > 0 ? *(const v4u*)(p - INW + OFF_AX) : z4, gcm = pos > 0 ? *(const v4u*)(p - INW + OFF_AC) : z4;
    const v4u xap = pos < S - 1 ? *(const v4u*)(p + INW + OFF_AX) : z4, gcp = pos < S - 1 ? *(const v4u*)(p + INW + OFF_AC) : z4;
    float a0[8], c0[8], b0[8], am[8], cm[8], ap[8], cp[8];
    unpack8(xa0, a0); unpack8(gc0, c0); unpack8(gb0, b0); unpack8(xam, am); unpack8(gcm, cm); unpack8(xap, ap); unpack8(gcp, cp);
    float w0[8], w1[8], w2[8];
#pragma unroll
    for (int i = 0; i < 2; ++i) { const f32x4 a = *(const f32x4*)(cw + lane * 8 + 4 * i), b = *(const f32x4*)(cw + 512 + lane * 8 + 4 * i), c = *(const f32x4*)(cw + 1024 + lane * 8 + 4 * i);
        w0[4 * i] = a.x; w0[4 * i + 1] = a.y; w0[4 * i + 2] = a.z; w0[4 * i + 3] = a.w; w1[4 * i] = b.x; w1[4 * i + 1] = b.y; w1[4 * i + 2] = b.z; w1[4 * i + 3] = b.w;
        w2[4 * i] = c.x; w2[4 * i + 1] = c.y; w2[4 * i + 2] = c.z; w2[4 * i + 3] = c.w; }
    float o[8];
#pragma unroll
    for (int j = 0; j < 8; ++j) o[j] = b0[j] * (w0[j] * (cm[j] * am[j]) + w1[j] * (c0[j] * a0[j]) + w2[j] * (cp[j] * ap[j]));
    v4u w; w.x = pk2(o[0], o[1]); w.y = pk2(o[2], o[3]); w.z = pk2(o[4], o[5]); w.w = pk2(o[6], o[7]);
    *(v4u*)(MIX + (size_t)row * DM + MIX_A + lane * 8) = w;
}

namespace att {
using bf16x8 = __attribute__((ext_vector_type(8))) short;
using s16x4  = __attribute__((ext_vector_type(4))) short;
using f32x16 = __attribute__((ext_vector_type(16))) float;
using u32x4  = __attribute__((ext_vector_type(4))) unsigned;
constexpr int KVBLK = 64;
constexpr int SHM_V = 16384, SHM_K = 16384, SCR_OFF = 133120;
#define KSWZ(row, colB) ((row) * 256 + ((colB) ^ (((row) & 15) << 4)))
#define SBAR() __builtin_amdgcn_sched_barrier(0)
DI int crow(int r, int hi) { return (r & 3) + 8 * (r >> 2) + 4 * hi; }
DI unsigned cvtpk(float lo, float hi) { unsigned r; asm volatile("v_cvt_pk_bf16_f32 %0, %1, %2" : "=v"(r) : "v"(lo), "v"(hi)); return r; }
DI int v_st(int k, int c) { const int kk = (k & ~0xC) | ((k & 4) << 1) | ((k & 8) >> 1); return ((kk >> 3) * 4 + (c >> 5)) * 512 + ((kk & 7) * 32 + (c & 31)) * 2; }
DI int v_rd_base(int lane) { return ((lane & 3) << 3) | (((lane >> 2) & 3) << 6) | (((lane >> 4) & 1) << 5) | (((lane >> 5) & 1) << 8); }
constexpr int v_rd_off(int d0, int ks, int half) { return d0 * 512 + ks * 4096 + half * 2048; }
template <int OFF> DI s16x4 tr_read(int vb) { s16x4 r; asm volatile("ds_read_b64_tr_b16 %0, %1 offset:%2" : "=&v"(r) : "v"(vb), "i"(OFF) : "memory"); return r; }
template <int D0> DI void pv_one(f32x16& od, int vb, bf16x8 pa0, bf16x8 pa1, bf16x8 pa2, bf16x8 pa3) {
  const s16x4 l0 = tr_read<v_rd_off(D0, 0, 0)>(vb), h0 = tr_read<v_rd_off(D0, 0, 1)>(vb), l1 = tr_read<v_rd_off(D0, 1, 0)>(vb), h1 = tr_read<v_rd_off(D0, 1, 1)>(vb);
  const s16x4 l2 = tr_read<v_rd_off(D0, 2, 0)>(vb), h2 = tr_read<v_rd_off(D0, 2, 1)>(vb), l3 = tr_read<v_rd_off(D0, 3, 0)>(vb), h3 = tr_read<v_rd_off(D0, 3, 1)>(vb);
  asm volatile("s_waitcnt lgkmcnt(0)" ::: "memory"); SBAR();
#define PK(L, H) (bf16x8){L[0], L[1], L[2], L[3], H[0], H[1], H[2], H[3]}
  od = __builtin_amdgcn_mfma_f32_32x32x16_bf16(pa0, PK(l0, h0), od, 0, 0, 0);
  od = __builtin_amdgcn_mfma_f32_32x32x16_bf16(pa1, PK(l1, h1), od, 0, 0, 0);
  od = __builtin_amdgcn_mfma_f32_32x32x16_bf16(pa2, PK(l2, h2), od, 0, 0, 0);
  od = __builtin_amdgcn_mfma_f32_32x32x16_bf16(pa3, PK(l3, h3), od, 0, 0, 0);
#undef PK
}
DI void pv_d0(f32x16* o, int vb, bf16x8 pa0, bf16x8 pa1, bf16x8 pa2, bf16x8 pa3) {
  pv_one<0>(o[0], vb, pa0, pa1, pa2, pa3); pv_one<1>(o[1], vb, pa0, pa1, pa2, pa3); pv_one<2>(o[2], vb, pa0, pa1, pa2, pa3); pv_one<3>(o[3], vb, pa0, pa1, pa2, pa3);
}
template <bool SHIFT> DI void qkt(f32x16& p0, f32x16& p1, const char* Ks, const bf16x8* qr, int r32, int hi, int c, float negmb) {
  if constexpr (SHIFT) {
#pragma unroll
    for (int r = 0; r < 16; ++r) { p0[r] = negmb; p1[r] = negmb; }
  } else { p0 = f32x16{}; p1 = f32x16{}; }
#pragma unroll
  for (int d0 = 0; d0 < 4; ++d0) { const int cb = (c * 64 + d0 * 16 + hi * 8) * 2;
    const bf16x8 b0 = *reinterpret_cast<const bf16x8*>(Ks + KSWZ(r32, cb));
    const bf16x8 b1 = *reinterpret_cast<const bf16x8*>(Ks + KSWZ(32 + r32, cb));
    p0 = __builtin_amdgcn_mfma_f32_32x32x16_bf16(b0, qr[d0], p0, 0, 0, 0);
    p1 = __builtin_amdgcn_mfma_f32_32x32x16_bf16(b1, qr[d0], p1, 0, 0, 0); }
}
DI void expA(f32x16& p0) {
#pragma unroll
  for (int r = 0; r < 16; ++r) p0[r] = __builtin_amdgcn_exp2f(p0[r]);
}
DI void finishSM(f32x16& p0, f32x16& p1, float& l_reg, bf16x8& pa0, bf16x8& pa1, bf16x8& pa2, bf16x8& pa3) {
#pragma unroll
  for (int r = 0; r < 16; ++r) p1[r] = __builtin_amdgcn_exp2f(p1[r]);
  float ps = 0.f;
#pragma unroll
  for (int r = 0; r < 16; ++r) ps += p0[r];
#pragma unroll
  for (int r = 0; r < 16; ++r) ps += p1[r];
  l_reg += ps;
#define PK4(P, BASE, OUT) do { unsigned a0 = cvtpk(P[BASE + 0], P[BASE + 1]), a1 = cvtpk(P[BASE + 2], P[BASE + 3]);   \
    unsigned b0 = cvtpk(P[BASE + 4], P[BASE + 5]), b1 = cvtpk(P[BASE + 6], P[BASE + 7]);                              \
    auto r0 = __builtin_amdgcn_permlane32_swap(a0, b0, false, false); auto r1 = __builtin_amdgcn_permlane32_swap(a1, b1, false, false); \
    u32x4 w = {r0[0], r1[0], r0[1], r1[1]}; OUT = *reinterpret_cast<bf16x8*>(&w); } while (0)
  PK4(p0, 0, pa0); PK4(p0, 8, pa1); PK4(p1, 0, pa2); PK4(p1, 8, pa3);
#undef PK4
}
DI unsigned cvtpk2(float lo, float hi) { typedef float f2_t __attribute__((ext_vector_type(2))); typedef __bf16 b2_t __attribute__((ext_vector_type(2))); f2_t v = {lo, hi}; b2_t b = __builtin_convertvector(v, b2_t); return __builtin_bit_cast(unsigned, b); }
template <int I> DI void vrd(s16x4& l, s16x4& h, int vb) { constexpr int ks = I >> 2, d0 = I & 3; l = tr_read<v_rd_off(d0, ks, 0)>(vb); h = tr_read<v_rd_off(d0, ks, 1)>(vb); }
#define TIEWAIT(N, L, H) asm volatile("s_waitcnt lgkmcnt(" #N ")" : "+v"(L), "+v"(H))
#define PK4B(P, BASE, OUT) do { u32x4 w = {cvtpk2(P[BASE + 0], P[BASE + 1]), cvtpk2(P[BASE + 2], P[BASE + 3]), cvtpk2(P[BASE + 4], P[BASE + 5]), cvtpk2(P[BASE + 6], P[BASE + 7])}; \
    OUT = *reinterpret_cast<bf16x8*>(&w); } while (0)
#define PKV(L, H) (bf16x8){L[0], L[1], L[2], L[3], H[0], H[1], H[2], H[3]}
#define PVSTEP(i, N, PA, SL, SH, NL, NH) do { TIEWAIT(N, SL, SH); o[(i) & 3] = __builtin_amdgcn_mfma_f32_32x32x16_bf16(PA, PKV(SL, SH), o[(i) & 3], 0, 0, 0); \
    if constexpr ((i) + 3 < 16) vrd<((i) + 3 < 16 ? (i) + 3 : 15)>(NL, NH, vb); } while (0)
DI void finish_pv(f32x16& p0, f32x16& p1, float& l_reg, f32x16* o, int vb) {
  s16x4 l0, h0, l1, h1, l2, h2, l3, h3;
  vrd<0>(l0, h0, vb); vrd<1>(l1, h1, vb); vrd<2>(l2, h2, vb);
  bf16x8 pa0, pa1, pa2, pa3;
  PK4B(p0, 0, pa0); PK4B(p0, 8, pa1);
  PVSTEP(0, 4, pa0, l0, h0, l3, h3); PVSTEP(1, 4, pa0, l1, h1, l0, h0); PVSTEP(2, 4, pa0, l2, h2, l1, h1); PVSTEP(3, 4, pa0, l3, h3, l2, h2);
  PVSTEP(4, 4, pa1, l0, h0, l3, h3); PVSTEP(5, 4, pa1, l1, h1, l0, h0); PVSTEP(6, 4, pa1, l2, h2, l1, h1); PVSTEP(7, 4, pa1, l3, h3, l2, h2);
  PK4B(p1, 0, pa2); PK4B(p1, 8, pa3);
  PVSTEP(8, 4, pa2, l0, h0, l3, h3); PVSTEP(9, 4, pa2, l1, h1, l0, h0); PVSTEP(10, 4, pa2, l2, h2, l1, h1); PVSTEP(11, 4, pa2, l3, h3, l2, h2);
  PVSTEP(12, 4, pa3, l0, h0, l3, h3); PVSTEP(13, 4, pa3, l1, h1, l0, h0); PVSTEP(14, 2, pa3, l2, h2, l1, h1); PVSTEP(15, 0, pa3, l3, h3, l2, h2);
  float ps = p0[0] + p0[1];
#pragma unroll
  for (int r = 2; r < 16; ++r) ps += p0[r];
#pragma unroll
  for (int r = 0; r < 16; ++r) ps += p1[r];
  l_reg += ps;
}
DI void glds16(const void* gsrc, unsigned lds_dst) { unsigned keep;
  asm volatile("s_mov_b32 %0, m0\n\ts_mov_b32 m0, %2\n\ts_nop 0\n\tglobal_load_lds_dwordx4 %1, off\n\ts_mov_b32 m0, %0" : "=&s"(keep) : "v"(gsrc), "s"(lds_dst) : "memory"); }
DI void glds_pair(unsigned voff0, unsigned voff1, const void* base, unsigned lds_dst) { unsigned keep;
  asm volatile("s_mov_b32 %0, m0\n\ts_mov_b32 m0, %4\n\ts_nop 0\n\tglobal_load_lds_dwordx4 %1, %3\n\ts_add_u32 m0, m0, 0x400\n\ts_nop 0\n\tglobal_load_lds_dwordx4 %2, %3\n\ts_mov_b32 m0, %0"
               : "=&s"(keep) : "v"(voff0), "v"(voff1), "s"(base), "s"(lds_dst) : "memory", "scc"); }
#define WAIT_BAR(N) asm volatile("s_waitcnt vmcnt(" #N ") lgkmcnt(0)\n\ts_barrier" ::: "memory")
template <bool SHIFT> DI void attn_unit(const bf16* __restrict__ Qb, const bf16* __restrict__ Kh, const bf16* __restrict__ Vh, bf16* __restrict__ Ob, int seq, char* lds,
                  float negmb, float lam, const float* __restrict__ gsub, float post, const float* __restrict__ qg, int qpos0) {
  int tid = threadIdx.x; asm volatile("" : "+v"(tid));
  const int lane = tid & 63, r32 = lane & 31, hi = lane >> 5; const int wid = __builtin_amdgcn_readfirstlane(tid >> 6), c = wid >> 2, wq = wid & 3;
  char* K_ring = lds; char* V_ring = lds + 3 * SHM_K;
  float* wsf = (float*)(lds + SCR_OFF) + wid * 64;
  const unsigned lds0 = (unsigned)(uintptr_t)lds;
  float l_reg = 0.f; f32x16 o[4] = {}; bf16x8 qr[4];
  const bf16* Qw = Qb + (size_t)(wq * 32 + r32) * INW + c * 64 + hi * 8;
#pragma unroll
  for (int d0 = 0; d0 < 4; ++d0) qr[d0] = *reinterpret_cast<const bf16x8*>(Qw + d0 * 16);
  unsigned kof0, kof1, vof0, vof1;
  { const int row0 = 8 * wid + (lane >> 4), row1 = row0 + 4, cp = lane & 15;
    kof0 = (unsigned)(row0 * INW + ((cp ^ (row0 & 15)) << 3)) * 2u; kof1 = (unsigned)(row1 * INW + ((cp ^ (row1 & 15)) << 3)) * 2u;
    const int kk = 8 * wid + ((lane & 31) >> 2), cc = (lane >> 5) * 32 + (lane & 3) * 8;
    vof0 = (unsigned)(kk * INW + cc) * 2u; vof1 = vof0 + 128u; }
  const unsigned kdst = lds0 + (unsigned)wid * 2048u, vdst = lds0 + 3u * SHM_K + (unsigned)wid * 2048u;
#define DMA_K(t, slot) glds_pair(kof0, kof1, (const char*)Kh + (size_t)(t) * (KVBLK * INW * 2), (unsigned)__builtin_amdgcn_readfirstlane(kdst + (unsigned)(slot)))
#define DMA_V(t, slot) glds_pair(vof0, vof1, (const char*)Vh + (size_t)(t) * (KVBLK * INW * 2), (unsigned)__builtin_amdgcn_readfirstlane(vdst + (unsigned)(slot)))
  const int vb0 = (int)(lds0 + 3u * SHM_K) + v_rd_base(lane);
  f32x16 pA0, pA1, pB0, pB1; const int NT = seq / KVBLK;
  int s0 = 0, s1 = SHM_K, s2 = 2 * SHM_K;
#define ROT() do { const int t_ = s0; s0 = s1; s1 = s2; s2 = t_; } while (0)
  DMA_K(0, 0); DMA_K(1, SHM_K); DMA_V(0, 0);
  { float x[4][8]; float ss = 0.f;
#pragma unroll
    for (int d0 = 0; d0 < 4; ++d0) { const u32x4 u = __builtin_bit_cast(u32x4, qr[d0]);
      x[d0][0] = __uint_as_float(u.x << 16); x[d0][1] = __uint_as_float(u.x & 0xffff0000u); x[d0][2] = __uint_as_float(u.y << 16); x[d0][3] = __uint_as_float(u.y & 0xffff0000u);
      x[d0][4] = __uint_as_float(u.z << 16); x[d0][5] = __uint_as_float(u.z & 0xffff0000u); x[d0][6] = __uint_as_float(u.w << 16); x[d0][7] = __uint_as_float(u.w & 0xffff0000u);
#pragma unroll
      for (int e = 0; e < 8; ++e) ss += x[d0][e] * x[d0][e]; }
    ss += __shfl_xor(ss, 32);
    const float rstd = 1.0f / sqrtf(ss * (1.f / 64.f) + EPS);
#pragma unroll
    for (int d0 = 0; d0 < 4; ++d0) { const f32x4 g0 = *(const f32x4*)(qg + 16 * d0 + 8 * hi), g1 = *(const f32x4*)(qg + 16 * d0 + 8 * hi + 4);
#pragma unroll
      for (int e = 0; e < 4; ++e) { x[d0][e] *= rstd * g0[e]; x[d0][4 + e] *= rstd * g1[e]; } }
    const double pos_d = (double)(qpos0 + wq * 32 + r32);
#pragma unroll
    for (int i = 0; i < 8; ++i) { const double t = pos_d * ROPE_INV[i] * 0.15915494309189535; const float fr = (float)(t - rint(t));
      const float cs = __builtin_amdgcn_cosf(fr), sn = __builtin_amdgcn_sinf(fr);
      const float y = __shfl_xor(x[0][i], 32);
      x[0][i] = x[0][i] * cs + (hi ? y : -y) * sn; }
#pragma unroll
    for (int d0 = 0; d0 < 4; ++d0) { u32x4 w = {pk2(x[d0][0] * C2, x[d0][1] * C2), pk2(x[d0][2] * C2, x[d0][3] * C2), pk2(x[d0][4] * C2, x[d0][5] * C2), pk2(x[d0][6] * C2, x[d0][7] * C2)};
      qr[d0] = __builtin_bit_cast(bf16x8, w); } }
  WAIT_BAR(4);
  DMA_K(2, 2 * SHM_K); DMA_V(1, SHM_K);
  qkt<SHIFT>(pA0, pA1, K_ring, qr, r32, hi, c, negmb); expA(pA0); expA(pA1);
#define ITER(CUR0, CUR1, PRV0, PRV1, j) do { \
    WAIT_BAR(4); \
    { const int tk_ = ((j) + 2 < NT) ? (j) + 2 : NT - 1, tv_ = ((j) + 1 < NT) ? (j) + 1 : NT - 1; DMA_K(tk_, s0); DMA_V(tv_, s2); } \
    SBAR(); qkt<SHIFT>(CUR0, CUR1, K_ring + s1, qr, r32, hi, c, negmb); \
    finish_pv(PRV0, PRV1, l_reg, o, vb0 + s0); expA(CUR0); expA(CUR1); \
    ROT(); } while (0)
  for (int j = 1; j + 1 < NT; j += 2) {
    ITER(pB0, pB1, pA0, pA1, j);
    ITER(pA0, pA1, pB0, pB1, j + 1);
  }
  ITER(pB0, pB1, pA0, pA1, NT - 1);
  WAIT_BAR(0);
  finish_pv(pB0, pB1, l_reg, o, vb0 + s0);
#undef ITER
#undef ROT
#undef DMA_K
#undef DMA_V
  int lane_e = lane; asm volatile("" : "+v"(lane_e));
  {
  const int lane = lane_e, r32 = lane & 31, hi = lane >> 5;
  { auto rr = __builtin_amdgcn_permlane32_swap(__float_as_uint(l_reg), __float_as_uint(l_reg), false, false); l_reg = __uint_as_float(rr[0]) + __uint_as_float(rr[1]); }
  if (hi == 0) wsf[r32] = l_reg;
  asm volatile("s_waitcnt lgkmcnt(0)" ::: "memory");
  __syncthreads();
  float* XY = (float*)lds + (c == 0 ? 16384 : 0) + wq * 4096;
#pragma unroll
  for (int r = 0; r < 16; ++r) { const float rl = __builtin_amdgcn_rcpf(wsf[crow(r, hi)]);
#pragma unroll
    for (int d0 = 0; d0 < 4; ++d0) XY[(d0 * 16 + r) * 64 + lane] = o[d0][r] * rl; }
  }
  __syncthreads();
  { int tid2 = threadIdx.x; asm volatile("" : "+v"(tid2));
    const int ch = tid2 & 15; const f32x4 g0 = *(const f32x4*)(gsub + ch * 8), g1 = *(const f32x4*)(gsub + ch * 8 + 4);
#pragma unroll
    for (int j = 0; j < 4; ++j) {
      const int row = (tid2 >> 4) + 32 * j, rr = row & 31;
      const int fi = (row >> 5) * 4096 + ((ch >> 2) * 16 + (rr & 3) + 4 * (rr >> 3)) * 64 + ((rr >> 2) & 1) * 32 + (ch & 3) * 8;
      const float* xp_ = (const float*)lds + fi;
      const f32x4 x0 = *(const f32x4*)(xp_), x1 = *(const f32x4*)(xp_ + 4), y0 = *(const f32x4*)(xp_ + 16384), y1 = *(const f32x4*)(xp_ + 16384 + 4);
      const f32x4 d0v = y0 - x0 * lam, d1v = y1 - x1 * lam;
      float ss = (d0v[0] * d0v[0] + d0v[1] * d0v[1]) + (d0v[2] * d0v[2] + d0v[3] * d0v[3]) + (d1v[0] * d1v[0] + d1v[1] * d1v[1]) + (d1v[2] * d1v[2] + d1v[3] * d1v[3]);
      ss += __shfl_xor(ss, 1); ss += __shfl_xor(ss, 2); ss += __shfl_xor(ss, 4); ss += __shfl_xor(ss, 8);
      const float rs = post / sqrtf(ss * (1.f / 128.f) + EPS);
      const f32x4 e0 = d0v * g0 * rs, e1 = d1v * g1 * rs;
      v4u w; w.x = pk2(e0[0], e0[1]); w.y = pk2(e0[2], e0[3]); w.z = pk2(e1[0], e1[1]); w.w = pk2(e1[2], e1[3]);
      *(v4u*)(Ob + (size_t)row * DM + ch * 8) = w; }
  }
  __syncthreads();
}
#undef SBAR
}

DI void sgu_unit(const bf16* P, bf16* MIX, int chunk, int hd, const float* Ws, const float* bs, const float* gv, char* lds) {
    using att::bf16x8; using att::f32x16;
    int tid = threadIdx.x; asm volatile("" : "+v"(tid));
    const int wid = tid >> 6, lane = tid & 63, r32 = lane & 31, hi = lane >> 5;
    bf16* vnT = (bf16*)lds;
    { const int p = tid >> 2, qtr = tid & 3; const bf16* src = P + (size_t)(chunk * 128 + p) * INW + OFF_CV + hd * 128 + qtr * 32;
      v4u raw[4];
#pragma unroll
      for (int i = 0; i < 4; ++i) raw[i] = *(const v4u*)(src + 8 * i);
      float x[32];
#pragma unroll
      for (int i = 0; i < 4; ++i) unpack8(raw[i], x + 8 * i);
      float ss = 0.f;
#pragma unroll
      for (int i = 0; i < 32; ++i) { x[i] = gelu_tanh(x[i]); ss += x[i] * x[i]; }
      ss += __shfl_xor(ss, 1); ss += __shfl_xor(ss, 2);
      const float rstd = 1.0f / sqrtf(ss * (1.f / 128.f) + EPS);
#pragma unroll
      for (int i = 0; i < 32; ++i) { const float v = x[i] * rstd * gv[qtr * 32 + i]; vnT[(qtr * 32 + i) * 136 + p] = (bf16)(pk2(v, 0.f) & 0xffffu); }
    }
    __syncthreads();
    const int qb = wid >> 1;
    bf16x8 a[8];
#pragma unroll
    for (int ks = 0; ks < 8; ++ks) { const float* w = Ws + (size_t)(32 * qb + r32) * 128 + 16 * ks + 8 * hi; const f32x4 w0 = *(const f32x4*)w, w1 = *(const f32x4*)(w + 4);
        att::u32x4 u = {pk2(w0.x, w0.y), pk2(w0.z, w0.w), pk2(w1.x, w1.y), pk2(w1.z, w1.w)}; a[ks] = *reinterpret_cast<bf16x8*>(&u); }
#pragma unroll
    for (int dd = 0; dd < 2; ++dd) { const int db = 2 * (wid & 1) + dd;
        f32x16 acc = {};
#pragma unroll
        for (int ks = 0; ks < 8; ++ks) { const bf16x8 b = *reinterpret_cast<const bf16x8*>(vnT + (32 * db + r32) * 136 + 16 * ks + 8 * hi);
            acc = __builtin_amdgcn_mfma_f32_32x32x16_bf16(a[ks], b, acc, 0, 0, 0); }
        const int d = 32 * db + r32;
#pragma unroll
        for (int i = 0; i < 16; ++i) { const int q = 32 * qb + att::crow(i, hi); const size_t tok = (size_t)chunk * 128 + q;
            const float uval = gelu_tanh(__uint_as_float((unsigned)P[tok * INW + OFF_CU + hd * 128 + d] << 16));
            MIX[tok * DM + MIX_C + hd * 128 + d] = (bf16)(pk2(uval * (acc[i] + bs[q]), 0.f) & 0xffffu); }
    }
    __syncthreads();
}

#define LAS __attribute__((address_space(3)))
#define XB_TMO      128
#define XB_XCNT(j)  (256  + 64 * (j))
#define XB_XSUB(j)  (1280 + 64 * (j))
#define XB_XGEN(j)  (2304 + 64 * (j))
#define XB_TOP      3328
#define XB_TOPGEN   3392
#define XCD_BAR_WORDS 3456
#define XB_SPIN_CAP (1u << 18)

__device__ __forceinline__ unsigned xb_ld(unsigned* p)              { return __hip_atomic_load(p, __ATOMIC_RELAXED, __HIP_MEMORY_SCOPE_AGENT); }
__device__ __forceinline__ unsigned xb_add(unsigned* p, unsigned v) { return __hip_atomic_fetch_add(p, v, __ATOMIC_RELAXED, __HIP_MEMORY_SCOPE_AGENT); }
__device__ __forceinline__ unsigned xb_xcc_id() { return (unsigned)__builtin_amdgcn_s_getreg((3 << 11) | 20) & 0xFu; }
#define XB_SPIN(cond, bar) do { unsigned _sp = 0; while (cond) { __builtin_amdgcn_s_sleep(1); \
    if ((++_sp & 255u) == 0u) { if (xb_ld(&(bar)[XB_TMO])) break; if (_sp > XB_SPIN_CAP) { atomicAdd(&(bar)[XB_TMO], 1u); break; } } } } while (0)

struct XcdBarrier {
    unsigned* bar; unsigned x;
    volatile LAS unsigned* st;
};

__device__ __forceinline__ XcdBarrier xcd_barrier_post(unsigned* bar, volatile LAS unsigned* st) {
    XcdBarrier b; b.bar = bar; b.x = xb_xcc_id(); b.st = st;
    if (threadIdx.x == 0) (void)xb_add(&bar[XB_XCNT(b.x)], 1u);
    return b;
}
__device__ __forceinline__ void xcd_barrier_complete(unsigned* bar, unsigned x, unsigned& nloc, unsigned& nx) {
    const unsigned G = gridDim.x * gridDim.y * gridDim.z;
    unsigned sum, cnt, mine, sp = 0u;
    for (;;) {
        sum = 0u; cnt = 0u; mine = 0u;
#pragma unroll
        for (unsigned j = 0; j < 16; ++j) { const unsigned c = xb_ld(&bar[XB_XCNT(j)]); sum += c; cnt += (c > 0u) ? 1u : 0u; mine = (j == x) ? c : mine; }
        if (sum == G) break;
        __builtin_amdgcn_s_sleep(1);
        if ((++sp & 255u) == 0u) { if (xb_ld(&bar[XB_TMO])) break; if (sp > XB_SPIN_CAP) { atomicAdd(&bar[XB_TMO], 1u); break; } }
    }
    nloc = mine > 0u ? mine : 1u; nx = cnt > 0u ? cnt : 1u;
}

__device__ __forceinline__ void xcd_barrier(const XcdBarrier& b) {
    asm volatile("s_waitcnt vmcnt(0)" ::: "memory");
    __syncthreads();
    if (threadIdx.x == 0) {
        unsigned* bar = b.bar;
        __builtin_amdgcn_s_waitcnt(0);
        unsigned nloc = b.st[0], nx = b.st[1];
        if (nloc == 0u) { xcd_barrier_complete(bar, b.x, nloc, nx); b.st[0] = nloc; b.st[1] = nx; }
        const unsigned old = xb_add(&bar[XB_XSUB(b.x)], 1u);
        const unsigned gen = old / nloc;
        if (old + 1u == (gen + 1u) * nloc) {
            __builtin_amdgcn_fence(__ATOMIC_RELEASE, "agent");
            asm volatile("s_waitcnt vmcnt(0)" ::: "memory");
            const unsigned og = xb_add(&bar[XB_TOP], 1u);
            const unsigned tg = og / nx;
            if (og + 1u == (tg + 1u) * nx) xb_add(&bar[XB_TOPGEN], 1u);
            else XB_SPIN(xb_ld(&bar[XB_TOPGEN]) == tg, bar);
            __builtin_amdgcn_fence(__ATOMIC_ACQUIRE, "agent");
            xb_add(&bar[XB_XGEN(b.x)], 1u);
            asm volatile("s_waitcnt vmcnt(0)" ::: "memory");
        } else {
            XB_SPIN(xb_ld(&bar[XB_XGEN(b.x)]) == gen, bar);
            __builtin_amdgcn_fence(__ATOMIC_ACQUIRE, "agent");
            asm volatile("s_waitcnt vmcnt(0)" ::: "memory");
        }
    }
    __syncthreads();
}

struct Args { const float* in[19]; float* out; unsigned char* ws; int ph_lo, ph_hi; };
constexpr int N_PHASES = 1 + 6 * NLAYER;

__global__ void __launch_bounds__(NWAVES * 64, 2) mk_fwd(Args args) {
    extern __shared__ __attribute__((aligned(16))) unsigned char lds[];
    cg::grid_group grid = cg::this_grid();
    const int G = gridDim.x; const int bx = blockIdx.x; const int vcu = (G % 8 == 0) ? (bx % 8) * (G / 8) + bx / 8 : bx;
    const int NGW = G * NWAVES;
    unsigned char* ws = args.ws;
    const float* xp = args.in[0]; const float* xs = args.in[1];
    float* out = args.out;
    bf16* XN = (bf16*)(ws + WS_XN); bf16* PROJ = (bf16*)(ws + WS_PROJ); bf16* MIX = (bf16*)(ws + WS_MIX); bf16* HB = (bf16*)(ws + WS_H);

    volatile LAS unsigned* MISC = (volatile LAS unsigned*)((LAS unsigned char*)lds + 131072 + 320);
    if (threadIdx.x < 32) MISC[threadIdx.x] = 0u;
    __syncthreads();
    const XcdBarrier bar = xcd_barrier_post((unsigned*)ws, MISC + 8);
    for (int ph = args.ph_lo; ph < args.ph_hi; ++ph) {
        int tid = threadIdx.x; asm volatile("" : "+v"(tid));
        const int lane = tid & 63, wave = __builtin_amdgcn_readfirstlane(tid >> 6), gw = vcu * NWAVES + wave;
        const int l = (ph - 1) / 6, k = (ph == 0) ? -1 : ((ph - 1) % 6);
        float* const RS = (float*)(ws + 65536);
        const unsigned char* wl = ws + WS_WT + (size_t)(l < 0 ? 0 : l) * WT_LAYER;
        if (ph == 0) {
#if PHM & 1
            for (int rep = 0; rep < PROBE_REP_MISC; ++rep) {
            float* scr = (float*)(lds + wave * 16384);
            constexpr int I_IN = 32 * 176, I_OUT = 32 * 64, I_UP = 32 * 256, I_DN = 128 * 64, I_L = I_IN + I_OUT + I_UP + I_DN;
            for (int it = gw; it < NLAYER * I_L; it += NGW) {
                const int ll = it / I_L; int r = it % I_L; unsigned char* wb = ws + WS_WT + (size_t)ll * WT_LAYER;
                if (r < I_IN) { transpose_item(args.in[3] + (size_t)ll * DM * INW, DM, INW, (bf16*)(wb + WT_IN), DM, args.in[2] + ll * DM, scr, r, lane); continue; } r -= I_IN;
                if (r < I_OUT) { transpose_item(args.in[15] + (size_t)ll * DM * DM, DM, DM, (bf16*)(wb + WT_OUT), DM, nullptr, scr, r, lane); continue; } r -= I_OUT;
                if (r < I_UP) { transpose_item(args.in[17] + (size_t)ll * DM * DFF, DM, DFF, (bf16*)(wb + WT_UP), DM, args.in[16] + ll * DM, scr, r, lane); continue; } r -= I_UP;
                transpose_item(args.in[18] + (size_t)ll * DFF * DM, DFF, DM, (bf16*)(wb + WT_DN), LDH, nullptr, scr, r, lane);
            }
            for (int m = gw; m < M_ALL; m += NGW) xb_row(m < MP ? xp + (size_t)m * DM : xs + (size_t)(m - MP) * DM, XN + (size_t)m * DM, RS + m, lane);
            for (int i = gw * 64 + lane; i < 3 * M_ALL; i += NGW * 64) RS[M_ALL + i] = 0.f;
            }
#endif
        } else if (k == 0) {
#if PHM & 2
            pg8::Gemm g{XN, (const bf16*)(wl + WT_IN), M_ALL, INW, DM, DM, DM}; pg8::StaticOrder S; S.init(M_ALL, INW, G, bx);
            pg8::EpiBf16<0> E{PROJ, INW, RS + (size_t)(2 * l) * M_ALL};
            for (int rep = 0; rep < PROBE_REP_WIN; ++rep)
            pg8::gemm_phase<pg8::EpiBf16<0>, pg8::StaticOrder, true, true>((PG8_LAS unsigned char*)lds, g, S, E);
#endif
        } else if (k == 1) {
#if PHM & 4
            const float* kg = args.in[6] + l * 64; const float* cw = args.in[4] + l * 1536;
            for (int m = 2 * gw; m < M_ALL; m += 2 * NGW) k_rows(PROJ, m, kg, lane);
            for (int m = gw; m < M_ALL; m += NGW) {
                const int pos = m < MP ? (m & (SEQ_P - 1)) : ((m - MP) & (SEQ_S - 1)); const int S = m < MP ? SEQ_P : SEQ_S;
                conv_row(PROJ, MIX, m, pos, S, cw, lane);
            }
            for (int u = vcu; u < (M_ALL / 128) * 4; u += G) { const int chunk = u >> 2, hd = u & 3;
                sgu_unit(PROJ, MIX, chunk, hd, args.in[13] + ((size_t)l * 4 + hd) * 128 * 128, args.in[14] + (l * 4 + hd) * 128, args.in[12] + l * 128, (char*)lds); }
#endif
        } else if (k == 2) {
#if PHM & 8
            const float linit = (l == 0) ? 0.2f : 0.35550906759096934f;
            const float s1 = wave_sum(args.in[7][l * 64 + lane] * args.in[8][l * 64 + lane]), s2 = wave_sum(args.in[9][l * 64 + lane] * args.in[10][l * 64 + lane]);
            const float lam = __uint_as_float(__builtin_amdgcn_readfirstlane(__float_as_uint(expf(s1) - expf(s2) + linit)));
            const float gq = wave_max(fabsf(args.in[5][l * 64 + lane])), gk = wave_max(fabsf(args.in[6][l * 64 + lane]));
            const float negmb = __uint_as_float(__builtin_amdgcn_readfirstlane(__float_as_uint(-(C2 * 64.0f * gq * gk))));
            for (int rep = 0; rep < PROBE_REP_ATT; ++rep)
            for (int t = vcu; t < 2560; t += G) {
                int pair, qb, seq, seqrow0;
                if (t < 2048) { const int i = t >> 8, v = t & 255; const int idx = (v >> 5) * 256 + i * 32 + (v & 31); pair = idx >> 7; qb = idx & 127; seq = SEQ_S; seqrow0 = MP + (pair >> 3) * SEQ_S; }
                else { const int t2 = t - 2048, i = t2 >> 8, v = t2 & 255; pair = 2 * (v >> 5) + i; qb = v & 31; seq = SEQ_P; seqrow0 = (pair >> 3) * SEQ_P; }
                const int h = pair & 7; const size_t row0 = (size_t)seqrow0 + (size_t)qb * 128;
                if (negmb >= -64.0f)
                att::attn_unit<false>(PROJ + row0 * INW + OFF_Q + h * 128, PROJ + (size_t)seqrow0 * INW + OFF_K + h * 128, PROJ + (size_t)seqrow0 * INW + OFF_V + h * 128,
                               MIX + row0 * DM + MIX_B + h * 128, seq, (char*)lds, 0.f, lam, args.in[11] + l * 128, 1.0f - linit, args.in[5] + l * 64, qb * 128);
                else
                att::attn_unit<true>(PROJ + row0 * INW + OFF_Q + h * 128, PROJ + (size_t)seqrow0 * INW + OFF_K + h * 128, PROJ + (size_t)seqrow0 * INW + OFF_V + h * 128,
                               MIX + row0 * DM + MIX_B + h * 128, seq, (char*)lds, negmb, lam, args.in[11] + l * 128, 1.0f - linit, args.in[5] + l * 64, qb * 128);
            }
#endif
        } else if (k == 3 || k == 5) {
#if PHM & 16
            pg8::Gemm g; if (k == 3) g = pg8::Gemm{MIX, (const bf16*)(wl + WT_OUT), M_ALL, DM, DM, DM, DM}; else g = pg8::Gemm{HB, (const bf16*)(wl + WT_DN), M_ALL, DM, DFF, LDH, LDH};
            pg8::StaticOrder S; S.init(M_ALL, DM, G, bx);
            pg8::EpiResF32 E;
            if (k == 3 && l == 0) E = pg8::EpiResF32{xp, xs, MP / 256, nullptr, nullptr, DM, XN, DM, RS + (size_t)1 * M_ALL};
            else if (k == 3) E = pg8::EpiResF32{nullptr, nullptr, 0, XN, nullptr, DM, XN, DM, RS + (size_t)3 * M_ALL};
            else if (l == 0) E = pg8::EpiResF32{nullptr, nullptr, 0, XN, nullptr, DM, XN, DM, RS + (size_t)2 * M_ALL};
            else E = pg8::EpiResF32{nullptr, nullptr, 0, XN, out, DM, nullptr, DM, nullptr};
            pg8::gemm_phase<pg8::EpiResF32, pg8::StaticOrder, true, true>((PG8_LAS unsigned char*)lds, g, S, E);
#endif
        } else {
#if PHM & 64
            pg8::Gemm g{XN, (const bf16*)(wl + WT_UP), M_ALL, DFF, DM, DM, DM}; pg8::StaticOrder S; S.init(M_ALL, DFF, G, bx);
            pg8::EpiBf16<2> E{HB, LDH, RS + (size_t)(2 * l + 1) * M_ALL};
            for (int rep = 0; rep < PROBE_REP_UP; ++rep)
            pg8::gemm_phase<pg8::EpiBf16<2>, pg8::StaticOrder, true, true>((PG8_LAS unsigned char*)lds, g, S, E);
#endif
        }
        if (ph + 1 < args.ph_hi) { if (ph == args.ph_lo) grid.sync(); else xcd_barrier(bar); }
    }
}

extern "C" void kernel_launch(void* const* d_in, const int* in_sizes, int n_in, void* d_out, int out_size, void* d_ws, size_t ws_size, hipStream_t stream) {
    static int grid = 0;
    if (grid == 0) {
        if (n_in != 19 || out_size != M_ALL * DM || ws_size < WS_END) { fprintf(stderr, "kernel_launch: unexpected shapes: n_in %d out %d ws %zu (need %zu)\n", n_in, out_size, ws_size, (size_t)WS_END); grid = -1; return; }
        int dev = 0, cus = 0, per_cu = 0;
        if (hipGetDevice(&dev) != hipSuccess || hipDeviceGetAttribute(&cus, hipDeviceAttributeMultiprocessorCount, dev) != hipSuccess) { fprintf(stderr, "kernel_launch: device query failed\n"); grid = -1; return; }
        if (hipFuncSetAttribute((const void*)mk_fwd, hipFuncAttributeMaxDynamicSharedMemorySize, LDS_BYTES) != hipSuccess) { fprintf(stderr, "kernel_launch: hipFuncSetAttribute failed\n"); grid = -1; return; }
        if (hipOccupancyMaxActiveBlocksPerMultiprocessor(&per_cu, (const void*)mk_fwd, NWAVES * 64, LDS_BYTES) != hipSuccess || per_cu < 1) { fprintf(stderr, "kernel_launch: occupancy query gave %d\n", per_cu); per_cu = 1; }
        (void)hipGetLastError();
        grid = cus * 1;
        fprintf(stderr, "kernel_launch: grid %d (cus %d, per_cu %d)\n", grid, cus, per_cu);
    }
    if (grid < 0) return;
    if (hipMemsetAsync(d_ws, 0, 65536, stream) != hipSuccess) { fprintf(stderr, "kernel_launch: memset failed\n"); return; }
    Args a{};
    for (int i = 0; i < 19; ++i) a.in[i] = (const float*)d_in[i];
    a.out = (float*)d_out; a.ws = (unsigned char*)d_ws;
#if MK_SINGLE
    a.ph_lo = 0; a.ph_hi = N_PHASES;
    { void* kargs[] = {&a}; hipError_t e = hipLaunchCooperativeKernel((const void*)mk_fwd, dim3(grid), dim3(NWAVES * 64), kargs, LDS_BYTES, stream);
      if (e != hipSuccess) fprintf(stderr, "kernel_launch: cooperative launch failed: %s\n", hipGetErrorString(e)); }
#else
    for (int ph = 0; ph < N_PHASES; ++ph) { a.ph_lo = ph; a.ph_hi = ph + 1; void* kargs[] = {&a};
        hipError_t e = hipLaunchCooperativeKernel((const void*)mk_fwd, dim3(grid), dim3(NWAVES * 64), kargs, LDS_BYTES, stream);
        if (e != hipSuccess) { fprintf(stderr, "kernel_launch: cooperative launch %d failed: %s\n", ph, hipGetErrorString(e)); break; } }
#endif
}
```
